# Optimizing an MI355X kernel written in HIP

```python
import jax, jax.numpy as jnp
from jax import lax
import numpy as np

D_MODEL = 1024
BATCH = 4
SEQ = 4096
DEPTH = 4

CHUNK = 64
D_MIX = D_MODEL
HEAD_DIM = 64
RWKV_DIM = D_MIX // 4
RWKV_HEADS = RWKV_DIM // HEAD_DIM
RWKV_W_LORA = 64
RWKV_A_LORA = 64
RWKV_G_LORA = 128
RWKV_GN_EPS = 64e-5
POOL_DIM = D_MIX // 4
POOL_WINDOWS = (2, 4, 8, 16)
POOL_GROUP = POOL_DIM // len(POOL_WINDOWS)
FOX_DIM = D_MIX - RWKV_DIM - POOL_DIM
FOX_HEADS = FOX_DIM // HEAD_DIM
QUERY_BLOCK = 128
N_EXPERTS = 32
TOP_K = 4
D_FF = D_MODEL
SWIGLU_LIMIT = 7.0
SWIGLU_ALPHA = 1.702
EXPERT_BLOCK = 128
NORM_EPS = 1e-6
RWKV_IN = 3 * RWKV_DIM + RWKV_W_LORA + RWKV_A_LORA + RWKV_G_LORA
FOX_IN = 3 * FOX_DIM + FOX_HEADS
P_IN = RWKV_IN + POOL_DIM + FOX_IN

kernel_name = "hybrid_rwkv7_pool_fox_moe_adaln"


def _f32(t):
    return t.astype(jnp.float32)


def rms_norm(x, g):
    xf = _f32(x)
    y = xf * lax.rsqrt(jnp.mean(xf * xf, axis=-1, keepdims=True) + NORM_EPS)
    return (y * _f32(g)).astype(x.dtype)


def rwkv7_mixer(z, mu, w0, w_up, a0, a_up, g_up, k_k, k_a, r_k, ln_w, ln_b):
    B, S, _ = z.shape
    H, N = RWKV_HEADS, HEAD_DIM
    zf = _f32(z)
    prev = jnp.pad(zf, ((0, 0), (1, 0), (0, 0)))[:, :S]
    zf = zf + (prev - zf) * _f32(mu)
    cuts = [RWKV_DIM, 2 * RWKV_DIM, 3 * RWKV_DIM, 3 * RWKV_DIM + RWKV_W_LORA,
            3 * RWKV_DIM + RWKV_W_LORA + RWKV_A_LORA]
    r, k, v, wd, ad, gd = jnp.split(zf, cuts, axis=-1)
    w_log = -jax.nn.softplus(-(_f32(w0) + jnp.tanh(wd) @ _f32(w_up))) - 0.5
    decay = jnp.exp(-jnp.exp(w_log))
    a = jax.nn.sigmoid(_f32(a0) + ad @ _f32(a_up))
    g = jax.nn.sigmoid(gd) @ _f32(g_up)
    heads = lambda t: t.reshape(B, S, H, N)
    kk = heads(k * _f32(k_k))
    kk = kk / jnp.maximum(jnp.sqrt(jnp.sum(kk * kk, axis=-1, keepdims=True)), 1e-12)
    k = k * (1.0 + (a - 1.0) * _f32(k_a))
    r_h, k_h, v_h, w_h, a_h = heads(r), heads(k), heads(v), heads(decay), heads(a)

    def step(state, inp):
        r_t, w_t, k_t, v_t, kk_t, a_t = inp
        sa = jnp.einsum('bhvk,bhk->bhv', state, -kk_t)
        state = (state * w_t[:, :, None, :]
                 + sa[..., None] * (kk_t * a_t)[:, :, None, :]
                 + v_t[..., None] * k_t[:, :, None, :])
        return state, jnp.einsum('bhvk,bhk->bhv', state, r_t)

    xs = tuple(jnp.moveaxis(t, 1, 0) for t in (r_h, w_h, k_h, v_h, kk, a_h))
    s0 = jnp.zeros((B, H, N, N), jnp.float32)
    _, y = lax.scan(step, s0, xs)
    y = jnp.moveaxis(y, 0, 1)
    mean = jnp.mean(y, axis=-1, keepdims=True)
    var = jnp.mean(jnp.square(y - mean), axis=-1, keepdims=True)
    y = (y - mean) * lax.rsqrt(var + RWKV_GN_EPS) * _f32(ln_w).reshape(H, N) + _f32(ln_b).reshape(H, N)
    y = y + jnp.sum(r_h * k_h * _f32(r_k), axis=-1, keepdims=True) * v_h
    return (y.reshape(B, S, RWKV_DIM) * g).astype(z.dtype)


def pool_mixer(z, w_pool, scale):
    B, S, _ = z.shape
    zg = _f32(z).reshape(B, S, len(POOL_WINDOWS), POOL_GROUP)
    cs = jnp.cumsum(zg, axis=1)
    count = jnp.arange(1, S + 1, dtype=jnp.float32)
    outs = []
    for gi, w in enumerate(POOL_WINDOWS):
        c_g = cs[:, :, gi]
        lagged = jnp.pad(c_g, ((0, 0), (w, 0), (0, 0)))[:, :S]
        mean = (c_g - lagged) / jnp.minimum(count, w)[None, :, None]
        outs.append(mean - zg[:, :, gi])
    pooled = jnp.stack(outs, axis=2)
    y = jnp.einsum('bsgc,gcd->bsgd', pooled, _f32(w_pool)).reshape(B, S, POOL_DIM) * _f32(scale)
    return y.astype(z.dtype)


def fox_mixer(z, b_f):
    B, S, _ = z.shape
    H, Dh = FOX_HEADS, HEAD_DIM
    to_heads = lambda t: t.reshape(B, S, H, Dh).transpose(0, 2, 1, 3)
    q = to_heads(z[..., :FOX_DIM])
    k = to_heads(z[..., FOX_DIM:2 * FOX_DIM])
    v = to_heads(z[..., 2 * FOX_DIM:3 * FOX_DIM])
    log_f = jax.nn.log_sigmoid(_f32(z[..., 3 * FOX_DIM:]) + _f32(b_f))
    cum = jnp.cumsum(log_f, axis=1).transpose(0, 2, 1)
    nq = S // QUERY_BLOCK
    q_blocks = q.reshape(B, H, nq, QUERY_BLOCK, Dh).transpose(2, 0, 1, 3, 4)
    c_blocks = cum.reshape(B, H, nq, QUERY_BLOCK).transpose(2, 0, 1, 3)
    key_pos = jnp.arange(S)
    sm_scale = HEAD_DIM ** -0.5

    def block(args):
        q_blk, c_blk, i = args
        s = (_f32(jnp.einsum('bhqd,bhkd->bhqk', q_blk, k)) * sm_scale
             + (c_blk[..., None] - cum[:, :, None, :]))
        q_pos = i * QUERY_BLOCK + jnp.arange(QUERY_BLOCK)
        s = jnp.where(key_pos[None, :] <= q_pos[:, None], s, -jnp.inf)
        p = jax.nn.softmax(s, axis=-1)
        return jnp.einsum('bhqk,bhkd->bhqd', p.astype(v.dtype), v)

    o = lax.map(block, (q_blocks, c_blocks, jnp.arange(nq)))
    return o.transpose(1, 0, 3, 2, 4).reshape(B, S, FOX_DIM).astype(z.dtype)


def moe_ffn(h, router_w, router_b, w_gu, b_gu, w_down, b_down):
    B, S, D = h.shape
    N = B * S
    NK = N * TOP_K
    xf = h.reshape(N, D)
    logits = _f32(xf @ router_w + router_b)
    top_v, top_i = lax.top_k(logits, TOP_K)
    gates = jax.nn.softmax(top_v, axis=-1)
    e_flat = top_i.reshape(NK).astype(jnp.int32)
    g_flat = gates.reshape(NK)
    order = jnp.argsort(e_flat)
    se = e_flat[order]
    stok = (order // TOP_K).astype(jnp.int32)
    sg = g_flat[order]
    counts = jnp.bincount(e_flat, length=N_EXPERTS).astype(jnp.int32)
    padded = (counts + EXPERT_BLOCK - 1) // EXPERT_BLOCK * EXPERT_BLOCK
    pend = jnp.cumsum(padded)
    pstart = pend - padded
    gstart = jnp.cumsum(counts) - counts
    dest = pstart[se] + jnp.arange(NK, dtype=jnp.int32) - gstart[se]
    nb = -(-(NK + N_EXPERTS * (EXPERT_BLOCK - 1)) // EXPERT_BLOCK)
    rows = nb * EXPERT_BLOCK
    row_tok = jnp.zeros((rows,), jnp.int32).at[dest].set(stok)
    block_e = jnp.minimum(
        jnp.searchsorted(pend, jnp.arange(nb, dtype=jnp.int32) * EXPERT_BLOCK, side='right'),
        N_EXPERTS - 1).astype(jnp.int32)
    xb = xf[row_tok].reshape(nb, EXPERT_BLOCK, D)

    def expert_block(args):
        x_blk, e = args
        gu = x_blk @ w_gu[e] + b_gu[e]
        gate = jnp.minimum(gu[:, :D_FF], SWIGLU_LIMIT)
        up = jnp.clip(gu[:, D_FF:], -SWIGLU_LIMIT, SWIGLU_LIMIT)
        act = (up + 1.0) * (gate * jax.nn.sigmoid(SWIGLU_ALPHA * gate))
        return act @ w_down[e] + b_down[e]

    yb = lax.map(expert_block, (xb, block_e)).reshape(rows, D)
    y = jnp.zeros((N, D), h.dtype).at[stok].add(yb[dest] * sg[:, None].astype(h.dtype))
    return y.reshape(B, S, D)


def setup_inputs(seed: int = 0) -> dict:
    key = jax.random.key(seed)
    ks = iter(jax.random.split(key, 40))
    nrm = lambda shape, s: jax.random.normal(next(ks), shape, jnp.float32) * s
    L, D, E = DEPTH, D_MODEL, N_EXPERTS
    return {
        "x": nrm((BATCH, SEQ, D), 1.0),
        "c": nrm((BATCH, D), 1.0),
        "ada_w": nrm((L, D, 6 * D), 0.5 * D ** -0.5),
        "ada_b": nrm((L, 6 * D), 0.02),
        "norm1": 1.0 + nrm((L, D), 0.05),
        "w_in": nrm((L, D, P_IN), D ** -0.5),
        "w_out": nrm((L, D_MIX, D), D_MIX ** -0.5),
        "rwkv_mu": 0.5 + nrm((L, RWKV_IN), 0.1),
        "rwkv_w0": -2.5 + nrm((L, RWKV_DIM), 1.0),
        "rwkv_w_up": nrm((L, RWKV_W_LORA, RWKV_DIM), 0.5 * RWKV_W_LORA ** -0.5),
        "rwkv_a0": nrm((L, RWKV_DIM), 0.1),
        "rwkv_a_up": nrm((L, RWKV_A_LORA, RWKV_DIM), 0.5 * RWKV_A_LORA ** -0.5),
        "rwkv_g_up": nrm((L, RWKV_G_LORA, RWKV_DIM), RWKV_G_LORA ** -0.5),
        "rwkv_k_k": 0.85 + nrm((L, RWKV_DIM), 0.05),
        "rwkv_k_a": 1.0 + nrm((L, RWKV_DIM), 0.05),
        "rwkv_r_k": nrm((L, RWKV_HEADS, HEAD_DIM), 0.1),
        "rwkv_ln_w": 1.0 + nrm((L, RWKV_DIM), 0.05),
        "rwkv_ln_b": nrm((L, RWKV_DIM), 0.02),
        "pool_w": nrm((L, len(POOL_WINDOWS), POOL_GROUP, POOL_GROUP), POOL_GROUP ** -0.5),
        "pool_scale": 1.0 + nrm((L, POOL_DIM), 0.1),
        "fox_b_f": 2.0 + nrm((L, FOX_HEADS), 1.0),
        "norm2": 1.0 + nrm((L, D), 0.05),
        "router_w": nrm((L, D, E), D ** -0.5),
        "router_b": nrm((L, E), 0.01),
        "moe_w_gu": nrm((L, E, D, 2 * D_FF), D ** -0.5),
        "moe_b_gu": nrm((L, E, 2 * D_FF), 0.01),
        "moe_w_down": nrm((L, E, D_FF, D), D_FF ** -0.5),
        "moe_b_down": nrm((L, E, D), 0.01),
        "norm_f": 1.0 + nrm((D,), 0.05),
    }


def reference(x, c, ada_w, ada_b, norm1, w_in, w_out, rwkv_mu, rwkv_w0, rwkv_w_up, rwkv_a0,
              rwkv_a_up, rwkv_g_up, rwkv_k_k, rwkv_k_a, rwkv_r_k, rwkv_ln_w, rwkv_ln_b,
              pool_w, pool_scale, fox_b_f, norm2, router_w, router_b, moe_w_gu, moe_b_gu,
              moe_w_down, moe_b_down, norm_f):
    cond = jax.nn.silu(c)
    for l in range(DEPTH):
        mod = (cond @ ada_w[l] + ada_b[l])[:, None, :]
        sh1, sc1, g1, sh2, sc2, g2 = jnp.split(mod, 6, axis=-1)
        h = rms_norm(x, norm1[l]) * (1.0 + sc1) + sh1
        zp = h @ w_in[l]
        z_rwkv = zp[..., :RWKV_IN]
        z_pool = zp[..., RWKV_IN:RWKV_IN + POOL_DIM]
        z_fox = zp[..., RWKV_IN + POOL_DIM:]
        y_rwkv = rwkv7_mixer(z_rwkv, rwkv_mu[l], rwkv_w0[l], rwkv_w_up[l], rwkv_a0[l], rwkv_a_up[l],
                             rwkv_g_up[l], rwkv_k_k[l], rwkv_k_a[l], rwkv_r_k[l], rwkv_ln_w[l],
                             rwkv_ln_b[l])
        y_pool = pool_mixer(z_pool, pool_w[l], pool_scale[l])
        y_fox = fox_mixer(z_fox, fox_b_f[l])
        mixed = jnp.concatenate([y_rwkv, y_pool, y_fox], axis=-1)
        x = x + g1 * (mixed @ w_out[l])
        h = rms_norm(x, norm2[l]) * (1.0 + sc2) + sh2
        x = x + g2 * moe_ffn(h, router_w[l], router_b[l], moe_w_gu[l], moe_b_gu[l],
                             moe_w_down[l], moe_b_down[l])
    return rms_norm(x, norm_f)
```

```cpp
#include <hip/hip_runtime.h>
#include <cstdio>
#include <cstdint>
#include <cmath>

#ifndef MK_PER_PHASE
#define MK_PER_PHASE 0
#endif

#ifndef CHUNKED_SCAN
#define CHUNKED_SCAN 1
#endif
#ifndef PROBE_DUP
#define PROBE_DUP 0
#endif
#define GAS __attribute__((address_space(1)))
#define LAS __attribute__((address_space(3)))
typedef unsigned short bf16_t;
typedef short bf16x8 __attribute__((ext_vector_type(8)));
typedef short s16x4 __attribute__((ext_vector_type(4)));
typedef float f32x2 __attribute__((ext_vector_type(2)));
typedef float f32x4 __attribute__((ext_vector_type(4)));
typedef float f32x16 __attribute__((ext_vector_type(16)));
typedef unsigned u32x2 __attribute__((ext_vector_type(2)));
typedef unsigned u32x4 __attribute__((ext_vector_type(4)));
typedef GAS unsigned gu32;


constexpr int NB = 4, SEQ = 4096, DM = 1024, NL = 4, NTOK = NB * SEQ;
constexpr int PIN = 2824, NPROJ = 2816;
constexpr int NE = 32, TOPK = 4;
constexpr int NWAVES = 8, NTHR = 512;
constexpr float LOG2E = 1.4426950408889634f;
constexpr float QSCALE = 0.125f * LOG2E;

constexpr size_t MiB = (size_t)1 << 20;
constexpr size_t WS_CTL = 0, CTL_ZERO_BYTES = 1 * MiB;
constexpr size_t WS_MOD = 1 * MiB;
constexpr size_t WS_FLOG = 2 * MiB;
constexpr size_t WS_BIAS = 3 * MiB;
constexpr size_t WS_ALORA = 4 * MiB;
constexpr size_t WS_GATE = 12 * MiB;
constexpr size_t WS_LIST = 13 * MiB;
constexpr size_t WS_WIN = 16 * MiB;
constexpr size_t WS_LORA = 38 * MiB;
constexpr size_t WS_WOUT = 40 * MiB;
constexpr size_t WS_WGU = 48 * MiB;
constexpr size_t WS_WDN = 560 * MiB;
constexpr size_t WS_X = 816 * MiB;
constexpr size_t WS_H = 880 * MiB;
constexpr size_t WS_ZR = 912 * MiB;
constexpr size_t WS_ZP = 976 * MiB;
constexpr size_t WS_Q = 992 * MiB, WS_K = 1008 * MiB, WS_V = 1024 * MiB;
constexpr size_t WS_SCAN = 1040 * MiB;
constexpr size_t WS_G = 1136 * MiB;
constexpr size_t WS_YRAW = 1152 * MiB;
constexpr size_t WS_MIXED = 1168 * MiB;
constexpr size_t WS_ACT = 1200 * MiB;
constexpr size_t WS_YSLOT = 1344 * MiB;
constexpr size_t WS_CPG = 1472 * MiB;
constexpr size_t WS_CPSI = 1496 * MiB;
constexpr size_t WS_CY0 = 1504 * MiB;
constexpr size_t WS_CS = 1520 * MiB;
constexpr size_t WS_END = 1528 * MiB;

constexpr int CW_TMO = 0, CW_CODE = 1;
constexpr int CW_BAR = 4096;
constexpr int CW_CNT = 16384;
constexpr int CW_QUEUE = 40960;

constexpr int RING_BYTES = 131072;
constexpr int LDS_BYTES = 147456;
constexpr int LDSCTL_OFF = 139264;
constexpr int MISC_OFF = LDSCTL_OFF;
constexpr int PTR_OFF = LDSCTL_OFF + 256;
constexpr int TAB_OFF = LDSCTL_OFF + 512;
constexpr int ROWTAB_OFF = LDSCTL_OFF + 4096;
constexpr int PCV_OFF = LDSCTL_OFF + 6144;

#define RLX_AGENT __ATOMIC_RELAXED, __HIP_MEMORY_SCOPE_AGENT
#define LDS_WAIT() asm volatile("s_waitcnt lgkmcnt(0)" ::: "memory")
#define VM_WAIT() asm volatile("s_waitcnt vmcnt(0)" ::: "memory")

__device__ __forceinline__ unsigned f2bf(float f) { unsigned u = __builtin_bit_cast(unsigned, f); return (u + 0x7fffu + ((u >> 16) & 1u)) >> 16; }
__device__ __forceinline__ unsigned pk2(float lo, float hi) { return f2bf(lo) | (f2bf(hi) << 16); }
typedef __bf16 bf16x2_t __attribute__((ext_vector_type(2)));
__device__ __forceinline__ unsigned cvtpk(float lo, float hi) { const f32x2 v = {lo, hi}; const bf16x2_t b = __builtin_convertvector(v, bf16x2_t); return __builtin_bit_cast(unsigned, b); }
__device__ __forceinline__ float bf2f(unsigned short b) { return __builtin_bit_cast(float, (unsigned)b << 16); }
__device__ __forceinline__ float dpp_f(float v, const int ctrl_sel) {
    const int iv = __builtin_bit_cast(int, v); int r;
    switch (ctrl_sel) { case 0: r = __builtin_amdgcn_update_dpp(0, iv, 0xB1, 0xf, 0xf, true); break; case 1: r = __builtin_amdgcn_update_dpp(0, iv, 0x4E, 0xf, 0xf, true); break;
                        case 2: r = __builtin_amdgcn_update_dpp(0, iv, 0x141, 0xf, 0xf, true); break; default: r = __builtin_amdgcn_update_dpp(0, iv, 0x140, 0xf, 0xf, true); break; }
    return __builtin_bit_cast(float, r);
}
__device__ __forceinline__ float red16(float v) { v += dpp_f(v, 0); v += dpp_f(v, 1); v += dpp_f(v, 2); v += dpp_f(v, 3); return v; }
__device__ __forceinline__ float fma_s(float a, float b, float c) { float d; asm("v_fma_f32 %0, %1, %2, %3" : "=v"(d) : "v"(a), "v"(b), "v"(c)); return d; }
__device__ __forceinline__ float fnma_s(float a, float b, float c) { float d; asm("v_fma_f32 %0, -%1, %2, %3" : "=v"(d) : "v"(a), "v"(b), "v"(c)); return d; }
__device__ __forceinline__ float mul_s(float a, float b) { float d; asm("v_mul_f32_e32 %0, %1, %2" : "=v"(d) : "v"(a), "v"(b)); return d; }
__device__ __forceinline__ float add_s(float a, float b) { float d; asm("v_add_f32_e32 %0, %1, %2" : "=v"(d) : "v"(a), "v"(b)); return d; }
__device__ __forceinline__ void red16_pair(float& a, float& b) {
    asm volatile("s_nop 1\n\t"
                 "v_add_f32_dpp %0, %0, %0 quad_perm:[1,0,3,2] row_mask:0xf bank_mask:0xf bound_ctrl:1\n\t"
                 "v_add_f32_dpp %1, %1, %1 quad_perm:[1,0,3,2] row_mask:0xf bank_mask:0xf bound_ctrl:1\n\t"
                 "s_nop 0\n\t"
                 "v_add_f32_dpp %0, %0, %0 quad_perm:[2,3,0,1] row_mask:0xf bank_mask:0xf bound_ctrl:1\n\t"
                 "v_add_f32_dpp %1, %1, %1 quad_perm:[2,3,0,1] row_mask:0xf bank_mask:0xf bound_ctrl:1\n\t"
                 "s_nop 0\n\t"
                 "v_add_f32_dpp %0, %0, %0 row_half_mirror row_mask:0xf bank_mask:0xf bound_ctrl:1\n\t"
                 "v_add_f32_dpp %1, %1, %1 row_half_mirror row_mask:0xf bank_mask:0xf bound_ctrl:1\n\t"
                 "s_nop 0\n\t"
                 "v_add_f32_dpp %0, %0, %0 row_mirror row_mask:0xf bank_mask:0xf bound_ctrl:1\n\t"
                 "v_add_f32_dpp %1, %1, %1 row_mirror row_mask:0xf bank_mask:0xf bound_ctrl:1\n\t"
                 "s_nop 0"
                 : "+v"(a), "+v"(b));
}
__device__ __forceinline__ float wave_sum(float v) {
    v = red16(v);
    { const auto rr = __builtin_amdgcn_permlane16_swap(__float_as_uint(v), __float_as_uint(v), false, false); v = __uint_as_float(rr[0]) + __uint_as_float(rr[1]); }
    { const auto rr = __builtin_amdgcn_permlane32_swap(__float_as_uint(v), __float_as_uint(v), false, false); v = __uint_as_float(rr[0]) + __uint_as_float(rr[1]); }
    return v;
}
__device__ __forceinline__ float wave_max(float v) {
    v = fmaxf(v, dpp_f(v, 0)); v = fmaxf(v, dpp_f(v, 1)); v = fmaxf(v, dpp_f(v, 2)); v = fmaxf(v, dpp_f(v, 3));
    { const auto rr = __builtin_amdgcn_permlane16_swap(__float_as_uint(v), __float_as_uint(v), false, false); v = fmaxf(__uint_as_float(rr[0]), __uint_as_float(rr[1])); }
    { const auto rr = __builtin_amdgcn_permlane32_swap(__float_as_uint(v), __float_as_uint(v), false, false); v = fmaxf(__uint_as_float(rr[0]), __uint_as_float(rr[1])); }
    return v;
}
__device__ __forceinline__ float sigmoidf_(float x) { return 1.f / (1.f + __expf(-x)); }
__device__ __forceinline__ float softplusf_(float u) { return fmaxf(u, 0.f) + log1pf(__expf(-fabsf(u))); }
__device__ __forceinline__ float softplus_fast(float u) { return fmaxf(u, 0.f) + __logf(1.f + __expf(-fabsf(u))); }

#define XB_TMO      128
#define XB_XCNT(j)  (256  + 64 * (j))
#define XB_XSUB(j)  (1280 + 64 * (j))
#define XB_XGEN(j)  (2304 + 64 * (j))
#define XB_TOP      3328
#define XB_TOPGEN   3392
#define XCD_BAR_WORDS 3456
#define XB_SPIN_CAP (1u << 18)
__device__ __forceinline__ unsigned xb_ld(unsigned* p)              { return __hip_atomic_load(p, __ATOMIC_RELAXED, __HIP_MEMORY_SCOPE_AGENT); }
__device__ __forceinline__ unsigned xb_add(unsigned* p, unsigned v) { return __hip_atomic_fetch_add(p, v, __ATOMIC_RELAXED, __HIP_MEMORY_SCOPE_AGENT); }
__device__ __forceinline__ unsigned xb_xcc_id() { return (unsigned)__builtin_amdgcn_s_getreg((3 << 11) | 20) & 0xFu; }
#define XB_SPIN(cond, bar) do { unsigned _sp = 0; while (cond) { __builtin_amdgcn_s_sleep(1); \
    if ((++_sp & 255u) == 0u) { if (xb_ld(&(bar)[XB_TMO])) break; if (_sp > XB_SPIN_CAP) { atomicAdd(&(bar)[XB_TMO], 1u); break; } } } } while (0)
struct XcdBarrier { unsigned* bar; unsigned x; volatile LAS unsigned* st; };
__device__ __forceinline__ XcdBarrier xcd_barrier_post(unsigned* bar, volatile LAS unsigned* st) {
    XcdBarrier b; b.bar = bar; b.x = xb_xcc_id(); b.st = st;
    if (threadIdx.x == 0) (void)xb_add(&bar[XB_XCNT(b.x)], 1u);
    return b;
}
__device__ __forceinline__ void xcd_barrier_complete(unsigned* bar, unsigned x, unsigned& nloc, unsigned& nx) {
    const unsigned G = gridDim.x * gridDim.y * gridDim.z;
    unsigned sum, cnt, mine, sp = 0u;
    for (;;) {
        sum = 0u; cnt = 0u; mine = 0u;
#pragma unroll
        for (unsigned j = 0; j < 16; ++j) { const unsigned c = xb_ld(&bar[XB_XCNT(j)]); sum += c; cnt += (c > 0u) ? 1u : 0u; mine = (j == x) ? c : mine; }
        if (sum == G) break;
        __builtin_amdgcn_s_sleep(1);
        if ((++sp & 255u) == 0u) { if (xb_ld(&bar[XB_TMO])) break; if (sp > XB_SPIN_CAP) { atomicAdd(&bar[XB_TMO], 1u); break; } }
    }
    nloc = mine > 0u ? mine : 1u; nx = cnt > 0u ? cnt : 1u;
}
__device__ __forceinline__ void xcd_barrier(const XcdBarrier& b) {
    asm volatile("s_waitcnt vmcnt(0)" ::: "memory");
    __syncthreads();
    if (threadIdx.x == 0) {
        unsigned* bar = b.bar;
        __builtin_amdgcn_s_waitcnt(0);
        unsigned nloc = b.st[0], nx = b.st[1];
        if (nloc == 0u) { xcd_barrier_complete(bar, b.x, nloc, nx); b.st[0] = nloc; b.st[1] = nx; }
        const unsigned old = xb_add(&bar[XB_XSUB(b.x)], 1u);
        const unsigned gen = old / nloc;
        if (old + 1u == (gen + 1u) * nloc) {
            __builtin_amdgcn_fence(__ATOMIC_RELEASE, "agent");
            asm volatile("s_waitcnt vmcnt(0)" ::: "memory");
            const unsigned og = xb_add(&bar[XB_TOP], 1u);
            const unsigned tg = og / nx;
            if (og + 1u == (tg + 1u) * nx) xb_add(&bar[XB_TOPGEN], 1u);
            else XB_SPIN(xb_ld(&bar[XB_TOPGEN]) == tg, bar);
            __builtin_amdgcn_fence(__ATOMIC_ACQUIRE, "agent");
            xb_add(&bar[XB_XGEN(b.x)], 1u);
            asm volatile("s_waitcnt vmcnt(0)" ::: "memory");
        } else {
            XB_SPIN(xb_ld(&bar[XB_XGEN(b.x)]) == gen, bar);
            __builtin_amdgcn_fence(__ATOMIC_ACQUIRE, "agent");
            asm volatile("s_waitcnt vmcnt(0)" ::: "memory");
        }
    }
    __syncthreads();
}

namespace pg8 {
constexpr int BM = 256, BK = 64, HALF = 128, HTB = HALF * BK * 2, STAGE_BYTES = 8 * HTB;
__device__ __forceinline__ int lds_byte(int r, int c) { const int st = (r >> 4) * 2 + (c >> 5), rr = r & 15, cc = c & 31, ob = rr * 64 + cc * 2; return st * 1024 + (ob ^ (((ob >> 9) & 1) << 5)); }
__device__ __forceinline__ void stage_rc(int b, int& R, int& C) { const int st = b / 1024, sb = b % 1024, swz = sb ^ (((sb >> 9) & 1) << 5); R = (st >> 1) * 16 + swz / 64; C = (st & 1) * 32 + (swz % 64) / 2; }
__device__ __forceinline__ int perm32(int rho) { const int n = rho >> 4, i = rho & 15; return 8 * (i >> 2) + 4 * n + (i & 3); }
struct Unit { int pm, pn, e; };
__device__ __forceinline__ unsigned cvt_pk_bf16(float lo, float hi) { unsigned r; asm volatile("v_cvt_pk_bf16_f32 %0, %1, %2" : "=v"(r) : "v"(lo), "v"(hi)); return r; }

template <bool GATHER, int K, class Prob, class Epi>
__device__ __forceinline__ void gemm_phase(LAS unsigned char* lds, LAS unsigned* rowtab  , const int tid, const Prob& S, const Epi& E) {
    const int wid = __builtin_amdgcn_readfirstlane(tid >> 6), lane = tid & 63, wr = wid >> 2, wc = wid & 3, fr = lane & 15, fq = lane >> 4;
    constexpr int nt = K / BK; static_assert(K % 128 == 0 && K >= 256 && (!GATHER || K == 1024), "K");
    unsigned voffA[2], voffB[2];
#pragma unroll
    for (int i = 0; i < 2; ++i) { int R, C; stage_rc(tid * 16 + i * 8192, R, C); const int Rb = (R & ~31) + perm32(R & 31); voffA[i] = (unsigned)(R * K + C) * 2u; voffB[i] = (unsigned)(Rb * K + C) * 2u; }
    constexpr size_t kstep = (size_t)(BK * 2);
    constexpr size_t hstep = (size_t)HALF * K * 2;
    const unsigned ldsw = (unsigned)wid * 1024u;
    const int aoff = lds_byte(wr * 64 + fr, fq * 8), boff = lds_byte(wc * 32 + fr, fq * 8);
#define PG8_SA(b, h) (((b) * 2 + (h)) * HTB)
#define PG8_SB(b, h) ((4 + (b) * 2 + (h)) * HTB)
#define PG8_STAGEB(bufoff, gbase) do { _Pragma("unroll") for (int _i = 0; _i < 2; ++_i) \
        __builtin_amdgcn_global_load_lds((const unsigned*)((const char*)(gbase) + voffB[_i]), (LAS unsigned*)(lds + (bufoff) + ldsw + _i * 8192), 16, 0, 0); } while (0)
#define PG8_STAGEA2(bufoff, gbase, o0, o1) do { \
        __builtin_amdgcn_global_load_lds((const unsigned*)((const char*)(gbase) + (o0)), (LAS unsigned*)(lds + (bufoff) + ldsw), 16, 0, 0); \
        __builtin_amdgcn_global_load_lds((const unsigned*)((const char*)(gbase) + (o1)), (LAS unsigned*)(lds + (bufoff) + ldsw + 8192), 16, 0, 0); } while (0)
#define PG8_STAGEA_C(bufoff, gbase, h) do { if constexpr (GATHER) PG8_STAGEA2(bufoff, gbase, oc[h][0], oc[h][1]); else PG8_STAGEA2(bufoff, (gbase) + (h) * hstep, voffA[0], voffA[1]); } while (0)
#define PG8_LDA(dst, b, h) do { _Pragma("unroll") for (int m = 0; m < 4; ++m) _Pragma("unroll") for (int k = 0; k < 2; ++k) dst[m][k] = *(const LAS bf16x8*)(lds + PG8_SA(b, h) + aoff + m * 2048 + k * 1024); } while (0)
#define PG8_LDB(dst, b, h) do { _Pragma("unroll") for (int n = 0; n < 2; ++n) _Pragma("unroll") for (int k = 0; k < 2; ++k) dst[n][k] = *(const LAS bf16x8*)(lds + PG8_SB(b, h) + boff + n * 2048 + k * 1024); } while (0)
#define PG8_MMA(ai, bj, At, Bt) do { __builtin_amdgcn_s_setprio(1); _Pragma("unroll") for (int m = 0; m < 4; ++m) _Pragma("unroll") for (int n = 0; n < 2; ++n) _Pragma("unroll") for (int k = 0; k < 2; ++k) \
        acc[ai][bj][m][n] = __builtin_amdgcn_mfma_f32_16x16x32_bf16(Bt[n][k], At[m][k], acc[ai][bj][m][n], 0, 0, 0); __builtin_amdgcn_s_setprio(0); } while (0)
#define PG8_WAIT_V(n) asm volatile("s_waitcnt vmcnt(" #n ")" ::: "memory")
#define PG8_WAIT_L(n) asm volatile("s_waitcnt lgkmcnt(" #n ")" ::: "memory")
#define PG8_BAR __builtin_amdgcn_s_barrier()
#define PG8_SCHED __builtin_amdgcn_sched_barrier(0)
    Unit cur, nxt; int ui = 0;
    if (!S.next(0, cur)) return;
    f32x4 acc[2][2][4][2];
#pragma unroll
    for (int a = 0; a < 2; ++a)
#pragma unroll
        for (int b = 0; b < 2; ++b)
#pragma unroll
            for (int m = 0; m < 4; ++m)
#pragma unroll
                for (int n = 0; n < 2; ++n) acc[a][b][m][n] = (f32x4){0.f, 0.f, 0.f, 0.f};
    bf16x8 At[4][2], B0[2][2], B1[2][2];
    const char* cA = S.a_ptr(cur); const char* cB = S.b_ptr(cur);
    unsigned oc[2][2];
    if constexpr (GATHER) {
#pragma unroll
        for (int h = 0; h < 2; ++h)
#pragma unroll
            for (int i = 0; i < 2; ++i) oc[h][i] = S.row_off(cur, h * 128 + (int)(voffA[i] >> 11)) + (voffA[i] & 2047u);
    }
    PG8_STAGEB(PG8_SB(0, 0), cB); PG8_STAGEB(PG8_SB(0, 1), cB + hstep); PG8_STAGEA_C(PG8_SA(0, 0), cA, 0); PG8_STAGEA_C(PG8_SA(0, 1), cA, 1);
    if (wr == 1) PG8_BAR;
    PG8_WAIT_V(2); PG8_BAR;
    PG8_STAGEB(PG8_SB(1, 0), cB + kstep); PG8_STAGEA_C(PG8_SA(1, 0), cA + kstep, 0); PG8_STAGEB(PG8_SB(1, 1), cB + hstep + kstep);
    PG8_WAIT_V(6); PG8_BAR;
    for (;;) {
        const bool has_next = S.next(ui + 1, nxt);
        const char* nA = cA; const char* nB = cB;
        if (has_next) { nA = S.a_ptr(nxt); nB = S.b_ptr(nxt); }
        if constexpr (GATHER) { if (has_next && tid < 256) rowtab[((ui + 1) & 1) * 256 + tid] = S.row_off(nxt, tid); }
#pragma nounroll
        for (int t = 0; t < nt; t += 2) {
            const bool last = (t == nt - 2);
            const char* a1 = cA + (size_t)(t + 1) * kstep;
            const char* a2 = last ? nA : cA + (size_t)(t + 2) * kstep; const char* b2 = last ? nB : cB + (size_t)(t + 2) * kstep;
            const char* a3 = a2 + kstep; const char* b3 = b2 + kstep;
            PG8_LDB(B0, 0, 0); PG8_LDB(B1, 0, 1); PG8_SCHED; PG8_LDA(At, 0, 0); PG8_STAGEA_C(PG8_SA(1, 1), a1, 1);
            if constexpr (GATHER) { if (last && has_next) {
#pragma unroll
                for (int h = 0; h < 2; ++h)
#pragma unroll
                    for (int i = 0; i < 2; ++i) oc[h][i] = rowtab[((ui + 1) & 1) * 256 + h * 128 + (int)(voffA[i] >> 11)] + (voffA[i] & 2047u); } }
            PG8_WAIT_V(8); PG8_WAIT_L(0); PG8_BAR; PG8_MMA(0, 0, At, B0); PG8_MMA(0, 1, At, B1); PG8_BAR; PG8_SCHED;
            PG8_LDA(At, 0, 1); PG8_STAGEB(PG8_SB(0, 0), b2); PG8_STAGEB(PG8_SB(0, 1), b2 + hstep); PG8_STAGEA_C(PG8_SA(0, 0), a2, 0);
            PG8_WAIT_V(8); PG8_WAIT_L(0); PG8_BAR; PG8_MMA(1, 0, At, B0); PG8_MMA(1, 1, At, B1); PG8_BAR; PG8_SCHED;
            PG8_LDB(B0, 1, 0); PG8_LDB(B1, 1, 1); PG8_SCHED; PG8_LDA(At, 1, 0); PG8_STAGEA_C(PG8_SA(0, 1), a2, 1);
            PG8_WAIT_V(8); PG8_WAIT_L(0); PG8_BAR; PG8_MMA(0, 0, At, B0); PG8_MMA(0, 1, At, B1); PG8_BAR; PG8_SCHED;
            PG8_LDA(At, 1, 1); PG8_STAGEB(PG8_SB(1, 0), b3); PG8_STAGEB(PG8_SB(1, 1), b3 + hstep); PG8_STAGEA_C(PG8_SA(1, 0), a3, 0);
            PG8_WAIT_V(8); PG8_WAIT_L(0); PG8_BAR; PG8_MMA(1, 0, At, B0); PG8_MMA(1, 1, At, B1); PG8_BAR; PG8_SCHED;
        }
        if (wr == 0) PG8_BAR;
        E(acc, cur, wr, wc, fr, fq);
        if (!has_next) break;
#pragma unroll
        for (int a = 0; a < 2; ++a)
#pragma unroll
            for (int b = 0; b < 2; ++b)
#pragma unroll
                for (int m = 0; m < 4; ++m)
#pragma unroll
                    for (int n = 0; n < 2; ++n) acc[a][b][m][n] = (f32x4){0.f, 0.f, 0.f, 0.f};
        cur = nxt; cA = nA; cB = nB; ++ui;
        if (wr == 1) PG8_BAR;
    }
    PG8_WAIT_V(0);
    PG8_BAR;
#undef PG8_SA
#undef PG8_SB
#undef PG8_STAGEA2
#undef PG8_STAGEA_C
#undef PG8_STAGEB
#undef PG8_LDA
#undef PG8_LDB
#undef PG8_MMA
#undef PG8_WAIT_V
#undef PG8_WAIT_L
#undef PG8_BAR
#undef PG8_SCHED
}
}

struct Frame {
    LAS unsigned char* lds;
    volatile LAS unsigned* MISC;
    int tid, lane, wave, vcu, G;
};
struct Args { const float* in[29]; float* out; unsigned char* ws; int ph_lo, ph_hi; };
__device__ __forceinline__ unsigned long long ldptr_raw(LAS unsigned char* lds, int i) {
    const unsigned long long v = *(const LAS unsigned long long*)(lds + PTR_OFF + 8 * i);
    const unsigned lo = __builtin_amdgcn_readfirstlane((unsigned)v), hi = __builtin_amdgcn_readfirstlane((unsigned)(v >> 32));
    return ((unsigned long long)hi << 32) | lo;
}
__device__ __forceinline__ void* ldptr(const Frame& F, int i) { return (void*)(GAS unsigned char*)ldptr_raw(F.lds, i); }
struct InTab { LAS unsigned char* lds; __device__ __forceinline__ const float* operator[](int i) const { return (const float*)(const GAS float*)ldptr_raw(lds, i); } };
__device__ __forceinline__ void refresh(Frame& F) { int t = F.tid; asm volatile("" : "+v"(t)); F.tid = t; F.lane = t & 63; F.wave = __builtin_amdgcn_readfirstlane(t >> 6); }


enum { I_X = 0, I_C, I_ADAW, I_ADAB, I_NORM1, I_WIN, I_WOUT, I_MU, I_W0, I_WUP, I_A0, I_AUP, I_GUP, I_KK, I_KA, I_RK, I_LNW, I_LNB, I_POOLW, I_POOLS, I_BF, I_NORM2, I_RW, I_RB, I_WGU, I_BGU, I_WDN, I_BDN, I_NORMF };

__device__ __forceinline__ void transpose_item(const float* W, int ldw, bf16_t* WT, int dst_row0, int k0, int n0, LAS float* scr, int lane) {
    float tmp[32];
#pragma unroll
    for (int i = 0; i < 32; ++i) { const int kk = 2 * i + (lane >> 5); tmp[i] = W[(size_t)(k0 + kk) * ldw + n0 + (lane & 31)]; }
#pragma unroll
    for (int i = 0; i < 32; ++i) { const int kk = 2 * i + (lane >> 5); scr[kk * 33 + (lane & 31)] = tmp[i]; }
    LDS_WAIT(); asm volatile("" ::: "memory");
    const int c = lane & 7;
#pragma unroll
    for (int j = 0; j < 4; ++j) { const int n = (lane >> 3) + 8 * j; const LAS float* s = scr + (8 * c) * 33 + n;
        u32x4 o; o.x = cvtpk(s[0 * 33], s[1 * 33]); o.y = cvtpk(s[2 * 33], s[3 * 33]); o.z = cvtpk(s[4 * 33], s[5 * 33]); o.w = cvtpk(s[6 * 33], s[7 * 33]);
        *(GAS u32x4*)(WT + (size_t)(dst_row0 + n) * 1024 + k0 + 8 * c) = o; }
    LDS_WAIT(); asm volatile("" ::: "memory");
}

__device__ __forceinline__ void convert_moe_batch(Frame& F, const InTab& in_, unsigned char* ws_, int l, int q);
__device__ __forceinline__ void phase_prologue(Frame& F) {
    refresh(F); unsigned char* ws_ = (unsigned char*)ldptr(F, 30); const InTab in_{F.lds}; gu32* ctl_ = (gu32*)ws_;

    if (blockIdx.x < 192) {
        LAS float* cond = (LAS float*)F.lds;
        LAS float* part = (LAS float*)(F.lds + 16384);
        const float* c = in_[I_C];
        for (int i = F.tid; i < 4096; i += NTHR) { const float v = c[i]; cond[i] = v / (1.f + __expf(-v)); }
        __syncthreads();
        const int l = blockIdx.x / 48, col0 = (blockIdx.x % 48) * 128;
        const float* W = in_[I_ADAW] + (size_t)l * 1024 * 6144 + col0 + 2 * F.lane;
        float a[4][2];
#pragma unroll
        for (int b = 0; b < 4; ++b) { a[b][0] = 0.f; a[b][1] = 0.f; }
        const int kb = F.wave * 128;
#pragma unroll 8
        for (int k = kb; k < kb + 128; ++k) {
            const f32x2 w = *(const f32x2*)(W + (size_t)k * 6144);
#pragma unroll
            for (int b = 0; b < 4; ++b) { const float cv = cond[b * 1024 + k]; a[b][0] += cv * w.x; a[b][1] += cv * w.y; }
        }
#pragma unroll
        for (int b = 0; b < 4; ++b) { part[(F.wave * 4 + b) * 128 + 2 * F.lane] = a[b][0]; part[(F.wave * 4 + b) * 128 + 2 * F.lane + 1] = a[b][1]; }
        __syncthreads();
        { const int b = F.tid >> 7, cc = F.tid & 127; float s = in_[I_ADAB][l * 6144 + col0 + cc];
#pragma unroll
          for (int w = 0; w < 8; ++w) s += part[(w * 4 + b) * 128 + cc];
          ((float*)(ws_ + WS_MOD))[(l * 4 + b) * 6144 + col0 + cc] = s; }
        __syncthreads();
    }
    {
        bf16_t* LT = (bf16_t*)(ws_ + WS_LORA);
        const float* wu = in_[I_WUP]; const float* au = in_[I_AUP]; const float* gu = in_[I_GUP];
        for (int idx = blockIdx.x * NTHR + F.tid; idx < NL * 768 * 256; idx += F.G * NTHR) {
            const int k = idx & 255, n = (idx >> 8) % 768, l = idx / (768 * 256);
            float v = 0.f;
            if (n < 256) { if (k < 64) v = wu[((size_t)l * 64 + k) * 256 + n]; }
            else if (n < 512) { if (k >= 64 && k < 128) v = au[((size_t)l * 64 + (k - 64)) * 256 + (n - 256)]; }
            else { if (k >= 128) v = gu[((size_t)l * 128 + (k - 128)) * 256 + (n - 512)]; }
            LT[idx] = (bf16_t)f2bf(v);
        }
    }
    LAS float* scr = (LAS float*)(F.lds + F.wave * 16384);
    const int gw = F.vcu * NWAVES + F.wave, NGW = F.G * NWAVES;
    constexpr int I_A = NL * 16 * 88, I_B = NL * 16 * 32;
    for (int it = gw; it < I_A + I_B; it += NGW) {
        int r = it;
        if (r < I_A) { const int l = r / (16 * 88), q = r % (16 * 88), kb = q / 88, nb = q % 88;
            transpose_item(in_[I_WIN] + (size_t)l * 1024 * PIN, PIN, (bf16_t*)(ws_ + WS_WIN) + (size_t)l * NPROJ * 1024, 32 * nb, 64 * kb, 32 * nb, scr, F.lane); continue; }
        r -= I_A;
        { const int l = r / (16 * 32), q = r % (16 * 32), kb = q / 32, nb = q % 32;
            transpose_item(in_[I_WOUT] + (size_t)l * 1024 * 1024, 1024, (bf16_t*)(ws_ + WS_WOUT) + (size_t)l * 1024 * 1024, 32 * nb, 64 * kb, 32 * nb, scr, F.lane); }
    }
}
__device__ __forceinline__ void convert_moe_batch(Frame& F, const InTab& in_, unsigned char* ws_, int l, int q) {
    LAS float* scr = (LAS float*)(F.lds + F.wave * 16384);
    for (int j = 0; j < 8; ++j) {
        int r = q * 64 + j * 8 + F.wave;
        if (r < NE * 16 * 64) { const int e = r / (16 * 64), qq = r % (16 * 64), kb = qq / 64, nb = qq % 64; const int n0 = 32 * nb; const int le = l * NE + e;
            const int dr = (n0 < 1024) ? ((n0 >> 7) * 256 + (n0 & 127)) : ((((n0 - 1024) >> 7) * 256) + 128 + ((n0 - 1024) & 127));
            transpose_item(in_[I_WGU] + (size_t)le * 1024 * 2048, 2048, (bf16_t*)(ws_ + WS_WGU) + (size_t)le * 2048 * 1024, dr, 64 * kb, n0, scr, F.lane); }
        else { r -= NE * 16 * 64; const int e = r / (16 * 32), qq = r % (16 * 32), kb = qq / 32, nb = qq % 32; const int le = l * NE + e;
            transpose_item(in_[I_WDN] + (size_t)le * 1024 * 1024, 1024, (bf16_t*)(ws_ + WS_WDN) + (size_t)le * 1024 * 1024, 32 * nb, 64 * kb, 32 * nb, scr, F.lane); }
    }
}

__device__ __forceinline__ void phase_combine(Frame& F, int l, float yscale = 1.f) {
    refresh(F); unsigned char* ws_ = (unsigned char*)ldptr(F, 30); const InTab in_{F.lds}; gu32* ctl_ = (gu32*)ws_;

    const bool has_next = (l + 1 < NL);
    LAS float* Wf = (LAS float*)F.lds;
    if (has_next) {
        const float* W = in_[I_WIN] + (size_t)(l + 1) * 1024 * PIN + NPROJ;
        f32x4 t4[4];
#pragma unroll
        for (int u = 0; u < 4; ++u) { const int i = F.tid + NTHR * u; t4[u] = *(const f32x4*)(W + (size_t)(i >> 1) * PIN + 4 * (i & 1)); }
#pragma unroll
        for (int u = 0; u < 4; ++u) { const int i = F.tid + NTHR * u; *(LAS f32x4*)(Wf + 4 * i) = t4[u]; }
    }
    __syncthreads();
    const int gw = F.vcu * NWAVES + F.wave, NGW = F.G * NWAVES;
    const float* xin = (l < 0) ? in_[I_X] : (const float*)(ws_ + WS_X);
    float* X = (float*)(ws_ + WS_X);
    const float* MOD = (const float*)(ws_ + WS_MOD);
    const bf16_t* YS = (const bf16_t*)(ws_ + WS_YSLOT);
    f32x4 xn[4]; u32x2 yn[4][4];
#define CMB_LOAD(mm) do { _Pragma("unroll") for (int j = 0; j < 4; ++j) xn[j] = *(const f32x4*)(xin + (size_t)(mm) * 1024 + 4 * F.lane + 256 * j); \
        if (l >= 0) { _Pragma("unroll") for (int k = 0; k < 4; ++k) _Pragma("unroll") for (int j = 0; j < 4; ++j) yn[k][j] = *(const u32x2*)(YS + ((size_t)(mm) * 4 + k) * 1024 + 4 * F.lane + 256 * j); } } while (0)
    if (gw < NTOK) CMB_LOAD(gw);
    for (int m = gw; m < NTOK; m += NGW) {
        const int b = m >> 12;
        f32x4 v[4]; u32x2 yc[4][4];
#pragma unroll
        for (int j = 0; j < 4; ++j) { v[j] = xn[j];
#pragma unroll
            for (int k = 0; k < 4; ++k) yc[k][j] = yn[k][j]; }
        if (m + NGW < NTOK) CMB_LOAD(m + NGW);
        if (l >= 0) {
            const float* g2 = MOD + (size_t)(l * 4 + b) * 6144 + 5 * 1024;
#pragma unroll
            for (int j = 0; j < 4; ++j) {
                f32x4 s = (f32x4){0.f, 0.f, 0.f, 0.f};
#pragma unroll
                for (int k = 0; k < 4; ++k) { const u32x2 y = yc[k][j];
                    s.x += __builtin_bit_cast(float, y.x << 16); s.y += __builtin_bit_cast(float, y.x & 0xffff0000u); s.z += __builtin_bit_cast(float, y.y << 16); s.w += __builtin_bit_cast(float, y.y & 0xffff0000u); }
                const f32x4 g = *(const f32x4*)(g2 + 4 * F.lane + 256 * j);
                v[j] = v[j] + g * yscale * s;
            }
        }
#pragma unroll
        for (int j = 0; j < 4; ++j) *(f32x4*)(X + (size_t)m * 1024 + 4 * F.lane + 256 * j) = v[j];
        float ss = 0.f;
#pragma unroll
        for (int j = 0; j < 4; ++j) ss += (v[j].x * v[j].x + v[j].y * v[j].y) + (v[j].z * v[j].z + v[j].w * v[j].w);
        const float rs = 1.f / sqrtf(wave_sum(ss) * (1.f / 1024.f) + 1e-6f);
        if (has_next) {
            const float* nw = in_[I_NORM1] + (l + 1) * 1024;
            const float* sh = MOD + (size_t)((l + 1) * 4 + b) * 6144; const float* sc = sh + 1024;
            float fl[8];
#pragma unroll
            for (int e = 0; e < 8; ++e) fl[e] = 0.f;
            bf16_t* H = (bf16_t*)(ws_ + WS_H) + (size_t)m * 1024;
#pragma unroll
            for (int j = 0; j < 4; ++j) {
                const int c0 = 4 * F.lane + 256 * j;
                const f32x4 w = *(const f32x4*)(nw + c0), s1 = *(const f32x4*)(sc + c0), s0 = *(const f32x4*)(sh + c0);
                f32x4 h = v[j] * rs * w * (s1 + 1.f) + s0;
                u32x2 o; o.x = cvtpk(h.x, h.y); o.y = cvtpk(h.z, h.w);
                *(u32x2*)(H + c0) = o;
#pragma unroll
                for (int i = 0; i < 4; ++i) {
                    const f32x4 wa = *(const LAS f32x4*)(Wf + (c0 + i) * 8), wb = *(const LAS f32x4*)(Wf + (c0 + i) * 8 + 4);
                    const float hv = h[i];
                    fl[0] += hv * wa.x; fl[1] += hv * wa.y; fl[2] += hv * wa.z; fl[3] += hv * wa.w; fl[4] += hv * wb.x; fl[5] += hv * wb.y; fl[6] += hv * wb.z; fl[7] += hv * wb.w;
                }
            }
#pragma unroll
            for (int e = 0; e < 8; ++e) fl[e] = wave_sum(fl[e]);
            if (F.lane == 0) { float* o = (float*)(ws_ + WS_FLOG) + (size_t)m * 8; *(f32x4*)o = (f32x4){fl[0], fl[1], fl[2], fl[3]}; *(f32x4*)(o + 4) = (f32x4){fl[4], fl[5], fl[6], fl[7]}; }
        } else {
            const float* nw = in_[I_NORMF]; float* out_ = (float*)ldptr(F, 29);
#pragma unroll
            for (int j = 0; j < 4; ++j) { const int c0 = 4 * F.lane + 256 * j; const f32x4 w = *(const f32x4*)(nw + c0);
                *(f32x4*)(out_ + (size_t)m * 1024 + c0) = v[j] * rs * w; }
        }
    }
}

#undef CMB_LOAD
struct ProbDense {
    const char* A; const char* Bt; int nM, nN, G, vcu;
    __device__ __forceinline__ bool next(int i, pg8::Unit& u) const { const int Lx = i * G + vcu; if (Lx >= nM * nN) return false; u.pn = Lx % nN; u.pm = Lx / nN; u.e = 0; return true; }
    __device__ __forceinline__ const char* a_ptr(const pg8::Unit& u) const { return A + (size_t)u.pm * 256 * 2048; }
    __device__ __forceinline__ const char* b_ptr(const pg8::Unit& u) const { return Bt + (size_t)u.pn * 256 * 2048; }
};
struct EpiProj {
    unsigned char* ws;
    __device__ __forceinline__ void operator()(const f32x4 (&acc)[2][2][4][2], const pg8::Unit& u, int wr, int wc, int fr, int fq) const {
        const int pn = u.pn;
#pragma unroll
        for (int ai = 0; ai < 2; ++ai)
#pragma unroll
            for (int m = 0; m < 4; ++m) {
                const size_t row = (size_t)u.pm * 256 + ai * 128 + wr * 64 + m * 16 + fr;
#pragma unroll
                for (int bj = 0; bj < 2; ++bj) {
                    const int ct = bj * 128 + wc * 32 + 8 * fq;
                    const f32x4 v0 = acc[ai][bj][m][0], v1 = acc[ai][bj][m][1];
                    if (pn < 4) { float* p = (float*)(ws + WS_ZR) + row * 1024 + pn * 256 + ct; *(f32x4*)p = v0; *(f32x4*)(p + 4) = v1; }
                    else if (pn == 4) { float* p = (float*)(ws + WS_ZP) + row * 256 + ct; *(f32x4*)p = v0; *(f32x4*)(p + 4) = v1; }
                    else { const int q = pn - 5, which = q >> 1; const float sc = (which == 0) ? QSCALE : 1.f;
                        bf16_t* p = (bf16_t*)(ws + (which == 0 ? WS_Q : (which == 1 ? WS_K : WS_V))) + row * 512 + (q & 1) * 256 + ct;
                        u32x4 w; w.x = pg8::cvt_pk_bf16(v0[0] * sc, v0[1] * sc); w.y = pg8::cvt_pk_bf16(v0[2] * sc, v0[3] * sc); w.z = pg8::cvt_pk_bf16(v1[0] * sc, v1[1] * sc); w.w = pg8::cvt_pk_bf16(v1[2] * sc, v1[3] * sc);
                        *(u32x4*)p = w; }
                }
            }
    }
};
struct EpiOut {
    float* X; const float* g1; float scale;
    __device__ __forceinline__ void operator()(const f32x4 (&acc)[2][2][4][2], const pg8::Unit& u, int wr, int wc, int fr, int fq) const {
        const int b = (u.pm * 256) >> 12;
#pragma unroll
        for (int bj = 0; bj < 2; ++bj) {
            const int col = u.pn * 256 + bj * 128 + wc * 32 + 8 * fq;
            const f32x4 ga = *(const f32x4*)(g1 + (size_t)b * 6144 + col), gb = *(const f32x4*)(g1 + (size_t)b * 6144 + col + 4);
#pragma unroll
            for (int ai = 0; ai < 2; ++ai)
#pragma unroll
                for (int m = 0; m < 4; ++m) {
                    const size_t row = (size_t)u.pm * 256 + ai * 128 + wr * 64 + m * 16 + fr;
                    float* p = X + row * 1024 + col;
                    const f32x4 x0 = *(const f32x4*)p, x1 = *(const f32x4*)(p + 4);
                    *(f32x4*)p = x0 + ga * scale * acc[ai][bj][m][0]; *(f32x4*)(p + 4) = x1 + gb * scale * acc[ai][bj][m][1];
                }
        }
    }
};

struct MoeTab { LAS int* te; LAS int* tr0; LAS int* cnt; LAS int* ntiles; };
__device__ __forceinline__ MoeTab moe_table(Frame& F, int l) {
    refresh(F); unsigned char* ws_ = (unsigned char*)ldptr(F, 30); const InTab in_{F.lds}; gu32* ctl_ = (gu32*)ws_;

    MoeTab T; T.te = (LAS int*)(F.lds + TAB_OFF); T.tr0 = T.te + 320; T.cnt = T.tr0 + 320; T.ntiles = T.cnt + 32;
    if (F.tid < 32) T.cnt[F.tid] = (int)__hip_atomic_load(ctl_ + CW_CNT + ((l + (PROBE_DUP == 8 ? 4 : 0)) * 32 + F.tid) * 64, RLX_AGENT);
    __syncthreads();
    if (F.tid < 64) {
        const int e = F.tid; const int nt_e = (e < 32) ? ((T.cnt[e & 31] + 255) >> 8) : 0;
        int incl = nt_e;
#pragma unroll
        for (int o = 1; o < 32; o <<= 1) { const int t = __shfl_up(incl, o); if (F.lane >= o) incl += t; }
        const int start = incl - nt_e;
#pragma nounroll
        for (int r = 0; r < nt_e; ++r) { T.te[start + r] = e; T.tr0[start + r] = r * 256; }
        if (e == 31) T.ntiles[0] = incl;
    }
    __syncthreads();
    return T;
}
struct ProbGU {
    const char* H; const char* W; const int* list; MoeTab T; int nun, G, vcu, l;
    __device__ __forceinline__ bool next(int i, pg8::Unit& u) const { const int Lx = i * G + vcu; if (Lx >= nun) return false; u.pm = Lx >> 3; u.pn = Lx & 7; u.e = __builtin_amdgcn_readfirstlane(T.te[u.pm]); return true; }
    __device__ __forceinline__ const char* a_ptr(const pg8::Unit&) const { return H; }
    __device__ __forceinline__ const char* b_ptr(const pg8::Unit& u) const { return W + ((size_t)(l * 32 + u.e) * 2048 + (size_t)u.pn * 256) * 2048; }
    __device__ __forceinline__ unsigned row_off(const pg8::Unit& u, int r) const { const int idx = __builtin_amdgcn_readfirstlane(T.tr0[u.pm]) + r; const int tok = (idx < __builtin_amdgcn_readfirstlane(T.cnt[u.e])) ? (list[u.e * NTOK + idx] >> 2) : 0; return (unsigned)tok * 2048u; }
};
struct EpiGU {
    bf16_t* ACT; const float* bgu; int l;
    __device__ __forceinline__ void operator()(const f32x4 (&acc)[2][2][4][2], const pg8::Unit& u, int wr, int wc, int fr, int fq) const {
        const int col = u.pn * 128 + wc * 32 + 8 * fq;
        const float* bb = bgu + (size_t)(l * 32 + u.e) * 2048 + col;
        const f32x4 bg0 = *(const f32x4*)bb, bg1 = *(const f32x4*)(bb + 4), bu0 = *(const f32x4*)(bb + 1024), bu1 = *(const f32x4*)(bb + 1028);
#pragma unroll
        for (int ai = 0; ai < 2; ++ai)
#pragma unroll
            for (int m = 0; m < 4; ++m) {
                const size_t row = (size_t)u.pm * 256 + ai * 128 + wr * 64 + m * 16 + fr;
                float a[8];
#pragma unroll
                for (int n = 0; n < 2; ++n)
#pragma unroll
                    for (int i = 0; i < 4; ++i) {
                        float g = acc[ai][0][m][n][i] + (n ? bg1[i] : bg0[i]); float up = acc[ai][1][m][n][i] + (n ? bu1[i] : bu0[i]);
                        g = fminf(g, 7.f); up = fminf(fmaxf(up, -7.f), 7.f);
                        a[n * 4 + i] = (up + 1.f) * (g / (1.f + __expf(-1.702f * g)));
                    }
                u32x4 w; w.x = pg8::cvt_pk_bf16(a[0], a[1]); w.y = pg8::cvt_pk_bf16(a[2], a[3]); w.z = pg8::cvt_pk_bf16(a[4], a[5]); w.w = pg8::cvt_pk_bf16(a[6], a[7]);
                *(u32x4*)(ACT + row * 1024 + col) = w;
            }
    }
};
struct ProbDN {
    const char* ACT; const char* W; MoeTab T; int nun, G, vcu, l;
    __device__ __forceinline__ bool next(int i, pg8::Unit& u) const { const int Lx = i * G + vcu; if (Lx >= nun) return false; u.pm = Lx >> 2; u.pn = Lx & 3; u.e = __builtin_amdgcn_readfirstlane(T.te[u.pm]); return true; }
    __device__ __forceinline__ const char* a_ptr(const pg8::Unit& u) const { return ACT + (size_t)u.pm * 256 * 2048; }
    __device__ __forceinline__ const char* b_ptr(const pg8::Unit& u) const { return W + ((size_t)(l * 32 + u.e) * 1024 + (size_t)u.pn * 256) * 2048; }
};
struct EpiDN {
    bf16_t* YS; const float* bdn; const int* list; const float* gate; MoeTab T; int l;
    __device__ __forceinline__ void operator()(const f32x4 (&acc)[2][2][4][2], const pg8::Unit& u, int wr, int wc, int fr, int fq) const {
        const int r0 = __builtin_amdgcn_readfirstlane(T.tr0[u.pm]), c = __builtin_amdgcn_readfirstlane(T.cnt[u.e]);
#pragma unroll
        for (int ai = 0; ai < 2; ++ai)
#pragma unroll
            for (int m = 0; m < 4; ++m) {
                const int idx = r0 + ai * 128 + wr * 64 + m * 16 + fr;
                if (idx < c) {
                    const int slot = list[u.e * NTOK + idx]; const float gt = gate[slot];
#pragma unroll
                    for (int bj = 0; bj < 2; ++bj) {
                        const int col = u.pn * 256 + bj * 128 + wc * 32 + 8 * fq;
                        const float* bb = bdn + (size_t)(l * 32 + u.e) * 1024 + col;
                        const f32x4 b0 = *(const f32x4*)bb, b1 = *(const f32x4*)(bb + 4);
                        const f32x4 v0 = (acc[ai][bj][m][0] + b0) * gt, v1 = (acc[ai][bj][m][1] + b1) * gt;
                        u32x4 w; w.x = pg8::cvt_pk_bf16(v0[0], v0[1]); w.y = pg8::cvt_pk_bf16(v0[2], v0[3]); w.z = pg8::cvt_pk_bf16(v1[0], v1[1]); w.w = pg8::cvt_pk_bf16(v1[2], v1[3]);
                        *(u32x4*)(YS + (size_t)slot * 1024 + col) = w;
                    }
                }
            }
    }
};

__device__ __forceinline__ void phase_prep(Frame& F, int l) {
    refresh(F); unsigned char* ws_ = (unsigned char*)ldptr(F, 30); const InTab in_{F.lds};
    if (blockIdx.x < 32) {
        const int b = blockIdx.x >> 3, hh = blockIdx.x & 7;
        const float bf = in_[I_BF][l * 8 + hh];
        const float* fl = (const float*)(ws_ + WS_FLOG) + ((size_t)b * SEQ + 8 * F.tid) * 8 + hh;
        float lf[8];
#pragma unroll
        for (int i = 0; i < 8; ++i) lf[i] = fl[i * 8];
#pragma unroll
        for (int i = 0; i < 8; ++i) { lf[i] = -softplusf_(-(lf[i] + bf)); if (i) lf[i] += lf[i - 1]; }
        float incl = lf[7];
#pragma unroll
        for (int o = 1; o < 64; o <<= 1) { const float t = __shfl_up(incl, o); if (F.lane >= o) incl += t; }
        LAS float* wtot = (LAS float*)F.lds;
        if (F.lane == 63) wtot[F.wave] = incl;
        __syncthreads();
        float off = incl - lf[7];
        for (int w = 0; w < F.wave; ++w) off += wtot[w];
        float* bo = (float*)(ws_ + WS_BIAS) + ((size_t)b * 8 + hh) * SEQ + 8 * F.tid;
        f32x4 o0, o1;
        o0.x = -(off + lf[0]) * LOG2E; o0.y = -(off + lf[1]) * LOG2E; o0.z = -(off + lf[2]) * LOG2E; o0.w = -(off + lf[3]) * LOG2E;
        o1.x = -(off + lf[4]) * LOG2E; o1.y = -(off + lf[5]) * LOG2E; o1.z = -(off + lf[6]) * LOG2E; o1.w = -(off + lf[7]) * LOG2E;
        *(f32x4*)bo = o0; *(f32x4*)(bo + 4) = o1;
    }
    const int gw = F.vcu * NWAVES + F.wave, NGW = F.G * NWAVES;
    const float* mu = in_[I_MU] + l * 1024;
    f32x4 muv[4];
#pragma unroll
    for (int j = 0; j < 4; ++j) muv[j] = *(const f32x4*)(mu + 4 * F.lane + 256 * j);
    const f32x4 kkw = *(const f32x4*)(in_[I_KK] + l * 256 + 4 * F.lane);
    const float* ZR = (const float*)(ws_ + WS_ZR);
    const int hd = F.lane >> 4, cc = 4 * (F.lane & 15);
    const float act_a = (F.lane < 16) ? 2.f : 1.f, act_b = (F.lane < 16) ? -1.f : 0.f; const bool act_id = (F.lane >= 16 && F.lane < 32);
    for (int g = gw; g < NTOK / 8; g += NGW) {
        const int m0 = g * 8;
        f32x4 prev[4], cur[4], nx[4];
#pragma unroll
        for (int j = 0; j < 4; ++j) { prev[j] = (f32x4){0.f, 0.f, 0.f, 0.f}; cur[j] = *(const f32x4*)(ZR + (size_t)m0 * 1024 + 4 * F.lane + 256 * j); }
        if ((m0 & (SEQ - 1)) != 0) {
#pragma unroll
            for (int j = 0; j < 4; ++j) prev[j] = *(const f32x4*)(ZR + (size_t)(m0 - 1) * 1024 + 4 * F.lane + 256 * j);
        }
#pragma unroll
        for (int i = 0; i < 8; ++i) {
            const int m = m0 + i, b = m >> 12, t = m & (SEQ - 1);
            if (i < 7) {
#pragma unroll
                for (int j = 0; j < 4; ++j) nx[j] = *(const f32x4*)(ZR + (size_t)(m + 1) * 1024 + 4 * F.lane + 256 * j);
            }
            f32x4 zs[4];
#pragma unroll
            for (int j = 0; j < 4; ++j) zs[j] = cur[j] + (prev[j] - cur[j]) * muv[j];
            float* o = (float*)(ws_ + WS_SCAN) + ((size_t)(b * 4 + hd) * SEQ + t) * 384 + cc;
            *(f32x4*)(o) = zs[0];
            *(f32x4*)(o + 128) = zs[1];
            *(f32x4*)(o + 192) = zs[2];
            f32x4 kk = zs[1] * kkw;
            const float ss = red16((kk.x * kk.x + kk.y * kk.y) + (kk.z * kk.z + kk.w * kk.w));
            kk = kk * (1.f / fmaxf(sqrtf(ss), 1e-12f));
            *(f32x4*)(o + 256) = kk;
            f32x4 a4;
#pragma unroll
            for (int q = 0; q < 4; ++q) { const float x = zs[3][q]; const float sg = 1.f / (1.f + __expf(-act_a * x)); a4[q] = act_id ? x : (act_a * sg + act_b); }
            u32x2 pk; pk.x = cvtpk(a4.x, a4.y); pk.y = cvtpk(a4.z, a4.w);
            *(u32x2*)((bf16_t*)(ws_ + WS_ALORA) + (size_t)m * 256 + 4 * F.lane) = pk;
#pragma unroll
            for (int j = 0; j < 4; ++j) { prev[j] = cur[j]; cur[j] = nx[j]; }
        }
    }
}
struct ProbLora {
    const char* A; const char* Bt; int G, vcu;
    __device__ __forceinline__ bool next(int i, pg8::Unit& u) const { const int Lx = i * G + vcu; if (Lx >= 64 * 3) return false; u.pn = Lx % 3; u.pm = Lx / 3; u.e = 0; return true; }
    __device__ __forceinline__ const char* a_ptr(const pg8::Unit& u) const { return A + (size_t)u.pm * 256 * 512; }
    __device__ __forceinline__ const char* b_ptr(const pg8::Unit& u) const { return Bt + (size_t)u.pn * 256 * 512; }
};
struct EpiLora {
    unsigned char* ws; const float* w0; const float* a0; const float* ka;
    __device__ __forceinline__ void operator()(const f32x4 (&acc)[2][2][4][2], const pg8::Unit& u, int wr, int wc, int fr, int fq) const {
        const int pn = u.pn;
#pragma unroll
        for (int bj = 0; bj < 2; ++bj) {
            const int c = bj * 128 + wc * 32 + 8 * fq, hd = c >> 6, cc = c & 63;
            f32x4 p0 = (f32x4){0.f, 0.f, 0.f, 0.f}, p1 = p0, q0 = p0, q1 = p0;
            if (pn == 0) { p0 = *(const f32x4*)(w0 + c); p1 = *(const f32x4*)(w0 + c + 4); }
            else if (pn == 1) { p0 = *(const f32x4*)(a0 + c); p1 = *(const f32x4*)(a0 + c + 4); q0 = *(const f32x4*)(ka + c); q1 = *(const f32x4*)(ka + c + 4); }
#pragma unroll
            for (int ai = 0; ai < 2; ++ai)
#pragma unroll
                for (int m = 0; m < 4; ++m) {
                    const int row = u.pm * 256 + ai * 128 + wr * 64 + m * 16 + fr, b = row >> 12, t = row & (SEQ - 1);
                    const f32x4 v0 = acc[ai][bj][m][0], v1 = acc[ai][bj][m][1];
                    float* o = (float*)(ws + WS_SCAN) + ((size_t)(b * 4 + hd) * SEQ + t) * 384 + cc;
                    if (pn == 0) {
                        f32x4 d0, d1;
#pragma unroll
                        for (int i = 0; i < 4; ++i) { d0[i] = -__expf(-softplus_fast(-(p0[i] + v0[i])) - 0.5f); d1[i] = -__expf(-softplus_fast(-(p1[i] + v1[i])) - 0.5f); if (!CHUNKED_SCAN) { d0[i] = __expf(d0[i]); d1[i] = __expf(d1[i]); } }
                        *(f32x4*)(o + 64) = d0; *(f32x4*)(o + 68) = d1;
                    } else if (pn == 1) {
                        const f32x4 k0 = *(const f32x4*)(o + 128), k1 = *(const f32x4*)(o + 132), n0 = *(const f32x4*)(o + 256), n1 = *(const f32x4*)(o + 260);
                        f32x4 a_0, a_1;
#pragma unroll
                        for (int i = 0; i < 4; ++i) { a_0[i] = sigmoidf_(p0[i] + v0[i]); a_1[i] = sigmoidf_(p1[i] + v1[i]); }
                        *(f32x4*)(o + 128) = k0 * ((a_0 - 1.f) * q0 + 1.f); *(f32x4*)(o + 132) = k1 * ((a_1 - 1.f) * q1 + 1.f);
                        *(f32x4*)(o + 320) = -(n0 * a_0); *(f32x4*)(o + 324) = -(n1 * a_1);
                    } else {
                        float* gq = (float*)(ws + WS_G) + (size_t)row * 256 + c;
                        *(f32x4*)gq = v0; *(f32x4*)(gq + 4) = v1;
                    }
                }
        }
    }
};

constexpr int SC_STEPS = 16, SC_CHUNK_F = SC_STEPS * 384, SC_NBUF = 5, SC_PPW = SC_STEPS * 6 / 16;
struct ScanIn { f32x4 r, w, k, kk, kb; float v; };
__device__ __forceinline__ ScanIn scan_ld(const LAS float* p, int ks, int row) {
    ScanIn x; x.r = *(const LAS f32x4*)(p + ks); x.w = *(const LAS f32x4*)(p + 64 + ks); x.k = *(const LAS f32x4*)(p + 128 + ks); x.kk = *(const LAS f32x4*)(p + 256 + ks); x.kb = *(const LAS f32x4*)(p + 320 + ks); x.v = p[192 + row]; return x;
}
__device__ __forceinline__ void scan_block(Frame& F, int rb) {
    refresh(F); unsigned char* ws_ = (unsigned char*)ldptr(F, 30);
    const int bh = rb >> 2, rg = rb & 3, b = bh >> 2, h = bh & 3;
    const float* src = (const float*)(ws_ + WS_SCAN) + (size_t)bh * SEQ * 384;
    LAS float* buf = (LAS float*)F.lds;
    constexpr int NCH = SEQ / SC_STEPS;
    if (F.wave >= 4) {
        const int lw = F.wave - 4;
#define SC_ISSUE(c, slot) do { _Pragma("unroll") for (int p_ = 0; p_ < SC_PPW; ++p_) { const int pc_ = lw * SC_PPW + p_; \
            __builtin_amdgcn_global_load_lds((const unsigned*)(src + (size_t)(c) * SC_CHUNK_F + pc_ * 256 + F.lane * 4), (LAS unsigned*)(buf + (slot) * SC_CHUNK_F + pc_ * 256), 16, 0, 0); } } while (0)
#pragma unroll
        for (int c = 0; c < SC_NBUF - 1; ++c) SC_ISSUE(c, c);
        asm volatile("s_waitcnt vmcnt(%0)" :: "n"((SC_NBUF - 2) * SC_PPW) : "memory");
        __builtin_amdgcn_s_barrier();
        int slot = SC_NBUF - 1;
        for (int c = 0; c < NCH; ++c) {
            if (c + SC_NBUF - 1 < NCH) { SC_ISSUE(c + SC_NBUF - 1, slot); asm volatile("s_waitcnt vmcnt(%0)" :: "n"((SC_NBUF - 2) * SC_PPW) : "memory"); }
            else asm volatile("s_waitcnt vmcnt(0)" ::: "memory");
            slot = (slot == SC_NBUF - 1) ? 0 : slot + 1;
            __builtin_amdgcn_s_barrier();
        }
#undef SC_ISSUE
    } else {
        const int row = rg * 16 + F.wave * 4 + (F.lane >> 4), ks = (F.lane & 15) * 4, l16 = F.lane & 15;
        f32x4 s = (f32x4){0.f, 0.f, 0.f, 0.f};
        float* yout = (float*)(ws_ + WS_YRAW) + (size_t)b * SEQ * 256 + 64 * h + row;
        float yp = 0.f;
        int slot = 0;
        __builtin_amdgcn_s_barrier();
        for (int c = 0; c < NCH; ++c) {
            const LAS float* base = buf + slot * SC_CHUNK_F;
            slot = (slot == SC_NBUF - 1) ? 0 : slot + 1;
            float ykeep = 0.f;
            ScanIn cur = scan_ld(base, ks, row);
#pragma unroll
            for (int st = 0; st < SC_STEPS; ++st) {
                ScanIn nxt = cur;
                if (st + 1 < SC_STEPS) nxt = scan_ld(base + (st + 1) * 384, ks, row);
                const f32x4 vk = cur.k * cur.v;
                const float t0 = s.x * cur.kk.x + s.y * cur.kk.y, t1 = s.z * cur.kk.z + s.w * cur.kk.w;
                const f32x4 u = s * cur.w + vk;
                float sa = t0 + t1;
                red16_pair(sa, yp);
                ykeep = (l16 == st) ? yp : ykeep;
                s = u + cur.kb * sa;
                const float y0 = s.x * cur.r.x + s.y * cur.r.y, y1 = s.z * cur.r.z + s.w * cur.r.w;
                yp = y0 + y1;
                cur = nxt;
            }
            { const int g = c * SC_STEPS + l16 - 1; if (l16 < SC_STEPS && g >= 0) yout[(size_t)g * 256] = ykeep; }
            __builtin_amdgcn_s_barrier();
        }
        yp = red16(yp);
        if (l16 == 0) yout[(size_t)(SEQ - 1) * 256] = yp;
    }
}


__device__ __forceinline__ int crow(int r, int hi) { return (r & 3) + 8 * (r >> 2) + 4 * hi; }
constexpr int CK_P = 144, CK_A = 64 * CK_P;
enum { CA_KKP = 0, CA_RP, CA_BI, CA_KI, CA_VT, CA_KKPT, CA_BHT, CA_KHT, CA_TB, CA_AUK, CA_ARB, CA_ARK, CA_TF0, CA_TF1, CA_N,
       CA_W1T = CA_KKP, CA_MT = CA_BI, CA_U0T = CA_KI,
       CA_D1T = CA_BI, CA_X1T = CA_KI };
constexpr int CK_TF = CA_TF0 * CK_A;
static_assert(CA_N * CK_A <= 139264 && 64 * 68 * 4 <= 2 * CK_A, "chunk LDS map");
__device__ __forceinline__ f32x16 ck_mma(const LAS unsigned char* A, const LAS unsigned char* B, int ksteps, f32x16 acc, int r32, int hi) {
#pragma unroll 4
    for (int s = 0; s < ksteps; ++s) {
        const bf16x8 a = *(const LAS bf16x8*)(A + r32 * CK_P + (16 * s + 8 * hi) * 2);
        const bf16x8 b = *(const LAS bf16x8*)(B + r32 * CK_P + (16 * s + 8 * hi) * 2);
        acc = __builtin_amdgcn_mfma_f32_32x32x16_bf16(a, b, acc, 0, 0, 0);
    }
    return acc;
}
__device__ __forceinline__ void ck_store_t(LAS unsigned char* dst, const f32x16& c, int R0, int C0, int r32, int hi) {
#pragma unroll
    for (int g = 0; g < 4; ++g) { u32x2 w; w.x = cvtpk(c[4 * g], c[4 * g + 1]); w.y = cvtpk(c[4 * g + 2], c[4 * g + 3]); *(LAS u32x2*)(dst + (C0 + r32) * CK_P + (R0 + 8 * g + 4 * hi) * 2) = w; }
}
struct ChunkRows { f32x4 r[2], w[2], k[2], v[2], kk[2], kb[2]; };
__device__ __forceinline__ ChunkRows chunk_load(Frame& F, unsigned char* ws_, int job) {
    const int t = F.tid & 63, c0 = (F.tid >> 6) * 8, bh = job >> 6, ch = job & 63;
    const float* row = (const float*)(ws_ + WS_SCAN) + ((size_t)bh * SEQ + (size_t)ch * 64 + t) * 384 + c0;
    ChunkRows x;
#pragma unroll
    for (int q = 0; q < 2; ++q) { x.r[q] = *(const f32x4*)(row + 4 * q); x.w[q] = *(const f32x4*)(row + 64 + 4 * q); x.k[q] = *(const f32x4*)(row + 128 + 4 * q); x.v[q] = *(const f32x4*)(row + 192 + 4 * q); x.kk[q] = *(const f32x4*)(row + 256 + 4 * q); x.kb[q] = *(const f32x4*)(row + 320 + 4 * q); }
    return x;
}
__device__ __forceinline__ void chunk_job(Frame& F, unsigned char* ws_, int job, const ChunkRows& in) {
    LAS unsigned char* L = F.lds;
    LAS float* Tf = (LAS float*)(L + CK_TF);
    const int tid = F.tid, lane = F.lane, wave = F.wave, r32 = lane & 31, hi = lane >> 5;
    {
        const int t = tid & 63, c0 = (tid >> 6) * 8;
        float r_[8], k_[8], v_[8], kk_[8], kb_[8], Lt[8];
#pragma unroll
        for (int q = 0; q < 2; ++q)
#pragma unroll
            for (int i = 0; i < 4; ++i) { r_[4 * q + i] = in.r[q][i]; k_[4 * q + i] = in.k[q][i]; v_[4 * q + i] = in.v[q][i]; kk_[4 * q + i] = in.kk[q][i]; kb_[4 * q + i] = -in.kb[q][i]; Lt[4 * q + i] = in.w[q][i]; }
#pragma unroll
        for (int o = 1; o < 64; o <<= 1) {
#pragma unroll
            for (int i = 0; i < 8; ++i) { const float up = __shfl_up(Lt[i], o); if (lane >= o) Lt[i] += up; }
        }
        float kkp[8], rp[8], bi[8], ki[8], bh_[8], kh_[8];
#pragma unroll
        for (int i = 0; i < 8; ++i) {
            const float Lm0 = __shfl_up(Lt[i], 1); const float Lm = (lane > 0) ? Lm0 : 0.f; const float Lc = __shfl(Lt[i], 63);
            const float ip = __expf(-Lt[i]);
            kkp[i] = kk_[i] * __expf(Lm); rp[i] = r_[i] * __expf(Lt[i]); bi[i] = kb_[i] * ip; ki[i] = k_[i] * ip;
            const float pc = __expf(Lc - Lt[i]); bh_[i] = kb_[i] * pc; kh_[i] = k_[i] * pc;
            if (t == 63) ((LAS float*)(L + PCV_OFF))[c0 + i] = __expf(Lc);
        }
#define CK_ROW8(arr, vals_) do { u32x4 w_ = (u32x4){cvtpk(vals_[0], vals_[1]), cvtpk(vals_[2], vals_[3]), cvtpk(vals_[4], vals_[5]), cvtpk(vals_[6], vals_[7])}; *(LAS u32x4*)(L + (arr) * CK_A + t * CK_P + c0 * 2) = w_; } while (0)
#define CK_COL8(arr, vals_) do { _Pragma("unroll") for (int i_ = 0; i_ < 8; ++i_) *(LAS unsigned short*)(L + (arr) * CK_A + (c0 + i_) * CK_P + t * 2) = (unsigned short)f2bf(vals_[i_]); } while (0)
        CK_ROW8(CA_KKP, kkp); CK_ROW8(CA_RP, rp); CK_ROW8(CA_BI, bi); CK_ROW8(CA_KI, ki);
        CK_COL8(CA_VT, v_); CK_COL8(CA_KKPT, kkp); CK_COL8(CA_BHT, bh_); CK_COL8(CA_KHT, kh_);
#undef CK_ROW8
#undef CK_COL8
    }
    __syncthreads();
#pragma unroll
    for (int q = 0; q < 2; ++q) {
        const int id = wave * 2 + q, which = id >> 2, tj = (id >> 1) & 1, tt = id & 1;
        const LAS unsigned char* Aop = L + ((which & 1) ? CA_KI : CA_BI) * CK_A + tj * 32 * CK_P;
        const LAS unsigned char* Bop = L + ((which & 2) ? CA_RP : CA_KKP) * CK_A + tt * 32 * CK_P;
        f32x16 c = {}; c = ck_mma(Aop, Bop, 4, c, r32, hi);
        const int t = tt * 32 + r32;
#pragma unroll
        for (int i = 0; i < 16; ++i) { const int j = tj * 32 + crow(i, hi); const bool keep = (which & 2) ? (j <= t) : (j < t); if (!keep) c[i] = 0.f; }
        if (which == 0) {
#pragma unroll
            for (int g = 0; g < 4; ++g) { const int j0 = tj * 32 + 8 * g + 4 * hi; Tf[t * 68 + j0] = c[4 * g]; Tf[t * 68 + j0 + 1] = c[4 * g + 1]; Tf[t * 68 + j0 + 2] = c[4 * g + 2]; Tf[t * 68 + j0 + 3] = c[4 * g + 3]; }
        } else ck_store_t(L + ((which == 1) ? CA_AUK : (which == 2) ? CA_ARB : CA_ARK) * CK_A, c, tj * 32, tt * 32, r32, hi);
    }
    __syncthreads();
    LAS unsigned char* TB = L + CA_TB * CK_A;
    if (wave == 4) {
        const int blk = lane >> 5, c = lane & 31;
        const LAS float* ab = Tf + blk * (32 * 68 + 32);
        float x[32];
#pragma unroll
        for (int t = 0; t < 32; ++t) x[t] = 0.f;
#pragma unroll
        for (int t = 0; t < 32; ++t) {
            int z = 0;
            if (t >= 2) asm volatile("" : "+v"(z) : "v"(x[t - 2]));
            const LAS float* rowp = ab + t * 68 + z;
            float a0 = (t == c) ? 1.f : 0.f, a1 = 0.f, a2 = 0.f, a3 = 0.f;
#pragma unroll
            for (int j = 0; j < t; j += 4) { const f32x4 a4 = *(const LAS f32x4*)(rowp + j);
                a0 -= a4.x * x[j]; a1 -= a4.y * x[j + 1]; a2 -= a4.z * x[j + 2]; a3 -= a4.w * x[j + 3]; }
            x[t] = (a0 + a1) + (a2 + a3);
        }
#pragma unroll
        for (int t = 0; t < 32; ++t) *(LAS unsigned short*)(TB + (32 * blk + t) * CK_P + (32 * blk + c) * 2) = (unsigned short)f2bf(x[t]);
        if (blk == 0) {
#pragma unroll
            for (int t8 = 0; t8 < 4; ++t8) { const u32x4 w_ = (u32x4){cvtpk(x[8 * t8], x[8 * t8 + 1]), cvtpk(x[8 * t8 + 2], x[8 * t8 + 3]), cvtpk(x[8 * t8 + 4], x[8 * t8 + 5]), cvtpk(x[8 * t8 + 6], x[8 * t8 + 7])}; *(LAS u32x4*)(L + CA_D1T * CK_A + c * CK_P + t8 * 16) = w_; }
        } else {
#pragma unroll
            for (int t8 = 0; t8 < 4; ++t8) *(LAS u32x4*)(TB + c * CK_P + 64 + t8 * 16) = (u32x4){0u, 0u, 0u, 0u};
        }
    } else if (wave < 4) {
        const int tt = wave >> 1, tv = wave & 1;
        f32x16 c = {}; c = ck_mma(L + CA_AUK * CK_A + tt * 32 * CK_P, L + CA_VT * CK_A + tv * 32 * CK_P, 4, c, r32, hi);
        ck_store_t(L + CA_W1T * CK_A, c, tt * 32, tv * 32, r32, hi);
    }
    __syncthreads();
    if (wave == 0) {
        f32x16 c = {};
#pragma unroll
        for (int s = 0; s < 2; ++s) {
            const f32x4 f0 = *(const LAS f32x4*)(Tf + (32 + r32) * 68 + 16 * s + 8 * hi), f1 = *(const LAS f32x4*)(Tf + (32 + r32) * 68 + 16 * s + 8 * hi + 4);
            const u32x4 aw = (u32x4){cvtpk(f0.x, f0.y), cvtpk(f0.z, f0.w), cvtpk(f1.x, f1.y), cvtpk(f1.z, f1.w)};
            const bf16x8 b = *(const LAS bf16x8*)(L + CA_D1T * CK_A + r32 * CK_P + (16 * s + 8 * hi) * 2);
            c = __builtin_amdgcn_mfma_f32_32x32x16_bf16(__builtin_bit_cast(bf16x8, aw), b, c, 0, 0, 0);
        }
        ck_store_t(L + CA_X1T * CK_A, c, 0, 0, r32, hi);
    }
    __syncthreads();
    if (wave == 0) {
        f32x16 c = {}; c = ck_mma(L + CA_X1T * CK_A, TB + 32 * CK_P + 64, 2, c, r32, hi);
#pragma unroll
        for (int i = 0; i < 16; ++i) c[i] = -c[i];
        ck_store_t(TB + 32 * CK_P, c, 0, 0, r32, hi);
    }
    __syncthreads();
    {
        const int which = wave >> 2, tt = (wave >> 1) & 1, tc = wave & 1;
        f32x16 c = {}; c = ck_mma(L + CA_TB * CK_A + tt * 32 * CK_P, L + (which ? CA_W1T : CA_KKPT) * CK_A + tc * 32 * CK_P, 4, c, r32, hi);
        if (which) {
#pragma unroll
            for (int i = 0; i < 16; ++i) c[i] = -c[i];
        }
        ck_store_t(L + (which ? CA_U0T : CA_MT) * CK_A, c, tt * 32, tc * 32, r32, hi);
    }
    __syncthreads();
    const size_t jb = (size_t)job;
#pragma unroll
    for (int q = 0; q < 2; ++q) {
        const int id = wave * 2 + q, which = id >> 2, ta = (id >> 1) & 1, tb = id & 1;
        f32x16 c = {};
        if (which == 0) {
            c = ck_mma(L + CA_MT * CK_A + ta * 32 * CK_P, L + CA_BHT * CK_A + tb * 32 * CK_P, 4, c, r32, hi);
            const int k2 = tb * 32 + r32; const float pcv = ((const LAS float*)(L + PCV_OFF))[k2];
            bf16_t* o = (bf16_t*)(ws_ + WS_CPG + jb * 24576) + (size_t)k2 * 64;
#pragma unroll
            for (int g = 0; g < 4; ++g) { const int k1 = ta * 32 + 8 * g + 4 * hi; float x[4];
#pragma unroll
                for (int i = 0; i < 4; ++i) x[i] = ((k1 + i == k2) ? pcv : 0.f) - c[4 * g + i];
                u32x2 w_; w_.x = cvtpk(x[0], x[1]); w_.y = cvtpk(x[2], x[3]); *(u32x2*)(o + k1) = w_; }
        } else if (which == 1) {
            c = ck_mma(L + CA_U0T * CK_A + ta * 32 * CK_P, L + CA_BHT * CK_A + tb * 32 * CK_P, 4, c, r32, hi);
            c = ck_mma(L + CA_VT * CK_A + ta * 32 * CK_P, L + CA_KHT * CK_A + tb * 32 * CK_P, 4, c, r32, hi);
            float* o = (float*)(ws_ + WS_CPG + jb * 24576 + 8192) + (size_t)(tb * 32 + r32) * 64;
#pragma unroll
            for (int g = 0; g < 4; ++g) *(f32x4*)(o + ta * 32 + 8 * g + 4 * hi) = (f32x4){c[4 * g], c[4 * g + 1], c[4 * g + 2], c[4 * g + 3]};
        } else if (which == 2) {
            c = ck_mma(L + CA_MT * CK_A + ta * 32 * CK_P, L + CA_ARB * CK_A + tb * 32 * CK_P, 4, c, r32, hi);
            const int t = tb * 32 + r32;
            bf16_t* o = (bf16_t*)(ws_ + WS_CPSI) + jb * 4096 + (size_t)t * 64;
#pragma unroll
            for (int g = 0; g < 4; ++g) { const int k0 = ta * 32 + 8 * g + 4 * hi; const u32x2 rp2 = *(const LAS u32x2*)(L + CA_RP * CK_A + t * CK_P + k0 * 2);
                const float r0 = __builtin_bit_cast(float, rp2.x << 16), r1 = __builtin_bit_cast(float, rp2.x & 0xffff0000u), r2 = __builtin_bit_cast(float, rp2.y << 16), r3 = __builtin_bit_cast(float, rp2.y & 0xffff0000u);
                u32x2 w_; w_.x = cvtpk(r0 - c[4 * g], r1 - c[4 * g + 1]); w_.y = cvtpk(r2 - c[4 * g + 2], r3 - c[4 * g + 3]); *(u32x2*)(o + k0) = w_; }
        } else {
            c = ck_mma(L + CA_U0T * CK_A + ta * 32 * CK_P, L + CA_ARB * CK_A + tb * 32 * CK_P, 4, c, r32, hi);
            c = ck_mma(L + CA_VT * CK_A + ta * 32 * CK_P, L + CA_ARK * CK_A + tb * 32 * CK_P, 4, c, r32, hi);
            float* o = (float*)(ws_ + WS_CY0) + jb * 4096 + (size_t)(tb * 32 + r32) * 64;
#pragma unroll
            for (int g = 0; g < 4; ++g) *(f32x4*)(o + ta * 32 + 8 * g + 4 * hi) = (f32x4){c[4 * g], c[4 * g + 1], c[4 * g + 2], c[4 * g + 3]};
        }
    }
    __syncthreads();
}


constexpr int S2_REC = 24576, S2_NSLOT = 4, S2_SB = S2_NSLOT * S2_REC;
__device__ __forceinline__ void chunk_states(Frame& F, unsigned char* ws_, int bh) {
    LAS unsigned char* L = F.lds;
    LAS unsigned char* Sb = L + S2_SB;
    const int tid = F.tid, lane = F.lane, wave = F.wave, r32 = lane & 31, hi = lane >> 5;
    for (int i = tid; i < 64 * CK_P / 4; i += NTHR) ((LAS unsigned*)Sb)[i] = 0u;
    const unsigned char* rec0 = ws_ + WS_CPG + (size_t)bh * 64 * S2_REC;
#define S2_ISSUE(c) do { if (wave >= 4) { _Pragma("unroll") for (int p_ = 0; p_ < 6; ++p_) { const int pc_ = (wave - 4) * 6 + p_; \
        __builtin_amdgcn_global_load_lds((const unsigned*)(rec0 + (size_t)(c) * S2_REC + pc_ * 1024 + lane * 16), (LAS unsigned*)(L + ((c) & (S2_NSLOT - 1)) * S2_REC + pc_ * 1024), 16, 0, 0); } } } while (0)
    S2_ISSUE(0); S2_ISSUE(1); S2_ISSUE(2);
    if (wave >= 4) asm volatile("s_waitcnt vmcnt(12)" ::: "memory");
    __syncthreads();
    const int ti = wave >> 1, tj = wave & 1;
    for (int c = 0; c < 64; ++c) {
        if (c + 3 < 64) { S2_ISSUE(c + 3); if (wave >= 4) asm volatile("s_waitcnt vmcnt(12)" ::: "memory"); }
        else if (wave >= 4) asm volatile("s_waitcnt vmcnt(0)" ::: "memory");
        { const int row = tid >> 3, ch = tid & 7; *(u32x4*)((bf16_t*)(ws_ + WS_CS) + ((size_t)bh * 64 + c) * 4096 + row * 64 + ch * 8) = *(const LAS u32x4*)(Sb + row * CK_P + ch * 16); }
        f32x16 acc = {};
        if (wave < 4) {
            const LAS unsigned char* R = L + (c & (S2_NSLOT - 1)) * S2_REC;
            const LAS float* G = (const LAS float*)(R + 8192);
#pragma unroll
            for (int i = 0; i < 16; ++i) acc[i] = G[(ti * 32 + crow(i, hi)) * 64 + tj * 32 + r32];
#pragma unroll
            for (int s = 0; s < 4; ++s) {
                const bf16x8 a = *(const LAS bf16x8*)(R + (ti * 32 + r32) * 128 + (16 * s + 8 * hi) * 2);
                const bf16x8 b = *(const LAS bf16x8*)(Sb + (tj * 32 + r32) * CK_P + (16 * s + 8 * hi) * 2);
                acc = __builtin_amdgcn_mfma_f32_32x32x16_bf16(a, b, acc, 0, 0, 0);
            }
        }
        __syncthreads();
        if (wave < 4) ck_store_t(Sb, acc, ti * 32, tj * 32, r32, hi);
        __syncthreads();
    }
#undef S2_ISSUE
}
__device__ __forceinline__ void chunk_out(Frame& F, unsigned char* ws_, int job, int w4) {
    const int lane = F.lane, r32 = lane & 31, hi = lane >> 5, tt = w4 >> 1, tv = w4 & 1;
    const bf16_t* Psi = (const bf16_t*)(ws_ + WS_CPSI) + (size_t)job * 4096; const bf16_t* CS = (const bf16_t*)(ws_ + WS_CS) + (size_t)job * 4096; const float* Y0 = (const float*)(ws_ + WS_CY0) + (size_t)job * 4096;
    bf16x8 a[4], b[4]; f32x16 acc;
#pragma unroll
    for (int s = 0; s < 4; ++s) { a[s] = *(const bf16x8*)(Psi + (tt * 32 + r32) * 64 + 16 * s + 8 * hi); b[s] = *(const bf16x8*)(CS + (tv * 32 + r32) * 64 + 16 * s + 8 * hi); }
#pragma unroll
    for (int i = 0; i < 16; ++i) acc[i] = Y0[(tt * 32 + crow(i, hi)) * 64 + tv * 32 + r32];
#pragma unroll
    for (int s = 0; s < 4; ++s) acc = __builtin_amdgcn_mfma_f32_32x32x16_bf16(a[s], b[s], acc, 0, 0, 0);
    LAS float* yl = (LAS float*)F.lds + (F.wave >> 2) * 4096 + (tt * 32) * 64 + tv * 32 + r32;
#pragma unroll
    for (int i = 0; i < 16; ++i) yl[crow(i, hi) * 64] = acc[i];
}
__device__ __forceinline__ void chunk_post(Frame& F, const InTab& in_, unsigned char* ws_, int l, int job, int w4, const LAS float* yimg) {
    const int c = F.lane, bh = job >> 6, ch = job & 63, b = bh >> 2, h = bh & 3;
    const float lw = in_[I_LNW][l * 256 + 64 * h + c], lb = in_[I_LNB][l * 256 + 64 * h + c], rkw = in_[I_RK][l * 256 + 64 * h + c];
    const float* SCN = (const float*)(ws_ + WS_SCAN) + ((size_t)bh * SEQ + (size_t)ch * 64) * 384 + c; const float* GG = (const float*)(ws_ + WS_G) + ((size_t)b * SEQ + (size_t)ch * 64) * 256 + 64 * h + c;
    bf16_t* MX = (bf16_t*)(ws_ + WS_MIXED) + ((size_t)b * SEQ + (size_t)ch * 64) * 1024 + 64 * h + c;
#pragma unroll
    for (int trip = 0; trip < 2; ++trip) {
        float y[8], vv[8], bn[8], gg[8];
#pragma unroll
        for (int u = 0; u < 8; ++u) { const int t = w4 * 16 + trip * 8 + u; const float* sp = SCN + (size_t)t * 384; y[u] = yimg[t * 64 + c]; vv[u] = sp[192]; bn[u] = sp[0] * sp[128] * rkw; gg[u] = GG[(size_t)t * 256]; }
#pragma unroll
        for (int u = 0; u < 8; ++u) {
            const int t = w4 * 16 + trip * 8 + u;
            const float mean = wave_sum(y[u]) * (1.f / 64.f); const float d = y[u] - mean; const float var = wave_sum(d * d) * (1.f / 64.f);
            float yn = d * (1.f / sqrtf(var + 64e-5f)) * lw + lb;
            yn += wave_sum(bn[u]) * vv[u];
            yn *= gg[u];
            MX[(size_t)t * 1024] = (bf16_t)f2bf(yn);
        }
    }
}

constexpr int AT_ROWB = 144;
constexpr int AT_KOFF = 0, AT_VOFF = 2 * 64 * AT_ROWB, AT_BOFF = 4 * 64 * AT_ROWB, AT_QUEUE = AT_BOFF + 2 * 256;
__device__ __forceinline__ void attn_unit(Frame& F, int b, int h, int qb) {
    refresh(F); unsigned char* ws_ = (unsigned char*)ldptr(F, 30); const InTab in_{F.lds}; gu32* ctl_ = (gu32*)ws_;

    const int lane = F.lane, r32 = lane & 31, hi = lane >> 5, wid = F.wave, tid = F.tid;
    const bf16_t* Q = (const bf16_t*)(ws_ + WS_Q); const bf16_t* Kg = (const bf16_t*)(ws_ + WS_K); const bf16_t* Vg = (const bf16_t*)(ws_ + WS_V);
    const float* BI = (const float*)(ws_ + WS_BIAS) + ((size_t)b * 8 + h) * SEQ;
    const size_t rowbase = (size_t)b * SEQ; const int q0 = qb * 256, qw0 = q0 + wid * 32;
    LAS unsigned char* lds = F.lds;
    bf16x8 qr[4];
#pragma unroll
    for (int d0 = 0; d0 < 4; ++d0) qr[d0] = *(const bf16x8*)(Q + (rowbase + qw0 + r32) * 512 + h * 64 + d0 * 16 + hi * 8);
    const int NT = (q0 + 256) / 64;
    int T0 = 0;
    { const float nbq = BI[q0]; const float vlast = (lane < NT) ? BI[64 * lane + 63] : 3.0e38f;
      const unsigned long long ok = __ballot(vlast - nbq >= -150.f);
      T0 = ok ? (int)(__ffsll((long long)ok) - 1) : 0; T0 = __builtin_amdgcn_readfirstlane(T0); }
    const int srow = tid >> 3, sch = tid & 7;
    const bf16_t* kp = Kg + (rowbase + srow) * 512 + h * 64 + sch * 8; const bf16_t* vp = Vg + (rowbase + srow) * 512 + h * 64 + sch * 8;
    u32x4 kreg = *(const u32x4*)(kp + (size_t)T0 * 64 * 512), vreg = *(const u32x4*)(vp + (size_t)T0 * 64 * 512); float breg = (tid < 64) ? BI[T0 * 64 + tid] : 0.f;
    { const int b0_ = T0 & 1;
      *(LAS u32x4*)(lds + AT_KOFF + b0_ * 64 * AT_ROWB + srow * AT_ROWB + sch * 16) = kreg; *(LAS u32x4*)(lds + AT_VOFF + b0_ * 64 * AT_ROWB + srow * AT_ROWB + sch * 16) = vreg;
      if (tid < 64) *(LAS float*)(lds + AT_BOFF + b0_ * 256 + tid * 4) = breg; }
    __syncthreads();
    f32x16 o0 = {}, o1 = {};
    float nbi = BI[qw0 + r32];
    float lrun = 0.f;
    const int i16 = lane & 15, tq = i16 >> 2, tp = i16 & 3, blk = (lane >> 4) & 1;
    for (int t = T0; t < NT; ++t) {
        const int cb = t & 1, nb = cb ^ 1;
        if (t + 1 < NT) { kreg = *(const u32x4*)(kp + (size_t)(t + 1) * 64 * 512); vreg = *(const u32x4*)(vp + (size_t)(t + 1) * 64 * 512); if (tid < 64) breg = BI[(t + 1) * 64 + tid]; }
        if (64 * t <= qw0 + 31) {
            const LAS unsigned char* Ks = lds + AT_KOFF + cb * 64 * AT_ROWB; const LAS unsigned char* Vs = lds + AT_VOFF + cb * 64 * AT_ROWB; const LAS float* Bs = (const LAS float*)(lds + AT_BOFF + cb * 256);
            f32x16 p0, p1;
#pragma unroll
            for (int g = 0; g < 4; ++g) {
                const f32x4 b0 = *(const LAS f32x4*)(Bs + 8 * g + 4 * hi), b1 = *(const LAS f32x4*)(Bs + 32 + 8 * g + 4 * hi);
#pragma unroll
                for (int i = 0; i < 4; ++i) { p0[4 * g + i] = b0[i] - nbi; p1[4 * g + i] = b1[i] - nbi; }
            }
#pragma unroll
            for (int d0 = 0; d0 < 4; ++d0) {
                const bf16x8 a0 = *(const LAS bf16x8*)(Ks + r32 * AT_ROWB + (d0 * 16 + hi * 8) * 2);
                const bf16x8 a1 = *(const LAS bf16x8*)(Ks + (32 + r32) * AT_ROWB + (d0 * 16 + hi * 8) * 2);
                p0 = __builtin_amdgcn_mfma_f32_32x32x16_bf16(a0, qr[d0], p0, 0, 0, 0);
                p1 = __builtin_amdgcn_mfma_f32_32x32x16_bf16(a1, qr[d0], p1, 0, 0, 0);
            }
            if (64 * t + 63 > qw0) {
                const int qabs = qw0 + r32;
#pragma unroll
                for (int i = 0; i < 16; ++i) { const int kv = 64 * t + crow(i, hi); if (kv > qabs) p0[i] = -INFINITY; if (kv + 32 > qabs) p1[i] = -INFINITY; }
            }
            float mx = fmaxf(fmaxf(p0[0], p0[1]), p1[0]);
#pragma unroll
            for (int i = 1; i < 16; ++i) mx = fmaxf(fmaxf(mx, p0[i]), p1[i]);
            if (__any(mx > 24.f)) {
                const float mo = fmaxf(mx, __shfl_xor(mx, 32));
                const float dl = fmaxf(mo, 0.f);
                nbi += dl;
                const float f = __builtin_amdgcn_exp2f(-dl);
                lrun *= f;
#pragma unroll
                for (int i = 0; i < 16; ++i) { p0[i] -= dl; p1[i] -= dl; o0[i] *= f; o1[i] *= f; }
            }
            float ls0 = 0.f, ls1 = 0.f;
#pragma unroll
            for (int i = 0; i < 16; ++i) { p0[i] = __builtin_amdgcn_exp2f(p0[i]); p1[i] = __builtin_amdgcn_exp2f(p1[i]); ls0 += p0[i]; ls1 += p1[i]; }
            lrun += ls0 + ls1;
            bf16x8 pf[4];
#pragma unroll
            for (int s = 0; s < 2; ++s) {
                u32x4 w0, w1;
                w0.x = cvtpk(p0[8 * s + 0], p0[8 * s + 1]); w0.y = cvtpk(p0[8 * s + 2], p0[8 * s + 3]); w0.z = cvtpk(p0[8 * s + 4], p0[8 * s + 5]); w0.w = cvtpk(p0[8 * s + 6], p0[8 * s + 7]);
                w1.x = cvtpk(p1[8 * s + 0], p1[8 * s + 1]); w1.y = cvtpk(p1[8 * s + 2], p1[8 * s + 3]); w1.z = cvtpk(p1[8 * s + 4], p1[8 * s + 5]); w1.w = cvtpk(p1[8 * s + 6], p1[8 * s + 7]);
                pf[s] = __builtin_bit_cast(bf16x8, w0); pf[2 + s] = __builtin_bit_cast(bf16x8, w1);
            }
#pragma unroll
            for (int ks4 = 0; ks4 < 4; ++ks4) {
                const int kvb = (ks4 >> 1) * 32 + (ks4 & 1) * 16 + 4 * hi;
#pragma unroll
                for (int d0 = 0; d0 < 2; ++d0) {
                    const LAS unsigned char* a_lo = Vs + (kvb + tq) * AT_ROWB + (32 * d0 + 16 * blk) * 2 + 8 * tp;
                    const s16x4 lo = __builtin_bit_cast(s16x4, __builtin_amdgcn_ds_read_tr16_b64_v4i16((LAS s16x4*)a_lo));
                    const s16x4 hv = __builtin_bit_cast(s16x4, __builtin_amdgcn_ds_read_tr16_b64_v4i16((LAS s16x4*)(a_lo + 8 * AT_ROWB)));
                    const bf16x8 va = __builtin_shufflevector(lo, hv, 0, 1, 2, 3, 4, 5, 6, 7);
                    if (d0 == 0) o0 = __builtin_amdgcn_mfma_f32_32x32x16_bf16(va, pf[ks4], o0, 0, 0, 0);
                    else o1 = __builtin_amdgcn_mfma_f32_32x32x16_bf16(va, pf[ks4], o1, 0, 0, 0);
                }
            }
        }
        if (t + 1 < NT) {
            *(LAS u32x4*)(lds + AT_KOFF + nb * 64 * AT_ROWB + srow * AT_ROWB + sch * 16) = kreg; *(LAS u32x4*)(lds + AT_VOFF + nb * 64 * AT_ROWB + srow * AT_ROWB + sch * 16) = vreg;
            if (tid < 64) *(LAS float*)(lds + AT_BOFF + nb * 256 + tid * 4) = breg;
        }
        __syncthreads();
    }
    lrun += __shfl_xor(lrun, 32);
    const float inv = 1.f / lrun;
    bf16_t* O = (bf16_t*)(ws_ + WS_MIXED) + (rowbase + qw0 + r32) * 1024 + 512 + h * 64;
#pragma unroll
    for (int g = 0; g < 4; ++g) {
        u32x2 w; w.x = cvtpk(o0[4 * g] * inv, o0[4 * g + 1] * inv); w.y = cvtpk(o0[4 * g + 2] * inv, o0[4 * g + 3] * inv);
        *(u32x2*)(O + 8 * g + 4 * hi) = w;
        u32x2 w2; w2.x = cvtpk(o1[4 * g] * inv, o1[4 * g + 1] * inv); w2.y = cvtpk(o1[4 * g + 2] * inv, o1[4 * g + 3] * inv);
        *(u32x2*)(O + 32 + 8 * g + 4 * hi) = w2;
    }
}
__device__ __forceinline__ void pool_batch(Frame& F, const InTab& in_, unsigned char* ws_, int l, int q) {
    LAS float* Wp = (LAS float*)F.lds;
    LAS float* ps = (LAS float*)(F.lds + 65536) + F.wave * 512;
    { const float* w = in_[I_POOLW] + (size_t)l * 4 * 64 * 64; f32x4 t8[8];
#pragma unroll
      for (int u = 0; u < 8; ++u) t8[u] = *(const f32x4*)(w + 4 * (F.tid + NTHR * u));
#pragma unroll
      for (int u = 0; u < 8; ++u) *(LAS f32x4*)(Wp + 4 * (F.tid + NTHR * u)) = t8[u]; }
    __syncthreads();
    const int c = F.lane;
    bf16_t* MX = (bf16_t*)(ws_ + WS_MIXED);
    const float* ZP = (const float*)(ws_ + WS_ZP);
    for (int jj = 0; jj < 8; ++jj) {
        const int it = q * 64 + jj * 8 + F.wave;
        const int g = it & 3, m0 = (it >> 2) * 8, win = 2 << g;
        {
            const int seq0 = m0 & ~(SEQ - 1);
            float zz[23];
#pragma unroll
            for (int qq = 0; qq < 23; ++qq) { const int rr = m0 - 15 + qq; zz[qq] = (rr >= seq0 && (qq >= 15 || 15 - qq < win + 7)) ? ZP[(size_t)rr * 256 + 64 * g + c] : 0.f; }
#pragma unroll
            for (int i = 0; i < 8; ++i) {
                const int t = (m0 + i) & (SEQ - 1); const int n = (t + 1 < win) ? t + 1 : win;
                float s = 0.f;
#pragma unroll
                for (int j = 0; j < 16; ++j) s += (j < win) ? zz[15 + i - j] : 0.f;
                ps[i * 64 + c] = s / (float)n - zz[15 + i];
            }
        }
        LDS_WAIT(); asm volatile("" ::: "memory");
        float acc[8];
#pragma unroll
        for (int i = 0; i < 8; ++i) acc[i] = 0.f;
        const LAS float* W = Wp + g * 4096;
        for (int j = 0; j < 64; j += 4) {
            const float w_0 = W[(j + 0) * 64 + c], w_1 = W[(j + 1) * 64 + c], w_2 = W[(j + 2) * 64 + c], w_3 = W[(j + 3) * 64 + c];
#pragma unroll
            for (int i = 0; i < 8; ++i) { const f32x4 x = *(const LAS f32x4*)(ps + i * 64 + j); acc[i] += x.x * w_0 + x.y * w_1 + x.z * w_2 + x.w * w_3; }
        }
        const float sc = in_[I_POOLS][l * 256 + 64 * g + c];
#pragma unroll
        for (int i = 0; i < 8; ++i) MX[(size_t)(m0 + i) * 1024 + 256 + 64 * g + c] = (bf16_t)f2bf(acc[i] * sc);
        LDS_WAIT(); asm volatile("" ::: "memory");
    }
    __syncthreads();
}
__device__ __forceinline__ void phase_mix(Frame& F, int l, int qsel = 0) {
    refresh(F); unsigned char* ws_ = (unsigned char*)ldptr(F, 30); const InTab in_{F.lds}; gu32* ctl_ = (gu32*)ws_;

#if CHUNKED_SCAN
    if (blockIdx.x < 16) { chunk_states(F, ws_, blockIdx.x); if (PROBE_DUP == 16) { __syncthreads(); chunk_states(F, ws_, blockIdx.x); } __syncthreads(); }
#else
    if (blockIdx.x < 64) { scan_block(F, blockIdx.x); if (PROBE_DUP == 12) { __syncthreads(); scan_block(F, blockIdx.x); } return; }
#endif
    LAS int* qslot = (LAS int*)(F.lds + MISC_OFF + 64);
    for (;;) {
        if (F.tid == 0) qslot[0] = (int)__hip_atomic_fetch_add(ctl_ + CW_QUEUE + (l + 4 * qsel) * 64, 1u, RLX_AGENT);
        __syncthreads();
        const int u = qslot[0];
        __syncthreads();
        if (PROBE_DUP == 17) { if (u >= 1024 + 128 + 768) break; if (u < 1024) { const int uu = u >> 1; const int qb = 15 - (uu >> 5), bh = uu & 31; attn_unit(F, bh >> 3, bh & 7, qb); } else if (u < 1152) pool_batch(F, in_, ws_, l, u - 1024); else convert_moe_batch(F, in_, ws_, l, u - 1152); continue; }
        if (PROBE_DUP == 18) { if (u >= 512 + 128 + 1536) break; if (u < 512) { const int qb = 15 - (u >> 5), bh = u & 31; attn_unit(F, bh >> 3, bh & 7, qb); } else if (u < 640) pool_batch(F, in_, ws_, l, u - 512); else convert_moe_batch(F, in_, ws_, l, (u - 640) >> 1); continue; }
        if (u >= 512 + 128 + 768) break;
        if (u < 512) { const int qb = 15 - (u >> 5), bh = u & 31; attn_unit(F, bh >> 3, bh & 7, qb); }
        else if (u < 640) pool_batch(F, in_, ws_, l, u - 512);
        else convert_moe_batch(F, in_, ws_, l, u - 640);
    }
}

__device__ __forceinline__ void phase_post(Frame& F, int l) {
    refresh(F); unsigned char* ws_ = (unsigned char*)ldptr(F, 30); const InTab in_{F.lds}; gu32* ctl_ = (gu32*)ws_;

    const int gw = F.vcu * NWAVES + F.wave, NGW = F.G * NWAVES, c = F.lane;
    bf16_t* MX = (bf16_t*)(ws_ + WS_MIXED);
    {
        float lw[4], lb[4], rkw[4];
#pragma unroll
        for (int h = 0; h < 4; ++h) { lw[h] = in_[I_LNW][l * 256 + 64 * h + c]; lb[h] = in_[I_LNB][l * 256 + 64 * h + c]; rkw[h] = in_[I_RK][l * 256 + 64 * h + c]; }
        const float* YR = (const float*)(ws_ + WS_YRAW); const float* SCN = (const float*)(ws_ + WS_SCAN); const float* GG = (const float*)(ws_ + WS_G);
        for (int it0 = gw * 8; it0 < NTOK * 4; it0 += NGW * 8) {
            float y[8], vv[8], bn[8], gg[8];
#pragma unroll
            for (int u = 0; u < 8; ++u) {
                const int it = it0 + u, m = it >> 2, h = u & 3, b = m >> 12, t = m & (SEQ - 1);
                const float* sp = SCN + ((size_t)(b * 4 + h) * SEQ + t) * 384 + c;
                y[u] = YR[(size_t)m * 256 + 64 * h + c]; vv[u] = sp[192]; bn[u] = sp[0] * sp[128] * rkw[h]; gg[u] = GG[(size_t)m * 256 + 64 * h + c];
            }
#pragma unroll
            for (int u = 0; u < 8; ++u) {
                const int it = it0 + u, m = it >> 2, h = u & 3;
                const float mean = wave_sum(y[u]) * (1.f / 64.f); const float d = y[u] - mean; const float var = wave_sum(d * d) * (1.f / 64.f);
                float yn = d * (1.f / sqrtf(var + 64e-5f)) * lw[h] + lb[h];
                yn += wave_sum(bn[u]) * vv[u];
                yn *= gg[u];
                MX[(size_t)m * 1024 + 64 * h + c] = (bf16_t)f2bf(yn);
            }
        }
    }
}

__device__ __forceinline__ void phase_route(Frame& F, int l, int csel = 0) {
    refresh(F); unsigned char* ws_ = (unsigned char*)ldptr(F, 30); const InTab in_{F.lds}; gu32* ctl_ = (gu32*)ws_;

    LAS float* WT = (LAS float*)F.lds;
    LAS int* lcnt = (LAS int*)(F.lds + TAB_OFF);
    LAS int* lbase = lcnt + 32;
    LAS int* le = lbase + 32;
    LAS int* lpos = le + 256;
    { const float* rw = in_[I_RW] + (size_t)l * 1024 * 32;
      f32x4 t16[16];
#pragma unroll
      for (int u = 0; u < 16; ++u) t16[u] = *(const f32x4*)(rw + 4 * (F.tid + NTHR * u));
#pragma unroll
      for (int u = 0; u < 16; ++u) { const int i = F.tid + NTHR * u, k = i >> 3, e = (i & 7) * 4; WT[(e + 0) * 1024 + k] = t16[u].x; WT[(e + 1) * 1024 + k] = t16[u].y; WT[(e + 2) * 1024 + k] = t16[u].z; WT[(e + 3) * 1024 + k] = t16[u].w; } }
    const float* X = (const float*)(ws_ + WS_X); const float* MOD = (const float*)(ws_ + WS_MOD);
    const float* nw = in_[I_NORM2] + l * 1024;
    const float rb = in_[I_RB][l * 32 + (F.lane >> 1)];
    for (int tb = blockIdx.x; tb < NTOK / 64; tb += F.G) {
        if (F.tid < 32) lcnt[F.tid] = 0;
        __syncthreads();
        f32x4 xnx[4];
#pragma unroll
        for (int j = 0; j < 4; ++j) xnx[j] = *(const f32x4*)(X + (size_t)(tb * 64 + F.wave * 8) * 1024 + 4 * F.lane + 256 * j);
        for (int i = 0; i < 8; ++i) {
            const int ti = F.wave * 8 + i, m = tb * 64 + ti, b = m >> 12;
            const float* sh = MOD + (size_t)(l * 4 + b) * 6144 + 3 * 1024; const float* sc = sh + 1024;
            f32x4 hv[4]; float ss = 0.f;
#pragma unroll
            for (int j = 0; j < 4; ++j) { hv[j] = xnx[j]; ss += (hv[j].x * hv[j].x + hv[j].y * hv[j].y) + (hv[j].z * hv[j].z + hv[j].w * hv[j].w); }
            if (i < 7) {
#pragma unroll
                for (int j = 0; j < 4; ++j) xnx[j] = *(const f32x4*)(X + (size_t)(m + 1) * 1024 + 4 * F.lane + 256 * j);
            }
            const float rs = 1.f / sqrtf(wave_sum(ss) * (1.f / 1024.f) + 1e-6f);
            bf16_t* H = (bf16_t*)(ws_ + WS_H) + (size_t)m * 1024;
#pragma unroll
            for (int j = 0; j < 4; ++j) { const int c0 = 4 * F.lane + 256 * j; const f32x4 w = *(const f32x4*)(nw + c0), s1 = *(const f32x4*)(sc + c0), s0 = *(const f32x4*)(sh + c0);
                hv[j] = hv[j] * rs * w * (s1 + 1.f) + s0; u32x2 o; o.x = cvtpk(hv[j].x, hv[j].y); o.y = cvtpk(hv[j].z, hv[j].w); *(u32x2*)(H + c0) = o; }
            float a[32];
#pragma unroll
            for (int e = 0; e < 32; ++e) {
                float s = 0.f;
#pragma unroll
                for (int j = 0; j < 4; ++j) { const f32x4 w = *(const LAS f32x4*)(WT + e * 1024 + 4 * F.lane + 256 * j); s += hv[j].x * w.x + hv[j].y * w.y + hv[j].z * w.z + hv[j].w * w.w; }
                a[e] = s;
            }
#pragma unroll
            for (int q = 0; q < 16; ++q) { const auto rr = __builtin_amdgcn_permlane32_swap(__float_as_uint(a[q]), __float_as_uint(a[q + 16]), false, false); a[q] = __uint_as_float(rr[0]) + __uint_as_float(rr[1]); }
#pragma unroll
            for (int q = 0; q < 8; ++q) { const auto rr = __builtin_amdgcn_permlane16_swap(__float_as_uint(a[q]), __float_as_uint(a[q + 8]), false, false); a[q] = __uint_as_float(rr[0]) + __uint_as_float(rr[1]); }
#define RSTEP(N, BIT, SEL) { const bool up_ = (F.lane & (BIT)) != 0; _Pragma("unroll") for (int q = 0; q < (N); ++q) { const float send = up_ ? a[q] : a[q + (N)]; const float keep = up_ ? a[q + (N)] : a[q]; a[q] = keep + dpp_f(send, SEL); } }
            RSTEP(4, 8, 3) RSTEP(2, 4, 2) RSTEP(1, 2, 1)
#undef RSTEP
            float val = a[0] + dpp_f(a[0], 0) + rb;
            float tv[4]; int te[4];
#pragma unroll
            for (int k = 0; k < 4; ++k) {
                const float mx = wave_max(val);
                const unsigned long long bal = __ballot(val == mx);
                const int ln = __ffsll((long long)bal) - 1; const int e = ln >> 1;
                tv[k] = mx; te[k] = e;
                if ((F.lane >> 1) == e) val = -INFINITY;
            }
            const float e1 = __expf(tv[1] - tv[0]), e2 = __expf(tv[2] - tv[0]), e3 = __expf(tv[3] - tv[0]); const float invs = 1.f / (1.f + e1 + e2 + e3);
            if (F.lane < 4) {
                const int k = F.lane; const int e = (k == 0) ? te[0] : (k == 1) ? te[1] : (k == 2) ? te[2] : te[3];
                const float gt = ((k == 0) ? 1.f : (k == 1) ? e1 : (k == 2) ? e2 : e3) * invs;
                ((float*)(ws_ + WS_GATE))[(size_t)m * 4 + k] = gt;
                le[ti * 4 + k] = e; lpos[ti * 4 + k] = atomicAdd((int*)&lcnt[e], 1);
            }
        }
        __syncthreads();
        if (F.tid < 32) lbase[F.tid] = (int)__hip_atomic_fetch_add(ctl_ + CW_CNT + ((l + 4 * csel) * 32 + F.tid) * 64, (unsigned)lcnt[F.tid], RLX_AGENT);
        __syncthreads();
        if (F.tid < 256) { const int e = le[F.tid]; ((int*)(ws_ + WS_LIST))[e * NTOK + lbase[e] + lpos[F.tid]] = (tb * 64 + (F.tid >> 2)) * 4 + (F.tid & 3); }
        __syncthreads();
    }
}

constexpr int NPHASE = 2 + 9 * NL;
__global__ void __launch_bounds__(NTHR, 2) trunk_fwd(Args args) {
    extern __shared__ __attribute__((aligned(16))) unsigned char lds_raw[];
    Frame F;
    F.lds = (LAS unsigned char*)lds_raw;
    F.MISC = (volatile LAS unsigned*)(F.lds + MISC_OFF);
    F.tid = threadIdx.x; F.lane = F.tid & 63; F.wave = __builtin_amdgcn_readfirstlane(F.tid >> 6);
    F.G = gridDim.x; { const int bx = blockIdx.x; F.vcu = (F.G % 8 == 0) ? (bx % 8) * (F.G / 8) + bx / 8 : bx; }
    for (int u = F.tid; u < 64; u += NTHR) ((LAS unsigned*)(F.lds + MISC_OFF))[u] = 0u;
    if (F.tid < 29) *(LAS unsigned long long*)(F.lds + PTR_OFF + 8 * F.tid) = (unsigned long long)args.in[F.tid];
    if (F.tid == 29) *(LAS unsigned long long*)(F.lds + PTR_OFF + 8 * 29) = (unsigned long long)args.out;
    if (F.tid == 30) *(LAS unsigned long long*)(F.lds + PTR_OFF + 8 * 30) = (unsigned long long)args.ws;
    __syncthreads();
#if MK_PER_PHASE
#define GRID_BAR() do { } while (0)
#else
    XcdBarrier bar = xcd_barrier_post((unsigned*)(args.ws) + CW_BAR, F.MISC + 8);
#define GRID_BAR() xcd_barrier(bar)
#endif
    const int lo = args.ph_lo, hi = args.ph_hi;
#define IN(k) (lo <= (k) && (k) < hi)
#define SEAM(k) do { if (IN(k) && IN((k) + 1)) GRID_BAR(); } while (0)
    if (IN(0)) { phase_prologue(F); if (PROBE_DUP == 1) { GRID_BAR(); phase_prologue(F); } SEAM(0); }
    if (IN(1)) { phase_combine(F, -1); if (PROBE_DUP == 2) { GRID_BAR(); phase_combine(F, -1); } SEAM(1); }
    for (int l = 0; l < NL; ++l) {
        const int p0 = 2 + 9 * l;
        if (IN(p0)) {
            refresh(F); unsigned char* ws_ = (unsigned char*)ldptr(F, 30); const InTab in_{F.lds};
            ProbDense P{(const char*)(ws_ + WS_H), (const char*)(ws_ + WS_WIN) + (size_t)l * NPROJ * 2048, NTOK / 256, NPROJ / 256, F.G, F.vcu};
            EpiProj E{ws_};
            pg8::gemm_phase<false, 1024>(F.lds, nullptr, F.tid, P, E);
            if (PROBE_DUP == 3) { GRID_BAR(); pg8::gemm_phase<false, 1024>(F.lds, nullptr, F.tid, P, E); }
            SEAM(p0);
        }
        if (IN(p0 + 1)) {
            phase_prep(F, l); if (PROBE_DUP == 4) { GRID_BAR(); phase_prep(F, l); }
            GRID_BAR();
            refresh(F); unsigned char* ws_ = (unsigned char*)ldptr(F, 30); const InTab in_{F.lds};
            ProbLora P{(const char*)(ws_ + WS_ALORA), (const char*)(ws_ + WS_LORA) + (size_t)l * 768 * 512, F.G, F.vcu};
            EpiLora E{ws_, in_[I_W0] + l * 256, in_[I_A0] + l * 256, in_[I_KA] + l * 256};
            pg8::gemm_phase<false, 256>(F.lds, nullptr, F.tid, P, E);
            SEAM(p0 + 1);
        }
        if (IN(p0 + 2)) {
#if CHUNKED_SCAN
            { refresh(F); unsigned char* ws_ = (unsigned char*)ldptr(F, 30);
              ChunkRows cur = chunk_load(F, ws_, F.vcu);
              for (int job = F.vcu; job < 1024; job += F.G) {
                  ChunkRows nxt = cur; if (job + F.G < 1024) nxt = chunk_load(F, ws_, job + F.G);
                  chunk_job(F, ws_, job, cur); cur = nxt; } }
            GRID_BAR();
#endif
            phase_mix(F, l); if (PROBE_DUP == 5) { GRID_BAR(); phase_mix(F, l, 1); } SEAM(p0 + 2); }
        if (IN(p0 + 3)) {
#if CHUNKED_SCAN
            { refresh(F); unsigned char* ws_ = (unsigned char*)ldptr(F, 30); const InTab in_{F.lds};
              for (int jp = F.vcu; jp < 512; jp += F.G) {
                  const int job = jp * 2 + (F.wave >> 2);
                  chunk_out(F, ws_, job, F.wave & 3);
                  __syncthreads();
                  chunk_post(F, in_, ws_, l, job, F.wave & 3, (const LAS float*)F.lds + (F.wave >> 2) * 4096);
                  __syncthreads();
              } }
            SEAM(p0 + 3);
#else
            phase_post(F, l); if (PROBE_DUP == 6) { GRID_BAR(); phase_post(F, l); } SEAM(p0 + 3);
#endif
        }
        if (IN(p0 + 4)) {
            refresh(F); unsigned char* ws_ = (unsigned char*)ldptr(F, 30); const InTab in_{F.lds};
            ProbDense P{(const char*)(ws_ + WS_MIXED), (const char*)(ws_ + WS_WOUT) + (size_t)l * 1024 * 2048, NTOK / 256, 4, F.G, F.vcu};
            EpiOut E{(float*)(ws_ + WS_X), (const float*)(ws_ + WS_MOD) + (size_t)l * 4 * 6144 + 2 * 1024, 1.f};
            if (PROBE_DUP == 7) { EpiOut E0{(float*)(ws_ + WS_X), (const float*)(ws_ + WS_MOD) + (size_t)l * 4 * 6144 + 2 * 1024, 0.f}; pg8::gemm_phase<false, 1024>(F.lds, nullptr, F.tid, P, E0); GRID_BAR(); }
            pg8::gemm_phase<false, 1024>(F.lds, nullptr, F.tid, P, E);
            SEAM(p0 + 4);
        }
        if (IN(p0 + 5)) { phase_route(F, l); if (PROBE_DUP == 8) { GRID_BAR(); phase_route(F, l, 1); } SEAM(p0 + 5); }
        if (IN(p0 + 6)) {
            refresh(F); unsigned char* ws_ = (unsigned char*)ldptr(F, 30); const InTab in_{F.lds};
            MoeTab T = moe_table(F, l);
            ProbGU P{(const char*)(ws_ + WS_H), (const char*)(ws_ + WS_WGU), (const int*)(ws_ + WS_LIST), T, __builtin_amdgcn_readfirstlane(T.ntiles[0]) * 8, F.G, F.vcu, l};
            EpiGU E{(bf16_t*)(ws_ + WS_ACT), in_[I_BGU], l};
            pg8::gemm_phase<true, 1024>(F.lds, (LAS unsigned*)(F.lds + ROWTAB_OFF), F.tid, P, E);
            if (PROBE_DUP == 9) { GRID_BAR(); pg8::gemm_phase<true, 1024>(F.lds, (LAS unsigned*)(F.lds + ROWTAB_OFF), F.tid, P, E); }
            SEAM(p0 + 6);
        }
        if (IN(p0 + 7)) {
            refresh(F); unsigned char* ws_ = (unsigned char*)ldptr(F, 30); const InTab in_{F.lds};
            MoeTab T = moe_table(F, l);
            ProbDN P{(const char*)(ws_ + WS_ACT), (const char*)(ws_ + WS_WDN), T, __builtin_amdgcn_readfirstlane(T.ntiles[0]) * 4, F.G, F.vcu, l};
            EpiDN E{(bf16_t*)(ws_ + WS_YSLOT), in_[I_BDN], (const int*)(ws_ + WS_LIST), (const float*)(ws_ + WS_GATE), T, l};
            pg8::gemm_phase<false, 1024>(F.lds, nullptr, F.tid, P, E);
            if (PROBE_DUP == 10) { GRID_BAR(); pg8::gemm_phase<false, 1024>(F.lds, nullptr, F.tid, P, E); }
            SEAM(p0 + 7);
        }
        if (IN(p0 + 8)) { if (PROBE_DUP == 11) { phase_combine(F, l, 0.f); GRID_BAR(); } phase_combine(F, l); SEAM(p0 + 8); }
    }
#undef IN
#undef SEAM
#if !MK_PER_PHASE
    if (blockIdx.x == 0 && F.tid == 0 && xb_ld(bar.bar + XB_TMO) != 0u) { float* o = (float*)ldptr(F, 29); o[0] = __builtin_nanf(""); }
#endif
}

extern "C" void kernel_launch(void* const* d_in, const int* in_sizes, int n_in, void* d_out, int out_size, void* d_ws, size_t ws_size, hipStream_t stream) {
    static int grid = 0;
    if (grid == 0) {
        if (n_in != 29 || out_size != NTOK * DM || ws_size < WS_END) { fprintf(stderr, "kernel_launch: unexpected sizes n_in %d out %d ws %zu (need %zu)\n", n_in, out_size, ws_size, (size_t)WS_END); grid = -1; return; }
        int dev = 0, cus = 0;
        if (hipGetDevice(&dev) != hipSuccess || hipDeviceGetAttribute(&cus, hipDeviceAttributeMultiprocessorCount, dev) != hipSuccess) { grid = -1; return; }
        if (hipFuncSetAttribute((const void*)trunk_fwd, hipFuncAttributeMaxDynamicSharedMemorySize, LDS_BYTES) != hipSuccess) { fprintf(stderr, "kernel_launch: hipFuncSetAttribute failed\n"); grid = -1; return; }
        int per_cu = 0;
        if (hipOccupancyMaxActiveBlocksPerMultiprocessor(&per_cu, (const void*)trunk_fwd, NTHR, LDS_BYTES) != hipSuccess || per_cu < 1) fprintf(stderr, "kernel_launch: occupancy query reports %d\n", per_cu);
        (void)hipGetLastError();
        grid = cus;
    }
    if (grid < 0) return;
    (void)hipMemsetAsync((char*)d_ws + WS_CTL, 0, CTL_ZERO_BYTES, stream);
    Args a{};
    for (int i = 0; i < 29; ++i) a.in[i] = (const float*)d_in[i];
    a.out = (float*)d_out; a.ws = (unsigned char*)d_ws;
#if MK_PER_PHASE
    for (int p = 0; p < NPHASE; ++p) { a.ph_lo = p; a.ph_hi = p + 1; hipLaunchKernelGGL(trunk_fwd, dim3(grid), dim3(NTHR), LDS_BYTES, stream, a); }
#else
    a.ph_lo = 0; a.ph_hi = NPHASE;
    hipLaunchKernelGGL(trunk_fwd, dim3(grid), dim3(NTHR), LDS_BYTES, stream, a);
#endif
}
```

```cpp
#include <hip/hip_runtime.h>
#include <cstdio>
#include <cstdint>
#include <cmath>

#ifndef MK_PER_PHASE
#define MK_PER_PHASE 0
#endif

#ifndef TAIL_CONVERT
#define TAIL_CONVERT 1
#endif
#ifndef CHUNKED_SCAN
#define CHUNKED_SCAN 1
#endif
#ifndef PROBE_T
#define PROBE_T -1
#endif
#ifndef PROBE_DUP
#define PROBE_DUP 0
#endif
#define GAS __attribute__((address_space(1)))
#define LAS __attribute__((address_space(3)))
typedef unsigned short bf16_t;
typedef short bf16x8 __attribute__((ext_vector_type(8)));
typedef short s16x4 __attribute__((ext_vector_type(4)));
typedef float f32x2 __attribute__((ext_vector_type(2)));
typedef float f32x4 __attribute__((ext_vector_type(4)));
typedef float f32x16 __attribute__((ext_vector_type(16)));
typedef unsigned u32x2 __attribute__((ext_vector_type(2)));
typedef unsigned u32x4 __attribute__((ext_vector_type(4)));
typedef GAS unsigned gu32;


constexpr int NB = 4, SEQ = 4096, DM = 1024, NL = 4, NTOK = NB * SEQ;
constexpr int PIN = 2824, NPROJ = 2816;
constexpr int NE = 32, TOPK = 4;
constexpr int NWAVES = 8, NTHR = 512;
constexpr float LOG2E = 1.4426950408889634f;
constexpr float QSCALE = 0.125f * LOG2E;

constexpr size_t MiB = (size_t)1 << 20;
constexpr size_t WS_CTL = 0, CTL_ZERO_BYTES = 1 * MiB;
constexpr size_t WS_MOD = 1 * MiB;
constexpr size_t WS_FLOG = 2 * MiB;
constexpr size_t WS_BIAS = 3 * MiB;
constexpr size_t WS_ALORA = 4 * MiB;
constexpr size_t WS_GATE = 12 * MiB;
constexpr size_t WS_LIST = 13 * MiB;
constexpr size_t WS_WIN = 16 * MiB;
constexpr size_t WS_LORA = 38 * MiB;
constexpr size_t WS_WOUT = 40 * MiB;
constexpr size_t WS_WGU = 48 * MiB;
constexpr size_t WS_WDN = 560 * MiB;
constexpr size_t WS_X = 816 * MiB;
constexpr size_t WS_H = 880 * MiB;
constexpr size_t WS_ZR = 912 * MiB;
constexpr size_t WS_ZP = 976 * MiB;
constexpr size_t WS_Q = 992 * MiB, WS_K = 1008 * MiB, WS_V = 1024 * MiB;
constexpr size_t WS_SCAN = 1040 * MiB;
constexpr int SCAN_ROW = 896;
constexpr size_t WS_G = 1136 * MiB;
constexpr size_t WS_YRAW = 1152 * MiB;
constexpr size_t WS_MIXED = 1168 * MiB;
constexpr size_t WS_ACT = 1200 * MiB;
constexpr size_t WS_YSLOT = 1344 * MiB;
constexpr size_t WS_CPG = 1472 * MiB;
constexpr size_t WS_CPSI = 1496 * MiB;
constexpr size_t WS_CY0 = 1504 * MiB;
constexpr size_t WS_CS = 1520 * MiB;
constexpr size_t WS_END = 1528 * MiB;

constexpr int CW_TMO = 0, CW_CODE = 1;
constexpr int CW_BAR = 4096;
constexpr int CW_CNT = 16384;
constexpr int CW_QUEUE = 40960;
constexpr int CW_CQ = 49152;

constexpr int RING_BYTES = 131072;
constexpr int LDS_BYTES = 147456;
constexpr int LDSCTL_OFF = 139264;
constexpr int MISC_OFF = LDSCTL_OFF;
constexpr int PTR_OFF = LDSCTL_OFF + 256;
constexpr int TAB_OFF = LDSCTL_OFF + 512;
constexpr int ROWTAB_OFF = LDSCTL_OFF + 4096;
constexpr int PCV_OFF = LDSCTL_OFF + 6144;

#define RLX_AGENT __ATOMIC_RELAXED, __HIP_MEMORY_SCOPE_AGENT
#define LDS_WAIT() asm volatile("s_waitcnt lgkmcnt(0)" ::: "memory")
#define VM_WAIT() asm volatile("s_waitcnt vmcnt(0)" ::: "memory")

__device__ __forceinline__ unsigned f2bf(float f) { unsigned u = __builtin_bit_cast(unsigned, f); return (u + 0x7fffu + ((u >> 16) & 1u)) >> 16; }
__device__ __forceinline__ unsigned pk2(float lo, float hi) { return f2bf(lo) | (f2bf(hi) << 16); }
typedef __bf16 bf16x2_t __attribute__((ext_vector_type(2)));
__device__ __forceinline__ unsigned cvtpk(float lo, float hi) { const f32x2 v = {lo, hi}; const bf16x2_t b = __builtin_convertvector(v, bf16x2_t); return __builtin_bit_cast(unsigned, b); }
__device__ __forceinline__ f32x4 unp4(u32x2 p) { return (f32x4){__builtin_bit_cast(float, p.x << 16), __builtin_bit_cast(float, p.x & 0xffff0000u), __builtin_bit_cast(float, p.y << 16), __builtin_bit_cast(float, p.y & 0xffff0000u)}; }
__device__ __forceinline__ u32x2 pk4(f32x4 v) { return (u32x2){cvtpk(v.x, v.y), cvtpk(v.z, v.w)}; }
__device__ __forceinline__ u32x4 pk8(f32x4 a, f32x4 b) { return (u32x4){cvtpk(a.x, a.y), cvtpk(a.z, a.w), cvtpk(b.x, b.y), cvtpk(b.z, b.w)}; }
__device__ __forceinline__ float bf2f(unsigned short b) { return __builtin_bit_cast(float, (unsigned)b << 16); }
__device__ __forceinline__ float dpp_f(float v, const int ctrl_sel) {
    const int iv = __builtin_bit_cast(int, v); int r;
    switch (ctrl_sel) { case 0: r = __builtin_amdgcn_update_dpp(0, iv, 0xB1, 0xf, 0xf, true); break; case 1: r = __builtin_amdgcn_update_dpp(0, iv, 0x4E, 0xf, 0xf, true); break;
                        case 2: r = __builtin_amdgcn_update_dpp(0, iv, 0x141, 0xf, 0xf, true); break; default: r = __builtin_amdgcn_update_dpp(0, iv, 0x140, 0xf, 0xf, true); break; }
    return __builtin_bit_cast(float, r);
}
__device__ __forceinline__ float red16(float v) { v += dpp_f(v, 0); v += dpp_f(v, 1); v += dpp_f(v, 2); v += dpp_f(v, 3); return v; }
__device__ __forceinline__ float fma_s(float a, float b, float c) { float d; asm("v_fma_f32 %0, %1, %2, %3" : "=v"(d) : "v"(a), "v"(b), "v"(c)); return d; }
__device__ __forceinline__ float fnma_s(float a, float b, float c) { float d; asm("v_fma_f32 %0, -%1, %2, %3" : "=v"(d) : "v"(a), "v"(b), "v"(c)); return d; }
__device__ __forceinline__ float mul_s(float a, float b) { float d; asm("v_mul_f32_e32 %0, %1, %2" : "=v"(d) : "v"(a), "v"(b)); return d; }
__device__ __forceinline__ float add_s(float a, float b) { float d; asm("v_add_f32_e32 %0, %1, %2" : "=v"(d) : "v"(a), "v"(b)); return d; }
__device__ __forceinline__ void red16_pair(float& a, float& b) {
    asm volatile("s_nop 1\n\t"
                 "v_add_f32_dpp %0, %0, %0 quad_perm:[1,0,3,2] row_mask:0xf bank_mask:0xf bound_ctrl:1\n\t"
                 "v_add_f32_dpp %1, %1, %1 quad_perm:[1,0,3,2] row_mask:0xf bank_mask:0xf bound_ctrl:1\n\t"
                 "s_nop 0\n\t"
                 "v_add_f32_dpp %0, %0, %0 quad_perm:[2,3,0,1] row_mask:0xf bank_mask:0xf bound_ctrl:1\n\t"
                 "v_add_f32_dpp %1, %1, %1 quad_perm:[2,3,0,1] row_mask:0xf bank_mask:0xf bound_ctrl:1\n\t"
                 "s_nop 0\n\t"
                 "v_add_f32_dpp %0, %0, %0 row_half_mirror row_mask:0xf bank_mask:0xf bound_ctrl:1\n\t"
                 "v_add_f32_dpp %1, %1, %1 row_half_mirror row_mask:0xf bank_mask:0xf bound_ctrl:1\n\t"
                 "s_nop 0\n\t"
                 "v_add_f32_dpp %0, %0, %0 row_mirror row_mask:0xf bank_mask:0xf bound_ctrl:1\n\t"
                 "v_add_f32_dpp %1, %1, %1 row_mirror row_mask:0xf bank_mask:0xf bound_ctrl:1\n\t"
                 "s_nop 0"
                 : "+v"(a), "+v"(b));
}
__device__ __forceinline__ float wave_sum(float v) {
    v = red16(v);
    { const auto rr = __builtin_amdgcn_permlane16_swap(__float_as_uint(v), __float_as_uint(v), false, false); v = __uint_as_float(rr[0]) + __uint_as_float(rr[1]); }
    { const auto rr = __builtin_amdgcn_permlane32_swap(__float_as_uint(v), __float_as_uint(v), false, false); v = __uint_as_float(rr[0]) + __uint_as_float(rr[1]); }
    return v;
}
__device__ __forceinline__ float wave_max(float v) {
    v = fmaxf(v, dpp_f(v, 0)); v = fmaxf(v, dpp_f(v, 1)); v = fmaxf(v, dpp_f(v, 2)); v = fmaxf(v, dpp_f(v, 3));
    { const auto rr = __builtin_amdgcn_permlane16_swap(__float_as_uint(v), __float_as_uint(v), false, false); v = fmaxf(__uint_as_float(rr[0]), __uint_as_float(rr[1])); }
    { const auto rr = __builtin_amdgcn_permlane32_swap(__float_as_uint(v), __float_as_uint(v), false, false); v = fmaxf(__uint_as_float(rr[0]), __uint_as_float(rr[1])); }
    return v;
}
__device__ __forceinline__ float sigmoidf_(float x) { return 1.f / (1.f + __expf(-x)); }
__device__ __forceinline__ float softplusf_(float u) { return fmaxf(u, 0.f) + log1pf(__expf(-fabsf(u))); }
__device__ __forceinline__ float softplus_fast(float u) { return fmaxf(u, 0.f) + __logf(1.f + __expf(-fabsf(u))); }

#define XB_TMO      128
#define XB_XCNT(j)  (256  + 64 * (j))
#define XB_XSUB(j)  (1280 + 64 * (j))
#define XB_XGEN(j)  (2304 + 64 * (j))
#define XB_TOP      3328
#define XB_TOPGEN   3392
#define XCD_BAR_WORDS 3456
#define XB_SPIN_CAP (1u << 18)
__device__ __forceinline__ unsigned xb_ld(unsigned* p)              { return __hip_atomic_load(p, __ATOMIC_RELAXED, __HIP_MEMORY_SCOPE_AGENT); }
__device__ __forceinline__ unsigned xb_add(unsigned* p, unsigned v) { return __hip_atomic_fetch_add(p, v, __ATOMIC_RELAXED, __HIP_MEMORY_SCOPE_AGENT); }
__device__ __forceinline__ unsigned xb_xcc_id() { return (unsigned)__builtin_amdgcn_s_getreg((3 << 11) | 20) & 0xFu; }
#define XB_SPIN(cond, bar) do { unsigned _sp = 0; while (cond) { __builtin_amdgcn_s_sleep(1); \
    if ((++_sp & 255u) == 0u) { if (xb_ld(&(bar)[XB_TMO])) break; if (_sp > XB_SPIN_CAP) { atomicAdd(&(bar)[XB_TMO], 1u); break; } } } } while (0)
struct XcdBarrier { unsigned* bar; unsigned x; volatile LAS unsigned* st; };
__device__ __forceinline__ XcdBarrier xcd_barrier_post(unsigned* bar, volatile LAS unsigned* st) {
    XcdBarrier b; b.bar = bar; b.x = xb_xcc_id(); b.st = st;
    if (threadIdx.x == 0) (void)xb_add(&bar[XB_XCNT(b.x)], 1u);
    return b;
}
__device__ __forceinline__ void xcd_barrier_complete(unsigned* bar, unsigned x, unsigned& nloc, unsigned& nx) {
    const unsigned G = gridDim.x * gridDim.y * gridDim.z;
    unsigned sum, cnt, mine, sp = 0u;
    for (;;) {
        sum = 0u; cnt = 0u; mine = 0u;
#pragma unroll
        for (unsigned j = 0; j < 16; ++j) { const unsigned c = xb_ld(&bar[XB_XCNT(j)]); sum += c; cnt += (c > 0u) ? 1u : 0u; mine = (j == x) ? c : mine; }
        if (sum == G) break;
        __builtin_amdgcn_s_sleep(1);
        if ((++sp & 255u) == 0u) { if (xb_ld(&bar[XB_TMO])) break; if (sp > XB_SPIN_CAP) { atomicAdd(&bar[XB_TMO], 1u); break; } }
    }
    nloc = mine > 0u ? mine : 1u; nx = cnt > 0u ? cnt : 1u;
}
__device__ __forceinline__ void xcd_barrier(const XcdBarrier& b) {
    asm volatile("s_waitcnt vmcnt(0)" ::: "memory");
    __syncthreads();
    if (threadIdx.x == 0) {
        unsigned* bar = b.bar;
        __builtin_amdgcn_s_waitcnt(0);
        unsigned nloc = b.st[0], nx = b.st[1];
        if (nloc == 0u) { xcd_barrier_complete(bar, b.x, nloc, nx); b.st[0] = nloc; b.st[1] = nx; }
        const unsigned old = xb_add(&bar[XB_XSUB(b.x)], 1u);
        const unsigned gen = old / nloc;
        if (old + 1u == (gen + 1u) * nloc) {
            __builtin_amdgcn_fence(__ATOMIC_RELEASE, "agent");
            asm volatile("s_waitcnt vmcnt(0)" ::: "memory");
            const unsigned og = xb_add(&bar[XB_TOP], 1u);
            const unsigned tg = og / nx;
            if (og + 1u == (tg + 1u) * nx) xb_add(&bar[XB_TOPGEN], 1u);
            else XB_SPIN(xb_ld(&bar[XB_TOPGEN]) == tg, bar);
            __builtin_amdgcn_fence(__ATOMIC_ACQUIRE, "agent");
            xb_add(&bar[XB_XGEN(b.x)], 1u);
            asm volatile("s_waitcnt vmcnt(0)" ::: "memory");
        } else {
            XB_SPIN(xb_ld(&bar[XB_XGEN(b.x)]) == gen, bar);
            __builtin_amdgcn_fence(__ATOMIC_ACQUIRE, "agent");
            asm volatile("s_waitcnt vmcnt(0)" ::: "memory");
        }
    }
    __syncthreads();
}

namespace pg8 {
constexpr int BM = 256, BK = 64, HALF = 128, HTB = HALF * BK * 2, STAGE_BYTES = 8 * HTB;
__device__ __forceinline__ int lds_byte(int r, int c) { const int st = (r >> 4) * 2 + (c >> 5), rr = r & 15, cc = c & 31, ob = rr * 64 + cc * 2; return st * 1024 + (ob ^ (((ob >> 9) & 1) << 5)); }
__device__ __forceinline__ void stage_rc(int b, int& R, int& C) { const int st = b / 1024, sb = b % 1024, swz = sb ^ (((sb >> 9) & 1) << 5); R = (st >> 1) * 16 + swz / 64; C = (st & 1) * 32 + (swz % 64) / 2; }
__device__ __forceinline__ int perm32(int rho) { const int n = rho >> 4, i = rho & 15; return 8 * (i >> 2) + 4 * n + (i & 3); }
struct Unit { int pm, pn, e; };
__device__ __forceinline__ unsigned cvt_pk_bf16(float lo, float hi) { unsigned r; asm volatile("v_cvt_pk_bf16_f32 %0, %1, %2" : "=v"(r) : "v"(lo), "v"(hi)); return r; }

template <bool GATHER, int K, class Prob, class Epi>
__device__ __forceinline__ void gemm_phase(LAS unsigned char* lds, LAS unsigned* rowtab  , const int tid, const Prob& S, const Epi& E) {
    const int wid = __builtin_amdgcn_readfirstlane(tid >> 6), lane = tid & 63, wr = wid >> 2, wc = wid & 3, fr = lane & 15, fq = lane >> 4;
    constexpr int nt = K / BK; static_assert(K % 128 == 0 && K >= 256 && (!GATHER || K == 1024), "K");
    unsigned voffA[2], voffB[2];
#pragma unroll
    for (int i = 0; i < 2; ++i) { int R, C; stage_rc(tid * 16 + i * 8192, R, C); const int Rb = (R & ~31) + perm32(R & 31); voffA[i] = (unsigned)(R * K + C) * 2u; voffB[i] = (unsigned)(Rb * K + C) * 2u; }
    constexpr size_t kstep = (size_t)(BK * 2);
    constexpr size_t hstep = (size_t)HALF * K * 2;
    const unsigned ldsw = (unsigned)wid * 1024u;
    const int aoff = lds_byte(wr * 64 + fr, fq * 8), boff = lds_byte(wc * 32 + fr, fq * 8);
#define PG8_SA(b, h) (((b) * 2 + (h)) * HTB)
#define PG8_SB(b, h) ((4 + (b) * 2 + (h)) * HTB)
#define PG8_STAGEB(bufoff, gbase) do { _Pragma("unroll") for (int _i = 0; _i < 2; ++_i) \
        __builtin_amdgcn_global_load_lds((const unsigned*)((const char*)(gbase) + voffB[_i]), (LAS unsigned*)(lds + (bufoff) + ldsw + _i * 8192), 16, 0, 0); } while (0)
#define PG8_STAGEA2(bufoff, gbase, o0, o1) do { \
        __builtin_amdgcn_global_load_lds((const unsigned*)((const char*)(gbase) + (o0)), (LAS unsigned*)(lds + (bufoff) + ldsw), 16, 0, 0); \
        __builtin_amdgcn_global_load_lds((const unsigned*)((const char*)(gbase) + (o1)), (LAS unsigned*)(lds + (bufoff) + ldsw + 8192), 16, 0, 0); } while (0)
#define PG8_STAGEA_C(bufoff, gbase, h) do { if constexpr (GATHER) PG8_STAGEA2(bufoff, gbase, oc[h][0], oc[h][1]); else PG8_STAGEA2(bufoff, (gbase) + (h) * hstep, voffA[0], voffA[1]); } while (0)
#define PG8_LDA(dst, b, h) do { _Pragma("unroll") for (int m = 0; m < 4; ++m) _Pragma("unroll") for (int k = 0; k < 2; ++k) dst[m][k] = *(const LAS bf16x8*)(lds + PG8_SA(b, h) + aoff + m * 2048 + k * 1024); } while (0)
#define PG8_LDB(dst, b, h) do { _Pragma("unroll") for (int n = 0; n < 2; ++n) _Pragma("unroll") for (int k = 0; k < 2; ++k) dst[n][k] = *(const LAS bf16x8*)(lds + PG8_SB(b, h) + boff + n * 2048 + k * 1024); } while (0)
#define PG8_MMA(ai, bj, At, Bt) do { __builtin_amdgcn_s_setprio(1); _Pragma("unroll") for (int m = 0; m < 4; ++m) _Pragma("unroll") for (int n = 0; n < 2; ++n) _Pragma("unroll") for (int k = 0; k < 2; ++k) \
        acc[ai][bj][m][n] = __builtin_amdgcn_mfma_f32_16x16x32_bf16(Bt[n][k], At[m][k], acc[ai][bj][m][n], 0, 0, 0); __builtin_amdgcn_s_setprio(0); } while (0)
#define PG8_WAIT_V(n) asm volatile("s_waitcnt vmcnt(" #n ")" ::: "memory")
#define PG8_WAIT_L(n) asm volatile("s_waitcnt lgkmcnt(" #n ")" ::: "memory")
#define PG8_BAR __builtin_amdgcn_s_barrier()
#define PG8_SCHED __builtin_amdgcn_sched_barrier(0)
    Unit cur, nxt; int ui = 0;
    if (!S.next(0, cur)) return;
    f32x4 acc[2][2][4][2];
#pragma unroll
    for (int a = 0; a < 2; ++a)
#pragma unroll
        for (int b = 0; b < 2; ++b)
#pragma unroll
            for (int m = 0; m < 4; ++m)
#pragma unroll
                for (int n = 0; n < 2; ++n) acc[a][b][m][n] = (f32x4){0.f, 0.f, 0.f, 0.f};
    bf16x8 At[4][2], B0[2][2], B1[2][2];
    const char* cA = S.a_ptr(cur); const char* cB = S.b_ptr(cur);
    unsigned oc[2][2];
    if constexpr (GATHER) {
#pragma unroll
        for (int h = 0; h < 2; ++h)
#pragma unroll
            for (int i = 0; i < 2; ++i) oc[h][i] = S.row_off(cur, h * 128 + (int)(voffA[i] >> 11)) + (voffA[i] & 2047u);
    }
    PG8_STAGEB(PG8_SB(0, 0), cB); PG8_STAGEB(PG8_SB(0, 1), cB + hstep); PG8_STAGEA_C(PG8_SA(0, 0), cA, 0); PG8_STAGEA_C(PG8_SA(0, 1), cA, 1);
    if (wr == 1) PG8_BAR;
    PG8_WAIT_V(2); PG8_BAR;
    PG8_STAGEB(PG8_SB(1, 0), cB + kstep); PG8_STAGEA_C(PG8_SA(1, 0), cA + kstep, 0); PG8_STAGEB(PG8_SB(1, 1), cB + hstep + kstep);
    PG8_WAIT_V(6); PG8_BAR;
    for (;;) {
        const bool has_next = S.next(ui + 1, nxt);
        const char* nA = cA; const char* nB = cB;
        if (has_next) { nA = S.a_ptr(nxt); nB = S.b_ptr(nxt); }
        if constexpr (GATHER) { if (has_next && tid < 256) rowtab[((ui + 1) & 1) * 256 + tid] = S.row_off(nxt, tid); }
#pragma nounroll
        for (int t = 0; t < nt; t += 2) {
            const bool last = (t == nt - 2);
            const char* a1 = cA + (size_t)(t + 1) * kstep;
            const char* a2 = last ? nA : cA + (size_t)(t + 2) * kstep; const char* b2 = last ? nB : cB + (size_t)(t + 2) * kstep;
            const char* a3 = a2 + kstep; const char* b3 = b2 + kstep;
            PG8_LDB(B0, 0, 0); PG8_LDB(B1, 0, 1); PG8_SCHED; PG8_LDA(At, 0, 0); PG8_STAGEA_C(PG8_SA(1, 1), a1, 1);
            if constexpr (GATHER) { if (last && has_next) {
#pragma unroll
                for (int h = 0; h < 2; ++h)
#pragma unroll
                    for (int i = 0; i < 2; ++i) oc[h][i] = rowtab[((ui + 1) & 1) * 256 + h * 128 + (int)(voffA[i] >> 11)] + (voffA[i] & 2047u); } }
            PG8_WAIT_V(8); PG8_WAIT_L(0); PG8_BAR; PG8_MMA(0, 0, At, B0); PG8_MMA(0, 1, At, B1); PG8_BAR; PG8_SCHED;
            PG8_LDA(At, 0, 1); PG8_STAGEB(PG8_SB(0, 0), b2); PG8_STAGEB(PG8_SB(0, 1), b2 + hstep); PG8_STAGEA_C(PG8_SA(0, 0), a2, 0);
            PG8_WAIT_V(8); PG8_WAIT_L(0); PG8_BAR; PG8_MMA(1, 0, At, B0); PG8_MMA(1, 1, At, B1); PG8_BAR; PG8_SCHED;
            PG8_LDB(B0, 1, 0); PG8_LDB(B1, 1, 1); PG8_SCHED; PG8_LDA(At, 1, 0); PG8_STAGEA_C(PG8_SA(0, 1), a2, 1);
            PG8_WAIT_V(8); PG8_WAIT_L(0); PG8_BAR; PG8_MMA(0, 0, At, B0); PG8_MMA(0, 1, At, B1); PG8_BAR; PG8_SCHED;
            PG8_LDA(At, 1, 1); PG8_STAGEB(PG8_SB(1, 0), b3); PG8_STAGEB(PG8_SB(1, 1), b3 + hstep); PG8_STAGEA_C(PG8_SA(1, 0), a3, 0);
            PG8_WAIT_V(8); PG8_WAIT_L(0); PG8_BAR; PG8_MMA(1, 0, At, B0); PG8_MMA(1, 1, At, B1); PG8_BAR; PG8_SCHED;
        }
        if (wr == 0) PG8_BAR;
        E(acc, cur, wr, wc, fr, fq);
        if (!has_next) break;
#pragma unroll
        for (int a = 0; a < 2; ++a)
#pragma unroll
            for (int b = 0; b < 2; ++b)
#pragma unroll
                for (int m = 0; m < 4; ++m)
#pragma unroll
                    for (int n = 0; n < 2; ++n) acc[a][b][m][n] = (f32x4){0.f, 0.f, 0.f, 0.f};
        cur = nxt; cA = nA; cB = nB; ++ui;
        if (wr == 1) PG8_BAR;
    }
    PG8_WAIT_V(0);
    PG8_BAR;
#undef PG8_SA
#undef PG8_SB
#undef PG8_STAGEA2
#undef PG8_STAGEA_C
#undef PG8_STAGEB
#undef PG8_LDA
#undef PG8_LDB
#undef PG8_MMA
#undef PG8_WAIT_V
#undef PG8_WAIT_L
#undef PG8_BAR
#undef PG8_SCHED
}
}

struct Frame {
    LAS unsigned char* lds;
    volatile LAS unsigned* MISC;
    int tid, lane, wave, vcu, G;
};
struct Args { const float* in[29]; float* out; unsigned char* ws; int ph_lo, ph_hi; };
__device__ __forceinline__ unsigned long long ldptr_raw(LAS unsigned char* lds, int i) {
    const unsigned long long v = *(const LAS unsigned long long*)(lds + PTR_OFF + 8 * i);
    const unsigned lo = __builtin_amdgcn_readfirstlane((unsigned)v), hi = __builtin_amdgcn_readfirstlane((unsigned)(v >> 32));
    return ((unsigned long long)hi << 32) | lo;
}
__device__ __forceinline__ void* ldptr(const Frame& F, int i) { return (void*)(GAS unsigned char*)ldptr_raw(F.lds, i); }
struct InTab { LAS unsigned char* lds; __device__ __forceinline__ const float* operator[](int i) const { return (const float*)(const GAS float*)ldptr_raw(lds, i); } };
__device__ __forceinline__ void refresh(Frame& F) { int t = F.tid; asm volatile("" : "+v"(t)); F.tid = t; F.lane = t & 63; F.wave = __builtin_amdgcn_readfirstlane(t >> 6); }


enum { I_X = 0, I_C, I_ADAW, I_ADAB, I_NORM1, I_WIN, I_WOUT, I_MU, I_W0, I_WUP, I_A0, I_AUP, I_GUP, I_KK, I_KA, I_RK, I_LNW, I_LNB, I_POOLW, I_POOLS, I_BF, I_NORM2, I_RW, I_RB, I_WGU, I_BGU, I_WDN, I_BDN, I_NORMF };

__device__ __forceinline__ void transpose_item(const float* W, int ldw, bf16_t* WT, int dst_row0, int k0, int n0, LAS float* scr, int lane) {
    float tmp[32];
#pragma unroll
    for (int i = 0; i < 32; ++i) { const int kk = 2 * i + (lane >> 5); tmp[i] = __builtin_nontemporal_load(W + (size_t)(k0 + kk) * ldw + n0 + (lane & 31)); }
#pragma unroll
    for (int i = 0; i < 32; ++i) { const int kk = 2 * i + (lane >> 5); scr[kk * 33 + (lane & 31)] = tmp[i]; }
    LDS_WAIT(); asm volatile("" ::: "memory");
    const int c = lane & 7;
#pragma unroll
    for (int j = 0; j < 4; ++j) { const int n = (lane >> 3) + 8 * j; const LAS float* s = scr + (8 * c) * 33 + n;
        u32x4 o; o.x = cvtpk(s[0 * 33], s[1 * 33]); o.y = cvtpk(s[2 * 33], s[3 * 33]); o.z = cvtpk(s[4 * 33], s[5 * 33]); o.w = cvtpk(s[6 * 33], s[7 * 33]);
        *(GAS u32x4*)(WT + (size_t)(dst_row0 + n) * 1024 + k0 + 8 * c) = o; }
    LDS_WAIT(); asm volatile("" ::: "memory");
}

__device__ __forceinline__ void convert_moe_batch(Frame& F, const InTab& in_, unsigned char* ws_, int l, int q);
__device__ __forceinline__ void phase_prologue(Frame& F) {
    refresh(F); unsigned char* ws_ = (unsigned char*)ldptr(F, 30); const InTab in_{F.lds}; gu32* ctl_ = (gu32*)ws_;

    if (blockIdx.x < 192) {
        LAS float* cond = (LAS float*)F.lds;
        LAS float* part = (LAS float*)(F.lds + 16384);
        const float* c = in_[I_C];
        for (int i = F.tid; i < 4096; i += NTHR) { const float v = c[i]; cond[i] = v / (1.f + __expf(-v)); }
        __syncthreads();
        const int l = blockIdx.x / 48, col0 = (blockIdx.x % 48) * 128;
        const float* W = in_[I_ADAW] + (size_t)l * 1024 * 6144 + col0 + 2 * F.lane;
        float a[4][2];
#pragma unroll
        for (int b = 0; b < 4; ++b) { a[b][0] = 0.f; a[b][1] = 0.f; }
        const int kb = F.wave * 128;
#pragma unroll 8
        for (int k = kb; k < kb + 128; ++k) {
            const f32x2 w = __builtin_nontemporal_load((const f32x2*)(W + (size_t)k * 6144));
#pragma unroll
            for (int b = 0; b < 4; ++b) { const float cv = cond[b * 1024 + k]; a[b][0] += cv * w.x; a[b][1] += cv * w.y; }
        }
#pragma unroll
        for (int b = 0; b < 4; ++b) { part[(F.wave * 4 + b) * 128 + 2 * F.lane] = a[b][0]; part[(F.wave * 4 + b) * 128 + 2 * F.lane + 1] = a[b][1]; }
        __syncthreads();
        { const int b = F.tid >> 7, cc = F.tid & 127; float s = in_[I_ADAB][l * 6144 + col0 + cc];
#pragma unroll
          for (int w = 0; w < 8; ++w) s += part[(w * 4 + b) * 128 + cc];
          ((float*)(ws_ + WS_MOD))[(l * 4 + b) * 6144 + col0 + cc] = s; }
        __syncthreads();
    }
    {
        bf16_t* LT = (bf16_t*)(ws_ + WS_LORA);
        const float* wu = in_[I_WUP]; const float* au = in_[I_AUP]; const float* gu = in_[I_GUP];
        for (int idx = blockIdx.x * NTHR + F.tid; idx < NL * 768 * 256; idx += F.G * NTHR) {
            const int k = idx & 255, n = (idx >> 8) % 768, l = idx / (768 * 256);
            float v = 0.f;
            if (n < 256) { if (k < 64) v = wu[((size_t)l * 64 + k) * 256 + n]; }
            else if (n < 512) { if (k >= 64 && k < 128) v = au[((size_t)l * 64 + (k - 64)) * 256 + (n - 256)]; }
            else { if (k >= 128) v = gu[((size_t)l * 128 + (k - 128)) * 256 + (n - 512)]; }
            LT[idx] = (bf16_t)f2bf(v);
        }
    }
    LAS float* scr = (LAS float*)(F.lds + F.wave * 16384);
    const int gw = F.vcu * NWAVES + F.wave, NGW = F.G * NWAVES;
    constexpr int I_A = NL * 16 * 88, I_B = NL * 16 * 32;
    for (int it = gw; it < I_A + I_B; it += NGW) {
        int r = it;
        if (r < I_A) { const int l = r / (16 * 88), q = r % (16 * 88), kb = q / 88, nb = q % 88;
            transpose_item(in_[I_WIN] + (size_t)l * 1024 * PIN, PIN, (bf16_t*)(ws_ + WS_WIN) + (size_t)l * NPROJ * 1024, 32 * nb, 64 * kb, 32 * nb, scr, F.lane); continue; }
        r -= I_A;
        { const int l = r / (16 * 32), q = r % (16 * 32), kb = q / 32, nb = q % 32;
            transpose_item(in_[I_WOUT] + (size_t)l * 1024 * 1024, 1024, (bf16_t*)(ws_ + WS_WOUT) + (size_t)l * 1024 * 1024, 32 * nb, 64 * kb, 32 * nb, scr, F.lane); }
    }
}
__device__ __forceinline__ void convert_moe_batch(Frame& F, const InTab& in_, unsigned char* ws_, int l, int q) {
    LAS float* scr = (LAS float*)(F.lds + F.wave * 16384);
    for (int j = 0; j < 8; ++j) {
        int r = q * 64 + j * 8 + F.wave;
        if (r < NE * 16 * 64) { const int e = r / (16 * 64), qq = r % (16 * 64), kb = qq / 64, nb = qq % 64; const int n0 = 32 * nb; const int le = l * NE + e;
            const int dr = (n0 < 1024) ? ((n0 >> 7) * 256 + (n0 & 127)) : ((((n0 - 1024) >> 7) * 256) + 128 + ((n0 - 1024) & 127));
            transpose_item(in_[I_WGU] + (size_t)le * 1024 * 2048, 2048, (bf16_t*)(ws_ + WS_WGU) + (size_t)le * 2048 * 1024, dr, 64 * kb, n0, scr, F.lane); }
        else { r -= NE * 16 * 64; const int e = r / (16 * 32), qq = r % (16 * 32), kb = qq / 32, nb = qq % 32; const int le = l * NE + e;
            transpose_item(in_[I_WDN] + (size_t)le * 1024 * 1024, 1024, (bf16_t*)(ws_ + WS_WDN) + (size_t)le * 1024 * 1024, 32 * nb, 64 * kb, 32 * nb, scr, F.lane); }
    }
}

__device__ __forceinline__ void phase_combine(Frame& F, int l, float yscale = 1.f) {
    refresh(F); unsigned char* ws_ = (unsigned char*)ldptr(F, 30); const InTab in_{F.lds}; gu32* ctl_ = (gu32*)ws_;

    const bool has_next = (l + 1 < NL);
    LAS float* Wf = (LAS float*)F.lds;
    if (has_next) {
        const float* W = in_[I_WIN] + (size_t)(l + 1) * 1024 * PIN + NPROJ;
        f32x4 t4[4];
#pragma unroll
        for (int u = 0; u < 4; ++u) { const int i = F.tid + NTHR * u; t4[u] = *(const f32x4*)(W + (size_t)(i >> 1) * PIN + 4 * (i & 1)); }
#pragma unroll
        for (int u = 0; u < 4; ++u) { const int i = F.tid + NTHR * u; *(LAS f32x4*)(Wf + 4 * i) = t4[u]; }
    }
    __syncthreads();
    const int gw = F.vcu * NWAVES + F.wave, NGW = F.G * NWAVES;
    const float* xin = (l < 0) ? in_[I_X] : (const float*)(ws_ + WS_X);
    float* X = (float*)(ws_ + WS_X);
    const float* MOD = (const float*)(ws_ + WS_MOD);
    const bf16_t* YS = (const bf16_t*)(ws_ + WS_YSLOT);
    f32x4 xn[4]; u32x2 yn[4][4];
#define CMB_LOAD(mm) do { _Pragma("unroll") for (int j = 0; j < 4; ++j) xn[j] = *(const f32x4*)(xin + (size_t)(mm) * 1024 + 4 * F.lane + 256 * j); \
        if (l >= 0) { _Pragma("unroll") for (int k = 0; k < 4; ++k) _Pragma("unroll") for (int j = 0; j < 4; ++j) yn[k][j] = *(const u32x2*)(YS + ((size_t)(mm) * 4 + k) * 1024 + 4 * F.lane + 256 * j); } } while (0)
    if (gw < NTOK) CMB_LOAD(gw);
    for (int m = gw; m < NTOK; m += NGW) {
        const int b = m >> 12;
        f32x4 v[4]; u32x2 yc[4][4];
#pragma unroll
        for (int j = 0; j < 4; ++j) { v[j] = xn[j];
#pragma unroll
            for (int k = 0; k < 4; ++k) yc[k][j] = yn[k][j]; }
        if (m + NGW < NTOK) CMB_LOAD(m + NGW);
        if (l >= 0) {
            const float* g2 = MOD + (size_t)(l * 4 + b) * 6144 + 5 * 1024;
#pragma unroll
            for (int j = 0; j < 4; ++j) {
                f32x4 s = (f32x4){0.f, 0.f, 0.f, 0.f};
#pragma unroll
                for (int k = 0; k < 4; ++k) { const u32x2 y = yc[k][j];
                    s.x += __builtin_bit_cast(float, y.x << 16); s.y += __builtin_bit_cast(float, y.x & 0xffff0000u); s.z += __builtin_bit_cast(float, y.y << 16); s.w += __builtin_bit_cast(float, y.y & 0xffff0000u); }
                const f32x4 g = *(const f32x4*)(g2 + 4 * F.lane + 256 * j);
                v[j] = v[j] + g * yscale * s;
            }
        }
        if (l >= 0 && has_next) {
#pragma unroll
            for (int j = 0; j < 4; ++j) *(f32x4*)(X + (size_t)m * 1024 + 4 * F.lane + 256 * j) = v[j];
        }
        float ss = 0.f;
#pragma unroll
        for (int j = 0; j < 4; ++j) ss += (v[j].x * v[j].x + v[j].y * v[j].y) + (v[j].z * v[j].z + v[j].w * v[j].w);
        const float rs = 1.f / sqrtf(wave_sum(ss) * (1.f / 1024.f) + 1e-6f);
        if (has_next) {
            const float* nw = in_[I_NORM1] + (l + 1) * 1024;
            const float* sh = MOD + (size_t)((l + 1) * 4 + b) * 6144; const float* sc = sh + 1024;
            float fl[8];
#pragma unroll
            for (int e = 0; e < 8; ++e) fl[e] = 0.f;
            bf16_t* H = (bf16_t*)(ws_ + WS_H) + (size_t)m * 1024;
#pragma unroll
            for (int j = 0; j < 4; ++j) {
                const int c0 = 4 * F.lane + 256 * j;
                const f32x4 w = *(const f32x4*)(nw + c0), s1 = *(const f32x4*)(sc + c0), s0 = *(const f32x4*)(sh + c0);
                f32x4 h = v[j] * rs * w * (s1 + 1.f) + s0;
                u32x2 o; o.x = cvtpk(h.x, h.y); o.y = cvtpk(h.z, h.w);
                *(u32x2*)(H + c0) = o;
#pragma unroll
                for (int i = 0; i < 4; ++i) {
                    const f32x4 wa = *(const LAS f32x4*)(Wf + (c0 + i) * 8), wb = *(const LAS f32x4*)(Wf + (c0 + i) * 8 + 4);
                    const float hv = h[i];
                    fl[0] += hv * wa.x; fl[1] += hv * wa.y; fl[2] += hv * wa.z; fl[3] += hv * wa.w; fl[4] += hv * wb.x; fl[5] += hv * wb.y; fl[6] += hv * wb.z; fl[7] += hv * wb.w;
                }
            }
#pragma unroll
            for (int e = 0; e < 8; ++e) fl[e] = wave_sum(fl[e]);
            if (F.lane == 0) { float* o = (float*)(ws_ + WS_FLOG) + (size_t)m * 8; *(f32x4*)o = (f32x4){fl[0], fl[1], fl[2], fl[3]}; *(f32x4*)(o + 4) = (f32x4){fl[4], fl[5], fl[6], fl[7]}; }
        } else {
            const float* nw = in_[I_NORMF]; float* out_ = (float*)ldptr(F, 29);
            const float pscale = (PROBE_T >= 0) ? 1.f + __hip_atomic_load((GAS float*)(ctl_ + CW_CODE + 1), RLX_AGENT) : 1.f;
#pragma unroll
            for (int j = 0; j < 4; ++j) { const int c0 = 4 * F.lane + 256 * j; const f32x4 w = *(const f32x4*)(nw + c0);
                *(f32x4*)(out_ + (size_t)m * 1024 + c0) = v[j] * rs * w * pscale; }
        }
    }
}

#undef CMB_LOAD
struct ProbDense {
    const char* A; const char* Bt; int nM, nN, G, vcu;
    __device__ __forceinline__ bool next(int i, pg8::Unit& u) const { const int Lx = i * G + vcu; if (Lx >= nM * nN) return false; u.pn = Lx % nN; u.pm = Lx / nN; u.e = 0; return true; }
    __device__ __forceinline__ const char* a_ptr(const pg8::Unit& u) const { return A + (size_t)u.pm * 256 * 2048; }
    __device__ __forceinline__ const char* b_ptr(const pg8::Unit& u) const { return Bt + (size_t)u.pn * 256 * 2048; }
};
struct EpiProj {
    unsigned char* ws;
    __device__ __forceinline__ void operator()(const f32x4 (&acc)[2][2][4][2], const pg8::Unit& u, int wr, int wc, int fr, int fq) const {
        const int pn = u.pn;
#pragma unroll
        for (int ai = 0; ai < 2; ++ai)
#pragma unroll
            for (int m = 0; m < 4; ++m) {
                const size_t row = (size_t)u.pm * 256 + ai * 128 + wr * 64 + m * 16 + fr;
#pragma unroll
                for (int bj = 0; bj < 2; ++bj) {
                    const int ct = bj * 128 + wc * 32 + 8 * fq;
                    const f32x4 v0 = acc[ai][bj][m][0], v1 = acc[ai][bj][m][1];
                    if (pn < 4) { *(u32x4*)((bf16_t*)(ws + WS_ZR) + row * 1024 + pn * 256 + ct) = pk8(v0, v1); }
                    else if (pn == 4) { float* p = (float*)(ws + WS_ZP) + row * 256 + ct; *(f32x4*)p = v0; *(f32x4*)(p + 4) = v1; }
                    else { const int q = pn - 5, which = q >> 1; const float sc = (which == 0) ? QSCALE : 1.f;
                        bf16_t* p = (bf16_t*)(ws + (which == 0 ? WS_Q : (which == 1 ? WS_K : WS_V))) + row * 512 + (q & 1) * 256 + ct;
                        u32x4 w; w.x = pg8::cvt_pk_bf16(v0[0] * sc, v0[1] * sc); w.y = pg8::cvt_pk_bf16(v0[2] * sc, v0[3] * sc); w.z = pg8::cvt_pk_bf16(v1[0] * sc, v1[1] * sc); w.w = pg8::cvt_pk_bf16(v1[2] * sc, v1[3] * sc);
                        *(u32x4*)p = w; }
                }
            }
    }
};
struct EpiOut {
    float* X; const float* Xin; const float* g1; float scale;
    __device__ __forceinline__ void operator()(const f32x4 (&acc)[2][2][4][2], const pg8::Unit& u, int wr, int wc, int fr, int fq) const {
        const int b = (u.pm * 256) >> 12;
#pragma unroll
        for (int bj = 0; bj < 2; ++bj) {
            const int col = u.pn * 256 + bj * 128 + wc * 32 + 8 * fq;
            const f32x4 ga = *(const f32x4*)(g1 + (size_t)b * 6144 + col), gb = *(const f32x4*)(g1 + (size_t)b * 6144 + col + 4);
#pragma unroll
            for (int ai = 0; ai < 2; ++ai)
#pragma unroll
                for (int m = 0; m < 4; ++m) {
                    const size_t row = (size_t)u.pm * 256 + ai * 128 + wr * 64 + m * 16 + fr;
                    float* p = X + row * 1024 + col; const float* pi = Xin + row * 1024 + col;
                    const f32x4 x0 = *(const f32x4*)pi, x1 = *(const f32x4*)(pi + 4);
                    *(f32x4*)p = x0 + ga * scale * acc[ai][bj][m][0]; *(f32x4*)(p + 4) = x1 + gb * scale * acc[ai][bj][m][1];
                }
        }
    }
};

struct MoeTab { LAS int* te; LAS int* tr0; LAS int* cnt; LAS int* ntiles; };
__device__ __forceinline__ MoeTab moe_table(Frame& F, int l) {
    refresh(F); unsigned char* ws_ = (unsigned char*)ldptr(F, 30); const InTab in_{F.lds}; gu32* ctl_ = (gu32*)ws_;

    MoeTab T; T.te = (LAS int*)(F.lds + TAB_OFF); T.tr0 = T.te + 320; T.cnt = T.tr0 + 320; T.ntiles = T.cnt + 32;
    if (F.tid < 32) T.cnt[F.tid] = (int)__hip_atomic_load(ctl_ + CW_CNT + ((l + (PROBE_DUP == 8 ? 4 : 0)) * 32 + F.tid) * 64, RLX_AGENT);
    __syncthreads();
    if (F.tid < 64) {
        const int e = F.tid; const int nt_e = (e < 32) ? ((T.cnt[e & 31] + 255) >> 8) : 0;
        int incl = nt_e;
#pragma unroll
        for (int o = 1; o < 32; o <<= 1) { const int t = __shfl_up(incl, o); if (F.lane >= o) incl += t; }
        const int start = incl - nt_e;
#pragma nounroll
        for (int r = 0; r < nt_e; ++r) { T.te[start + r] = e; T.tr0[start + r] = r * 256; }
        if (e == 31) T.ntiles[0] = incl;
    }
    __syncthreads();
    return T;
}
struct ProbGU {
    const char* H; const char* W; const int* list; MoeTab T; int nun, G, vcu, l;
    __device__ __forceinline__ bool next(int i, pg8::Unit& u) const { const int Lx = i * G + vcu; if (Lx >= nun) return false; u.pm = Lx >> 3; u.pn = Lx & 7; u.e = __builtin_amdgcn_readfirstlane(T.te[u.pm]); return true; }
    __device__ __forceinline__ const char* a_ptr(const pg8::Unit&) const { return H; }
    __device__ __forceinline__ const char* b_ptr(const pg8::Unit& u) const { return W + ((size_t)(l * 32 + u.e) * 2048 + (size_t)u.pn * 256) * 2048; }
    __device__ __forceinline__ unsigned row_off(const pg8::Unit& u, int r) const { const int idx = __builtin_amdgcn_readfirstlane(T.tr0[u.pm]) + r; const int tok = (idx < __builtin_amdgcn_readfirstlane(T.cnt[u.e])) ? (list[u.e * NTOK + idx] >> 2) : 0; return (unsigned)tok * 2048u; }
};
struct EpiGU {
    bf16_t* ACT; const float* bgu; int l;
    __device__ __forceinline__ void operator()(const f32x4 (&acc)[2][2][4][2], const pg8::Unit& u, int wr, int wc, int fr, int fq) const {
        const int col = u.pn * 128 + wc * 32 + 8 * fq;
        const float* bb = bgu + (size_t)(l * 32 + u.e) * 2048 + col;
        const f32x4 bg0 = *(const f32x4*)bb, bg1 = *(const f32x4*)(bb + 4), bu0 = *(const f32x4*)(bb + 1024), bu1 = *(const f32x4*)(bb + 1028);
#pragma unroll
        for (int ai = 0; ai < 2; ++ai)
#pragma unroll
            for (int m = 0; m < 4; ++m) {
                const size_t row = (size_t)u.pm * 256 + ai * 128 + wr * 64 + m * 16 + fr;
                float a[8];
#pragma unroll
                for (int n = 0; n < 2; ++n)
#pragma unroll
                    for (int i = 0; i < 4; ++i) {
                        float g = acc[ai][0][m][n][i] + (n ? bg1[i] : bg0[i]); float up = acc[ai][1][m][n][i] + (n ? bu1[i] : bu0[i]);
                        g = fminf(g, 7.f); up = fminf(fmaxf(up, -7.f), 7.f);
                        a[n * 4 + i] = (up + 1.f) * (g / (1.f + __expf(-1.702f * g)));
                    }
                u32x4 w; w.x = pg8::cvt_pk_bf16(a[0], a[1]); w.y = pg8::cvt_pk_bf16(a[2], a[3]); w.z = pg8::cvt_pk_bf16(a[4], a[5]); w.w = pg8::cvt_pk_bf16(a[6], a[7]);
                *(u32x4*)(ACT + row * 1024 + col) = w;
            }
    }
};
struct ProbDN {
    const char* ACT; const char* W; MoeTab T; int nun, G, vcu, l;
    __device__ __forceinline__ bool next(int i, pg8::Unit& u) const { const int Lx = i * G + vcu; if (Lx >= nun) return false; u.pm = Lx >> 2; u.pn = Lx & 3; u.e = __builtin_amdgcn_readfirstlane(T.te[u.pm]); return true; }
    __device__ __forceinline__ const char* a_ptr(const pg8::Unit& u) const { return ACT + (size_t)u.pm * 256 * 2048; }
    __device__ __forceinline__ const char* b_ptr(const pg8::Unit& u) const { return W + ((size_t)(l * 32 + u.e) * 1024 + (size_t)u.pn * 256) * 2048; }
};
struct EpiDN {
    bf16_t* YS; const float* bdn; const int* list; const float* gate; MoeTab T; int l;
    __device__ __forceinline__ void operator()(const f32x4 (&acc)[2][2][4][2], const pg8::Unit& u, int wr, int wc, int fr, int fq) const {
        const int r0 = __builtin_amdgcn_readfirstlane(T.tr0[u.pm]), c = __builtin_amdgcn_readfirstlane(T.cnt[u.e]);
#pragma unroll
        for (int ai = 0; ai < 2; ++ai)
#pragma unroll
            for (int m = 0; m < 4; ++m) {
                const int idx = r0 + ai * 128 + wr * 64 + m * 16 + fr;
                if (idx < c) {
                    const int slot = list[u.e * NTOK + idx]; const float gt = gate[slot];
#pragma unroll
                    for (int bj = 0; bj < 2; ++bj) {
                        const int col = u.pn * 256 + bj * 128 + wc * 32 + 8 * fq;
                        const float* bb = bdn + (size_t)(l * 32 + u.e) * 1024 + col;
                        const f32x4 b0 = *(const f32x4*)bb, b1 = *(const f32x4*)(bb + 4);
                        const f32x4 v0 = (acc[ai][bj][m][0] + b0) * gt, v1 = (acc[ai][bj][m][1] + b1) * gt;
                        u32x4 w; w.x = pg8::cvt_pk_bf16(v0[0], v0[1]); w.y = pg8::cvt_pk_bf16(v0[2], v0[3]); w.z = pg8::cvt_pk_bf16(v1[0], v1[1]); w.w = pg8::cvt_pk_bf16(v1[2], v1[3]);
                        *(u32x4*)(YS + (size_t)slot * 1024 + col) = w;
                    }
                }
            }
    }
};

__device__ __forceinline__ void phase_prep(Frame& F, int l) {
    refresh(F); unsigned char* ws_ = (unsigned char*)ldptr(F, 30); const InTab in_{F.lds};
    if (blockIdx.x < 32) {
        const int b = blockIdx.x >> 3, hh = blockIdx.x & 7;
        const float bf = in_[I_BF][l * 8 + hh];
        const float* fl = (const float*)(ws_ + WS_FLOG) + ((size_t)b * SEQ + 8 * F.tid) * 8 + hh;
        float lf[8];
#pragma unroll
        for (int i = 0; i < 8; ++i) lf[i] = fl[i * 8];
#pragma unroll
        for (int i = 0; i < 8; ++i) { lf[i] = -softplusf_(-(lf[i] + bf)); if (i) lf[i] += lf[i - 1]; }
        float incl = lf[7];
#pragma unroll
        for (int o = 1; o < 64; o <<= 1) { const float t = __shfl_up(incl, o); if (F.lane >= o) incl += t; }
        LAS float* wtot = (LAS float*)F.lds;
        if (F.lane == 63) wtot[F.wave] = incl;
        __syncthreads();
        float off = incl - lf[7];
        for (int w = 0; w < F.wave; ++w) off += wtot[w];
        float* bo = (float*)(ws_ + WS_BIAS) + ((size_t)b * 8 + hh) * SEQ + 8 * F.tid;
        f32x4 o0, o1;
        o0.x = -(off + lf[0]) * LOG2E; o0.y = -(off + lf[1]) * LOG2E; o0.z = -(off + lf[2]) * LOG2E; o0.w = -(off + lf[3]) * LOG2E;
        o1.x = -(off + lf[4]) * LOG2E; o1.y = -(off + lf[5]) * LOG2E; o1.z = -(off + lf[6]) * LOG2E; o1.w = -(off + lf[7]) * LOG2E;
        *(f32x4*)bo = o0; *(f32x4*)(bo + 4) = o1;
    }
    const int gw = F.vcu * NWAVES + F.wave, NGW = F.G * NWAVES;
    const float* mu = in_[I_MU] + l * 1024;
    f32x4 muv[4];
#pragma unroll
    for (int j = 0; j < 4; ++j) muv[j] = *(const f32x4*)(mu + 4 * F.lane + 256 * j);
    const f32x4 kkw = *(const f32x4*)(in_[I_KK] + l * 256 + 4 * F.lane);
    const bf16_t* ZR = (const bf16_t*)(ws_ + WS_ZR);
    const int hd = F.lane >> 4, cc = 4 * (F.lane & 15);
    const float act_a = (F.lane < 16) ? 2.f : 1.f, act_b = (F.lane < 16) ? -1.f : 0.f; const bool act_id = (F.lane >= 16 && F.lane < 32);
    for (int g = gw; g < NTOK / 8; g += NGW) {
        const int m0 = g * 8;
        u32x2 raw[9][4];
        const bool hasp = (m0 & (SEQ - 1)) != 0;
#pragma unroll
        for (int i = 0; i < 9; ++i)
#pragma unroll
            for (int j = 0; j < 4; ++j) raw[i][j] = (i > 0 || hasp) ? *(const u32x2*)(ZR + (size_t)(m0 - 1 + i) * 1024 + 4 * F.lane + 256 * j) : (u32x2){0u, 0u};
        f32x4 prev[4], cur[4];
#pragma unroll
        for (int j = 0; j < 4; ++j) prev[j] = unp4(raw[0][j]);
#pragma unroll
        for (int i = 0; i < 8; ++i) {
            const int m = m0 + i, b = m >> 12, t = m & (SEQ - 1);
#pragma unroll
            for (int j = 0; j < 4; ++j) cur[j] = unp4(raw[i + 1][j]);
            f32x4 zs[4];
#pragma unroll
            for (int j = 0; j < 4; ++j) zs[j] = cur[j] + (prev[j] - cur[j]) * muv[j];
            unsigned char* o = ws_ + WS_SCAN + ((size_t)(b * 4 + hd) * SEQ + t) * SCAN_ROW + cc * 2;
            *(u32x2*)(o) = pk4(zs[0]);
            *(u32x2*)(o + 128) = pk4(zs[1]);
            *(u32x2*)(o + 256) = pk4(zs[2]);
            f32x4 kk = zs[1] * kkw;
            const float ss = red16((kk.x * kk.x + kk.y * kk.y) + (kk.z * kk.z + kk.w * kk.w));
            kk = kk * (1.f / fmaxf(sqrtf(ss), 1e-12f));
            *(u32x2*)(o + 384) = pk4(kk);
            f32x4 a4;
#pragma unroll
            for (int q = 0; q < 4; ++q) { const float x = zs[3][q]; const float sg = 1.f / (1.f + __expf(-act_a * x)); a4[q] = act_id ? x : (act_a * sg + act_b); }
            u32x2 pk; pk.x = cvtpk(a4.x, a4.y); pk.y = cvtpk(a4.z, a4.w);
            *(u32x2*)((bf16_t*)(ws_ + WS_ALORA) + (size_t)m * 256 + 4 * F.lane) = pk;
#pragma unroll
            for (int j = 0; j < 4; ++j) prev[j] = cur[j];
        }
    }
}
struct ProbLora {
    const char* A; const char* Bt; int G, vcu;
    __device__ __forceinline__ bool next(int i, pg8::Unit& u) const { const int Lx = i * G + vcu; if (Lx >= 64 * 3) return false; u.pn = Lx % 3; u.pm = Lx / 3; u.e = 0; return true; }
    __device__ __forceinline__ const char* a_ptr(const pg8::Unit& u) const { return A + (size_t)u.pm * 256 * 512; }
    __device__ __forceinline__ const char* b_ptr(const pg8::Unit& u) const { return Bt + (size_t)u.pn * 256 * 512; }
};
struct EpiLora {
    unsigned char* ws; const float* w0; const float* a0; const float* ka;
    __device__ __forceinline__ void operator()(const f32x4 (&acc)[2][2][4][2], const pg8::Unit& u, int wr, int wc, int fr, int fq) const {
        const int pn = u.pn;
#pragma unroll
        for (int bj = 0; bj < 2; ++bj) {
            const int c = bj * 128 + wc * 32 + 8 * fq, hd = c >> 6, cc = c & 63;
            f32x4 p0 = (f32x4){0.f, 0.f, 0.f, 0.f}, p1 = p0, q0 = p0, q1 = p0;
            if (pn == 0) { p0 = *(const f32x4*)(w0 + c); p1 = *(const f32x4*)(w0 + c + 4); }
            else if (pn == 1) { p0 = *(const f32x4*)(a0 + c); p1 = *(const f32x4*)(a0 + c + 4); q0 = *(const f32x4*)(ka + c); q1 = *(const f32x4*)(ka + c + 4); }
#pragma unroll
            for (int ai = 0; ai < 2; ++ai)
#pragma unroll
                for (int m = 0; m < 4; ++m) {
                    const int row = u.pm * 256 + ai * 128 + wr * 64 + m * 16 + fr, b = row >> 12, t = row & (SEQ - 1);
                    const f32x4 v0 = acc[ai][bj][m][0], v1 = acc[ai][bj][m][1];
                    unsigned char* o = ws + WS_SCAN + ((size_t)(b * 4 + hd) * SEQ + t) * SCAN_ROW;
                    if (pn == 0) {
                        f32x4 d0, d1;
#pragma unroll
                        for (int i = 0; i < 4; ++i) { d0[i] = -__expf(-softplus_fast(-(p0[i] + v0[i])) - 0.5f); d1[i] = -__expf(-softplus_fast(-(p1[i] + v1[i])) - 0.5f); if (!CHUNKED_SCAN) { d0[i] = __expf(d0[i]); d1[i] = __expf(d1[i]); } }
                        *(f32x4*)(o + 640 + cc * 4) = d0; *(f32x4*)(o + 640 + cc * 4 + 16) = d1;
                    } else if (pn == 1) {
                        const u32x4 kp = *(const u32x4*)(o + 128 + cc * 2), np = *(const u32x4*)(o + 384 + cc * 2);
                        const f32x4 k0 = unp4((u32x2){kp.x, kp.y}), k1 = unp4((u32x2){kp.z, kp.w}), n0 = unp4((u32x2){np.x, np.y}), n1 = unp4((u32x2){np.z, np.w});
                        f32x4 a_0, a_1;
#pragma unroll
                        for (int i = 0; i < 4; ++i) { a_0[i] = sigmoidf_(p0[i] + v0[i]); a_1[i] = sigmoidf_(p1[i] + v1[i]); }
                        *(u32x4*)(o + 128 + cc * 2) = pk8(k0 * ((a_0 - 1.f) * q0 + 1.f), k1 * ((a_1 - 1.f) * q1 + 1.f));
                        *(u32x4*)(o + 512 + cc * 2) = pk8(-(n0 * a_0), -(n1 * a_1));
                    } else {
                        *(u32x4*)((bf16_t*)(ws + WS_G) + (size_t)row * 256 + c) = pk8(v0, v1);
                    }
                }
        }
    }
};

constexpr int SC_STEPS = 16, SC_CHUNK_F = SC_STEPS * 384, SC_NBUF = 5, SC_PPW = SC_STEPS * 6 / 16;
struct ScanIn { f32x4 r, w, k, kk, kb; float v; };
__device__ __forceinline__ ScanIn scan_ld(const LAS float* p, int ks, int row) {
    ScanIn x; x.r = *(const LAS f32x4*)(p + ks); x.w = *(const LAS f32x4*)(p + 64 + ks); x.k = *(const LAS f32x4*)(p + 128 + ks); x.kk = *(const LAS f32x4*)(p + 256 + ks); x.kb = *(const LAS f32x4*)(p + 320 + ks); x.v = p[192 + row]; return x;
}
__device__ __forceinline__ void scan_block(Frame& F, int rb) {
    refresh(F); unsigned char* ws_ = (unsigned char*)ldptr(F, 30);
    const int bh = rb >> 2, rg = rb & 3, b = bh >> 2, h = bh & 3;
    const float* src = (const float*)(ws_ + WS_SCAN) + (size_t)bh * SEQ * 384;
    LAS float* buf = (LAS float*)F.lds;
    constexpr int NCH = SEQ / SC_STEPS;
    if (F.wave >= 4) {
        const int lw = F.wave - 4;
#define SC_ISSUE(c, slot) do { _Pragma("unroll") for (int p_ = 0; p_ < SC_PPW; ++p_) { const int pc_ = lw * SC_PPW + p_; \
            __builtin_amdgcn_global_load_lds((const unsigned*)(src + (size_t)(c) * SC_CHUNK_F + pc_ * 256 + F.lane * 4), (LAS unsigned*)(buf + (slot) * SC_CHUNK_F + pc_ * 256), 16, 0, 0); } } while (0)
#pragma unroll
        for (int c = 0; c < SC_NBUF - 1; ++c) SC_ISSUE(c, c);
        asm volatile("s_waitcnt vmcnt(%0)" :: "n"((SC_NBUF - 2) * SC_PPW) : "memory");
        __builtin_amdgcn_s_barrier();
        int slot = SC_NBUF - 1;
        for (int c = 0; c < NCH; ++c) {
            if (c + SC_NBUF - 1 < NCH) { SC_ISSUE(c + SC_NBUF - 1, slot); asm volatile("s_waitcnt vmcnt(%0)" :: "n"((SC_NBUF - 2) * SC_PPW) : "memory"); }
            else asm volatile("s_waitcnt vmcnt(0)" ::: "memory");
            slot = (slot == SC_NBUF - 1) ? 0 : slot + 1;
            __builtin_amdgcn_s_barrier();
        }
#undef SC_ISSUE
    } else {
        const int row = rg * 16 + F.wave * 4 + (F.lane >> 4), ks = (F.lane & 15) * 4, l16 = F.lane & 15;
        f32x4 s = (f32x4){0.f, 0.f, 0.f, 0.f};
        float* yout = (float*)(ws_ + WS_YRAW) + (size_t)b * SEQ * 256 + 64 * h + row;
        float yp = 0.f;
        int slot = 0;
        __builtin_amdgcn_s_barrier();
        for (int c = 0; c < NCH; ++c) {
            const LAS float* base = buf + slot * SC_CHUNK_F;
            slot = (slot == SC_NBUF - 1) ? 0 : slot + 1;
            float ykeep = 0.f;
            ScanIn cur = scan_ld(base, ks, row);
#pragma unroll
            for (int st = 0; st < SC_STEPS; ++st) {
                ScanIn nxt = cur;
                if (st + 1 < SC_STEPS) nxt = scan_ld(base + (st + 1) * 384, ks, row);
                const f32x4 vk = cur.k * cur.v;
                const float t0 = s.x * cur.kk.x + s.y * cur.kk.y, t1 = s.z * cur.kk.z + s.w * cur.kk.w;
                const f32x4 u = s * cur.w + vk;
                float sa = t0 + t1;
                red16_pair(sa, yp);
                ykeep = (l16 == st) ? yp : ykeep;
                s = u + cur.kb * sa;
                const float y0 = s.x * cur.r.x + s.y * cur.r.y, y1 = s.z * cur.r.z + s.w * cur.r.w;
                yp = y0 + y1;
                cur = nxt;
            }
            { const int g = c * SC_STEPS + l16 - 1; if (l16 < SC_STEPS && g >= 0) yout[(size_t)g * 256] = ykeep; }
            __builtin_amdgcn_s_barrier();
        }
        yp = red16(yp);
        if (l16 == 0) yout[(size_t)(SEQ - 1) * 256] = yp;
    }
}


__device__ __forceinline__ int crow(int r, int hi) { return (r & 3) + 8 * (r >> 2) + 4 * hi; }
constexpr int CK_P = 144, CK_A = 64 * CK_P;
enum { CA_KKP = 0, CA_RP, CA_BI, CA_KI, CA_VT, CA_KKPT, CA_BHT, CA_KHT, CA_TB, CA_AUK, CA_ARB, CA_ARK, CA_TF0, CA_TF1, CA_N,
       CA_W1T = CA_KKP, CA_MT = CA_BI, CA_U0T = CA_KI,
       CA_D1T = CA_BI, CA_X1T = CA_KI };
constexpr int CK_TF = CA_TF0 * CK_A;
static_assert(CA_N * CK_A <= 139264 && 64 * 68 * 4 <= 2 * CK_A, "chunk LDS map");
__device__ __forceinline__ f32x16 ck_mma(const LAS unsigned char* A, const LAS unsigned char* B, int ksteps, f32x16 acc, int r32, int hi) {
#pragma unroll 4
    for (int s = 0; s < ksteps; ++s) {
        const bf16x8 a = *(const LAS bf16x8*)(A + r32 * CK_P + (16 * s + 8 * hi) * 2);
        const bf16x8 b = *(const LAS bf16x8*)(B + r32 * CK_P + (16 * s + 8 * hi) * 2);
        acc = __builtin_amdgcn_mfma_f32_32x32x16_bf16(a, b, acc, 0, 0, 0);
    }
    return acc;
}
__device__ __forceinline__ void ck_store_t(LAS unsigned char* dst, const f32x16& c, int R0, int C0, int r32, int hi) {
#pragma unroll
    for (int g = 0; g < 4; ++g) { u32x2 w; w.x = cvtpk(c[4 * g], c[4 * g + 1]); w.y = cvtpk(c[4 * g + 2], c[4 * g + 3]); *(LAS u32x2*)(dst + (C0 + r32) * CK_P + (R0 + 8 * g + 4 * hi) * 2) = w; }
}
#define STAMPF(F_, id) do { if (PROBE_T >= 20 && blockIdx.x == 0 && (F_).tid == 0) { volatile LAS unsigned long long* tsw_ = (volatile LAS unsigned long long*)((F_).lds + MISC_OFF + 192); const unsigned long long now_ = wall_clock64(); if ((id) == PROBE_T) tsw_[1] += now_ - tsw_[0]; tsw_[0] = now_; } } while (0)
struct ChunkRows { u32x4 r, k, v, kk, kb; f32x4 w[2]; };
__device__ __forceinline__ ChunkRows chunk_load(Frame& F, unsigned char* ws_, int job) {
    const int t = F.tid & 63, c0 = (F.tid >> 6) * 8, bh = job >> 6, ch = job & 63;
    const unsigned char* row = ws_ + WS_SCAN + ((size_t)bh * SEQ + (size_t)ch * 64 + t) * SCAN_ROW;
    ChunkRows x;
    x.r = *(const u32x4*)(row + c0 * 2); x.k = *(const u32x4*)(row + 128 + c0 * 2); x.v = *(const u32x4*)(row + 256 + c0 * 2); x.kk = *(const u32x4*)(row + 384 + c0 * 2); x.kb = *(const u32x4*)(row + 512 + c0 * 2);
    x.w[0] = *(const f32x4*)(row + 640 + c0 * 4); x.w[1] = *(const f32x4*)(row + 640 + c0 * 4 + 16);
    return x;
}
__device__ __forceinline__ void chunk_job(Frame& F, unsigned char* ws_, int job, const ChunkRows& in) {
    LAS unsigned char* L = F.lds;
    LAS float* Tf = (LAS float*)(L + CK_TF);
    const int tid = F.tid, lane = F.lane, wave = F.wave, r32 = lane & 31, hi = lane >> 5;
    {
        const int t = tid & 63, c0 = (tid >> 6) * 8;
        float r_[8], k_[8], v_[8], kk_[8], kb_[8], Lt[8];
#pragma unroll
        for (int q = 0; q < 2; ++q) {
            const f32x4 r4 = unp4((u32x2){in.r[2 * q], in.r[2 * q + 1]}), k4 = unp4((u32x2){in.k[2 * q], in.k[2 * q + 1]}), v4 = unp4((u32x2){in.v[2 * q], in.v[2 * q + 1]}), n4 = unp4((u32x2){in.kk[2 * q], in.kk[2 * q + 1]}), b4 = unp4((u32x2){in.kb[2 * q], in.kb[2 * q + 1]});
#pragma unroll
            for (int i = 0; i < 4; ++i) { r_[4 * q + i] = r4[i]; k_[4 * q + i] = k4[i]; v_[4 * q + i] = v4[i]; kk_[4 * q + i] = n4[i]; kb_[4 * q + i] = -b4[i]; Lt[4 * q + i] = in.w[q][i]; }
        }
#pragma unroll
        for (int i = 0; i < 8; ++i) {
            float x = Lt[i];
            x += __builtin_bit_cast(float, __builtin_amdgcn_update_dpp(0, __builtin_bit_cast(int, x), 0x111, 0xf, 0xf, true));
            x += __builtin_bit_cast(float, __builtin_amdgcn_update_dpp(0, __builtin_bit_cast(int, x), 0x112, 0xf, 0xf, true));
            x += __builtin_bit_cast(float, __builtin_amdgcn_update_dpp(0, __builtin_bit_cast(int, x), 0x114, 0xf, 0xf, true));
            x += __builtin_bit_cast(float, __builtin_amdgcn_update_dpp(0, __builtin_bit_cast(int, x), 0x118, 0xf, 0xf, true));
            const float r0 = __builtin_bit_cast(float, __builtin_amdgcn_readlane(__builtin_bit_cast(int, x), 15)), r1 = __builtin_bit_cast(float, __builtin_amdgcn_readlane(__builtin_bit_cast(int, x), 31)), r2 = __builtin_bit_cast(float, __builtin_amdgcn_readlane(__builtin_bit_cast(int, x), 47));
            const int rw = lane >> 4;
            x += (rw >= 1 ? r0 : 0.f) + (rw >= 2 ? r1 : 0.f) + (rw >= 3 ? r2 : 0.f);
            Lt[i] = x;
        }
        float kkp[8], rp[8], bi[8], ki[8], bh_[8], kh_[8];
#pragma unroll
        for (int i = 0; i < 8; ++i) {
            const float Lm0 = __shfl_up(Lt[i], 1); const float Lm = (lane > 0) ? Lm0 : 0.f; const float Lc = __shfl(Lt[i], 63);
            const float ip = __expf(-Lt[i]);
            kkp[i] = kk_[i] * __expf(Lm); rp[i] = r_[i] * __expf(Lt[i]); bi[i] = kb_[i] * ip; ki[i] = k_[i] * ip;
            const float pc = __expf(Lc - Lt[i]); bh_[i] = kb_[i] * pc; kh_[i] = k_[i] * pc;
            if (t == 63) ((LAS float*)(L + PCV_OFF))[c0 + i] = __expf(Lc);
        }
#define CK_ROW8(arr, vals_) do { u32x4 w_ = (u32x4){cvtpk(vals_[0], vals_[1]), cvtpk(vals_[2], vals_[3]), cvtpk(vals_[4], vals_[5]), cvtpk(vals_[6], vals_[7])}; *(LAS u32x4*)(L + (arr) * CK_A + t * CK_P + c0 * 2) = w_; } while (0)
#define CK_COL8(arr, vals_) do { _Pragma("unroll") for (int i_ = 0; i_ < 8; ++i_) *(LAS unsigned short*)(L + (arr) * CK_A + (c0 + i_) * CK_P + t * 2) = (unsigned short)cvtpk(vals_[i_], 0.f); } while (0)
        CK_ROW8(CA_KKP, kkp); CK_ROW8(CA_RP, rp); CK_ROW8(CA_BI, bi); CK_ROW8(CA_KI, ki);
        CK_COL8(CA_VT, v_); CK_COL8(CA_KKPT, kkp); CK_COL8(CA_BHT, bh_); CK_COL8(CA_KHT, kh_);
#undef CK_ROW8
#undef CK_COL8
    }
    __syncthreads(); STAMPF(F, 20);
#pragma unroll
    for (int q = 0; q < 2; ++q) {
        const int id = wave * 2 + q, which = id >> 2, tj = (id >> 1) & 1, tt = id & 1;
        const LAS unsigned char* Aop = L + ((which & 1) ? CA_KI : CA_BI) * CK_A + tj * 32 * CK_P;
        const LAS unsigned char* Bop = L + ((which & 2) ? CA_RP : CA_KKP) * CK_A + tt * 32 * CK_P;
        f32x16 c = {}; c = ck_mma(Aop, Bop, 4, c, r32, hi);
        const int t = tt * 32 + r32;
#pragma unroll
        for (int i = 0; i < 16; ++i) { const int j = tj * 32 + crow(i, hi); const bool keep = (which & 2) ? (j <= t) : (j < t); if (!keep) c[i] = 0.f; }
        if (which == 0) {
#pragma unroll
            for (int g = 0; g < 4; ++g) { const int j0 = tj * 32 + 8 * g + 4 * hi; Tf[t * 68 + j0] = c[4 * g]; Tf[t * 68 + j0 + 1] = c[4 * g + 1]; Tf[t * 68 + j0 + 2] = c[4 * g + 2]; Tf[t * 68 + j0 + 3] = c[4 * g + 3]; }
        } else ck_store_t(L + ((which == 1) ? CA_AUK : (which == 2) ? CA_ARB : CA_ARK) * CK_A, c, tj * 32, tt * 32, r32, hi);
    }
    __syncthreads(); STAMPF(F, 21);
    LAS unsigned char* TB = L + CA_TB * CK_A;
    if (wave == 4) {
        const int blk = lane >> 5, c = lane & 31;
        const LAS float* ab = Tf + blk * (32 * 68 + 32);
        float x[32];
#pragma unroll
        for (int t = 0; t < 32; ++t) x[t] = 0.f;
#pragma unroll
        for (int t = 0; t < 32; ++t) {
            int z = 0;
            if (t >= 2) asm volatile("" : "+v"(z) : "v"(x[t - 2]));
            const LAS float* rowp = ab + t * 68 + z;
            float a0 = (t == c) ? 1.f : 0.f, a1 = 0.f, a2 = 0.f, a3 = 0.f;
#pragma unroll
            for (int j = 0; j < t; j += 4) { const f32x4 a4 = *(const LAS f32x4*)(rowp + j);
                a0 -= a4.x * x[j]; a1 -= a4.y * x[j + 1]; a2 -= a4.z * x[j + 2]; a3 -= a4.w * x[j + 3]; }
            x[t] = (a0 + a1) + (a2 + a3);
        }
#pragma unroll
        for (int t = 0; t < 32; ++t) *(LAS unsigned short*)(TB + (32 * blk + t) * CK_P + (32 * blk + c) * 2) = (unsigned short)f2bf(x[t]);
        if (blk == 0) {
#pragma unroll
            for (int t8 = 0; t8 < 4; ++t8) { const u32x4 w_ = (u32x4){cvtpk(x[8 * t8], x[8 * t8 + 1]), cvtpk(x[8 * t8 + 2], x[8 * t8 + 3]), cvtpk(x[8 * t8 + 4], x[8 * t8 + 5]), cvtpk(x[8 * t8 + 6], x[8 * t8 + 7])}; *(LAS u32x4*)(L + CA_D1T * CK_A + c * CK_P + t8 * 16) = w_; }
        } else {
#pragma unroll
            for (int t8 = 0; t8 < 4; ++t8) *(LAS u32x4*)(TB + c * CK_P + 64 + t8 * 16) = (u32x4){0u, 0u, 0u, 0u};
        }
    } else if (wave < 4) {
        const int tt = wave >> 1, tv = wave & 1;
        f32x16 c = {}; c = ck_mma(L + CA_AUK * CK_A + tt * 32 * CK_P, L + CA_VT * CK_A + tv * 32 * CK_P, 4, c, r32, hi);
        ck_store_t(L + CA_W1T * CK_A, c, tt * 32, tv * 32, r32, hi);
    }
    __syncthreads(); STAMPF(F, 22);
    if (wave == 0) {
        f32x16 c = {};
#pragma unroll
        for (int s = 0; s < 2; ++s) {
            const f32x4 f0 = *(const LAS f32x4*)(Tf + (32 + r32) * 68 + 16 * s + 8 * hi), f1 = *(const LAS f32x4*)(Tf + (32 + r32) * 68 + 16 * s + 8 * hi + 4);
            const u32x4 aw = (u32x4){cvtpk(f0.x, f0.y), cvtpk(f0.z, f0.w), cvtpk(f1.x, f1.y), cvtpk(f1.z, f1.w)};
            const bf16x8 b = *(const LAS bf16x8*)(L + CA_D1T * CK_A + r32 * CK_P + (16 * s + 8 * hi) * 2);
            c = __builtin_amdgcn_mfma_f32_32x32x16_bf16(__builtin_bit_cast(bf16x8, aw), b, c, 0, 0, 0);
        }
        ck_store_t(L + CA_X1T * CK_A, c, 0, 0, r32, hi);
    }
    __syncthreads(); STAMPF(F, 23);
    if (wave == 0) {
        f32x16 c = {}; c = ck_mma(L + CA_X1T * CK_A, TB + 32 * CK_P + 64, 2, c, r32, hi);
#pragma unroll
        for (int i = 0; i < 16; ++i) c[i] = -c[i];
        ck_store_t(TB + 32 * CK_P, c, 0, 0, r32, hi);
    }
    __syncthreads(); STAMPF(F, 24);
    {
        const int which = wave >> 2, tt = (wave >> 1) & 1, tc = wave & 1;
        f32x16 c = {}; c = ck_mma(L + CA_TB * CK_A + tt * 32 * CK_P, L + (which ? CA_W1T : CA_KKPT) * CK_A + tc * 32 * CK_P, 4, c, r32, hi);
        if (which) {
#pragma unroll
            for (int i = 0; i < 16; ++i) c[i] = -c[i];
        }
        ck_store_t(L + (which ? CA_U0T : CA_MT) * CK_A, c, tt * 32, tc * 32, r32, hi);
    }
    __syncthreads(); STAMPF(F, 25);
    const size_t jb = (size_t)job;
#pragma unroll
    for (int q = 0; q < 2; ++q) {
        const int id = wave * 2 + q, which = id >> 2, ta = (id >> 1) & 1, tb = id & 1;
        f32x16 c = {};
        if (which == 0) {
            c = ck_mma(L + CA_MT * CK_A + ta * 32 * CK_P, L + CA_BHT * CK_A + tb * 32 * CK_P, 4, c, r32, hi);
            const int k2 = tb * 32 + r32; const float pcv = ((const LAS float*)(L + PCV_OFF))[k2];
            bf16_t* o = (bf16_t*)(ws_ + WS_CPG + jb * 24576) + (size_t)k2 * 64;
#pragma unroll
            for (int g = 0; g < 4; ++g) { const int k1 = ta * 32 + 8 * g + 4 * hi; float x[4];
#pragma unroll
                for (int i = 0; i < 4; ++i) x[i] = ((k1 + i == k2) ? pcv : 0.f) - c[4 * g + i];
                u32x2 w_; w_.x = cvtpk(x[0], x[1]); w_.y = cvtpk(x[2], x[3]); *(u32x2*)(o + k1) = w_; }
        } else if (which == 1) {
            c = ck_mma(L + CA_BHT * CK_A + ta * 32 * CK_P, L + CA_U0T * CK_A + tb * 32 * CK_P, 4, c, r32, hi);
            c = ck_mma(L + CA_KHT * CK_A + ta * 32 * CK_P, L + CA_VT * CK_A + tb * 32 * CK_P, 4, c, r32, hi);
            float* o = (float*)(ws_ + WS_CPG + jb * 24576 + 8192) + (size_t)(ta * 32) * 64 + tb * 32 + r32;
#pragma unroll
            for (int i = 0; i < 16; ++i) o[crow(i, hi) * 64] = c[i];
        } else if (which == 2) {
            c = ck_mma(L + CA_MT * CK_A + ta * 32 * CK_P, L + CA_ARB * CK_A + tb * 32 * CK_P, 4, c, r32, hi);
            const int t = tb * 32 + r32;
            bf16_t* o = (bf16_t*)(ws_ + WS_CPSI) + jb * 4096 + (size_t)t * 64;
#pragma unroll
            for (int g = 0; g < 4; ++g) { const int k0 = ta * 32 + 8 * g + 4 * hi; const u32x2 rp2 = *(const LAS u32x2*)(L + CA_RP * CK_A + t * CK_P + k0 * 2);
                const float r0 = __builtin_bit_cast(float, rp2.x << 16), r1 = __builtin_bit_cast(float, rp2.x & 0xffff0000u), r2 = __builtin_bit_cast(float, rp2.y << 16), r3 = __builtin_bit_cast(float, rp2.y & 0xffff0000u);
                u32x2 w_; w_.x = cvtpk(r0 - c[4 * g], r1 - c[4 * g + 1]); w_.y = cvtpk(r2 - c[4 * g + 2], r3 - c[4 * g + 3]); *(u32x2*)(o + k0) = w_; }
        } else {
            c = ck_mma(L + CA_ARB * CK_A + ta * 32 * CK_P, L + CA_U0T * CK_A + tb * 32 * CK_P, 4, c, r32, hi);
            c = ck_mma(L + CA_ARK * CK_A + ta * 32 * CK_P, L + CA_VT * CK_A + tb * 32 * CK_P, 4, c, r32, hi);
            float* o = (float*)(ws_ + WS_CY0) + jb * 4096 + (size_t)(ta * 32) * 64 + tb * 32 + r32;
#pragma unroll
            for (int i = 0; i < 16; ++i) o[crow(i, hi) * 64] = c[i];
        }
    }
    __syncthreads(); STAMPF(F, 26);
}


constexpr int S2_REC = 24576, S2_NSLOT = 4, S2_SB = S2_NSLOT * S2_REC;
__device__ __forceinline__ void chunk_states(Frame& F, unsigned char* ws_, int bh) {
    LAS unsigned char* L = F.lds;
    LAS unsigned char* Sb = L + S2_SB;
    const int tid = F.tid, lane = F.lane, wave = F.wave, r32 = lane & 31, hi = lane >> 5;
    for (int i = tid; i < 64 * CK_P / 4; i += NTHR) ((LAS unsigned*)Sb)[i] = 0u;
    const unsigned char* rec0 = ws_ + WS_CPG + (size_t)bh * 64 * S2_REC;
#define S2_ISSUE(c) do { if (wave >= 4) { _Pragma("unroll") for (int p_ = 0; p_ < 6; ++p_) { const int pc_ = (wave - 4) * 6 + p_; \
        __builtin_amdgcn_global_load_lds((const unsigned*)(rec0 + (size_t)(c) * S2_REC + pc_ * 1024 + lane * 16), (LAS unsigned*)(L + ((c) & (S2_NSLOT - 1)) * S2_REC + pc_ * 1024), 16, 0, 0); } } } while (0)
    S2_ISSUE(0); S2_ISSUE(1); S2_ISSUE(2);
    if (wave >= 4) asm volatile("s_waitcnt vmcnt(12)" ::: "memory");
    __syncthreads();
    const int ti = wave >> 1, tj = wave & 1;
    for (int c = 0; c < 64; ++c) {
        if (c + 3 < 64) { S2_ISSUE(c + 3); if (wave >= 4) asm volatile("s_waitcnt vmcnt(12)" ::: "memory"); }
        else if (wave >= 4) asm volatile("s_waitcnt vmcnt(0)" ::: "memory");
        { const int row = tid >> 3, ch = tid & 7; *(u32x4*)((bf16_t*)(ws_ + WS_CS) + ((size_t)bh * 64 + c) * 4096 + row * 64 + ch * 8) = *(const LAS u32x4*)(Sb + row * CK_P + ch * 16); }
        f32x16 acc = {};
        if (wave < 4) {
            const LAS unsigned char* R = L + (c & (S2_NSLOT - 1)) * S2_REC;
            const LAS float* G = (const LAS float*)(R + 8192);
#pragma unroll
            for (int i = 0; i < 16; ++i) acc[i] = G[(ti * 32 + crow(i, hi)) * 64 + tj * 32 + r32];
#pragma unroll
            for (int s = 0; s < 4; ++s) {
                const bf16x8 a = *(const LAS bf16x8*)(R + (ti * 32 + r32) * 128 + (16 * s + 8 * hi) * 2);
                const bf16x8 b = *(const LAS bf16x8*)(Sb + (tj * 32 + r32) * CK_P + (16 * s + 8 * hi) * 2);
                acc = __builtin_amdgcn_mfma_f32_32x32x16_bf16(a, b, acc, 0, 0, 0);
            }
        }
        __syncthreads();
        if (wave < 4) ck_store_t(Sb, acc, ti * 32, tj * 32, r32, hi);
        __syncthreads();
    }
#undef S2_ISSUE
}
struct OutOps { bf16x8 a[4], b[4]; f32x16 acc; };
struct PostOps { float vv[16], rr[16], kk[16], gg[16]; };
__device__ __forceinline__ OutOps out_load(Frame& F, unsigned char* ws_, int job, int w4) {
    const int lane = F.lane, r32 = lane & 31, hi = lane >> 5, tt = w4 >> 1, tv = w4 & 1;
    const bf16_t* Psi = (const bf16_t*)(ws_ + WS_CPSI) + (size_t)job * 4096; const bf16_t* CS = (const bf16_t*)(ws_ + WS_CS) + (size_t)job * 4096; const float* Y0 = (const float*)(ws_ + WS_CY0) + (size_t)job * 4096;
    OutOps o;
#pragma unroll
    for (int s = 0; s < 4; ++s) { o.a[s] = *(const bf16x8*)(Psi + (tt * 32 + r32) * 64 + 16 * s + 8 * hi); o.b[s] = *(const bf16x8*)(CS + (tv * 32 + r32) * 64 + 16 * s + 8 * hi); }
#pragma unroll
    for (int i = 0; i < 16; ++i) o.acc[i] = Y0[(tt * 32 + crow(i, hi)) * 64 + tv * 32 + r32];
    return o;
}
__device__ __forceinline__ PostOps post_load(Frame& F, unsigned char* ws_, int job, int w4) {
    const int c = F.lane, bh = job >> 6, ch = job & 63, b = bh >> 2, h = bh & 3;
    const unsigned char* SCN = ws_ + WS_SCAN + ((size_t)bh * SEQ + (size_t)ch * 64 + w4 * 16) * SCAN_ROW + c * 2; const bf16_t* GG = (const bf16_t*)(ws_ + WS_G) + ((size_t)b * SEQ + (size_t)ch * 64 + w4 * 16) * 256 + 64 * h + c;
    PostOps p;
#pragma unroll
    for (int u = 0; u < 16; ++u) { const unsigned char* sp = SCN + (size_t)u * SCAN_ROW; p.vv[u] = bf2f(*(const unsigned short*)(sp + 256)); p.rr[u] = bf2f(*(const unsigned short*)sp); p.kk[u] = bf2f(*(const unsigned short*)(sp + 128)); p.gg[u] = bf2f(GG[(size_t)u * 256]); }
    return p;
}
__device__ __forceinline__ void out_compute(Frame& F, const OutOps& o, int w4) {
    const int lane = F.lane, r32 = lane & 31, hi = lane >> 5, tt = w4 >> 1, tv = w4 & 1;
    f32x16 acc = o.acc;
#pragma unroll
    for (int s = 0; s < 4; ++s) acc = __builtin_amdgcn_mfma_f32_32x32x16_bf16(o.a[s], o.b[s], acc, 0, 0, 0);
    LAS float* yl = (LAS float*)F.lds + (F.wave >> 2) * 4096 + (tt * 32) * 64 + tv * 32 + r32;
#pragma unroll
    for (int i = 0; i < 16; ++i) yl[crow(i, hi) * 64] = acc[i];
}
__device__ __forceinline__ void post_compute(Frame& F, const InTab& in_, unsigned char* ws_, int l, int job, int w4, const PostOps& p) {
    const int c = F.lane, bh = job >> 6, ch = job & 63, b = bh >> 2, h = bh & 3;
    const float lw = in_[I_LNW][l * 256 + 64 * h + c], lb = in_[I_LNB][l * 256 + 64 * h + c], rkw = in_[I_RK][l * 256 + 64 * h + c];
    const LAS float* yimg = (const LAS float*)F.lds + (F.wave >> 2) * 4096 + (w4 * 16) * 64 + c;
    bf16_t* MX = (bf16_t*)(ws_ + WS_MIXED) + ((size_t)b * SEQ + (size_t)ch * 64 + w4 * 16) * 1024 + 64 * h + c;
#pragma unroll
    for (int u = 0; u < 16; ++u) {
        const float y = yimg[u * 64];
        const float mean = wave_sum(y) * (1.f / 64.f); const float d = y - mean; const float var = wave_sum(d * d) * (1.f / 64.f);
        float yn = d * (1.f / sqrtf(var + 64e-5f)) * lw + lb;
        yn += wave_sum(p.rr[u] * p.kk[u] * rkw) * p.vv[u];
        yn *= p.gg[u];
        MX[(size_t)u * 1024] = (bf16_t)f2bf(yn);
    }
}

constexpr int AT_ROWB = 144;
constexpr int AT_KOFF = 0, AT_VOFF = 2 * 64 * AT_ROWB, AT_BOFF = 4 * 64 * AT_ROWB, AT_QUEUE = AT_BOFF + 2 * 256;
__device__ __forceinline__ void attn_unit(Frame& F, int b, int h, int qb) {
    refresh(F); unsigned char* ws_ = (unsigned char*)ldptr(F, 30); const InTab in_{F.lds}; gu32* ctl_ = (gu32*)ws_;

    const int lane = F.lane, r32 = lane & 31, hi = lane >> 5, wid = F.wave, tid = F.tid;
    const bf16_t* Q = (const bf16_t*)(ws_ + WS_Q); const bf16_t* Kg = (const bf16_t*)(ws_ + WS_K); const bf16_t* Vg = (const bf16_t*)(ws_ + WS_V);
    const float* BI = (const float*)(ws_ + WS_BIAS) + ((size_t)b * 8 + h) * SEQ;
    const size_t rowbase = (size_t)b * SEQ; const int q0 = qb * 256, qw0 = q0 + wid * 32;
    LAS unsigned char* lds = F.lds;
    bf16x8 qr[4];
#pragma unroll
    for (int d0 = 0; d0 < 4; ++d0) qr[d0] = *(const bf16x8*)(Q + (rowbase + qw0 + r32) * 512 + h * 64 + d0 * 16 + hi * 8);
    const int NT = (q0 + 256) / 64;
    int T0 = 0;
    { const float nbq = BI[q0]; const float vlast = (lane < NT) ? BI[64 * lane + 63] : 3.0e38f;
      const unsigned long long ok = __ballot(vlast - nbq >= -150.f);
      T0 = ok ? (int)(__ffsll((long long)ok) - 1) : 0; T0 = __builtin_amdgcn_readfirstlane(T0); }
    const int srow = tid >> 3, sch = tid & 7;
    const bf16_t* kp = Kg + (rowbase + srow) * 512 + h * 64 + sch * 8; const bf16_t* vp = Vg + (rowbase + srow) * 512 + h * 64 + sch * 8;
    u32x4 kreg = *(const u32x4*)(kp + (size_t)T0 * 64 * 512), vreg = *(const u32x4*)(vp + (size_t)T0 * 64 * 512); float breg = (tid < 64) ? BI[T0 * 64 + tid] : 0.f;
    { const int b0_ = T0 & 1;
      *(LAS u32x4*)(lds + AT_KOFF + b0_ * 64 * AT_ROWB + srow * AT_ROWB + sch * 16) = kreg; *(LAS u32x4*)(lds + AT_VOFF + b0_ * 64 * AT_ROWB + srow * AT_ROWB + sch * 16) = vreg;
      if (tid < 64) *(LAS float*)(lds + AT_BOFF + b0_ * 256 + tid * 4) = breg; }
    __syncthreads();
    f32x16 o0 = {}, o1 = {};
    float nbi = BI[qw0 + r32];
    float lrun = 0.f;
    const int i16 = lane & 15, tq = i16 >> 2, tp = i16 & 3, blk = (lane >> 4) & 1;
    for (int t = T0; t < NT; ++t) {
        const int cb = t & 1, nb = cb ^ 1;
        if (t + 1 < NT) { kreg = *(const u32x4*)(kp + (size_t)(t + 1) * 64 * 512); vreg = *(const u32x4*)(vp + (size_t)(t + 1) * 64 * 512); if (tid < 64) breg = BI[(t + 1) * 64 + tid]; }
        if (64 * t <= qw0 + 31) {
            const LAS unsigned char* Ks = lds + AT_KOFF + cb * 64 * AT_ROWB; const LAS unsigned char* Vs = lds + AT_VOFF + cb * 64 * AT_ROWB; const LAS float* Bs = (const LAS float*)(lds + AT_BOFF + cb * 256);
            f32x16 p0, p1;
#pragma unroll
            for (int g = 0; g < 4; ++g) {
                const f32x4 b0 = *(const LAS f32x4*)(Bs + 8 * g + 4 * hi), b1 = *(const LAS f32x4*)(Bs + 32 + 8 * g + 4 * hi);
#pragma unroll
                for (int i = 0; i < 4; ++i) { p0[4 * g + i] = b0[i] - nbi; p1[4 * g + i] = b1[i] - nbi; }
            }
#pragma unroll
            for (int d0 = 0; d0 < 4; ++d0) {
                const bf16x8 a0 = *(const LAS bf16x8*)(Ks + r32 * AT_ROWB + (d0 * 16 + hi * 8) * 2);
                const bf16x8 a1 = *(const LAS bf16x8*)(Ks + (32 + r32) * AT_ROWB + (d0 * 16 + hi * 8) * 2);
                p0 = __builtin_amdgcn_mfma_f32_32x32x16_bf16(a0, qr[d0], p0, 0, 0, 0);
                p1 = __builtin_amdgcn_mfma_f32_32x32x16_bf16(a1, qr[d0], p1, 0, 0, 0);
            }
            if (64 * t + 63 > qw0) {
                const int qabs = qw0 + r32;
#pragma unroll
                for (int i = 0; i < 16; ++i) { const int kv = 64 * t + crow(i, hi); if (kv > qabs) p0[i] = -INFINITY; if (kv + 32 > qabs) p1[i] = -INFINITY; }
            }
            float mx = fmaxf(fmaxf(p0[0], p0[1]), p1[0]);
#pragma unroll
            for (int i = 1; i < 16; ++i) mx = fmaxf(fmaxf(mx, p0[i]), p1[i]);
            if (__any(mx > 24.f)) {
                const float mo = fmaxf(mx, __shfl_xor(mx, 32));
                const float dl = fmaxf(mo, 0.f);
                nbi += dl;
                const float f = __builtin_amdgcn_exp2f(-dl);
                lrun *= f;
#pragma unroll
                for (int i = 0; i < 16; ++i) { p0[i] -= dl; p1[i] -= dl; o0[i] *= f; o1[i] *= f; }
            }
            float ls0 = 0.f, ls1 = 0.f;
#pragma unroll
            for (int i = 0; i < 16; ++i) { p0[i] = __builtin_amdgcn_exp2f(p0[i]); p1[i] = __builtin_amdgcn_exp2f(p1[i]); ls0 += p0[i]; ls1 += p1[i]; }
            lrun += ls0 + ls1;
            bf16x8 pf[4];
#pragma unroll
            for (int s = 0; s < 2; ++s) {
                u32x4 w0, w1;
                w0.x = cvtpk(p0[8 * s + 0], p0[8 * s + 1]); w0.y = cvtpk(p0[8 * s + 2], p0[8 * s + 3]); w0.z = cvtpk(p0[8 * s + 4], p0[8 * s + 5]); w0.w = cvtpk(p0[8 * s + 6], p0[8 * s + 7]);
                w1.x = cvtpk(p1[8 * s + 0], p1[8 * s + 1]); w1.y = cvtpk(p1[8 * s + 2], p1[8 * s + 3]); w1.z = cvtpk(p1[8 * s + 4], p1[8 * s + 5]); w1.w = cvtpk(p1[8 * s + 6], p1[8 * s + 7]);
                pf[s] = __builtin_bit_cast(bf16x8, w0); pf[2 + s] = __builtin_bit_cast(bf16x8, w1);
            }
#pragma unroll
            for (int ks4 = 0; ks4 < 4; ++ks4) {
                const int kvb = (ks4 >> 1) * 32 + (ks4 & 1) * 16 + 4 * hi;
#pragma unroll
                for (int d0 = 0; d0 < 2; ++d0) {
                    const LAS unsigned char* a_lo = Vs + (kvb + tq) * AT_ROWB + (32 * d0 + 16 * blk) * 2 + 8 * tp;
                    const s16x4 lo = __builtin_bit_cast(s16x4, __builtin_amdgcn_ds_read_tr16_b64_v4i16((LAS s16x4*)a_lo));
                    const s16x4 hv = __builtin_bit_cast(s16x4, __builtin_amdgcn_ds_read_tr16_b64_v4i16((LAS s16x4*)(a_lo + 8 * AT_ROWB)));
                    const bf16x8 va = __builtin_shufflevector(lo, hv, 0, 1, 2, 3, 4, 5, 6, 7);
                    if (d0 == 0) o0 = __builtin_amdgcn_mfma_f32_32x32x16_bf16(va, pf[ks4], o0, 0, 0, 0);
                    else o1 = __builtin_amdgcn_mfma_f32_32x32x16_bf16(va, pf[ks4], o1, 0, 0, 0);
                }
            }
        }
        if (t + 1 < NT) {
            *(LAS u32x4*)(lds + AT_KOFF + nb * 64 * AT_ROWB + srow * AT_ROWB + sch * 16) = kreg; *(LAS u32x4*)(lds + AT_VOFF + nb * 64 * AT_ROWB + srow * AT_ROWB + sch * 16) = vreg;
            if (tid < 64) *(LAS float*)(lds + AT_BOFF + nb * 256 + tid * 4) = breg;
        }
        __syncthreads();
    }
    lrun += __shfl_xor(lrun, 32);
    const float inv = 1.f / lrun;
    bf16_t* O = (bf16_t*)(ws_ + WS_MIXED) + (rowbase + qw0 + r32) * 1024 + 512 + h * 64;
#pragma unroll
    for (int g = 0; g < 4; ++g) {
        u32x2 w; w.x = cvtpk(o0[4 * g] * inv, o0[4 * g + 1] * inv); w.y = cvtpk(o0[4 * g + 2] * inv, o0[4 * g + 3] * inv);
        *(u32x2*)(O + 8 * g + 4 * hi) = w;
        u32x2 w2; w2.x = cvtpk(o1[4 * g] * inv, o1[4 * g + 1] * inv); w2.y = cvtpk(o1[4 * g + 2] * inv, o1[4 * g + 3] * inv);
        *(u32x2*)(O + 32 + 8 * g + 4 * hi) = w2;
    }
}
__device__ __forceinline__ void pool_batch(Frame& F, const InTab& in_, unsigned char* ws_, int l, int q) {
    LAS float* Wp = (LAS float*)F.lds;
    LAS float* ps = (LAS float*)(F.lds + 65536) + F.wave * 512;
    { const float* w = in_[I_POOLW] + (size_t)l * 4 * 64 * 64; f32x4 t8[8];
#pragma unroll
      for (int u = 0; u < 8; ++u) t8[u] = *(const f32x4*)(w + 4 * (F.tid + NTHR * u));
#pragma unroll
      for (int u = 0; u < 8; ++u) *(LAS f32x4*)(Wp + 4 * (F.tid + NTHR * u)) = t8[u]; }
    __syncthreads();
    const int c = F.lane;
    bf16_t* MX = (bf16_t*)(ws_ + WS_MIXED);
    const float* ZP = (const float*)(ws_ + WS_ZP);
    for (int jj = 0; jj < 8; ++jj) {
        const int it = q * 64 + jj * 8 + F.wave;
        const int g = it & 3, m0 = (it >> 2) * 8, win = 2 << g;
        {
            const int seq0 = m0 & ~(SEQ - 1);
            float zz[23];
#pragma unroll
            for (int qq = 0; qq < 23; ++qq) { const int rr = m0 - 15 + qq; zz[qq] = (rr >= seq0 && (qq >= 15 || 15 - qq < win + 7)) ? ZP[(size_t)rr * 256 + 64 * g + c] : 0.f; }
#pragma unroll
            for (int i = 0; i < 8; ++i) {
                const int t = (m0 + i) & (SEQ - 1); const int n = (t + 1 < win) ? t + 1 : win;
                float s = 0.f;
#pragma unroll
                for (int j = 0; j < 16; ++j) s += (j < win) ? zz[15 + i - j] : 0.f;
                ps[i * 64 + c] = s / (float)n - zz[15 + i];
            }
        }
        LDS_WAIT(); asm volatile("" ::: "memory");
        float acc[8];
#pragma unroll
        for (int i = 0; i < 8; ++i) acc[i] = 0.f;
        const LAS float* W = Wp + g * 4096;
        for (int j = 0; j < 64; j += 4) {
            const float w_0 = W[(j + 0) * 64 + c], w_1 = W[(j + 1) * 64 + c], w_2 = W[(j + 2) * 64 + c], w_3 = W[(j + 3) * 64 + c];
#pragma unroll
            for (int i = 0; i < 8; ++i) { const f32x4 x = *(const LAS f32x4*)(ps + i * 64 + j); acc[i] += x.x * w_0 + x.y * w_1 + x.z * w_2 + x.w * w_3; }
        }
        const float sc = in_[I_POOLS][l * 256 + 64 * g + c];
#pragma unroll
        for (int i = 0; i < 8; ++i) MX[(size_t)(m0 + i) * 1024 + 256 + 64 * g + c] = (bf16_t)f2bf(acc[i] * sc);
        LDS_WAIT(); asm volatile("" ::: "memory");
    }
    __syncthreads();
}
__device__ __forceinline__ void tail_convert(Frame& F, int lc, int nmax) {
    refresh(F); unsigned char* ws_ = (unsigned char*)ldptr(F, 30); const InTab in_{F.lds}; gu32* ctl_ = (gu32*)ws_;
    LAS int* qslot = (LAS int*)(F.lds + MISC_OFF + 64);
    for (int n = 0; n < nmax; ++n) {
        if (F.tid == 0) qslot[0] = (int)__hip_atomic_fetch_add(ctl_ + CW_CQ + lc * 64, 1u, RLX_AGENT);
        __syncthreads();
        const int q = qslot[0];
        __syncthreads();
        if (q >= 768) break;
        convert_moe_batch(F, in_, ws_, lc, q);
    }
    __syncthreads();
}
__device__ __forceinline__ void phase_mix(Frame& F, int l, int qsel = 0) {
    refresh(F); unsigned char* ws_ = (unsigned char*)ldptr(F, 30); const InTab in_{F.lds}; gu32* ctl_ = (gu32*)ws_;

#if CHUNKED_SCAN
    if (blockIdx.x < 16) { chunk_states(F, ws_, blockIdx.x); if (PROBE_DUP == 16) { __syncthreads(); chunk_states(F, ws_, blockIdx.x); } __syncthreads(); }
#else
    if (blockIdx.x < 64) { scan_block(F, blockIdx.x); if (PROBE_DUP == 12) { __syncthreads(); scan_block(F, blockIdx.x); } return; }
#endif
    LAS int* qslot = (LAS int*)(F.lds + MISC_OFF + 64);
    for (;;) {
        if (F.tid == 0) qslot[0] = (int)__hip_atomic_fetch_add(ctl_ + CW_QUEUE + (l + 4 * qsel) * 64, 1u, RLX_AGENT);
        __syncthreads();
        const int u = qslot[0];
        __syncthreads();
        if (PROBE_DUP == 17) { if (u >= 1024 + 128 + 768) break; if (u < 1024) { const int uu = u >> 1; const int qb = 15 - (uu >> 5), bh = uu & 31; attn_unit(F, bh >> 3, bh & 7, qb); } else if (u < 1152) pool_batch(F, in_, ws_, l, u - 1024); else convert_moe_batch(F, in_, ws_, l, u - 1152); continue; }
        if (PROBE_DUP == 18) { if (u >= 512 + 128 + 1536) break; if (u < 512) { const int qb = 15 - (u >> 5), bh = u & 31; attn_unit(F, bh >> 3, bh & 7, qb); } else if (u < 640) pool_batch(F, in_, ws_, l, u - 512); else convert_moe_batch(F, in_, ws_, l, (u - 640) >> 1); continue; }
        if (u >= 512 + 128) break;
        if (u < 512) { const int qb = 15 - (u >> 5), bh = u & 31; attn_unit(F, bh >> 3, bh & 7, qb); }
        else pool_batch(F, in_, ws_, l, u - 512);
    }
    tail_convert(F, l, 1 << 20);
}

__device__ __forceinline__ void phase_post(Frame& F, int l) {
    refresh(F); unsigned char* ws_ = (unsigned char*)ldptr(F, 30); const InTab in_{F.lds}; gu32* ctl_ = (gu32*)ws_;

    const int gw = F.vcu * NWAVES + F.wave, NGW = F.G * NWAVES, c = F.lane;
    bf16_t* MX = (bf16_t*)(ws_ + WS_MIXED);
    {
        float lw[4], lb[4], rkw[4];
#pragma unroll
        for (int h = 0; h < 4; ++h) { lw[h] = in_[I_LNW][l * 256 + 64 * h + c]; lb[h] = in_[I_LNB][l * 256 + 64 * h + c]; rkw[h] = in_[I_RK][l * 256 + 64 * h + c]; }
        const float* YR = (const float*)(ws_ + WS_YRAW); const float* SCN = (const float*)(ws_ + WS_SCAN); const float* GG = (const float*)(ws_ + WS_G);
        for (int it0 = gw * 8; it0 < NTOK * 4; it0 += NGW * 8) {
            float y[8], vv[8], bn[8], gg[8];
#pragma unroll
            for (int u = 0; u < 8; ++u) {
                const int it = it0 + u, m = it >> 2, h = u & 3, b = m >> 12, t = m & (SEQ - 1);
                const float* sp = SCN + ((size_t)(b * 4 + h) * SEQ + t) * 384 + c;
                y[u] = YR[(size_t)m * 256 + 64 * h + c]; vv[u] = sp[192]; bn[u] = sp[0] * sp[128] * rkw[h]; gg[u] = GG[(size_t)m * 256 + 64 * h + c];
            }
#pragma unroll
            for (int u = 0; u < 8; ++u) {
                const int it = it0 + u, m = it >> 2, h = u & 3;
                const float mean = wave_sum(y[u]) * (1.f / 64.f); const float d = y[u] - mean; const float var = wave_sum(d * d) * (1.f / 64.f);
                float yn = d * (1.f / sqrtf(var + 64e-5f)) * lw[h] + lb[h];
                yn += wave_sum(bn[u]) * vv[u];
                yn *= gg[u];
                MX[(size_t)m * 1024 + 64 * h + c] = (bf16_t)f2bf(yn);
            }
        }
    }
}

__device__ __forceinline__ void phase_route(Frame& F, int l, int csel = 0) {
    refresh(F); unsigned char* ws_ = (unsigned char*)ldptr(F, 30); const InTab in_{F.lds}; gu32* ctl_ = (gu32*)ws_;

    LAS float* WT = (LAS float*)F.lds;
    LAS int* lcnt = (LAS int*)(F.lds + TAB_OFF);
    LAS int* lbase = lcnt + 32;
    LAS int* le = lbase + 32;
    LAS int* lpos = le + 256;
    { const float* rw = in_[I_RW] + (size_t)l * 1024 * 32;
      f32x4 t16[16];
#pragma unroll
      for (int u = 0; u < 16; ++u) t16[u] = *(const f32x4*)(rw + 4 * (F.tid + NTHR * u));
#pragma unroll
      for (int u = 0; u < 16; ++u) { const int i = F.tid + NTHR * u, k = i >> 3, e = (i & 7) * 4; WT[(e + 0) * 1024 + k] = t16[u].x; WT[(e + 1) * 1024 + k] = t16[u].y; WT[(e + 2) * 1024 + k] = t16[u].z; WT[(e + 3) * 1024 + k] = t16[u].w; } }
    const float* X = (const float*)(ws_ + WS_X); const float* MOD = (const float*)(ws_ + WS_MOD);
    const float* nw = in_[I_NORM2] + l * 1024;
    const float rb = in_[I_RB][l * 32 + (F.lane >> 1)];
    for (int tb = blockIdx.x; tb < NTOK / 64; tb += F.G) {
        if (F.tid < 32) lcnt[F.tid] = 0;
        __syncthreads();
        f32x4 xnx[2][4];
#pragma unroll
        for (int u = 0; u < 2; ++u)
#pragma unroll
            for (int j = 0; j < 4; ++j) xnx[u][j] = *(const f32x4*)(X + (size_t)(tb * 64 + F.wave * 8 + u) * 1024 + 4 * F.lane + 256 * j);
#pragma nounroll
        for (int ip = 0; ip < 4; ++ip) {
            const int ti0 = F.wave * 8 + 2 * ip, m0 = tb * 64 + ti0, b = m0 >> 12;
            const float* sh = MOD + (size_t)(l * 4 + b) * 6144 + 3 * 1024; const float* sc = sh + 1024;
            f32x4 hv[2][4];
#pragma unroll
            for (int u = 0; u < 2; ++u) {
                float ss = 0.f;
#pragma unroll
                for (int j = 0; j < 4; ++j) { hv[u][j] = xnx[u][j]; ss += (hv[u][j].x * hv[u][j].x + hv[u][j].y * hv[u][j].y) + (hv[u][j].z * hv[u][j].z + hv[u][j].w * hv[u][j].w); }
                const float rs = 1.f / sqrtf(wave_sum(ss) * (1.f / 1024.f) + 1e-6f);
                bf16_t* H = (bf16_t*)(ws_ + WS_H) + (size_t)(m0 + u) * 1024;
#pragma unroll
                for (int j = 0; j < 4; ++j) { const int c0 = 4 * F.lane + 256 * j; const f32x4 w = *(const f32x4*)(nw + c0), s1 = *(const f32x4*)(sc + c0), s0 = *(const f32x4*)(sh + c0);
                    hv[u][j] = hv[u][j] * rs * w * (s1 + 1.f) + s0; u32x2 o; o.x = cvtpk(hv[u][j].x, hv[u][j].y); o.y = cvtpk(hv[u][j].z, hv[u][j].w); *(u32x2*)(H + c0) = o; }
            }
            if (ip < 3) {
#pragma unroll
                for (int u = 0; u < 2; ++u)
#pragma unroll
                    for (int j = 0; j < 4; ++j) xnx[u][j] = *(const f32x4*)(X + (size_t)(m0 + 2 + u) * 1024 + 4 * F.lane + 256 * j);
            }
            float val[2] = {0.f, 0.f};
#pragma unroll
            for (int half = 0; half < 2; ++half) {
                float a[2][16];
#pragma unroll
                for (int e = 0; e < 16; ++e) {
                    float s0 = 0.f, s1 = 0.f;
#pragma unroll
                    for (int j = 0; j < 4; ++j) { const f32x4 w = *(const LAS f32x4*)(WT + (16 * half + e) * 1024 + 4 * F.lane + 256 * j);
                        s0 += hv[0][j].x * w.x + hv[0][j].y * w.y + hv[0][j].z * w.z + hv[0][j].w * w.w; s1 += hv[1][j].x * w.x + hv[1][j].y * w.y + hv[1][j].z * w.z + hv[1][j].w * w.w; }
                    a[0][e] = s0; a[1][e] = s1;
                }
#pragma unroll
                for (int u = 0; u < 2; ++u) {
#pragma unroll
                    for (int q = 0; q < 8; ++q) { const auto rr = __builtin_amdgcn_permlane16_swap(__float_as_uint(a[u][q]), __float_as_uint(a[u][q + 8]), false, false); a[u][q] = __uint_as_float(rr[0]) + __uint_as_float(rr[1]); }
#define RSTEP(N, BIT, SEL) { const bool up_ = (F.lane & (BIT)) != 0; _Pragma("unroll") for (int q = 0; q < (N); ++q) { const float send = up_ ? a[u][q] : a[u][q + (N)]; const float keep = up_ ? a[u][q + (N)] : a[u][q]; a[u][q] = keep + dpp_f(send, SEL); } }
                    RSTEP(4, 8, 3) RSTEP(2, 4, 2) RSTEP(1, 2, 1)
#undef RSTEP
                    float v = a[u][0] + dpp_f(a[u][0], 0);
                    { const auto rr = __builtin_amdgcn_permlane32_swap(__float_as_uint(v), __float_as_uint(v), false, false); v = __uint_as_float(rr[0]) + __uint_as_float(rr[1]); }
                    if ((F.lane >> 5) == half) val[u] = v;
                }
            }
#pragma unroll
            for (int u = 0; u < 2; ++u) {
                float vv = val[u] + rb;
                const int ti = ti0 + u, m = m0 + u;
                float tv[4]; int te[4];
#pragma unroll
                for (int k = 0; k < 4; ++k) {
                    const float mx = wave_max(vv);
                    const unsigned long long bal = __ballot(vv == mx);
                    const int ln = __ffsll((long long)bal) - 1; const int e = ln >> 1;
                    tv[k] = mx; te[k] = e;
                    if ((F.lane >> 1) == e) vv = -INFINITY;
                }
                const float e1 = __expf(tv[1] - tv[0]), e2 = __expf(tv[2] - tv[0]), e3 = __expf(tv[3] - tv[0]); const float invs = 1.f / (1.f + e1 + e2 + e3);
                if (F.lane < 4) {
                    const int k = F.lane; const int e = (k == 0) ? te[0] : (k == 1) ? te[1] : (k == 2) ? te[2] : te[3];
                    const float gt = ((k == 0) ? 1.f : (k == 1) ? e1 : (k == 2) ? e2 : e3) * invs;
                    ((float*)(ws_ + WS_GATE))[(size_t)m * 4 + k] = gt;
                    le[ti * 4 + k] = e; lpos[ti * 4 + k] = atomicAdd((int*)&lcnt[e], 1);
                }
            }
        }
        __syncthreads();
        if (F.tid < 32) lbase[F.tid] = (int)__hip_atomic_fetch_add(ctl_ + CW_CNT + ((l + 4 * csel) * 32 + F.tid) * 64, (unsigned)lcnt[F.tid], RLX_AGENT);
        __syncthreads();
        if (F.tid < 256) { const int e = le[F.tid]; ((int*)(ws_ + WS_LIST))[e * NTOK + lbase[e] + lpos[F.tid]] = (tb * 64 + (F.tid >> 2)) * 4 + (F.tid & 3); }
        __syncthreads();
    }
}

constexpr int NPHASE = 2 + 9 * NL;
__global__ void __launch_bounds__(NTHR, 2) trunk_fwd(Args args) {
    extern __shared__ __attribute__((aligned(16))) unsigned char lds_raw[];
    Frame F;
    F.lds = (LAS unsigned char*)lds_raw;
    F.MISC = (volatile LAS unsigned*)(F.lds + MISC_OFF);
    F.tid = threadIdx.x; F.lane = F.tid & 63; F.wave = __builtin_amdgcn_readfirstlane(F.tid >> 6);
    F.G = gridDim.x; { const int bx = blockIdx.x; F.vcu = (F.G % 8 == 0) ? (bx % 8) * (F.G / 8) + bx / 8 : bx; }
    for (int u = F.tid; u < 64; u += NTHR) ((LAS unsigned*)(F.lds + MISC_OFF))[u] = 0u;
    if (F.tid < 29) *(LAS unsigned long long*)(F.lds + PTR_OFF + 8 * F.tid) = (unsigned long long)args.in[F.tid];
    if (F.tid == 29) *(LAS unsigned long long*)(F.lds + PTR_OFF + 8 * 29) = (unsigned long long)args.out;
    if (F.tid == 30) *(LAS unsigned long long*)(F.lds + PTR_OFF + 8 * 30) = (unsigned long long)args.ws;
    __syncthreads();
#if MK_PER_PHASE
#define GRID_BAR() do { } while (0)
#else
    XcdBarrier bar = xcd_barrier_post((unsigned*)(args.ws) + CW_BAR, F.MISC + 8);
#define GRID_BAR() xcd_barrier(bar)
#endif
    const int lo = args.ph_lo, hi = args.ph_hi;
    volatile LAS unsigned long long* tsw = (volatile LAS unsigned long long*)(F.lds + MISC_OFF + 192);
#define STAMP(id) do { if (PROBE_T >= 0 && blockIdx.x == 0 && F.tid == 0) { const unsigned long long now_ = wall_clock64(); if ((id) == PROBE_T) tsw[1] += now_ - tsw[0]; tsw[0] = now_; } } while (0)
    if (PROBE_T >= 0 && blockIdx.x == 0 && F.tid == 0) { const unsigned long long now_ = wall_clock64(); tsw[0] = now_; tsw[1] = 0ull; tsw[2] = now_; }
#define IN(k) (lo <= (k) && (k) < hi)
#define SEAM(k) do { if (IN(k) && IN((k) + 1)) GRID_BAR(); } while (0)
    if (IN(0)) { phase_prologue(F); if (PROBE_DUP == 1) { GRID_BAR(); phase_prologue(F); } SEAM(0); }
    if (IN(1)) { phase_combine(F, -1); if (PROBE_DUP == 2) { GRID_BAR(); phase_combine(F, -1); } SEAM(1); }
    for (int l = 0; l < NL; ++l) {
        const int p0 = 2 + 9 * l;
        if (IN(p0)) {
            refresh(F); unsigned char* ws_ = (unsigned char*)ldptr(F, 30); const InTab in_{F.lds};
            ProbDense P{(const char*)(ws_ + WS_H), (const char*)(ws_ + WS_WIN) + (size_t)l * NPROJ * 2048, NTOK / 256, NPROJ / 256, F.G, F.vcu};
            EpiProj E{ws_};
            pg8::gemm_phase<false, 1024>(F.lds, nullptr, F.tid, P, E);
            if (PROBE_DUP == 3) { GRID_BAR(); pg8::gemm_phase<false, 1024>(F.lds, nullptr, F.tid, P, E); }
            if (TAIL_CONVERT) { const int nun = (NTOK / 256) * (NPROJ / 256), mine = (nun - F.vcu + F.G - 1) / F.G, most = (nun + F.G - 1) / F.G; if (mine < most) tail_convert(F, l, most - mine); }
            SEAM(p0); STAMP(0);
        }
        if (IN(p0 + 1)) {
            phase_prep(F, l); if (PROBE_DUP == 4) { GRID_BAR(); phase_prep(F, l); }
            GRID_BAR(); STAMP(1);
            refresh(F); unsigned char* ws_ = (unsigned char*)ldptr(F, 30); const InTab in_{F.lds};
            ProbLora P{(const char*)(ws_ + WS_ALORA), (const char*)(ws_ + WS_LORA) + (size_t)l * 768 * 512, F.G, F.vcu};
            EpiLora E{ws_, in_[I_W0] + l * 256, in_[I_A0] + l * 256, in_[I_KA] + l * 256};
            pg8::gemm_phase<false, 256>(F.lds, nullptr, F.tid, P, E);
            if (TAIL_CONVERT && F.vcu >= 192) tail_convert(F, l, 1);
            SEAM(p0 + 1); STAMP(2);
        }
        if (IN(p0 + 2)) {
#if CHUNKED_SCAN
            { refresh(F); unsigned char* ws_ = (unsigned char*)ldptr(F, 30);
              ChunkRows cur = chunk_load(F, ws_, F.vcu);
              for (int job = F.vcu; job < 1024; job += F.G) {
                  ChunkRows nxt = cur; if (job + F.G < 1024) nxt = chunk_load(F, ws_, job + F.G);
                  chunk_job(F, ws_, job, cur); cur = nxt; } }
            GRID_BAR(); STAMP(3);
#endif
            phase_mix(F, l); if (PROBE_DUP == 5) { GRID_BAR(); phase_mix(F, l, 1); } SEAM(p0 + 2); STAMP(4); }
        if (IN(p0 + 3)) {
#if CHUNKED_SCAN
            { refresh(F); unsigned char* ws_ = (unsigned char*)ldptr(F, 30); const InTab in_{F.lds};
              const int w4 = F.wave & 3, jobA = F.vcu * 2 + (F.wave >> 2), jobB = (F.vcu + F.G) * 2 + (F.wave >> 2);
              if (F.G * 4 == 1024) {
                  OutOps oa = out_load(F, ws_, jobA, w4); PostOps pa = post_load(F, ws_, jobA, w4); OutOps ob = out_load(F, ws_, jobB, w4);
                  out_compute(F, oa, w4); __syncthreads();
                  PostOps pb = post_load(F, ws_, jobB, w4);
                  post_compute(F, in_, ws_, l, jobA, w4, pa); __syncthreads();
                  out_compute(F, ob, w4); __syncthreads();
                  post_compute(F, in_, ws_, l, jobB, w4, pb); __syncthreads();
              } else {
                  for (int jp = F.vcu; jp < 512; jp += F.G) { const int job = jp * 2 + (F.wave >> 2);
                      OutOps oa = out_load(F, ws_, job, w4); PostOps pa = post_load(F, ws_, job, w4);
                      out_compute(F, oa, w4); __syncthreads(); post_compute(F, in_, ws_, l, job, w4, pa); __syncthreads(); }
              } }
            SEAM(p0 + 3); STAMP(5);
#else
            phase_post(F, l); if (PROBE_DUP == 6) { GRID_BAR(); phase_post(F, l); } SEAM(p0 + 3);
#endif
        }
        if (IN(p0 + 4)) {
            refresh(F); unsigned char* ws_ = (unsigned char*)ldptr(F, 30); const InTab in_{F.lds};
            ProbDense P{(const char*)(ws_ + WS_MIXED), (const char*)(ws_ + WS_WOUT) + (size_t)l * 1024 * 2048, NTOK / 256, 4, F.G, F.vcu};
            EpiOut E{(float*)(ws_ + WS_X), (l == 0) ? in_[I_X] : (const float*)(ws_ + WS_X), (const float*)(ws_ + WS_MOD) + (size_t)l * 4 * 6144 + 2 * 1024, 1.f};
            if (PROBE_DUP == 7) { EpiOut E0{(float*)(ws_ + WS_X), (l == 0) ? in_[I_X] : (const float*)(ws_ + WS_X), (const float*)(ws_ + WS_MOD) + (size_t)l * 4 * 6144 + 2 * 1024, 0.f}; pg8::gemm_phase<false, 1024>(F.lds, nullptr, F.tid, P, E0); GRID_BAR(); }
            pg8::gemm_phase<false, 1024>(F.lds, nullptr, F.tid, P, E);
            SEAM(p0 + 4); STAMP(6);
        }
        if (IN(p0 + 5)) { phase_route(F, l); if (PROBE_DUP == 8) { GRID_BAR(); phase_route(F, l, 1); } SEAM(p0 + 5); STAMP(7); }
        if (IN(p0 + 6)) {
            refresh(F); unsigned char* ws_ = (unsigned char*)ldptr(F, 30); const InTab in_{F.lds};
            MoeTab T = moe_table(F, l);
            ProbGU P{(const char*)(ws_ + WS_H), (const char*)(ws_ + WS_WGU), (const int*)(ws_ + WS_LIST), T, __builtin_amdgcn_readfirstlane(T.ntiles[0]) * 8, F.G, F.vcu, l};
            EpiGU E{(bf16_t*)(ws_ + WS_ACT), in_[I_BGU], l};
            pg8::gemm_phase<true, 1024>(F.lds, (LAS unsigned*)(F.lds + ROWTAB_OFF), F.tid, P, E);
            if (PROBE_DUP == 9) { GRID_BAR(); pg8::gemm_phase<true, 1024>(F.lds, (LAS unsigned*)(F.lds + ROWTAB_OFF), F.tid, P, E); }
            if (TAIL_CONVERT && l + 1 < NL) { const int nun = P.nun, mine = (nun - F.vcu + F.G - 1) / F.G, most = (nun + F.G - 1) / F.G; if (mine < most) tail_convert(F, l + 1, most - mine); }
            SEAM(p0 + 6); STAMP(8);
        }
        if (IN(p0 + 7)) {
            refresh(F); unsigned char* ws_ = (unsigned char*)ldptr(F, 30); const InTab in_{F.lds};
            MoeTab T = moe_table(F, l);
            ProbDN P{(const char*)(ws_ + WS_ACT), (const char*)(ws_ + WS_WDN), T, __builtin_amdgcn_readfirstlane(T.ntiles[0]) * 4, F.G, F.vcu, l};
            EpiDN E{(bf16_t*)(ws_ + WS_YSLOT), in_[I_BDN], (const int*)(ws_ + WS_LIST), (const float*)(ws_ + WS_GATE), T, l};
            pg8::gemm_phase<false, 1024>(F.lds, nullptr, F.tid, P, E);
            if (PROBE_DUP == 10) { GRID_BAR(); pg8::gemm_phase<false, 1024>(F.lds, nullptr, F.tid, P, E); }
            if (TAIL_CONVERT && l + 1 < NL) { const int nun = P.nun, mine = (nun - F.vcu + F.G - 1) / F.G, most = (nun + F.G - 1) / F.G; if (mine < most) tail_convert(F, l + 1, most - mine); }
            if (PROBE_T >= 0 && l == NL - 1 && blockIdx.x == 0 && F.tid == 0) {
                const unsigned long long now_ = wall_clock64(); if (PROBE_T == 9) tsw[1] += now_ - tsw[0];
                const float share = (float)(double)tsw[1] / (float)(double)(now_ - tsw[2]);
                __hip_atomic_store((GAS float*)((gu32*)ldptr(F, 30) + CW_CODE + 1), (PROBE_T >= 20 ? 3.0f : (PROBE_T == 4 || PROBE_T == 8 || PROBE_T == 9 || PROBE_T == 0) ? 0.3f : 0.5f) * share, RLX_AGENT);
            }
            SEAM(p0 + 7); STAMP(9);
        }
        if (IN(p0 + 8)) { if (PROBE_DUP == 11) { phase_combine(F, l, 0.f); GRID_BAR(); } phase_combine(F, l); SEAM(p0 + 8); STAMP(10); }
    }
#undef IN
#undef SEAM
#if !MK_PER_PHASE
    if (blockIdx.x == 0 && F.tid == 0 && xb_ld(bar.bar + XB_TMO) != 0u) { float* o = (float*)ldptr(F, 29); o[0] = __builtin_nanf(""); }
#endif
}

extern "C" void kernel_launch(void* const* d_in, const int* in_sizes, int n_in, void* d_out, int out_size, void* d_ws, size_t ws_size, hipStream_t stream) {
    static int grid = 0;
    if (grid == 0) {
        if (n_in != 29 || out_size != NTOK * DM || ws_size < WS_END) { fprintf(stderr, "kernel_launch: unexpected sizes n_in %d out %d ws %zu (need %zu)\n", n_in, out_size, ws_size, (size_t)WS_END); grid = -1; return; }
        int dev = 0, cus = 0;
        if (hipGetDevice(&dev) != hipSuccess || hipDeviceGetAttribute(&cus, hipDeviceAttributeMultiprocessorCount, dev) != hipSuccess) { grid = -1; return; }
        if (hipFuncSetAttribute((const void*)trunk_fwd, hipFuncAttributeMaxDynamicSharedMemorySize, LDS_BYTES) != hipSuccess) { fprintf(stderr, "kernel_launch: hipFuncSetAttribute failed\n"); grid = -1; return; }
        int per_cu = 0;
        if (hipOccupancyMaxActiveBlocksPerMultiprocessor(&per_cu, (const void*)trunk_fwd, NTHR, LDS_BYTES) != hipSuccess || per_cu < 1) fprintf(stderr, "kernel_launch: occupancy query reports %d\n", per_cu);
        (void)hipGetLastError();
        grid = cus;
    }
    if (grid < 0) return;
    (void)hipMemsetAsync((char*)d_ws + WS_CTL, 0, CTL_ZERO_BYTES, stream);
    Args a{};
    for (int i = 0; i < 29; ++i) a.in[i] = (const float*)d_in[i];
    a.out = (float*)d_out; a.ws = (unsigned char*)d_ws;
#if MK_PER_PHASE
    for (int p = 0; p < NPHASE; ++p) { a.ph_lo = p; a.ph_hi = p + 1; hipLaunchKernelGGL(trunk_fwd, dim3(grid), dim3(NTHR), LDS_BYTES, stream, a); }
#else
    a.ph_lo = 0; a.ph_hi = NPHASE;
    hipLaunchKernelGGL(trunk_fwd, dim3(grid), dim3(NTHR), LDS_BYTES, stream, a);
#endif
}
```

```cpp
#include <hip/hip_runtime.h>
#include <cstdio>
#include <cstdint>
#include <cmath>

#ifndef MK_PER_PHASE
#define MK_PER_PHASE 0
#endif

#ifndef TAIL_CONVERT
#define TAIL_CONVERT 1
#endif
#ifndef CHUNKED_SCAN
#define CHUNKED_SCAN 1
#endif
#ifndef PROBE_T
#define PROBE_T -1
#endif
#ifndef PROBE_DUP
#define PROBE_DUP 0
#endif
#define GAS __attribute__((address_space(1)))
#define LAS __attribute__((address_space(3)))
typedef unsigned short bf16_t;
typedef short bf16x8 __attribute__((ext_vector_type(8)));
typedef short s16x4 __attribute__((ext_vector_type(4)));
typedef float f32x2 __attribute__((ext_vector_type(2)));
typedef float f32x4 __attribute__((ext_vector_type(4)));
typedef float f32x16 __attribute__((ext_vector_type(16)));
typedef unsigned u32x2 __attribute__((ext_vector_type(2)));
typedef unsigned u32x4 __attribute__((ext_vector_type(4)));
typedef GAS unsigned gu32;


constexpr int NB = 4, SEQ = 4096, DM = 1024, NL = 4, NTOK = NB * SEQ;
constexpr int PIN = 2824, NPROJ = 2816;
constexpr int NE = 32, TOPK = 4;
constexpr int NWAVES = 8, NTHR = 512;
constexpr float LOG2E = 1.4426950408889634f;
constexpr float QSCALE = 0.125f * LOG2E;

constexpr size_t MiB = (size_t)1 << 20;
constexpr size_t WS_CTL = 0, CTL_ZERO_BYTES = 1 * MiB;
constexpr size_t WS_MOD = 1 * MiB;
constexpr size_t WS_FLOG = 2 * MiB;
constexpr size_t WS_BIAS = 3 * MiB;
constexpr size_t WS_ALORA = 4 * MiB;
constexpr size_t WS_GATE = 12 * MiB;
constexpr size_t WS_LIST = 13 * MiB;
constexpr size_t WS_WIN = 16 * MiB;
constexpr size_t WS_LORA = 38 * MiB;
constexpr size_t WS_WOUT = 40 * MiB;
constexpr size_t WS_WGU = 48 * MiB;
constexpr size_t WS_WDN = 560 * MiB;
constexpr size_t WS_X = 816 * MiB;
constexpr size_t WS_H = 880 * MiB;
constexpr size_t WS_ZR = 912 * MiB;
constexpr size_t WS_ZP = 976 * MiB;
constexpr size_t WS_Q = 992 * MiB, WS_K = 1008 * MiB, WS_V = 1024 * MiB;
constexpr size_t WS_SCAN = 1040 * MiB;
constexpr int SCAN_ROW = 896;
constexpr size_t WS_G = 1136 * MiB;
constexpr size_t WS_YRAW = 1152 * MiB;
constexpr size_t WS_MIXED = 1168 * MiB;
constexpr size_t WS_ACT = 1200 * MiB;
constexpr size_t WS_YSLOT = 1344 * MiB;
constexpr size_t WS_CPG = 1472 * MiB;
constexpr size_t WS_CPSI = 1496 * MiB;
constexpr size_t WS_CY0 = 1504 * MiB;
constexpr size_t WS_CS = 1520 * MiB;
constexpr size_t WS_END = 1528 * MiB;

constexpr int CW_TMO = 0, CW_CODE = 1;
constexpr int CW_BAR = 4096;
constexpr int CW_CNT = 16384;
constexpr int CW_QUEUE = 40960;
constexpr int CW_CQ = 49152;

constexpr int RING_BYTES = 131072;
constexpr int LDS_BYTES = 147456;
constexpr int LDSCTL_OFF = 139264;
constexpr int MISC_OFF = LDSCTL_OFF;
constexpr int PTR_OFF = LDSCTL_OFF + 256;
constexpr int TAB_OFF = LDSCTL_OFF + 512;
constexpr int ROWTAB_OFF = LDSCTL_OFF + 4096;
constexpr int PCV_OFF = LDSCTL_OFF + 6144;

#define RLX_AGENT __ATOMIC_RELAXED, __HIP_MEMORY_SCOPE_AGENT
#define LDS_WAIT() asm volatile("s_waitcnt lgkmcnt(0)" ::: "memory")
#define VM_WAIT() asm volatile("s_waitcnt vmcnt(0)" ::: "memory")

__device__ __forceinline__ unsigned f2bf(float f) { unsigned u = __builtin_bit_cast(unsigned, f); return (u + 0x7fffu + ((u >> 16) & 1u)) >> 16; }
__device__ __forceinline__ unsigned pk2(float lo, float hi) { return f2bf(lo) | (f2bf(hi) << 16); }
typedef __bf16 bf16x2_t __attribute__((ext_vector_type(2)));
__device__ __forceinline__ unsigned cvtpk(float lo, float hi) { const f32x2 v = {lo, hi}; const bf16x2_t b = __builtin_convertvector(v, bf16x2_t); return __builtin_bit_cast(unsigned, b); }
__device__ __forceinline__ f32x4 unp4(u32x2 p) { return (f32x4){__builtin_bit_cast(float, p.x << 16), __builtin_bit_cast(float, p.x & 0xffff0000u), __builtin_bit_cast(float, p.y << 16), __builtin_bit_cast(float, p.y & 0xffff0000u)}; }
__device__ __forceinline__ f32x4 up4(u32x2 y) { return (f32x4){__builtin_bit_cast(float, y.x << 16), __builtin_bit_cast(float, y.x & 0xffff0000u), __builtin_bit_cast(float, y.y << 16), __builtin_bit_cast(float, y.y & 0xffff0000u)}; }
__device__ __forceinline__ u32x2 pk4(f32x4 v) { return (u32x2){cvtpk(v.x, v.y), cvtpk(v.z, v.w)}; }
__device__ __forceinline__ u32x4 pk8(f32x4 a, f32x4 b) { return (u32x4){cvtpk(a.x, a.y), cvtpk(a.z, a.w), cvtpk(b.x, b.y), cvtpk(b.z, b.w)}; }
__device__ __forceinline__ float bf2f(unsigned short b) { return __builtin_bit_cast(float, (unsigned)b << 16); }
__device__ __forceinline__ float dpp_f(float v, const int ctrl_sel) {
    const int iv = __builtin_bit_cast(int, v); int r;
    switch (ctrl_sel) { case 0: r = __builtin_amdgcn_update_dpp(0, iv, 0xB1, 0xf, 0xf, true); break; case 1: r = __builtin_amdgcn_update_dpp(0, iv, 0x4E, 0xf, 0xf, true); break;
                        case 2: r = __builtin_amdgcn_update_dpp(0, iv, 0x141, 0xf, 0xf, true); break; default: r = __builtin_amdgcn_update_dpp(0, iv, 0x140, 0xf, 0xf, true); break; }
    return __builtin_bit_cast(float, r);
}
__device__ __forceinline__ float red16(float v) { v += dpp_f(v, 0); v += dpp_f(v, 1); v += dpp_f(v, 2); v += dpp_f(v, 3); return v; }
__device__ __forceinline__ float fma_s(float a, float b, float c) { float d; asm("v_fma_f32 %0, %1, %2, %3" : "=v"(d) : "v"(a), "v"(b), "v"(c)); return d; }
__device__ __forceinline__ float fnma_s(float a, float b, float c) { float d; asm("v_fma_f32 %0, -%1, %2, %3" : "=v"(d) : "v"(a), "v"(b), "v"(c)); return d; }
__device__ __forceinline__ float mul_s(float a, float b) { float d; asm("v_mul_f32_e32 %0, %1, %2" : "=v"(d) : "v"(a), "v"(b)); return d; }
__device__ __forceinline__ float add_s(float a, float b) { float d; asm("v_add_f32_e32 %0, %1, %2" : "=v"(d) : "v"(a), "v"(b)); return d; }
__device__ __forceinline__ void red16_pair(float& a, float& b) {
    asm volatile("s_nop 1\n\t"
                 "v_add_f32_dpp %0, %0, %0 quad_perm:[1,0,3,2] row_mask:0xf bank_mask:0xf bound_ctrl:1\n\t"
                 "v_add_f32_dpp %1, %1, %1 quad_perm:[1,0,3,2] row_mask:0xf bank_mask:0xf bound_ctrl:1\n\t"
                 "s_nop 0\n\t"
                 "v_add_f32_dpp %0, %0, %0 quad_perm:[2,3,0,1] row_mask:0xf bank_mask:0xf bound_ctrl:1\n\t"
                 "v_add_f32_dpp %1, %1, %1 quad_perm:[2,3,0,1] row_mask:0xf bank_mask:0xf bound_ctrl:1\n\t"
                 "s_nop 0\n\t"
                 "v_add_f32_dpp %0, %0, %0 row_half_mirror row_mask:0xf bank_mask:0xf bound_ctrl:1\n\t"
                 "v_add_f32_dpp %1, %1, %1 row_half_mirror row_mask:0xf bank_mask:0xf bound_ctrl:1\n\t"
                 "s_nop 0\n\t"
                 "v_add_f32_dpp %0, %0, %0 row_mirror row_mask:0xf bank_mask:0xf bound_ctrl:1\n\t"
                 "v_add_f32_dpp %1, %1, %1 row_mirror row_mask:0xf bank_mask:0xf bound_ctrl:1\n\t"
                 "s_nop 0"
                 : "+v"(a), "+v"(b));
}
__device__ __forceinline__ float wave_sum(float v) {
    v = red16(v);
    { const auto rr = __builtin_amdgcn_permlane16_swap(__float_as_uint(v), __float_as_uint(v), false, false); v = __uint_as_float(rr[0]) + __uint_as_float(rr[1]); }
    { const auto rr = __builtin_amdgcn_permlane32_swap(__float_as_uint(v), __float_as_uint(v), false, false); v = __uint_as_float(rr[0]) + __uint_as_float(rr[1]); }
    return v;
}
__device__ __forceinline__ float wave_max(float v) {
    v = fmaxf(v, dpp_f(v, 0)); v = fmaxf(v, dpp_f(v, 1)); v = fmaxf(v, dpp_f(v, 2)); v = fmaxf(v, dpp_f(v, 3));
    { const auto rr = __builtin_amdgcn_permlane16_swap(__float_as_uint(v), __float_as_uint(v), false, false); v = fmaxf(__uint_as_float(rr[0]), __uint_as_float(rr[1])); }
    { const auto rr = __builtin_amdgcn_permlane32_swap(__float_as_uint(v), __float_as_uint(v), false, false); v = fmaxf(__uint_as_float(rr[0]), __uint_as_float(rr[1])); }
    return v;
}
__device__ __forceinline__ float sigmoidf_(float x) { return 1.f / (1.f + __expf(-x)); }
__device__ __forceinline__ float softplusf_(float u) { return fmaxf(u, 0.f) + log1pf(__expf(-fabsf(u))); }
__device__ __forceinline__ float softplus_fast(float u) { return fmaxf(u, 0.f) + __logf(1.f + __expf(-fabsf(u))); }

#define XB_TMO      128
#define XB_XCNT(j)  (256  + 64 * (j))
#define XB_XSUB(j)  (1280 + 64 * (j))
#define XB_XGEN(j)  (2304 + 64 * (j))
#define XB_TOP      3328
#define XB_TOPGEN   3392
#define XCD_BAR_WORDS 3456
#define XB_SPIN_CAP (1u << 18)
__device__ __forceinline__ unsigned xb_ld(unsigned* p)              { return __hip_atomic_load(p, __ATOMIC_RELAXED, __HIP_MEMORY_SCOPE_AGENT); }
__device__ __forceinline__ unsigned xb_add(unsigned* p, unsigned v) { return __hip_atomic_fetch_add(p, v, __ATOMIC_RELAXED, __HIP_MEMORY_SCOPE_AGENT); }
__device__ __forceinline__ unsigned xb_xcc_id() { return (unsigned)__builtin_amdgcn_s_getreg((3 << 11) | 20) & 0xFu; }
#define XB_SPIN(cond, bar) do { unsigned _sp = 0; while (cond) { __builtin_amdgcn_s_sleep(1); \
    if ((++_sp & 255u) == 0u) { if (xb_ld(&(bar)[XB_TMO])) break; if (_sp > XB_SPIN_CAP) { atomicAdd(&(bar)[XB_TMO], 1u); break; } } } } while (0)
struct XcdBarrier { unsigned* bar; unsigned x; volatile LAS unsigned* st; };
__device__ __forceinline__ XcdBarrier xcd_barrier_post(unsigned* bar, volatile LAS unsigned* st) {
    XcdBarrier b; b.bar = bar; b.x = xb_xcc_id(); b.st = st;
    if (threadIdx.x == 0) (void)xb_add(&bar[XB_XCNT(b.x)], 1u);
    return b;
}
__device__ __forceinline__ void xcd_barrier_complete(unsigned* bar, unsigned x, unsigned& nloc, unsigned& nx) {
    const unsigned G = gridDim.x * gridDim.y * gridDim.z;
    unsigned sum, cnt, mine, sp = 0u;
    for (;;) {
        sum = 0u; cnt = 0u; mine = 0u;
#pragma unroll
        for (unsigned j = 0; j < 16; ++j) { const unsigned c = xb_ld(&bar[XB_XCNT(j)]); sum += c; cnt += (c > 0u) ? 1u : 0u; mine = (j == x) ? c : mine; }
        if (sum == G) break;
        __builtin_amdgcn_s_sleep(1);
        if ((++sp & 255u) == 0u) { if (xb_ld(&bar[XB_TMO])) break; if (sp > XB_SPIN_CAP) { atomicAdd(&bar[XB_TMO], 1u); break; } }
    }
    nloc = mine > 0u ? mine : 1u; nx = cnt > 0u ? cnt : 1u;
}
__device__ __forceinline__ void xcd_barrier(const XcdBarrier& b) {
    asm volatile("s_waitcnt vmcnt(0)" ::: "memory");
    __syncthreads();
    if (threadIdx.x == 0) {
        unsigned* bar = b.bar;
        __builtin_amdgcn_s_waitcnt(0);
        unsigned nloc = b.st[0], nx = b.st[1];
        if (nloc == 0u) { xcd_barrier_complete(bar, b.x, nloc, nx); b.st[0] = nloc; b.st[1] = nx; }
        const unsigned old = xb_add(&bar[XB_XSUB(b.x)], 1u);
        const unsigned gen = old / nloc;
        if (old + 1u == (gen + 1u) * nloc) {
            __builtin_amdgcn_fence(__ATOMIC_RELEASE, "agent");
            asm volatile("s_waitcnt vmcnt(0)" ::: "memory");
            const unsigned og = xb_add(&bar[XB_TOP], 1u);
            const unsigned tg = og / nx;
            if (og + 1u == (tg + 1u) * nx) xb_add(&bar[XB_TOPGEN], 1u);
            else XB_SPIN(xb_ld(&bar[XB_TOPGEN]) == tg, bar);
            __builtin_amdgcn_fence(__ATOMIC_ACQUIRE, "agent");
            xb_add(&bar[XB_XGEN(b.x)], 1u);
            asm volatile("s_waitcnt vmcnt(0)" ::: "memory");
        } else {
            XB_SPIN(xb_ld(&bar[XB_XGEN(b.x)]) == gen, bar);
            __builtin_amdgcn_fence(__ATOMIC_ACQUIRE, "agent");
            asm volatile("s_waitcnt vmcnt(0)" ::: "memory");
        }
    }
    __syncthreads();
}

namespace pg8 {
constexpr int BM = 256, BK = 64, HALF = 128, HTB = HALF * BK * 2, STAGE_BYTES = 8 * HTB;
__device__ __forceinline__ int lds_byte(int r, int c) { const int st = (r >> 4) * 2 + (c >> 5), rr = r & 15, cc = c & 31, ob = rr * 64 + cc * 2; return st * 1024 + (ob ^ (((ob >> 9) & 1) << 5)); }
__device__ __forceinline__ void stage_rc(int b, int& R, int& C) { const int st = b / 1024, sb = b % 1024, swz = sb ^ (((sb >> 9) & 1) << 5); R = (st >> 1) * 16 + swz / 64; C = (st & 1) * 32 + (swz % 64) / 2; }
__device__ __forceinline__ int perm32(int rho) { const int n = rho >> 4, i = rho & 15; return 8 * (i >> 2) + 4 * n + (i & 3); }
struct Unit { int pm, pn, e; };
__device__ __forceinline__ unsigned cvt_pk_bf16(float lo, float hi) { unsigned r; asm volatile("v_cvt_pk_bf16_f32 %0, %1, %2" : "=v"(r) : "v"(lo), "v"(hi)); return r; }

template <bool GATHER, int K, class Prob, class Epi>
__device__ __forceinline__ void gemm_phase(LAS unsigned char* lds, LAS unsigned* rowtab  , const int tid, const Prob& S, const Epi& E) {
    const int wid = __builtin_amdgcn_readfirstlane(tid >> 6), lane = tid & 63, wr = wid >> 2, wc = wid & 3, fr = lane & 15, fq = lane >> 4;
    constexpr int nt = K / BK; static_assert(K % 128 == 0 && K >= 256 && (!GATHER || K == 1024), "K");
    unsigned voffA[2], voffB[2];
#pragma unroll
    for (int i = 0; i < 2; ++i) { int R, C; stage_rc(tid * 16 + i * 8192, R, C); const int Rb = (R & ~31) + perm32(R & 31); voffA[i] = (unsigned)(R * K + C) * 2u; voffB[i] = (unsigned)(Rb * K + C) * 2u; }
    constexpr size_t kstep = (size_t)(BK * 2);
    constexpr size_t hstep = (size_t)HALF * K * 2;
    const unsigned ldsw = (unsigned)wid * 1024u;
    const int aoff = lds_byte(wr * 64 + fr, fq * 8), boff = lds_byte(wc * 32 + fr, fq * 8);
#define PG8_SA(b, h) (((b) * 2 + (h)) * HTB)
#define PG8_SB(b, h) ((4 + (b) * 2 + (h)) * HTB)
#define PG8_STAGEB(bufoff, gbase) do { _Pragma("unroll") for (int _i = 0; _i < 2; ++_i) \
        __builtin_amdgcn_global_load_lds((const unsigned*)((const char*)(gbase) + voffB[_i]), (LAS unsigned*)(lds + (bufoff) + ldsw + _i * 8192), 16, 0, 0); } while (0)
#define PG8_STAGEA2(bufoff, gbase, o0, o1) do { \
        __builtin_amdgcn_global_load_lds((const unsigned*)((const char*)(gbase) + (o0)), (LAS unsigned*)(lds + (bufoff) + ldsw), 16, 0, 0); \
        __builtin_amdgcn_global_load_lds((const unsigned*)((const char*)(gbase) + (o1)), (LAS unsigned*)(lds + (bufoff) + ldsw + 8192), 16, 0, 0); } while (0)
#define PG8_STAGEA_C(bufoff, gbase, h) do { if constexpr (GATHER) PG8_STAGEA2(bufoff, gbase, oc[h][0], oc[h][1]); else PG8_STAGEA2(bufoff, (gbase) + (h) * hstep, voffA[0], voffA[1]); } while (0)
#define PG8_LDA(dst, b, h) do { _Pragma("unroll") for (int m = 0; m < 4; ++m) _Pragma("unroll") for (int k = 0; k < 2; ++k) dst[m][k] = *(const LAS bf16x8*)(lds + PG8_SA(b, h) + aoff + m * 2048 + k * 1024); } while (0)
#define PG8_LDB(dst, b, h) do { _Pragma("unroll") for (int n = 0; n < 2; ++n) _Pragma("unroll") for (int k = 0; k < 2; ++k) dst[n][k] = *(const LAS bf16x8*)(lds + PG8_SB(b, h) + boff + n * 2048 + k * 1024); } while (0)
#define PG8_MMA(ai, bj, At, Bt) do { __builtin_amdgcn_s_setprio(1); _Pragma("unroll") for (int m = 0; m < 4; ++m) _Pragma("unroll") for (int n = 0; n < 2; ++n) _Pragma("unroll") for (int k = 0; k < 2; ++k) \
        acc[ai][bj][m][n] = __builtin_amdgcn_mfma_f32_16x16x32_bf16(Bt[n][k], At[m][k], acc[ai][bj][m][n], 0, 0, 0); __builtin_amdgcn_s_setprio(0); } while (0)
#define PG8_WAIT_V(n) asm volatile("s_waitcnt vmcnt(" #n ")" ::: "memory")
#define PG8_WAIT_L(n) asm volatile("s_waitcnt lgkmcnt(" #n ")" ::: "memory")
#define PG8_BAR __builtin_amdgcn_s_barrier()
#define PG8_SCHED __builtin_amdgcn_sched_barrier(0)
    Unit cur, nxt; int ui = 0;
    if (!S.next(0, cur)) return;
    f32x4 acc[2][2][4][2];
#pragma unroll
    for (int a = 0; a < 2; ++a)
#pragma unroll
        for (int b = 0; b < 2; ++b)
#pragma unroll
            for (int m = 0; m < 4; ++m)
#pragma unroll
                for (int n = 0; n < 2; ++n) acc[a][b][m][n] = (f32x4){0.f, 0.f, 0.f, 0.f};
    bf16x8 At[4][2], B0[2][2], B1[2][2];
    const char* cA = S.a_ptr(cur); const char* cB = S.b_ptr(cur);
    unsigned oc[2][2];
    if constexpr (GATHER) {
#pragma unroll
        for (int h = 0; h < 2; ++h)
#pragma unroll
            for (int i = 0; i < 2; ++i) oc[h][i] = S.row_off(cur, h * 128 + (int)(voffA[i] >> 11)) + (voffA[i] & 2047u);
    }
    PG8_STAGEB(PG8_SB(0, 0), cB); PG8_STAGEB(PG8_SB(0, 1), cB + hstep); PG8_STAGEA_C(PG8_SA(0, 0), cA, 0); PG8_STAGEA_C(PG8_SA(0, 1), cA, 1);
    if (wr == 1) PG8_BAR;
    PG8_WAIT_V(2); PG8_BAR;
    PG8_STAGEB(PG8_SB(1, 0), cB + kstep); PG8_STAGEA_C(PG8_SA(1, 0), cA + kstep, 0); PG8_STAGEB(PG8_SB(1, 1), cB + hstep + kstep);
    PG8_WAIT_V(6); PG8_BAR;
    for (;;) {
        const bool has_next = S.next(ui + 1, nxt);
        const char* nA = cA; const char* nB = cB;
        if (has_next) { nA = S.a_ptr(nxt); nB = S.b_ptr(nxt); }
        if constexpr (GATHER) { if (has_next && tid < 256) rowtab[((ui + 1) & 1) * 256 + tid] = S.row_off(nxt, tid); }
#pragma nounroll
        for (int t = 0; t < nt; t += 2) {
            const bool last = (t == nt - 2);
            const char* a1 = cA + (size_t)(t + 1) * kstep;
            const char* a2 = last ? nA : cA + (size_t)(t + 2) * kstep; const char* b2 = last ? nB : cB + (size_t)(t + 2) * kstep;
            const char* a3 = a2 + kstep; const char* b3 = b2 + kstep;
            PG8_LDB(B0, 0, 0); PG8_LDB(B1, 0, 1); PG8_SCHED; PG8_LDA(At, 0, 0); PG8_STAGEA_C(PG8_SA(1, 1), a1, 1);
            if constexpr (GATHER) { if (last && has_next) {
#pragma unroll
                for (int h = 0; h < 2; ++h)
#pragma unroll
                    for (int i = 0; i < 2; ++i) oc[h][i] = rowtab[((ui + 1) & 1) * 256 + h * 128 + (int)(voffA[i] >> 11)] + (voffA[i] & 2047u); } }
            PG8_WAIT_V(8); PG8_WAIT_L(0); PG8_BAR; PG8_MMA(0, 0, At, B0); PG8_MMA(0, 1, At, B1); PG8_BAR; PG8_SCHED;
            PG8_LDA(At, 0, 1); PG8_STAGEB(PG8_SB(0, 0), b2); PG8_STAGEB(PG8_SB(0, 1), b2 + hstep); PG8_STAGEA_C(PG8_SA(0, 0), a2, 0);
            PG8_WAIT_V(8); PG8_WAIT_L(0); PG8_BAR; PG8_MMA(1, 0, At, B0); PG8_MMA(1, 1, At, B1); PG8_BAR; PG8_SCHED;
            PG8_LDB(B0, 1, 0); PG8_LDB(B1, 1, 1); PG8_SCHED; PG8_LDA(At, 1, 0); PG8_STAGEA_C(PG8_SA(0, 1), a2, 1);
            PG8_WAIT_V(8); PG8_WAIT_L(0); PG8_BAR; PG8_MMA(0, 0, At, B0); PG8_MMA(0, 1, At, B1); PG8_BAR; PG8_SCHED;
            PG8_LDA(At, 1, 1); PG8_STAGEB(PG8_SB(1, 0), b3); PG8_STAGEB(PG8_SB(1, 1), b3 + hstep); PG8_STAGEA_C(PG8_SA(1, 0), a3, 0);
            PG8_WAIT_V(8); PG8_WAIT_L(0); PG8_BAR; PG8_MMA(1, 0, At, B0); PG8_MMA(1, 1, At, B1); PG8_BAR; PG8_SCHED;
        }
        if (wr == 0) PG8_BAR;
        E(acc, cur, wr, wc, fr, fq);
        if (!has_next) break;
#pragma unroll
        for (int a = 0; a < 2; ++a)
#pragma unroll
            for (int b = 0; b < 2; ++b)
#pragma unroll
                for (int m = 0; m < 4; ++m)
#pragma unroll
                    for (int n = 0; n < 2; ++n) acc[a][b][m][n] = (f32x4){0.f, 0.f, 0.f, 0.f};
        cur = nxt; cA = nA; cB = nB; ++ui;
        if (wr == 1) PG8_BAR;
    }
    PG8_WAIT_V(0);
    PG8_BAR;
#undef PG8_SA
#undef PG8_SB
#undef PG8_STAGEA2
#undef PG8_STAGEA_C
#undef PG8_STAGEB
#undef PG8_LDA
#undef PG8_LDB
#undef PG8_MMA
#undef PG8_WAIT_V
#undef PG8_WAIT_L
#undef PG8_BAR
#undef PG8_SCHED
}
}

struct Frame {
    LAS unsigned char* lds;
    volatile LAS unsigned* MISC;
    int tid, lane, wave, vcu, G;
};
struct Args { const float* in[29]; float* out; unsigned char* ws; int ph_lo, ph_hi; };
__device__ __forceinline__ unsigned long long ldptr_raw(LAS unsigned char* lds, int i) {
    const unsigned long long v = *(const LAS unsigned long long*)(lds + PTR_OFF + 8 * i);
    const unsigned lo = __builtin_amdgcn_readfirstlane((unsigned)v), hi = __builtin_amdgcn_readfirstlane((unsigned)(v >> 32));
    return ((unsigned long long)hi << 32) | lo;
}
__device__ __forceinline__ void* ldptr(const Frame& F, int i) { return (void*)(GAS unsigned char*)ldptr_raw(F.lds, i); }
struct InTab { LAS unsigned char* lds; __device__ __forceinline__ const float* operator[](int i) const { return (const float*)(const GAS float*)ldptr_raw(lds, i); } };
__device__ __forceinline__ void refresh(Frame& F) { int t = F.tid; asm volatile("" : "+v"(t)); F.tid = t; F.lane = t & 63; F.wave = __builtin_amdgcn_readfirstlane(t >> 6); }


enum { I_X = 0, I_C, I_ADAW, I_ADAB, I_NORM1, I_WIN, I_WOUT, I_MU, I_W0, I_WUP, I_A0, I_AUP, I_GUP, I_KK, I_KA, I_RK, I_LNW, I_LNB, I_POOLW, I_POOLS, I_BF, I_NORM2, I_RW, I_RB, I_WGU, I_BGU, I_WDN, I_BDN, I_NORMF };

__device__ __forceinline__ void transpose_item(const float* W, int ldw, bf16_t* WT, int dst_row0, int k0, int n0, LAS float* scr, int lane) {
    float tmp[32];
#pragma unroll
    for (int i = 0; i < 32; ++i) { const int kk = 2 * i + (lane >> 5); tmp[i] = __builtin_nontemporal_load(W + (size_t)(k0 + kk) * ldw + n0 + (lane & 31)); }
#pragma unroll
    for (int i = 0; i < 32; ++i) { const int kk = 2 * i + (lane >> 5); scr[kk * 33 + (lane & 31)] = tmp[i]; }
    LDS_WAIT(); asm volatile("" ::: "memory");
    const int c = lane & 7;
#pragma unroll
    for (int j = 0; j < 4; ++j) { const int n = (lane >> 3) + 8 * j; const LAS float* s = scr + (8 * c) * 33 + n;
        u32x4 o; o.x = cvtpk(s[0 * 33], s[1 * 33]); o.y = cvtpk(s[2 * 33], s[3 * 33]); o.z = cvtpk(s[4 * 33], s[5 * 33]); o.w = cvtpk(s[6 * 33], s[7 * 33]);
        *(GAS u32x4*)(WT + (size_t)(dst_row0 + n) * 1024 + k0 + 8 * c) = o; }
    LDS_WAIT(); asm volatile("" ::: "memory");
}

__device__ __forceinline__ void convert_moe_batch(Frame& F, const InTab& in_, unsigned char* ws_, int l, int q);
__device__ __forceinline__ void phase_prologue(Frame& F) {
    refresh(F); unsigned char* ws_ = (unsigned char*)ldptr(F, 30); const InTab in_{F.lds}; gu32* ctl_ = (gu32*)ws_;

    if (blockIdx.x < 192) {
        LAS float* cond = (LAS float*)F.lds;
        LAS float* part = (LAS float*)(F.lds + 16384);
        const float* c = in_[I_C];
        for (int i = F.tid; i < 4096; i += NTHR) { const float v = c[i]; cond[i] = v / (1.f + __expf(-v)); }
        __syncthreads();
        const int l = blockIdx.x / 48, col0 = (blockIdx.x % 48) * 128;
        const float* W = in_[I_ADAW] + (size_t)l * 1024 * 6144 + col0 + 2 * F.lane;
        float a[4][2];
#pragma unroll
        for (int b = 0; b < 4; ++b) { a[b][0] = 0.f; a[b][1] = 0.f; }
        const int kb = F.wave * 128;
#pragma unroll 8
        for (int k = kb; k < kb + 128; ++k) {
            const f32x2 w = __builtin_nontemporal_load((const f32x2*)(W + (size_t)k * 6144));
#pragma unroll
            for (int b = 0; b < 4; ++b) { const float cv = cond[b * 1024 + k]; a[b][0] += cv * w.x; a[b][1] += cv * w.y; }
        }
#pragma unroll
        for (int b = 0; b < 4; ++b) { part[(F.wave * 4 + b) * 128 + 2 * F.lane] = a[b][0]; part[(F.wave * 4 + b) * 128 + 2 * F.lane + 1] = a[b][1]; }
        __syncthreads();
        { const int b = F.tid >> 7, cc = F.tid & 127; float s = in_[I_ADAB][l * 6144 + col0 + cc];
#pragma unroll
          for (int w = 0; w < 8; ++w) s += part[(w * 4 + b) * 128 + cc];
          ((float*)(ws_ + WS_MOD))[(l * 4 + b) * 6144 + col0 + cc] = s; }
        __syncthreads();
    }
    {
        bf16_t* LT = (bf16_t*)(ws_ + WS_LORA);
        const float* wu = in_[I_WUP]; const float* au = in_[I_AUP]; const float* gu = in_[I_GUP];
        for (int idx = blockIdx.x * NTHR + F.tid; idx < NL * 768 * 256; idx += F.G * NTHR) {
            const int k = idx & 255, n = (idx >> 8) % 768, l = idx / (768 * 256);
            float v = 0.f;
            if (n < 256) { if (k < 64) v = wu[((size_t)l * 64 + k) * 256 + n]; }
            else if (n < 512) { if (k >= 64 && k < 128) v = au[((size_t)l * 64 + (k - 64)) * 256 + (n - 256)]; }
            else { if (k >= 128) v = gu[((size_t)l * 128 + (k - 128)) * 256 + (n - 512)]; }
            LT[idx] = (bf16_t)f2bf(v);
        }
    }
    LAS float* scr = (LAS float*)(F.lds + F.wave * 16384);
    const int gw = F.vcu * NWAVES + F.wave, NGW = F.G * NWAVES;
    constexpr int I_A = NL * 16 * 88, I_B = NL * 16 * 32;
    for (int it = gw; it < I_A + I_B; it += NGW) {
        int r = it;
        if (r < I_A) { const int l = r / (16 * 88), q = r % (16 * 88), kb = q / 88, nb = q % 88;
            transpose_item(in_[I_WIN] + (size_t)l * 1024 * PIN, PIN, (bf16_t*)(ws_ + WS_WIN) + (size_t)l * NPROJ * 1024, 32 * nb, 64 * kb, 32 * nb, scr, F.lane); continue; }
        r -= I_A;
        { const int l = r / (16 * 32), q = r % (16 * 32), kb = q / 32, nb = q % 32;
            transpose_item(in_[I_WOUT] + (size_t)l * 1024 * 1024, 1024, (bf16_t*)(ws_ + WS_WOUT) + (size_t)l * 1024 * 1024, 32 * nb, 64 * kb, 32 * nb, scr, F.lane); }
    }
}
__device__ __forceinline__ void convert_moe_batch(Frame& F, const InTab& in_, unsigned char* ws_, int l, int q) {
    LAS float* scr = (LAS float*)(F.lds + F.wave * 16384);
    for (int j = 0; j < 8; ++j) {
        int r = q * 64 + j * 8 + F.wave;
        if (r < NE * 16 * 64) { const int e = r / (16 * 64), qq = r % (16 * 64), kb = qq / 64, nb = qq % 64; const int n0 = 32 * nb; const int le = l * NE + e;
            const int dr = (n0 < 1024) ? ((n0 >> 7) * 256 + (n0 & 127)) : ((((n0 - 1024) >> 7) * 256) + 128 + ((n0 - 1024) & 127));
            transpose_item(in_[I_WGU] + (size_t)le * 1024 * 2048, 2048, (bf16_t*)(ws_ + WS_WGU) + (size_t)le * 2048 * 1024, dr, 64 * kb, n0, scr, F.lane); }
        else { r -= NE * 16 * 64; const int e = r / (16 * 32), qq = r % (16 * 32), kb = qq / 32, nb = qq % 32; const int le = l * NE + e;
            transpose_item(in_[I_WDN] + (size_t)le * 1024 * 1024, 1024, (bf16_t*)(ws_ + WS_WDN) + (size_t)le * 1024 * 1024, 32 * nb, 64 * kb, 32 * nb, scr, F.lane); }
    }
}

__device__ __forceinline__ void phase_combine(Frame& F, int l, float yscale = 1.f) {
    refresh(F); unsigned char* ws_ = (unsigned char*)ldptr(F, 30); const InTab in_{F.lds}; gu32* ctl_ = (gu32*)ws_;

    const bool has_next = (l + 1 < NL);
    LAS float* Wf = (LAS float*)F.lds;
    if (has_next) {
        const float* W = in_[I_WIN] + (size_t)(l + 1) * 1024 * PIN + NPROJ;
        f32x4 t4[4];
#pragma unroll
        for (int u = 0; u < 4; ++u) { const int i = F.tid + NTHR * u; t4[u] = *(const f32x4*)(W + (size_t)(i >> 1) * PIN + 4 * (i & 1)); }
#pragma unroll
        for (int u = 0; u < 4; ++u) { const int i = F.tid + NTHR * u; *(LAS f32x4*)(Wf + 4 * i) = t4[u]; }
    }
    __syncthreads();
    const int gw = F.vcu * NWAVES + F.wave, NGW = F.G * NWAVES;
    const float* xin = in_[I_X];
    bf16_t* X = (bf16_t*)(ws_ + WS_X);
    const float* MOD = (const float*)(ws_ + WS_MOD);
    const bf16_t* YS = (const bf16_t*)(ws_ + WS_YSLOT);
    f32x4 xn[4]; u32x2 xb[4], yn[4][4];
#define CMB_LOAD(mm) do { if (l < 0) { _Pragma("unroll") for (int j = 0; j < 4; ++j) xn[j] = *(const f32x4*)(xin + (size_t)(mm) * 1024 + 4 * F.lane + 256 * j); } \
        else { _Pragma("unroll") for (int j = 0; j < 4; ++j) xb[j] = *(const u32x2*)(X + (size_t)(mm) * 1024 + 4 * F.lane + 256 * j); } \
        if (l >= 0) { _Pragma("unroll") for (int k = 0; k < 4; ++k) _Pragma("unroll") for (int j = 0; j < 4; ++j) yn[k][j] = *(const u32x2*)(YS + ((size_t)(mm) * 4 + k) * 1024 + 4 * F.lane + 256 * j); } } while (0)
    if (gw < NTOK) CMB_LOAD(gw);
    for (int m = gw; m < NTOK; m += NGW) {
        const int b = m >> 12;
        f32x4 v[4]; u32x2 yc[4][4];
#pragma unroll
        for (int j = 0; j < 4; ++j) { v[j] = (l < 0) ? xn[j] : up4(xb[j]);
#pragma unroll
            for (int k = 0; k < 4; ++k) yc[k][j] = yn[k][j]; }
        if (m + NGW < NTOK) CMB_LOAD(m + NGW);
        if (l >= 0) {
            const float* g2 = MOD + (size_t)(l * 4 + b) * 6144 + 5 * 1024;
#pragma unroll
            for (int j = 0; j < 4; ++j) {
                f32x4 s = (f32x4){0.f, 0.f, 0.f, 0.f};
#pragma unroll
                for (int k = 0; k < 4; ++k) { const u32x2 y = yc[k][j];
                    s.x += __builtin_bit_cast(float, y.x << 16); s.y += __builtin_bit_cast(float, y.x & 0xffff0000u); s.z += __builtin_bit_cast(float, y.y << 16); s.w += __builtin_bit_cast(float, y.y & 0xffff0000u); }
                const f32x4 g = *(const f32x4*)(g2 + 4 * F.lane + 256 * j);
                v[j] = v[j] + g * yscale * s;
            }
        }
        if (l >= 0 && has_next) {
#pragma unroll
            for (int j = 0; j < 4; ++j) *(u32x2*)(X + (size_t)m * 1024 + 4 * F.lane + 256 * j) = pk4(v[j]);
        }
        float ss = 0.f;
#pragma unroll
        for (int j = 0; j < 4; ++j) ss += (v[j].x * v[j].x + v[j].y * v[j].y) + (v[j].z * v[j].z + v[j].w * v[j].w);
        const float rs = 1.f / sqrtf(wave_sum(ss) * (1.f / 1024.f) + 1e-6f);
        if (has_next) {
            const float* nw = in_[I_NORM1] + (l + 1) * 1024;
            const float* sh = MOD + (size_t)((l + 1) * 4 + b) * 6144; const float* sc = sh + 1024;
            float fl[8];
#pragma unroll
            for (int e = 0; e < 8; ++e) fl[e] = 0.f;
            bf16_t* H = (bf16_t*)(ws_ + WS_H) + (size_t)m * 1024;
#pragma unroll
            for (int j = 0; j < 4; ++j) {
                const int c0 = 4 * F.lane + 256 * j;
                const f32x4 w = *(const f32x4*)(nw + c0), s1 = *(const f32x4*)(sc + c0), s0 = *(const f32x4*)(sh + c0);
                f32x4 h = v[j] * rs * w * (s1 + 1.f) + s0;
                u32x2 o; o.x = cvtpk(h.x, h.y); o.y = cvtpk(h.z, h.w);
                *(u32x2*)(H + c0) = o;
#pragma unroll
                for (int i = 0; i < 4; ++i) {
                    const f32x4 wa = *(const LAS f32x4*)(Wf + (c0 + i) * 8), wb = *(const LAS f32x4*)(Wf + (c0 + i) * 8 + 4);
                    const float hv = h[i];
                    fl[0] += hv * wa.x; fl[1] += hv * wa.y; fl[2] += hv * wa.z; fl[3] += hv * wa.w; fl[4] += hv * wb.x; fl[5] += hv * wb.y; fl[6] += hv * wb.z; fl[7] += hv * wb.w;
                }
            }
#pragma unroll
            for (int e = 0; e < 8; ++e) fl[e] = wave_sum(fl[e]);
            if (F.lane == 0) { float* o = (float*)(ws_ + WS_FLOG) + (size_t)m * 8; *(f32x4*)o = (f32x4){fl[0], fl[1], fl[2], fl[3]}; *(f32x4*)(o + 4) = (f32x4){fl[4], fl[5], fl[6], fl[7]}; }
        } else {
            const float* nw = in_[I_NORMF]; float* out_ = (float*)ldptr(F, 29);
            const float pscale = (PROBE_T >= 0) ? 1.f + __hip_atomic_load((GAS float*)(ctl_ + CW_CODE + 1), RLX_AGENT) : 1.f;
#pragma unroll
            for (int j = 0; j < 4; ++j) { const int c0 = 4 * F.lane + 256 * j; const f32x4 w = *(const f32x4*)(nw + c0);
                *(f32x4*)(out_ + (size_t)m * 1024 + c0) = v[j] * rs * w * pscale; }
        }
    }
}

#undef CMB_LOAD
struct ProbDense {
    const char* A; const char* Bt; int nM, nN, G, vcu;
    __device__ __forceinline__ bool next(int i, pg8::Unit& u) const { const int Lx = i * G + vcu; if (Lx >= nM * nN) return false; u.pn = Lx % nN; u.pm = Lx / nN; u.e = 0; return true; }
    __device__ __forceinline__ const char* a_ptr(const pg8::Unit& u) const { return A + (size_t)u.pm * 256 * 2048; }
    __device__ __forceinline__ const char* b_ptr(const pg8::Unit& u) const { return Bt + (size_t)u.pn * 256 * 2048; }
};
struct EpiProj {
    unsigned char* ws;
    __device__ __forceinline__ void operator()(const f32x4 (&acc)[2][2][4][2], const pg8::Unit& u, int wr, int wc, int fr, int fq) const {
        const int pn = u.pn;
#pragma unroll
        for (int ai = 0; ai < 2; ++ai)
#pragma unroll
            for (int m = 0; m < 4; ++m) {
                const size_t row = (size_t)u.pm * 256 + ai * 128 + wr * 64 + m * 16 + fr;
#pragma unroll
                for (int bj = 0; bj < 2; ++bj) {
                    const int ct = bj * 128 + wc * 32 + 8 * fq;
                    const f32x4 v0 = acc[ai][bj][m][0], v1 = acc[ai][bj][m][1];
                    if (pn < 4) { *(u32x4*)((bf16_t*)(ws + WS_ZR) + row * 1024 + pn * 256 + ct) = pk8(v0, v1); }
                    else if (pn == 4) { float* p = (float*)(ws + WS_ZP) + row * 256 + ct; *(f32x4*)p = v0; *(f32x4*)(p + 4) = v1; }
                    else { const int q = pn - 5, which = q >> 1; const float sc = (which == 0) ? QSCALE : 1.f;
                        bf16_t* p = (bf16_t*)(ws + (which == 0 ? WS_Q : (which == 1 ? WS_K : WS_V))) + row * 512 + (q & 1) * 256 + ct;
                        u32x4 w; w.x = pg8::cvt_pk_bf16(v0[0] * sc, v0[1] * sc); w.y = pg8::cvt_pk_bf16(v0[2] * sc, v0[3] * sc); w.z = pg8::cvt_pk_bf16(v1[0] * sc, v1[1] * sc); w.w = pg8::cvt_pk_bf16(v1[2] * sc, v1[3] * sc);
                        *(u32x4*)p = w; }
                }
            }
    }
};
struct EpiOut {
    bf16_t* X; const float* Xin; const float* g1; float scale;
    __device__ __forceinline__ void operator()(const f32x4 (&acc)[2][2][4][2], const pg8::Unit& u, int wr, int wc, int fr, int fq) const {
        const int b = (u.pm * 256) >> 12;
#pragma unroll
        for (int bj = 0; bj < 2; ++bj) {
            const int col = u.pn * 256 + bj * 128 + wc * 32 + 8 * fq;
            const f32x4 ga = *(const f32x4*)(g1 + (size_t)b * 6144 + col), gb = *(const f32x4*)(g1 + (size_t)b * 6144 + col + 4);
#pragma unroll
            for (int ai = 0; ai < 2; ++ai)
#pragma unroll
                for (int m = 0; m < 4; ++m) {
                    const size_t row = (size_t)u.pm * 256 + ai * 128 + wr * 64 + m * 16 + fr;
                    bf16_t* p = X + row * 1024 + col;
                    f32x4 x0, x1;
                    if (Xin) { const float* pi = Xin + row * 1024 + col; x0 = *(const f32x4*)pi; x1 = *(const f32x4*)(pi + 4); }
                    else { const u32x4 xb = *(const u32x4*)p; x0 = up4((u32x2){xb.x, xb.y}); x1 = up4((u32x2){xb.z, xb.w}); }
                    *(u32x4*)p = pk8(x0 + ga * scale * acc[ai][bj][m][0], x1 + gb * scale * acc[ai][bj][m][1]);
                }
        }
    }
};

struct MoeTab { LAS int* te; LAS int* tr0; LAS int* cnt; LAS int* ntiles; };
__device__ __forceinline__ MoeTab moe_table(Frame& F, int l) {
    refresh(F); unsigned char* ws_ = (unsigned char*)ldptr(F, 30); const InTab in_{F.lds}; gu32* ctl_ = (gu32*)ws_;

    MoeTab T; T.te = (LAS int*)(F.lds + TAB_OFF); T.tr0 = T.te + 320; T.cnt = T.tr0 + 320; T.ntiles = T.cnt + 32;
    if (F.tid < 32) T.cnt[F.tid] = (int)__hip_atomic_load(ctl_ + CW_CNT + ((l + (PROBE_DUP == 8 ? 4 : 0)) * 32 + F.tid) * 64, RLX_AGENT);
    __syncthreads();
    if (F.tid < 64) {
        const int e = F.tid; const int nt_e = (e < 32) ? ((T.cnt[e & 31] + 255) >> 8) : 0;
        int incl = nt_e;
#pragma unroll
        for (int o = 1; o < 32; o <<= 1) { const int t = __shfl_up(incl, o); if (F.lane >= o) incl += t; }
        const int start = incl - nt_e;
#pragma nounroll
        for (int r = 0; r < nt_e; ++r) { T.te[start + r] = e; T.tr0[start + r] = r * 256; }
        if (e == 31) T.ntiles[0] = incl;
    }
    __syncthreads();
    return T;
}
struct ProbGU {
    const char* H; const char* W; const int* list; MoeTab T; int nun, G, vcu, l;
    __device__ __forceinline__ bool next(int i, pg8::Unit& u) const { const int Lx = i * G + vcu; if (Lx >= nun) return false; u.pm = Lx >> 3; u.pn = Lx & 7; u.e = __builtin_amdgcn_readfirstlane(T.te[u.pm]); return true; }
    __device__ __forceinline__ const char* a_ptr(const pg8::Unit&) const { return H; }
    __device__ __forceinline__ const char* b_ptr(const pg8::Unit& u) const { return W + ((size_t)(l * 32 + u.e) * 2048 + (size_t)u.pn * 256) * 2048; }
    __device__ __forceinline__ unsigned row_off(const pg8::Unit& u, int r) const { const int idx = __builtin_amdgcn_readfirstlane(T.tr0[u.pm]) + r; const int tok = (idx < __builtin_amdgcn_readfirstlane(T.cnt[u.e])) ? (list[u.e * NTOK + idx] >> 2) : 0; return (unsigned)tok * 2048u; }
};
struct EpiGU {
    bf16_t* ACT; const float* bgu; int l;
    __device__ __forceinline__ void operator()(const f32x4 (&acc)[2][2][4][2], const pg8::Unit& u, int wr, int wc, int fr, int fq) const {
        const int col = u.pn * 128 + wc * 32 + 8 * fq;
        const float* bb = bgu + (size_t)(l * 32 + u.e) * 2048 + col;
        const f32x4 bg0 = *(const f32x4*)bb, bg1 = *(const f32x4*)(bb + 4), bu0 = *(const f32x4*)(bb + 1024), bu1 = *(const f32x4*)(bb + 1028);
#pragma unroll
        for (int ai = 0; ai < 2; ++ai)
#pragma unroll
            for (int m = 0; m < 4; ++m) {
                const size_t row = (size_t)u.pm * 256 + ai * 128 + wr * 64 + m * 16 + fr;
                float a[8];
#pragma unroll
                for (int n = 0; n < 2; ++n)
#pragma unroll
                    for (int i = 0; i < 4; ++i) {
                        float g = acc[ai][0][m][n][i] + (n ? bg1[i] : bg0[i]); float up = acc[ai][1][m][n][i] + (n ? bu1[i] : bu0[i]);
                        g = fminf(g, 7.f); up = fminf(fmaxf(up, -7.f), 7.f);
                        a[n * 4 + i] = (up + 1.f) * (g / (1.f + __expf(-1.702f * g)));
                    }
                u32x4 w; w.x = pg8::cvt_pk_bf16(a[0], a[1]); w.y = pg8::cvt_pk_bf16(a[2], a[3]); w.z = pg8::cvt_pk_bf16(a[4], a[5]); w.w = pg8::cvt_pk_bf16(a[6], a[7]);
                *(u32x4*)(ACT + row * 1024 + col) = w;
            }
    }
};
struct ProbDN {
    const char* ACT; const char* W; MoeTab T; int nun, G, vcu, l;
    __device__ __forceinline__ bool next(int i, pg8::Unit& u) const { const int Lx = i * G + vcu; if (Lx >= nun) return false; u.pm = Lx >> 2; u.pn = Lx & 3; u.e = __builtin_amdgcn_readfirstlane(T.te[u.pm]); return true; }
    __device__ __forceinline__ const char* a_ptr(const pg8::Unit& u) const { return ACT + (size_t)u.pm * 256 * 2048; }
    __device__ __forceinline__ const char* b_ptr(const pg8::Unit& u) const { return W + ((size_t)(l * 32 + u.e) * 1024 + (size_t)u.pn * 256) * 2048; }
};
struct EpiDN {
    bf16_t* YS; const float* bdn; const int* list; const float* gate; MoeTab T; int l;
    __device__ __forceinline__ void operator()(const f32x4 (&acc)[2][2][4][2], const pg8::Unit& u, int wr, int wc, int fr, int fq) const {
        const int r0 = __builtin_amdgcn_readfirstlane(T.tr0[u.pm]), c = __builtin_amdgcn_readfirstlane(T.cnt[u.e]);
#pragma unroll
        for (int ai = 0; ai < 2; ++ai)
#pragma unroll
            for (int m = 0; m < 4; ++m) {
                const int idx = r0 + ai * 128 + wr * 64 + m * 16 + fr;
                if (idx < c) {
                    const int slot = list[u.e * NTOK + idx]; const float gt = gate[slot];
#pragma unroll
                    for (int bj = 0; bj < 2; ++bj) {
                        const int col = u.pn * 256 + bj * 128 + wc * 32 + 8 * fq;
                        const float* bb = bdn + (size_t)(l * 32 + u.e) * 1024 + col;
                        const f32x4 b0 = *(const f32x4*)bb, b1 = *(const f32x4*)(bb + 4);
                        const f32x4 v0 = (acc[ai][bj][m][0] + b0) * gt, v1 = (acc[ai][bj][m][1] + b1) * gt;
                        u32x4 w; w.x = pg8::cvt_pk_bf16(v0[0], v0[1]); w.y = pg8::cvt_pk_bf16(v0[2], v0[3]); w.z = pg8::cvt_pk_bf16(v1[0], v1[1]); w.w = pg8::cvt_pk_bf16(v1[2], v1[3]);
                        *(u32x4*)(YS + (size_t)slot * 1024 + col) = w;
                    }
                }
            }
    }
};

__device__ __forceinline__ void phase_prep(Frame& F, int l) {
    refresh(F); unsigned char* ws_ = (unsigned char*)ldptr(F, 30); const InTab in_{F.lds};
    if (blockIdx.x < 32) {
        const int b = blockIdx.x >> 3, hh = blockIdx.x & 7;
        const float bf = in_[I_BF][l * 8 + hh];
        const float* fl = (const float*)(ws_ + WS_FLOG) + ((size_t)b * SEQ + 8 * F.tid) * 8 + hh;
        float lf[8];
#pragma unroll
        for (int i = 0; i < 8; ++i) lf[i] = fl[i * 8];
#pragma unroll
        for (int i = 0; i < 8; ++i) { lf[i] = -softplusf_(-(lf[i] + bf)); if (i) lf[i] += lf[i - 1]; }
        float incl = lf[7];
#pragma unroll
        for (int o = 1; o < 64; o <<= 1) { const float t = __shfl_up(incl, o); if (F.lane >= o) incl += t; }
        LAS float* wtot = (LAS float*)F.lds;
        if (F.lane == 63) wtot[F.wave] = incl;
        __syncthreads();
        float off = incl - lf[7];
        for (int w = 0; w < F.wave; ++w) off += wtot[w];
        float* bo = (float*)(ws_ + WS_BIAS) + ((size_t)b * 8 + hh) * SEQ + 8 * F.tid;
        f32x4 o0, o1;
        o0.x = -(off + lf[0]) * LOG2E; o0.y = -(off + lf[1]) * LOG2E; o0.z = -(off + lf[2]) * LOG2E; o0.w = -(off + lf[3]) * LOG2E;
        o1.x = -(off + lf[4]) * LOG2E; o1.y = -(off + lf[5]) * LOG2E; o1.z = -(off + lf[6]) * LOG2E; o1.w = -(off + lf[7]) * LOG2E;
        *(f32x4*)bo = o0; *(f32x4*)(bo + 4) = o1;
    }
    const int gw = F.vcu * NWAVES + F.wave, NGW = F.G * NWAVES;
    const float* mu = in_[I_MU] + l * 1024;
    f32x4 muv[4];
#pragma unroll
    for (int j = 0; j < 4; ++j) muv[j] = *(const f32x4*)(mu + 4 * F.lane + 256 * j);
    const f32x4 kkw = *(const f32x4*)(in_[I_KK] + l * 256 + 4 * F.lane);
    const bf16_t* ZR = (const bf16_t*)(ws_ + WS_ZR);
    const int hd = F.lane >> 4, cc = 4 * (F.lane & 15);
    const float act_a = (F.lane < 16) ? 2.f : 1.f, act_b = (F.lane < 16) ? -1.f : 0.f; const bool act_id = (F.lane >= 16 && F.lane < 32);
    for (int g = gw; g < NTOK / 8; g += NGW) {
        const int m0 = g * 8;
        u32x2 raw[9][4];
        const bool hasp = (m0 & (SEQ - 1)) != 0;
#pragma unroll
        for (int i = 0; i < 9; ++i)
#pragma unroll
            for (int j = 0; j < 4; ++j) raw[i][j] = (i > 0 || hasp) ? *(const u32x2*)(ZR + (size_t)(m0 - 1 + i) * 1024 + 4 * F.lane + 256 * j) : (u32x2){0u, 0u};
        f32x4 prev[4], cur[4];
#pragma unroll
        for (int j = 0; j < 4; ++j) prev[j] = unp4(raw[0][j]);
#pragma unroll
        for (int i = 0; i < 8; ++i) {
            const int m = m0 + i, b = m >> 12, t = m & (SEQ - 1);
#pragma unroll
            for (int j = 0; j < 4; ++j) cur[j] = unp4(raw[i + 1][j]);
            f32x4 zs[4];
#pragma unroll
            for (int j = 0; j < 4; ++j) zs[j] = cur[j] + (prev[j] - cur[j]) * muv[j];
            unsigned char* o = ws_ + WS_SCAN + ((size_t)(b * 4 + hd) * SEQ + t) * SCAN_ROW + cc * 2;
            *(u32x2*)(o) = pk4(zs[0]);
            *(u32x2*)(o + 128) = pk4(zs[1]);
            *(u32x2*)(o + 256) = pk4(zs[2]);
            f32x4 kk = zs[1] * kkw;
            const float ss = red16((kk.x * kk.x + kk.y * kk.y) + (kk.z * kk.z + kk.w * kk.w));
            kk = kk * (1.f / fmaxf(sqrtf(ss), 1e-12f));
            *(u32x2*)(o + 384) = pk4(kk);
            f32x4 a4;
#pragma unroll
            for (int q = 0; q < 4; ++q) { const float x = zs[3][q]; const float sg = 1.f / (1.f + __expf(-act_a * x)); a4[q] = act_id ? x : (act_a * sg + act_b); }
            u32x2 pk; pk.x = cvtpk(a4.x, a4.y); pk.y = cvtpk(a4.z, a4.w);
            *(u32x2*)((bf16_t*)(ws_ + WS_ALORA) + (size_t)m * 256 + 4 * F.lane) = pk;
#pragma unroll
            for (int j = 0; j < 4; ++j) prev[j] = cur[j];
        }
    }
}
struct ProbLora {
    const char* A; const char* Bt; int G, vcu;
    __device__ __forceinline__ bool next(int i, pg8::Unit& u) const { const int Lx = i * G + vcu; if (Lx >= 64 * 3) return false; u.pn = Lx % 3; u.pm = Lx / 3; u.e = 0; return true; }
    __device__ __forceinline__ const char* a_ptr(const pg8::Unit& u) const { return A + (size_t)u.pm * 256 * 512; }
    __device__ __forceinline__ const char* b_ptr(const pg8::Unit& u) const { return Bt + (size_t)u.pn * 256 * 512; }
};
struct EpiLora {
    unsigned char* ws; const float* w0; const float* a0; const float* ka;
    __device__ __forceinline__ void operator()(const f32x4 (&acc)[2][2][4][2], const pg8::Unit& u, int wr, int wc, int fr, int fq) const {
        const int pn = u.pn;
#pragma unroll
        for (int bj = 0; bj < 2; ++bj) {
            const int c = bj * 128 + wc * 32 + 8 * fq, hd = c >> 6, cc = c & 63;
            f32x4 p0 = (f32x4){0.f, 0.f, 0.f, 0.f}, p1 = p0, q0 = p0, q1 = p0;
            if (pn == 0) { p0 = *(const f32x4*)(w0 + c); p1 = *(const f32x4*)(w0 + c + 4); }
            else if (pn == 1) { p0 = *(const f32x4*)(a0 + c); p1 = *(const f32x4*)(a0 + c + 4); q0 = *(const f32x4*)(ka + c); q1 = *(const f32x4*)(ka + c + 4); }
#pragma unroll
            for (int ai = 0; ai < 2; ++ai)
#pragma unroll
                for (int m = 0; m < 4; ++m) {
                    const int row = u.pm * 256 + ai * 128 + wr * 64 + m * 16 + fr, b = row >> 12, t = row & (SEQ - 1);
                    const f32x4 v0 = acc[ai][bj][m][0], v1 = acc[ai][bj][m][1];
                    unsigned char* o = ws + WS_SCAN + ((size_t)(b * 4 + hd) * SEQ + t) * SCAN_ROW;
                    if (pn == 0) {
                        f32x4 d0, d1;
#pragma unroll
                        for (int i = 0; i < 4; ++i) { d0[i] = -__expf(-softplus_fast(-(p0[i] + v0[i])) - 0.5f); d1[i] = -__expf(-softplus_fast(-(p1[i] + v1[i])) - 0.5f); if (!CHUNKED_SCAN) { d0[i] = __expf(d0[i]); d1[i] = __expf(d1[i]); } }
                        *(f32x4*)(o + 640 + cc * 4) = d0; *(f32x4*)(o + 640 + cc * 4 + 16) = d1;
                    } else if (pn == 1) {
                        const u32x4 kp = *(const u32x4*)(o + 128 + cc * 2), np = *(const u32x4*)(o + 384 + cc * 2);
                        const f32x4 k0 = unp4((u32x2){kp.x, kp.y}), k1 = unp4((u32x2){kp.z, kp.w}), n0 = unp4((u32x2){np.x, np.y}), n1 = unp4((u32x2){np.z, np.w});
                        f32x4 a_0, a_1;
#pragma unroll
                        for (int i = 0; i < 4; ++i) { a_0[i] = sigmoidf_(p0[i] + v0[i]); a_1[i] = sigmoidf_(p1[i] + v1[i]); }
                        *(u32x4*)(o + 128 + cc * 2) = pk8(k0 * ((a_0 - 1.f) * q0 + 1.f), k1 * ((a_1 - 1.f) * q1 + 1.f));
                        *(u32x4*)(o + 512 + cc * 2) = pk8(-(n0 * a_0), -(n1 * a_1));
                    } else {
                        *(u32x4*)((bf16_t*)(ws + WS_G) + (size_t)row * 256 + c) = pk8(v0, v1);
                    }
                }
        }
    }
};

constexpr int SC_STEPS = 16, SC_CHUNK_F = SC_STEPS * 384, SC_NBUF = 5, SC_PPW = SC_STEPS * 6 / 16;
struct ScanIn { f32x4 r, w, k, kk, kb; float v; };
__device__ __forceinline__ ScanIn scan_ld(const LAS float* p, int ks, int row) {
    ScanIn x; x.r = *(const LAS f32x4*)(p + ks); x.w = *(const LAS f32x4*)(p + 64 + ks); x.k = *(const LAS f32x4*)(p + 128 + ks); x.kk = *(const LAS f32x4*)(p + 256 + ks); x.kb = *(const LAS f32x4*)(p + 320 + ks); x.v = p[192 + row]; return x;
}
__device__ __forceinline__ void scan_block(Frame& F, int rb) {
    refresh(F); unsigned char* ws_ = (unsigned char*)ldptr(F, 30);
    const int bh = rb >> 2, rg = rb & 3, b = bh >> 2, h = bh & 3;
    const float* src = (const float*)(ws_ + WS_SCAN) + (size_t)bh * SEQ * 384;
    LAS float* buf = (LAS float*)F.lds;
    constexpr int NCH = SEQ / SC_STEPS;
    if (F.wave >= 4) {
        const int lw = F.wave - 4;
#define SC_ISSUE(c, slot) do { _Pragma("unroll") for (int p_ = 0; p_ < SC_PPW; ++p_) { const int pc_ = lw * SC_PPW + p_; \
            __builtin_amdgcn_global_load_lds((const unsigned*)(src + (size_t)(c) * SC_CHUNK_F + pc_ * 256 + F.lane * 4), (LAS unsigned*)(buf + (slot) * SC_CHUNK_F + pc_ * 256), 16, 0, 0); } } while (0)
#pragma unroll
        for (int c = 0; c < SC_NBUF - 1; ++c) SC_ISSUE(c, c);
        asm volatile("s_waitcnt vmcnt(%0)" :: "n"((SC_NBUF - 2) * SC_PPW) : "memory");
        __builtin_amdgcn_s_barrier();
        int slot = SC_NBUF - 1;
        for (int c = 0; c < NCH; ++c) {
            if (c + SC_NBUF - 1 < NCH) { SC_ISSUE(c + SC_NBUF - 1, slot); asm volatile("s_waitcnt vmcnt(%0)" :: "n"((SC_NBUF - 2) * SC_PPW) : "memory"); }
            else asm volatile("s_waitcnt vmcnt(0)" ::: "memory");
            slot = (slot == SC_NBUF - 1) ? 0 : slot + 1;
            __builtin_amdgcn_s_barrier();
        }
#undef SC_ISSUE
    } else {
        const int row = rg * 16 + F.wave * 4 + (F.lane >> 4), ks = (F.lane & 15) * 4, l16 = F.lane & 15;
        f32x4 s = (f32x4){0.f, 0.f, 0.f, 0.f};
        float* yout = (float*)(ws_ + WS_YRAW) + (size_t)b * SEQ * 256 + 64 * h + row;
        float yp = 0.f;
        int slot = 0;
        __builtin_amdgcn_s_barrier();
        for (int c = 0; c < NCH; ++c) {
            const LAS float* base = buf + slot * SC_CHUNK_F;
            slot = (slot == SC_NBUF - 1) ? 0 : slot + 1;
            float ykeep = 0.f;
            ScanIn cur = scan_ld(base, ks, row);
#pragma unroll
            for (int st = 0; st < SC_STEPS; ++st) {
                ScanIn nxt = cur;
                if (st + 1 < SC_STEPS) nxt = scan_ld(base + (st + 1) * 384, ks, row);
                const f32x4 vk = cur.k * cur.v;
                const float t0 = s.x * cur.kk.x + s.y * cur.kk.y, t1 = s.z * cur.kk.z + s.w * cur.kk.w;
                const f32x4 u = s * cur.w + vk;
                float sa = t0 + t1;
                red16_pair(sa, yp);
                ykeep = (l16 == st) ? yp : ykeep;
                s = u + cur.kb * sa;
                const float y0 = s.x * cur.r.x + s.y * cur.r.y, y1 = s.z * cur.r.z + s.w * cur.r.w;
                yp = y0 + y1;
                cur = nxt;
            }
            { const int g = c * SC_STEPS + l16 - 1; if (l16 < SC_STEPS && g >= 0) yout[(size_t)g * 256] = ykeep; }
            __builtin_amdgcn_s_barrier();
        }
        yp = red16(yp);
        if (l16 == 0) yout[(size_t)(SEQ - 1) * 256] = yp;
    }
}


__device__ __forceinline__ int crow(int r, int hi) { return (r & 3) + 8 * (r >> 2) + 4 * hi; }
constexpr int CK_P = 144, CK_A = 64 * CK_P;
enum { CA_KKP = 0, CA_RP, CA_BI, CA_KI, CA_VT, CA_KKPT, CA_BHT, CA_KHT, CA_TB, CA_AUK, CA_ARB, CA_ARK, CA_TF0, CA_TF1, CA_N,
       CA_W1T = CA_KKP, CA_MT = CA_BI, CA_U0T = CA_KI,
       CA_D1T = CA_BI, CA_X1T = CA_KI };
constexpr int CK_TF = CA_TF0 * CK_A;
static_assert(CA_N * CK_A <= 139264 && 64 * 68 * 4 <= 2 * CK_A, "chunk LDS map");
__device__ __forceinline__ f32x16 ck_mma(const LAS unsigned char* A, const LAS unsigned char* B, int ksteps, f32x16 acc, int r32, int hi) {
#pragma unroll 4
    for (int s = 0; s < ksteps; ++s) {
        const bf16x8 a = *(const LAS bf16x8*)(A + r32 * CK_P + (16 * s + 8 * hi) * 2);
        const bf16x8 b = *(const LAS bf16x8*)(B + r32 * CK_P + (16 * s + 8 * hi) * 2);
        acc = __builtin_amdgcn_mfma_f32_32x32x16_bf16(a, b, acc, 0, 0, 0);
    }
    return acc;
}
__device__ __forceinline__ void ck_store_t(LAS unsigned char* dst, const f32x16& c, int R0, int C0, int r32, int hi) {
#pragma unroll
    for (int g = 0; g < 4; ++g) { u32x2 w; w.x = cvtpk(c[4 * g], c[4 * g + 1]); w.y = cvtpk(c[4 * g + 2], c[4 * g + 3]); *(LAS u32x2*)(dst + (C0 + r32) * CK_P + (R0 + 8 * g + 4 * hi) * 2) = w; }
}
#define STAMPF(F_, id) do { if (PROBE_T >= 20 && blockIdx.x == 0 && (F_).tid == 0) { volatile LAS unsigned long long* tsw_ = (volatile LAS unsigned long long*)((F_).lds + MISC_OFF + 192); const unsigned long long now_ = wall_clock64(); if ((id) == PROBE_T) tsw_[1] += now_ - tsw_[0]; tsw_[0] = now_; } } while (0)
struct ChunkRows { u32x4 r, k, v, kk, kb; f32x4 w[2]; };
__device__ __forceinline__ ChunkRows chunk_load(Frame& F, unsigned char* ws_, int job) {
    const int t = F.tid & 63, c0 = (F.tid >> 6) * 8, bh = job >> 6, ch = job & 63;
    const unsigned char* row = ws_ + WS_SCAN + ((size_t)bh * SEQ + (size_t)ch * 64 + t) * SCAN_ROW;
    ChunkRows x;
    x.r = *(const u32x4*)(row + c0 * 2); x.k = *(const u32x4*)(row + 128 + c0 * 2); x.v = *(const u32x4*)(row + 256 + c0 * 2); x.kk = *(const u32x4*)(row + 384 + c0 * 2); x.kb = *(const u32x4*)(row + 512 + c0 * 2);
    x.w[0] = *(const f32x4*)(row + 640 + c0 * 4); x.w[1] = *(const f32x4*)(row + 640 + c0 * 4 + 16);
    return x;
}
__device__ __forceinline__ void chunk_job(Frame& F, unsigned char* ws_, int job, const ChunkRows& in) {
    LAS unsigned char* L = F.lds;
    LAS float* Tf = (LAS float*)(L + CK_TF);
    const int tid = F.tid, lane = F.lane, wave = F.wave, r32 = lane & 31, hi = lane >> 5;
    {
        const int t = tid & 63, c0 = (tid >> 6) * 8;
        float r_[8], k_[8], v_[8], kk_[8], kb_[8], Lt[8];
#pragma unroll
        for (int q = 0; q < 2; ++q) {
            const f32x4 r4 = unp4((u32x2){in.r[2 * q], in.r[2 * q + 1]}), k4 = unp4((u32x2){in.k[2 * q], in.k[2 * q + 1]}), v4 = unp4((u32x2){in.v[2 * q], in.v[2 * q + 1]}), n4 = unp4((u32x2){in.kk[2 * q], in.kk[2 * q + 1]}), b4 = unp4((u32x2){in.kb[2 * q], in.kb[2 * q + 1]});
#pragma unroll
            for (int i = 0; i < 4; ++i) { r_[4 * q + i] = r4[i]; k_[4 * q + i] = k4[i]; v_[4 * q + i] = v4[i]; kk_[4 * q + i] = n4[i]; kb_[4 * q + i] = -b4[i]; Lt[4 * q + i] = in.w[q][i]; }
        }
#pragma unroll
        for (int i = 0; i < 8; ++i) {
            float x = Lt[i];
            x += __builtin_bit_cast(float, __builtin_amdgcn_update_dpp(0, __builtin_bit_cast(int, x), 0x111, 0xf, 0xf, true));
            x += __builtin_bit_cast(float, __builtin_amdgcn_update_dpp(0, __builtin_bit_cast(int, x), 0x112, 0xf, 0xf, true));
            x += __builtin_bit_cast(float, __builtin_amdgcn_update_dpp(0, __builtin_bit_cast(int, x), 0x114, 0xf, 0xf, true));
            x += __builtin_bit_cast(float, __builtin_amdgcn_update_dpp(0, __builtin_bit_cast(int, x), 0x118, 0xf, 0xf, true));
            const float r0 = __builtin_bit_cast(float, __builtin_amdgcn_readlane(__builtin_bit_cast(int, x), 15)), r1 = __builtin_bit_cast(float, __builtin_amdgcn_readlane(__builtin_bit_cast(int, x), 31)), r2 = __builtin_bit_cast(float, __builtin_amdgcn_readlane(__builtin_bit_cast(int, x), 47));
            const int rw = lane >> 4;
            x += (rw >= 1 ? r0 : 0.f) + (rw >= 2 ? r1 : 0.f) + (rw >= 3 ? r2 : 0.f);
            Lt[i] = x;
        }
        float kkp[8], rp[8], bi[8], ki[8], bh_[8], kh_[8];
#pragma unroll
        for (int i = 0; i < 8; ++i) {
            const float Lm0 = __shfl_up(Lt[i], 1); const float Lm = (lane > 0) ? Lm0 : 0.f; const float Lc = __shfl(Lt[i], 63);
            const float ip = __expf(-Lt[i]);
            kkp[i] = kk_[i] * __expf(Lm); rp[i] = r_[i] * __expf(Lt[i]); bi[i] = kb_[i] * ip; ki[i] = k_[i] * ip;
            const float pc = __expf(Lc - Lt[i]); bh_[i] = kb_[i] * pc; kh_[i] = k_[i] * pc;
            if (t == 63) ((LAS float*)(L + PCV_OFF))[c0 + i] = __expf(Lc);
        }
#define CK_ROW8(arr, vals_) do { u32x4 w_ = (u32x4){cvtpk(vals_[0], vals_[1]), cvtpk(vals_[2], vals_[3]), cvtpk(vals_[4], vals_[5]), cvtpk(vals_[6], vals_[7])}; *(LAS u32x4*)(L + (arr) * CK_A + t * CK_P + c0 * 2) = w_; } while (0)
#define CK_COL8(arr, vals_) do { _Pragma("unroll") for (int i_ = 0; i_ < 8; ++i_) *(LAS unsigned short*)(L + (arr) * CK_A + (c0 + i_) * CK_P + t * 2) = (unsigned short)cvtpk(vals_[i_], 0.f); } while (0)
        CK_ROW8(CA_KKP, kkp); CK_ROW8(CA_RP, rp); CK_ROW8(CA_BI, bi); CK_ROW8(CA_KI, ki);
        CK_COL8(CA_VT, v_); CK_COL8(CA_KKPT, kkp); CK_COL8(CA_BHT, bh_); CK_COL8(CA_KHT, kh_);
#undef CK_ROW8
#undef CK_COL8
    }
    __syncthreads(); STAMPF(F, 20);
#pragma unroll
    for (int q = 0; q < 2; ++q) {
        const int id = wave * 2 + q, which = id >> 2, tj = (id >> 1) & 1, tt = id & 1;
        const LAS unsigned char* Aop = L + ((which & 1) ? CA_KI : CA_BI) * CK_A + tj * 32 * CK_P;
        const LAS unsigned char* Bop = L + ((which & 2) ? CA_RP : CA_KKP) * CK_A + tt * 32 * CK_P;
        f32x16 c = {}; c = ck_mma(Aop, Bop, 4, c, r32, hi);
        const int t = tt * 32 + r32;
#pragma unroll
        for (int i = 0; i < 16; ++i) { const int j = tj * 32 + crow(i, hi); const bool keep = (which & 2) ? (j <= t) : (j < t); if (!keep) c[i] = 0.f; }
        if (which == 0) {
#pragma unroll
            for (int g = 0; g < 4; ++g) { const int j0 = tj * 32 + 8 * g + 4 * hi; Tf[t * 68 + j0] = c[4 * g]; Tf[t * 68 + j0 + 1] = c[4 * g + 1]; Tf[t * 68 + j0 + 2] = c[4 * g + 2]; Tf[t * 68 + j0 + 3] = c[4 * g + 3]; }
        } else ck_store_t(L + ((which == 1) ? CA_AUK : (which == 2) ? CA_ARB : CA_ARK) * CK_A, c, tj * 32, tt * 32, r32, hi);
    }
    __syncthreads(); STAMPF(F, 21);
    LAS unsigned char* TB = L + CA_TB * CK_A;
    if (wave == 4) {
        const int blk = lane >> 5, c = lane & 31;
        const LAS float* ab = Tf + blk * (32 * 68 + 32);
        float x[32];
#pragma unroll
        for (int t = 0; t < 32; ++t) x[t] = 0.f;
#pragma unroll
        for (int t = 0; t < 32; ++t) {
            int z = 0;
            if (t >= 2) asm volatile("" : "+v"(z) : "v"(x[t - 2]));
            const LAS float* rowp = ab + t * 68 + z;
            float a0 = (t == c) ? 1.f : 0.f, a1 = 0.f, a2 = 0.f, a3 = 0.f;
#pragma unroll
            for (int j = 0; j < t; j += 4) { const f32x4 a4 = *(const LAS f32x4*)(rowp + j);
                a0 -= a4.x * x[j]; a1 -= a4.y * x[j + 1]; a2 -= a4.z * x[j + 2]; a3 -= a4.w * x[j + 3]; }
            x[t] = (a0 + a1) + (a2 + a3);
        }
#pragma unroll
        for (int t = 0; t < 32; ++t) *(LAS unsigned short*)(TB + (32 * blk + t) * CK_P + (32 * blk + c) * 2) = (unsigned short)f2bf(x[t]);
        if (blk == 0) {
#pragma unroll
            for (int t8 = 0; t8 < 4; ++t8) { const u32x4 w_ = (u32x4){cvtpk(x[8 * t8], x[8 * t8 + 1]), cvtpk(x[8 * t8 + 2], x[8 * t8 + 3]), cvtpk(x[8 * t8 + 4], x[8 * t8 + 5]), cvtpk(x[8 * t8 + 6], x[8 * t8 + 7])}; *(LAS u32x4*)(L + CA_D1T * CK_A + c * CK_P + t8 * 16) = w_; }
        } else {
#pragma unroll
            for (int t8 = 0; t8 < 4; ++t8) *(LAS u32x4*)(TB + c * CK_P + 64 + t8 * 16) = (u32x4){0u, 0u, 0u, 0u};
        }
    } else if (wave < 4) {
        const int tt = wave >> 1, tv = wave & 1;
        f32x16 c = {}; c = ck_mma(L + CA_AUK * CK_A + tt * 32 * CK_P, L + CA_VT * CK_A + tv * 32 * CK_P, 4, c, r32, hi);
        ck_store_t(L + CA_W1T * CK_A, c, tt * 32, tv * 32, r32, hi);
    }
    __syncthreads(); STAMPF(F, 22);
    if (wave == 0) {
        f32x16 c = {};
#pragma unroll
        for (int s = 0; s < 2; ++s) {
            const f32x4 f0 = *(const LAS f32x4*)(Tf + (32 + r32) * 68 + 16 * s + 8 * hi), f1 = *(const LAS f32x4*)(Tf + (32 + r32) * 68 + 16 * s + 8 * hi + 4);
            const u32x4 aw = (u32x4){cvtpk(f0.x, f0.y), cvtpk(f0.z, f0.w), cvtpk(f1.x, f1.y), cvtpk(f1.z, f1.w)};
            const bf16x8 b = *(const LAS bf16x8*)(L + CA_D1T * CK_A + r32 * CK_P + (16 * s + 8 * hi) * 2);
            c = __builtin_amdgcn_mfma_f32_32x32x16_bf16(__builtin_bit_cast(bf16x8, aw), b, c, 0, 0, 0);
        }
        ck_store_t(L + CA_X1T * CK_A, c, 0, 0, r32, hi);
    }
    __syncthreads(); STAMPF(F, 23);
    if (wave == 0) {
        f32x16 c = {}; c = ck_mma(L + CA_X1T * CK_A, TB + 32 * CK_P + 64, 2, c, r32, hi);
#pragma unroll
        for (int i = 0; i < 16; ++i) c[i] = -c[i];
        ck_store_t(TB + 32 * CK_P, c, 0, 0, r32, hi);
    }
    __syncthreads(); STAMPF(F, 24);
    {
        const int which = wave >> 2, tt = (wave >> 1) & 1, tc = wave & 1;
        f32x16 c = {}; c = ck_mma(L + CA_TB * CK_A + tt * 32 * CK_P, L + (which ? CA_W1T : CA_KKPT) * CK_A + tc * 32 * CK_P, 4, c, r32, hi);
        if (which) {
#pragma unroll
            for (int i = 0; i < 16; ++i) c[i] = -c[i];
        }
        ck_store_t(L + (which ? CA_U0T : CA_MT) * CK_A, c, tt * 32, tc * 32, r32, hi);
    }
    __syncthreads(); STAMPF(F, 25);
    const size_t jb = (size_t)job;
#pragma unroll
    for (int q = 0; q < 2; ++q) {
        const int id = wave * 2 + q, which = id >> 2, ta = (id >> 1) & 1, tb = id & 1;
        f32x16 c = {};
        if (which == 0) {
            c = ck_mma(L + CA_MT * CK_A + ta * 32 * CK_P, L + CA_BHT * CK_A + tb * 32 * CK_P, 4, c, r32, hi);
            const int k2 = tb * 32 + r32; const float pcv = ((const LAS float*)(L + PCV_OFF))[k2];
            bf16_t* o = (bf16_t*)(ws_ + WS_CPG + jb * 24576) + (size_t)k2 * 64;
#pragma unroll
            for (int g = 0; g < 4; ++g) { const int k1 = ta * 32 + 8 * g + 4 * hi; float x[4];
#pragma unroll
                for (int i = 0; i < 4; ++i) x[i] = ((k1 + i == k2) ? pcv : 0.f) - c[4 * g + i];
                u32x2 w_; w_.x = cvtpk(x[0], x[1]); w_.y = cvtpk(x[2], x[3]); *(u32x2*)(o + k1) = w_; }
        } else if (which == 1) {
            c = ck_mma(L + CA_BHT * CK_A + ta * 32 * CK_P, L + CA_U0T * CK_A + tb * 32 * CK_P, 4, c, r32, hi);
            c = ck_mma(L + CA_KHT * CK_A + ta * 32 * CK_P, L + CA_VT * CK_A + tb * 32 * CK_P, 4, c, r32, hi);
            float* o = (float*)(ws_ + WS_CPG + jb * 24576 + 8192) + (size_t)(ta * 32) * 64 + tb * 32 + r32;
#pragma unroll
            for (int i = 0; i < 16; ++i) o[crow(i, hi) * 64] = c[i];
        } else if (which == 2) {
            c = ck_mma(L + CA_MT * CK_A + ta * 32 * CK_P, L + CA_ARB * CK_A + tb * 32 * CK_P, 4, c, r32, hi);
            const int t = tb * 32 + r32;
            bf16_t* o = (bf16_t*)(ws_ + WS_CPSI) + jb * 4096 + (size_t)t * 64;
#pragma unroll
            for (int g = 0; g < 4; ++g) { const int k0 = ta * 32 + 8 * g + 4 * hi; const u32x2 rp2 = *(const LAS u32x2*)(L + CA_RP * CK_A + t * CK_P + k0 * 2);
                const float r0 = __builtin_bit_cast(float, rp2.x << 16), r1 = __builtin_bit_cast(float, rp2.x & 0xffff0000u), r2 = __builtin_bit_cast(float, rp2.y << 16), r3 = __builtin_bit_cast(float, rp2.y & 0xffff0000u);
                u32x2 w_; w_.x = cvtpk(r0 - c[4 * g], r1 - c[4 * g + 1]); w_.y = cvtpk(r2 - c[4 * g + 2], r3 - c[4 * g + 3]); *(u32x2*)(o + k0) = w_; }
        } else {
            c = ck_mma(L + CA_ARB * CK_A + ta * 32 * CK_P, L + CA_U0T * CK_A + tb * 32 * CK_P, 4, c, r32, hi);
            c = ck_mma(L + CA_ARK * CK_A + ta * 32 * CK_P, L + CA_VT * CK_A + tb * 32 * CK_P, 4, c, r32, hi);
            float* o = (float*)(ws_ + WS_CY0) + jb * 4096 + (size_t)(ta * 32) * 64 + tb * 32 + r32;
#pragma unroll
            for (int i = 0; i < 16; ++i) o[crow(i, hi) * 64] = c[i];
        }
    }
    __syncthreads(); STAMPF(F, 26);
}


constexpr int S2_REC = 24576, S2_NSLOT = 4, S2_SB = S2_NSLOT * S2_REC;
__device__ __forceinline__ void chunk_states(Frame& F, unsigned char* ws_, int bh) {
    LAS unsigned char* L = F.lds;
    LAS unsigned char* Sb = L + S2_SB;
    const int tid = F.tid, lane = F.lane, wave = F.wave, r32 = lane & 31, hi = lane >> 5;
    for (int i = tid; i < 64 * CK_P / 4; i += NTHR) ((LAS unsigned*)Sb)[i] = 0u;
    const unsigned char* rec0 = ws_ + WS_CPG + (size_t)bh * 64 * S2_REC;
#define S2_ISSUE(c) do { if (wave >= 4) { _Pragma("unroll") for (int p_ = 0; p_ < 6; ++p_) { const int pc_ = (wave - 4) * 6 + p_; \
        __builtin_amdgcn_global_load_lds((const unsigned*)(rec0 + (size_t)(c) * S2_REC + pc_ * 1024 + lane * 16), (LAS unsigned*)(L + ((c) & (S2_NSLOT - 1)) * S2_REC + pc_ * 1024), 16, 0, 0); } } } while (0)
    S2_ISSUE(0); S2_ISSUE(1); S2_ISSUE(2);
    if (wave >= 4) asm volatile("s_waitcnt vmcnt(12)" ::: "memory");
    __syncthreads();
    const int ti = wave >> 1, tj = wave & 1;
    for (int c = 0; c < 64; ++c) {
        if (c + 3 < 64) { S2_ISSUE(c + 3); if (wave >= 4) asm volatile("s_waitcnt vmcnt(12)" ::: "memory"); }
        else if (wave >= 4) asm volatile("s_waitcnt vmcnt(0)" ::: "memory");
        { const int row = tid >> 3, ch = tid & 7; *(u32x4*)((bf16_t*)(ws_ + WS_CS) + ((size_t)bh * 64 + c) * 4096 + row * 64 + ch * 8) = *(const LAS u32x4*)(Sb + row * CK_P + ch * 16); }
        f32x16 acc = {};
        if (wave < 4) {
            const LAS unsigned char* R = L + (c & (S2_NSLOT - 1)) * S2_REC;
            const LAS float* G = (const LAS float*)(R + 8192);
#pragma unroll
            for (int i = 0; i < 16; ++i) acc[i] = G[(ti * 32 + crow(i, hi)) * 64 + tj * 32 + r32];
#pragma unroll
            for (int s = 0; s < 4; ++s) {
                const bf16x8 a = *(const LAS bf16x8*)(R + (ti * 32 + r32) * 128 + (16 * s + 8 * hi) * 2);
                const bf16x8 b = *(const LAS bf16x8*)(Sb + (tj * 32 + r32) * CK_P + (16 * s + 8 * hi) * 2);
                acc = __builtin_amdgcn_mfma_f32_32x32x16_bf16(a, b, acc, 0, 0, 0);
            }
        }
        __syncthreads();
        if (wave < 4) ck_store_t(Sb, acc, ti * 32, tj * 32, r32, hi);
        __syncthreads();
    }
#undef S2_ISSUE
}
struct OutOps { bf16x8 a[4], b[4]; f32x16 acc; };
struct PostOps { float vv[16], rr[16], kk[16], gg[16]; };
__device__ __forceinline__ OutOps out_load(Frame& F, unsigned char* ws_, int job, int w4) {
    const int lane = F.lane, r32 = lane & 31, hi = lane >> 5, tt = w4 >> 1, tv = w4 & 1;
    const bf16_t* Psi = (const bf16_t*)(ws_ + WS_CPSI) + (size_t)job * 4096; const bf16_t* CS = (const bf16_t*)(ws_ + WS_CS) + (size_t)job * 4096; const float* Y0 = (const float*)(ws_ + WS_CY0) + (size_t)job * 4096;
    OutOps o;
#pragma unroll
    for (int s = 0; s < 4; ++s) { o.a[s] = *(const bf16x8*)(Psi + (tt * 32 + r32) * 64 + 16 * s + 8 * hi); o.b[s] = *(const bf16x8*)(CS + (tv * 32 + r32) * 64 + 16 * s + 8 * hi); }
#pragma unroll
    for (int i = 0; i < 16; ++i) o.acc[i] = Y0[(tt * 32 + crow(i, hi)) * 64 + tv * 32 + r32];
    return o;
}
__device__ __forceinline__ PostOps post_load(Frame& F, unsigned char* ws_, int job, int w4) {
    const int c = F.lane, bh = job >> 6, ch = job & 63, b = bh >> 2, h = bh & 3;
    const unsigned char* SCN = ws_ + WS_SCAN + ((size_t)bh * SEQ + (size_t)ch * 64 + w4 * 16) * SCAN_ROW + c * 2; const bf16_t* GG = (const bf16_t*)(ws_ + WS_G) + ((size_t)b * SEQ + (size_t)ch * 64 + w4 * 16) * 256 + 64 * h + c;
    PostOps p;
#pragma unroll
    for (int u = 0; u < 16; ++u) { const unsigned char* sp = SCN + (size_t)u * SCAN_ROW; p.vv[u] = bf2f(*(const unsigned short*)(sp + 256)); p.rr[u] = bf2f(*(const unsigned short*)sp); p.kk[u] = bf2f(*(const unsigned short*)(sp + 128)); p.gg[u] = bf2f(GG[(size_t)u * 256]); }
    return p;
}
__device__ __forceinline__ void out_compute(Frame& F, const OutOps& o, int w4) {
    const int lane = F.lane, r32 = lane & 31, hi = lane >> 5, tt = w4 >> 1, tv = w4 & 1;
    f32x16 acc = o.acc;
#pragma unroll
    for (int s = 0; s < 4; ++s) acc = __builtin_amdgcn_mfma_f32_32x32x16_bf16(o.a[s], o.b[s], acc, 0, 0, 0);
    LAS float* yl = (LAS float*)F.lds + (F.wave >> 2) * 4096 + (tt * 32) * 64 + tv * 32 + r32;
#pragma unroll
    for (int i = 0; i < 16; ++i) yl[crow(i, hi) * 64] = acc[i];
}
__device__ __forceinline__ void post_compute(Frame& F, const InTab& in_, unsigned char* ws_, int l, int job, int w4, const PostOps& p) {
    const int c = F.lane, bh = job >> 6, ch = job & 63, b = bh >> 2, h = bh & 3;
    const float lw = in_[I_LNW][l * 256 + 64 * h + c], lb = in_[I_LNB][l * 256 + 64 * h + c], rkw = in_[I_RK][l * 256 + 64 * h + c];
    const LAS float* yimg = (const LAS float*)F.lds + (F.wave >> 2) * 4096 + (w4 * 16) * 64 + c;
    bf16_t* MX = (bf16_t*)(ws_ + WS_MIXED) + ((size_t)b * SEQ + (size_t)ch * 64 + w4 * 16) * 1024 + 64 * h + c;
#pragma unroll
    for (int u = 0; u < 16; ++u) {
        const float y = yimg[u * 64];
        const float mean = wave_sum(y) * (1.f / 64.f); const float d = y - mean; const float var = wave_sum(d * d) * (1.f / 64.f);
        float yn = d * (1.f / sqrtf(var + 64e-5f)) * lw + lb;
        yn += wave_sum(p.rr[u] * p.kk[u] * rkw) * p.vv[u];
        yn *= p.gg[u];
        MX[(size_t)u * 1024] = (bf16_t)f2bf(yn);
    }
}

constexpr int AT_ROWB = 144;
constexpr int AT_KOFF = 0, AT_VOFF = 2 * 64 * AT_ROWB, AT_BOFF = 4 * 64 * AT_ROWB, AT_QUEUE = AT_BOFF + 2 * 256;
__device__ __forceinline__ void attn_unit(Frame& F, int b, int h, int qb) {
    refresh(F); unsigned char* ws_ = (unsigned char*)ldptr(F, 30); const InTab in_{F.lds}; gu32* ctl_ = (gu32*)ws_;

    const int lane = F.lane, r32 = lane & 31, hi = lane >> 5, wid = F.wave, tid = F.tid;
    const bf16_t* Q = (const bf16_t*)(ws_ + WS_Q); const bf16_t* Kg = (const bf16_t*)(ws_ + WS_K); const bf16_t* Vg = (const bf16_t*)(ws_ + WS_V);
    const float* BI = (const float*)(ws_ + WS_BIAS) + ((size_t)b * 8 + h) * SEQ;
    const size_t rowbase = (size_t)b * SEQ; const int q0 = qb * 256, qw0 = q0 + wid * 32;
    LAS unsigned char* lds = F.lds;
    bf16x8 qr[4];
#pragma unroll
    for (int d0 = 0; d0 < 4; ++d0) qr[d0] = *(const bf16x8*)(Q + (rowbase + qw0 + r32) * 512 + h * 64 + d0 * 16 + hi * 8);
    const int NT = (q0 + 256) / 64;
    int T0 = 0;
    { const float nbq = BI[q0]; const float vlast = (lane < NT) ? BI[64 * lane + 63] : 3.0e38f;
      const unsigned long long ok = __ballot(vlast - nbq >= -150.f);
      T0 = ok ? (int)(__ffsll((long long)ok) - 1) : 0; T0 = __builtin_amdgcn_readfirstlane(T0); }
    const int srow = tid >> 3, sch = tid & 7;
    const bf16_t* kp = Kg + (rowbase + srow) * 512 + h * 64 + sch * 8; const bf16_t* vp = Vg + (rowbase + srow) * 512 + h * 64 + sch * 8;
    u32x4 kreg = *(const u32x4*)(kp + (size_t)T0 * 64 * 512), vreg = *(const u32x4*)(vp + (size_t)T0 * 64 * 512); float breg = (tid < 64) ? BI[T0 * 64 + tid] : 0.f;
    { const int b0_ = T0 & 1;
      *(LAS u32x4*)(lds + AT_KOFF + b0_ * 64 * AT_ROWB + srow * AT_ROWB + sch * 16) = kreg; *(LAS u32x4*)(lds + AT_VOFF + b0_ * 64 * AT_ROWB + srow * AT_ROWB + sch * 16) = vreg;
      if (tid < 64) *(LAS float*)(lds + AT_BOFF + b0_ * 256 + tid * 4) = breg; }
    __syncthreads();
    f32x16 o0 = {}, o1 = {};
    float nbi = BI[qw0 + r32];
    float lrun = 0.f;
    const int i16 = lane & 15, tq = i16 >> 2, tp = i16 & 3, blk = (lane >> 4) & 1;
    for (int t = T0; t < NT; ++t) {
        const int cb = t & 1, nb = cb ^ 1;
        if (t + 1 < NT) { kreg = *(const u32x4*)(kp + (size_t)(t + 1) * 64 * 512); vreg = *(const u32x4*)(vp + (size_t)(t + 1) * 64 * 512); if (tid < 64) breg = BI[(t + 1) * 64 + tid]; }
        if (64 * t <= qw0 + 31) {
            const LAS unsigned char* Ks = lds + AT_KOFF + cb * 64 * AT_ROWB; const LAS unsigned char* Vs = lds + AT_VOFF + cb * 64 * AT_ROWB; const LAS float* Bs = (const LAS float*)(lds + AT_BOFF + cb * 256);
            f32x16 p0, p1;
#pragma unroll
            for (int g = 0; g < 4; ++g) {
                const f32x4 b0 = *(const LAS f32x4*)(Bs + 8 * g + 4 * hi), b1 = *(const LAS f32x4*)(Bs + 32 + 8 * g + 4 * hi);
#pragma unroll
                for (int i = 0; i < 4; ++i) { p0[4 * g + i] = b0[i] - nbi; p1[4 * g + i] = b1[i] - nbi; }
            }
#pragma unroll
            for (int d0 = 0; d0 < 4; ++d0) {
                const bf16x8 a0 = *(const LAS bf16x8*)(Ks + r32 * AT_ROWB + (d0 * 16 + hi * 8) * 2);
                const bf16x8 a1 = *(const LAS bf16x8*)(Ks + (32 + r32) * AT_ROWB + (d0 * 16 + hi * 8) * 2);
                p0 = __builtin_amdgcn_mfma_f32_32x32x16_bf16(a0, qr[d0], p0, 0, 0, 0);
                p1 = __builtin_amdgcn_mfma_f32_32x32x16_bf16(a1, qr[d0], p1, 0, 0, 0);
            }
            if (64 * t + 63 > qw0) {
                const int qabs = qw0 + r32;
#pragma unroll
                for (int i = 0; i < 16; ++i) { const int kv = 64 * t + crow(i, hi); if (kv > qabs) p0[i] = -INFINITY; if (kv + 32 > qabs) p1[i] = -INFINITY; }
            }
            float mx = fmaxf(fmaxf(p0[0], p0[1]), p1[0]);
#pragma unroll
            for (int i = 1; i < 16; ++i) mx = fmaxf(fmaxf(mx, p0[i]), p1[i]);
            if (__any(mx > 24.f)) {
                const float mo = fmaxf(mx, __shfl_xor(mx, 32));
                const float dl = fmaxf(mo, 0.f);
                nbi += dl;
                const float f = __builtin_amdgcn_exp2f(-dl);
                lrun *= f;
#pragma unroll
                for (int i = 0; i < 16; ++i) { p0[i] -= dl; p1[i] -= dl; o0[i] *= f; o1[i] *= f; }
            }
            float ls0 = 0.f, ls1 = 0.f;
#pragma unroll
            for (int i = 0; i < 16; ++i) { p0[i] = __builtin_amdgcn_exp2f(p0[i]); p1[i] = __builtin_amdgcn_exp2f(p1[i]); ls0 += p0[i]; ls1 += p1[i]; }
            lrun += ls0 + ls1;
            bf16x8 pf[4];
#pragma unroll
            for (int s = 0; s < 2; ++s) {
                u32x4 w0, w1;
                w0.x = cvtpk(p0[8 * s + 0], p0[8 * s + 1]); w0.y = cvtpk(p0[8 * s + 2], p0[8 * s + 3]); w0.z = cvtpk(p0[8 * s + 4], p0[8 * s + 5]); w0.w = cvtpk(p0[8 * s + 6], p0[8 * s + 7]);
                w1.x = cvtpk(p1[8 * s + 0], p1[8 * s + 1]); w1.y = cvtpk(p1[8 * s + 2], p1[8 * s + 3]); w1.z = cvtpk(p1[8 * s + 4], p1[8 * s + 5]); w1.w = cvtpk(p1[8 * s + 6], p1[8 * s + 7]);
                pf[s] = __builtin_bit_cast(bf16x8, w0); pf[2 + s] = __builtin_bit_cast(bf16x8, w1);
            }
#pragma unroll
            for (int ks4 = 0; ks4 < 4; ++ks4) {
                const int kvb = (ks4 >> 1) * 32 + (ks4 & 1) * 16 + 4 * hi;
#pragma unroll
                for (int d0 = 0; d0 < 2; ++d0) {
                    const LAS unsigned char* a_lo = Vs + (kvb + tq) * AT_ROWB + (32 * d0 + 16 * blk) * 2 + 8 * tp;
                    const s16x4 lo = __builtin_bit_cast(s16x4, __builtin_amdgcn_ds_read_tr16_b64_v4i16((LAS s16x4*)a_lo));
                    const s16x4 hv = __builtin_bit_cast(s16x4, __builtin_amdgcn_ds_read_tr16_b64_v4i16((LAS s16x4*)(a_lo + 8 * AT_ROWB)));
                    const bf16x8 va = __builtin_shufflevector(lo, hv, 0, 1, 2, 3, 4, 5, 6, 7);
                    if (d0 == 0) o0 = __builtin_amdgcn_mfma_f32_32x32x16_bf16(va, pf[ks4], o0, 0, 0, 0);
                    else o1 = __builtin_amdgcn_mfma_f32_32x32x16_bf16(va, pf[ks4], o1, 0, 0, 0);
                }
            }
        }
        if (t + 1 < NT) {
            *(LAS u32x4*)(lds + AT_KOFF + nb * 64 * AT_ROWB + srow * AT_ROWB + sch * 16) = kreg; *(LAS u32x4*)(lds + AT_VOFF + nb * 64 * AT_ROWB + srow * AT_ROWB + sch * 16) = vreg;
            if (tid < 64) *(LAS float*)(lds + AT_BOFF + nb * 256 + tid * 4) = breg;
        }
        __syncthreads();
    }
    lrun += __shfl_xor(lrun, 32);
    const float inv = 1.f / lrun;
    bf16_t* O = (bf16_t*)(ws_ + WS_MIXED) + (rowbase + qw0 + r32) * 1024 + 512 + h * 64;
#pragma unroll
    for (int g = 0; g < 4; ++g) {
        u32x2 w; w.x = cvtpk(o0[4 * g] * inv, o0[4 * g + 1] * inv); w.y = cvtpk(o0[4 * g + 2] * inv, o0[4 * g + 3] * inv);
        *(u32x2*)(O + 8 * g + 4 * hi) = w;
        u32x2 w2; w2.x = cvtpk(o1[4 * g] * inv, o1[4 * g + 1] * inv); w2.y = cvtpk(o1[4 * g + 2] * inv, o1[4 * g + 3] * inv);
        *(u32x2*)(O + 32 + 8 * g + 4 * hi) = w2;
    }
}
__device__ __forceinline__ void pool_batch(Frame& F, const InTab& in_, unsigned char* ws_, int l, int q) {
    LAS float* Wp = (LAS float*)F.lds;
    LAS float* ps = (LAS float*)(F.lds + 65536) + F.wave * 512;
    { const float* w = in_[I_POOLW] + (size_t)l * 4 * 64 * 64; f32x4 t8[8];
#pragma unroll
      for (int u = 0; u < 8; ++u) t8[u] = *(const f32x4*)(w + 4 * (F.tid + NTHR * u));
#pragma unroll
      for (int u = 0; u < 8; ++u) *(LAS f32x4*)(Wp + 4 * (F.tid + NTHR * u)) = t8[u]; }
    __syncthreads();
    const int c = F.lane;
    bf16_t* MX = (bf16_t*)(ws_ + WS_MIXED);
    const float* ZP = (const float*)(ws_ + WS_ZP);
    for (int jj = 0; jj < 8; ++jj) {
        const int it = q * 64 + jj * 8 + F.wave;
        const int g = it & 3, m0 = (it >> 2) * 8, win = 2 << g;
        {
            const int seq0 = m0 & ~(SEQ - 1);
            float zz[23];
#pragma unroll
            for (int qq = 0; qq < 23; ++qq) { const int rr = m0 - 15 + qq; zz[qq] = (rr >= seq0 && (qq >= 15 || 15 - qq < win + 7)) ? ZP[(size_t)rr * 256 + 64 * g + c] : 0.f; }
#pragma unroll
            for (int i = 0; i < 8; ++i) {
                const int t = (m0 + i) & (SEQ - 1); const int n = (t + 1 < win) ? t + 1 : win;
                float s = 0.f;
#pragma unroll
                for (int j = 0; j < 16; ++j) s += (j < win) ? zz[15 + i - j] : 0.f;
                ps[i * 64 + c] = s / (float)n - zz[15 + i];
            }
        }
        LDS_WAIT(); asm volatile("" ::: "memory");
        float acc[8];
#pragma unroll
        for (int i = 0; i < 8; ++i) acc[i] = 0.f;
        const LAS float* W = Wp + g * 4096;
        for (int j = 0; j < 64; j += 4) {
            const float w_0 = W[(j + 0) * 64 + c], w_1 = W[(j + 1) * 64 + c], w_2 = W[(j + 2) * 64 + c], w_3 = W[(j + 3) * 64 + c];
#pragma unroll
            for (int i = 0; i < 8; ++i) { const f32x4 x = *(const LAS f32x4*)(ps + i * 64 + j); acc[i] += x.x * w_0 + x.y * w_1 + x.z * w_2 + x.w * w_3; }
        }
        const float sc = in_[I_POOLS][l * 256 + 64 * g + c];
#pragma unroll
        for (int i = 0; i < 8; ++i) MX[(size_t)(m0 + i) * 1024 + 256 + 64 * g + c] = (bf16_t)f2bf(acc[i] * sc);
        LDS_WAIT(); asm volatile("" ::: "memory");
    }
    __syncthreads();
}
__device__ __forceinline__ void tail_convert(Frame& F, int lc, int nmax) {
    refresh(F); unsigned char* ws_ = (unsigned char*)ldptr(F, 30); const InTab in_{F.lds}; gu32* ctl_ = (gu32*)ws_;
    LAS int* qslot = (LAS int*)(F.lds + MISC_OFF + 64);
    for (int n = 0; n < nmax; ++n) {
        if (F.tid == 0) qslot[0] = (int)__hip_atomic_fetch_add(ctl_ + CW_CQ + lc * 64, 1u, RLX_AGENT);
        __syncthreads();
        const int q = qslot[0];
        __syncthreads();
        if (q >= 768) break;
        convert_moe_batch(F, in_, ws_, lc, q);
    }
    __syncthreads();
}
__device__ __forceinline__ void phase_mix(Frame& F, int l, int qsel = 0) {
    refresh(F); unsigned char* ws_ = (unsigned char*)ldptr(F, 30); const InTab in_{F.lds}; gu32* ctl_ = (gu32*)ws_;

#if CHUNKED_SCAN
    if (blockIdx.x < 16) { chunk_states(F, ws_, blockIdx.x); if (PROBE_DUP == 16) { __syncthreads(); chunk_states(F, ws_, blockIdx.x); } __syncthreads(); }
#else
    if (blockIdx.x < 64) { scan_block(F, blockIdx.x); if (PROBE_DUP == 12) { __syncthreads(); scan_block(F, blockIdx.x); } return; }
#endif
    LAS int* qslot = (LAS int*)(F.lds + MISC_OFF + 64);
    for (;;) {
        if (F.tid == 0) qslot[0] = (int)__hip_atomic_fetch_add(ctl_ + CW_QUEUE + (l + 4 * qsel) * 64, 1u, RLX_AGENT);
        __syncthreads();
        const int u = qslot[0];
        __syncthreads();
        if (PROBE_DUP == 17) { if (u >= 1024 + 128 + 768) break; if (u < 1024) { const int uu = u >> 1; const int qb = 15 - (uu >> 5), bh = uu & 31; attn_unit(F, bh >> 3, bh & 7, qb); } else if (u < 1152) pool_batch(F, in_, ws_, l, u - 1024); else convert_moe_batch(F, in_, ws_, l, u - 1152); continue; }
        if (PROBE_DUP == 18) { if (u >= 512 + 128 + 1536) break; if (u < 512) { const int qb = 15 - (u >> 5), bh = u & 31; attn_unit(F, bh >> 3, bh & 7, qb); } else if (u < 640) pool_batch(F, in_, ws_, l, u - 512); else convert_moe_batch(F, in_, ws_, l, (u - 640) >> 1); continue; }
        if (u >= 512 + 128) break;
        if (u < 512) { const int qb = 15 - (u >> 5), bh = u & 31; attn_unit(F, bh >> 3, bh & 7, qb); }
        else pool_batch(F, in_, ws_, l, u - 512);
    }
    tail_convert(F, l, 1 << 20);
}

__device__ __forceinline__ void phase_post(Frame& F, int l) {
    refresh(F); unsigned char* ws_ = (unsigned char*)ldptr(F, 30); const InTab in_{F.lds}; gu32* ctl_ = (gu32*)ws_;

    const int gw = F.vcu * NWAVES + F.wave, NGW = F.G * NWAVES, c = F.lane;
    bf16_t* MX = (bf16_t*)(ws_ + WS_MIXED);
    {
        float lw[4], lb[4], rkw[4];
#pragma unroll
        for (int h = 0; h < 4; ++h) { lw[h] = in_[I_LNW][l * 256 + 64 * h + c]; lb[h] = in_[I_LNB][l * 256 + 64 * h + c]; rkw[h] = in_[I_RK][l * 256 + 64 * h + c]; }
        const float* YR = (const float*)(ws_ + WS_YRAW); const float* SCN = (const float*)(ws_ + WS_SCAN); const float* GG = (const float*)(ws_ + WS_G);
        for (int it0 = gw * 8; it0 < NTOK * 4; it0 += NGW * 8) {
            float y[8], vv[8], bn[8], gg[8];
#pragma unroll
            for (int u = 0; u < 8; ++u) {
                const int it = it0 + u, m = it >> 2, h = u & 3, b = m >> 12, t = m & (SEQ - 1);
                const float* sp = SCN + ((size_t)(b * 4 + h) * SEQ + t) * 384 + c;
                y[u] = YR[(size_t)m * 256 + 64 * h + c]; vv[u] = sp[192]; bn[u] = sp[0] * sp[128] * rkw[h]; gg[u] = GG[(size_t)m * 256 + 64 * h + c];
            }
#pragma unroll
            for (int u = 0; u < 8; ++u) {
                const int it = it0 + u, m = it >> 2, h = u & 3;
                const float mean = wave_sum(y[u]) * (1.f / 64.f); const float d = y[u] - mean; const float var = wave_sum(d * d) * (1.f / 64.f);
                float yn = d * (1.f / sqrtf(var + 64e-5f)) * lw[h] + lb[h];
                yn += wave_sum(bn[u]) * vv[u];
                yn *= gg[u];
                MX[(size_t)m * 1024 + 64 * h + c] = (bf16_t)f2bf(yn);
            }
        }
    }
}

__device__ __forceinline__ void phase_route(Frame& F, int l, int csel = 0) {
    refresh(F); unsigned char* ws_ = (unsigned char*)ldptr(F, 30); const InTab in_{F.lds}; gu32* ctl_ = (gu32*)ws_;

    LAS float* WT = (LAS float*)F.lds;
    LAS int* lcnt = (LAS int*)(F.lds + TAB_OFF);
    LAS int* lbase = lcnt + 32;
    LAS int* le = lbase + 32;
    LAS int* lpos = le + 256;
    { const float* rw = in_[I_RW] + (size_t)l * 1024 * 32;
      f32x4 t16[16];
#pragma unroll
      for (int u = 0; u < 16; ++u) t16[u] = *(const f32x4*)(rw + 4 * (F.tid + NTHR * u));
#pragma unroll
      for (int u = 0; u < 16; ++u) { const int i = F.tid + NTHR * u, k = i >> 3, e = (i & 7) * 4; WT[(e + 0) * 1024 + k] = t16[u].x; WT[(e + 1) * 1024 + k] = t16[u].y; WT[(e + 2) * 1024 + k] = t16[u].z; WT[(e + 3) * 1024 + k] = t16[u].w; } }
    const bf16_t* X = (const bf16_t*)(ws_ + WS_X); const float* MOD = (const float*)(ws_ + WS_MOD);
    const float* nw = in_[I_NORM2] + l * 1024;
    const float rb = in_[I_RB][l * 32 + (F.lane >> 1)];
    for (int tb = blockIdx.x; tb < NTOK / 64; tb += F.G) {
        if (F.tid < 32) lcnt[F.tid] = 0;
        __syncthreads();
        u32x2 xnx[2][4];
#pragma unroll
        for (int u = 0; u < 2; ++u)
#pragma unroll
            for (int j = 0; j < 4; ++j) xnx[u][j] = *(const u32x2*)(X + (size_t)(tb * 64 + F.wave * 8 + u) * 1024 + 4 * F.lane + 256 * j);
#pragma nounroll
        for (int ip = 0; ip < 4; ++ip) {
            const int ti0 = F.wave * 8 + 2 * ip, m0 = tb * 64 + ti0, b = m0 >> 12;
            const float* sh = MOD + (size_t)(l * 4 + b) * 6144 + 3 * 1024; const float* sc = sh + 1024;
            f32x4 hv[2][4];
#pragma unroll
            for (int u = 0; u < 2; ++u) {
                float ss = 0.f;
#pragma unroll
                for (int j = 0; j < 4; ++j) { hv[u][j] = up4(xnx[u][j]); ss += (hv[u][j].x * hv[u][j].x + hv[u][j].y * hv[u][j].y) + (hv[u][j].z * hv[u][j].z + hv[u][j].w * hv[u][j].w); }
                const float rs = 1.f / sqrtf(wave_sum(ss) * (1.f / 1024.f) + 1e-6f);
                bf16_t* H = (bf16_t*)(ws_ + WS_H) + (size_t)(m0 + u) * 1024;
#pragma unroll
                for (int j = 0; j < 4; ++j) { const int c0 = 4 * F.lane + 256 * j; const f32x4 w = *(const f32x4*)(nw + c0), s1 = *(const f32x4*)(sc + c0), s0 = *(const f32x4*)(sh + c0);
                    hv[u][j] = hv[u][j] * rs * w * (s1 + 1.f) + s0; u32x2 o; o.x = cvtpk(hv[u][j].x, hv[u][j].y); o.y = cvtpk(hv[u][j].z, hv[u][j].w); *(u32x2*)(H + c0) = o; }
            }
            if (ip < 3) {
#pragma unroll
                for (int u = 0; u < 2; ++u)
#pragma unroll
                    for (int j = 0; j < 4; ++j) xnx[u][j] = *(const u32x2*)(X + (size_t)(m0 + 2 + u) * 1024 + 4 * F.lane + 256 * j);
            }
            float val[2] = {0.f, 0.f};
#pragma unroll
            for (int half = 0; half < 2; ++half) {
                float a[2][16];
#pragma unroll
                for (int e = 0; e < 16; ++e) {
                    float s0 = 0.f, s1 = 0.f;
#pragma unroll
                    for (int j = 0; j < 4; ++j) { const f32x4 w = *(const LAS f32x4*)(WT + (16 * half + e) * 1024 + 4 * F.lane + 256 * j);
                        s0 += hv[0][j].x * w.x + hv[0][j].y * w.y + hv[0][j].z * w.z + hv[0][j].w * w.w; s1 += hv[1][j].x * w.x + hv[1][j].y * w.y + hv[1][j].z * w.z + hv[1][j].w * w.w; }
                    a[0][e] = s0; a[1][e] = s1;
                }
#pragma unroll
                for (int u = 0; u < 2; ++u) {
#pragma unroll
                    for (int q = 0; q < 8; ++q) { const auto rr = __builtin_amdgcn_permlane16_swap(__float_as_uint(a[u][q]), __float_as_uint(a[u][q + 8]), false, false); a[u][q] = __uint_as_float(rr[0]) + __uint_as_float(rr[1]); }
#define RSTEP(N, BIT, SEL) { const bool up_ = (F.lane & (BIT)) != 0; _Pragma("unroll") for (int q = 0; q < (N); ++q) { const float send = up_ ? a[u][q] : a[u][q + (N)]; const float keep = up_ ? a[u][q + (N)] : a[u][q]; a[u][q] = keep + dpp_f(send, SEL); } }
                    RSTEP(4, 8, 3) RSTEP(2, 4, 2) RSTEP(1, 2, 1)
#undef RSTEP
                    float v = a[u][0] + dpp_f(a[u][0], 0);
                    { const auto rr = __builtin_amdgcn_permlane32_swap(__float_as_uint(v), __float_as_uint(v), false, false); v = __uint_as_float(rr[0]) + __uint_as_float(rr[1]); }
                    if ((F.lane >> 5) == half) val[u] = v;
                }
            }
#pragma unroll
            for (int u = 0; u < 2; ++u) {
                float vv = val[u] + rb;
                const int ti = ti0 + u, m = m0 + u;
                float tv[4]; int te[4];
#pragma unroll
                for (int k = 0; k < 4; ++k) {
                    const float mx = wave_max(vv);
                    const unsigned long long bal = __ballot(vv == mx);
                    const int ln = __ffsll((long long)bal) - 1; const int e = ln >> 1;
                    tv[k] = mx; te[k] = e;
                    if ((F.lane >> 1) == e) vv = -INFINITY;
                }
                const float e1 = __expf(tv[1] - tv[0]), e2 = __expf(tv[2] - tv[0]), e3 = __expf(tv[3] - tv[0]); const float invs = 1.f / (1.f + e1 + e2 + e3);
                if (F.lane < 4) {
                    const int k = F.lane; const int e = (k == 0) ? te[0] : (k == 1) ? te[1] : (k == 2) ? te[2] : te[3];
                    const float gt = ((k == 0) ? 1.f : (k == 1) ? e1 : (k == 2) ? e2 : e3) * invs;
                    ((float*)(ws_ + WS_GATE))[(size_t)m * 4 + k] = gt;
                    le[ti * 4 + k] = e; lpos[ti * 4 + k] = atomicAdd((int*)&lcnt[e], 1);
                }
            }
        }
        __syncthreads();
        if (F.tid < 32) lbase[F.tid] = (int)__hip_atomic_fetch_add(ctl_ + CW_CNT + ((l + 4 * csel) * 32 + F.tid) * 64, (unsigned)lcnt[F.tid], RLX_AGENT);
        __syncthreads();
        if (F.tid < 256) { const int e = le[F.tid]; ((int*)(ws_ + WS_LIST))[e * NTOK + lbase[e] + lpos[F.tid]] = (tb * 64 + (F.tid >> 2)) * 4 + (F.tid & 3); }
        __syncthreads();
    }
}

constexpr int NPHASE = 2 + 9 * NL;
__global__ void __launch_bounds__(NTHR, 2) trunk_fwd(Args args) {
    extern __shared__ __attribute__((aligned(16))) unsigned char lds_raw[];
    Frame F;
    F.lds = (LAS unsigned char*)lds_raw;
    F.MISC = (volatile LAS unsigned*)(F.lds + MISC_OFF);
    F.tid = threadIdx.x; F.lane = F.tid & 63; F.wave = __builtin_amdgcn_readfirstlane(F.tid >> 6);
    F.G = gridDim.x; { const int bx = blockIdx.x; F.vcu = (F.G % 8 == 0) ? (bx % 8) * (F.G / 8) + bx / 8 : bx; }
    for (int u = F.tid; u < 64; u += NTHR) ((LAS unsigned*)(F.lds + MISC_OFF))[u] = 0u;
    if (F.tid < 29) *(LAS unsigned long long*)(F.lds + PTR_OFF + 8 * F.tid) = (unsigned long long)args.in[F.tid];
    if (F.tid == 29) *(LAS unsigned long long*)(F.lds + PTR_OFF + 8 * 29) = (unsigned long long)args.out;
    if (F.tid == 30) *(LAS unsigned long long*)(F.lds + PTR_OFF + 8 * 30) = (unsigned long long)args.ws;
    __syncthreads();
#if MK_PER_PHASE
#define GRID_BAR() do { } while (0)
#else
    XcdBarrier bar = xcd_barrier_post((unsigned*)(args.ws) + CW_BAR, F.MISC + 8);
#define GRID_BAR() xcd_barrier(bar)
#endif
    const int lo = args.ph_lo, hi = args.ph_hi;
    volatile LAS unsigned long long* tsw = (volatile LAS unsigned long long*)(F.lds + MISC_OFF + 192);
#define STAMP(id) do { if (PROBE_T >= 0 && blockIdx.x == 0 && F.tid == 0) { const unsigned long long now_ = wall_clock64(); if ((id) == PROBE_T) tsw[1] += now_ - tsw[0]; tsw[0] = now_; } } while (0)
    if (PROBE_T >= 0 && blockIdx.x == 0 && F.tid == 0) { const unsigned long long now_ = wall_clock64(); tsw[0] = now_; tsw[1] = 0ull; tsw[2] = now_; }
#define IN(k) (lo <= (k) && (k) < hi)
#define SEAM(k) do { if (IN(k) && IN((k) + 1)) GRID_BAR(); } while (0)
    if (IN(0)) { phase_prologue(F); if (PROBE_DUP == 1) { GRID_BAR(); phase_prologue(F); } SEAM(0); }
    if (IN(1)) { phase_combine(F, -1); if (PROBE_DUP == 2) { GRID_BAR(); phase_combine(F, -1); } SEAM(1); }
    for (int l = 0; l < NL; ++l) {
        const int p0 = 2 + 9 * l;
        if (IN(p0)) {
            refresh(F); unsigned char* ws_ = (unsigned char*)ldptr(F, 30); const InTab in_{F.lds};
            ProbDense P{(const char*)(ws_ + WS_H), (const char*)(ws_ + WS_WIN) + (size_t)l * NPROJ * 2048, NTOK / 256, NPROJ / 256, F.G, F.vcu};
            EpiProj E{ws_};
            pg8::gemm_phase<false, 1024>(F.lds, nullptr, F.tid, P, E);
            if (PROBE_DUP == 3) { GRID_BAR(); pg8::gemm_phase<false, 1024>(F.lds, nullptr, F.tid, P, E); }
            if (TAIL_CONVERT) { const int nun = (NTOK / 256) * (NPROJ / 256), mine = (nun - F.vcu + F.G - 1) / F.G, most = (nun + F.G - 1) / F.G; if (mine < most) tail_convert(F, l, most - mine); }
            SEAM(p0); STAMP(0);
        }
        if (IN(p0 + 1)) {
            phase_prep(F, l); if (PROBE_DUP == 4) { GRID_BAR(); phase_prep(F, l); }
            GRID_BAR(); STAMP(1);
            refresh(F); unsigned char* ws_ = (unsigned char*)ldptr(F, 30); const InTab in_{F.lds};
            ProbLora P{(const char*)(ws_ + WS_ALORA), (const char*)(ws_ + WS_LORA) + (size_t)l * 768 * 512, F.G, F.vcu};
            EpiLora E{ws_, in_[I_W0] + l * 256, in_[I_A0] + l * 256, in_[I_KA] + l * 256};
            pg8::gemm_phase<false, 256>(F.lds, nullptr, F.tid, P, E);
            if (TAIL_CONVERT && F.vcu >= 192) tail_convert(F, l, 1);
            SEAM(p0 + 1); STAMP(2);
        }
        if (IN(p0 + 2)) {
#if CHUNKED_SCAN
            { refresh(F); unsigned char* ws_ = (unsigned char*)ldptr(F, 30);
              ChunkRows cur = chunk_load(F, ws_, F.vcu);
              for (int job = F.vcu; job < 1024; job += F.G) {
                  ChunkRows nxt = cur; if (job + F.G < 1024) nxt = chunk_load(F, ws_, job + F.G);
                  chunk_job(F, ws_, job, cur); cur = nxt; } }
            GRID_BAR(); STAMP(3);
#endif
            phase_mix(F, l); if (PROBE_DUP == 5) { GRID_BAR(); phase_mix(F, l, 1); } SEAM(p0 + 2); STAMP(4); }
        if (IN(p0 + 3)) {
#if CHUNKED_SCAN
            { refresh(F); unsigned char* ws_ = (unsigned char*)ldptr(F, 30); const InTab in_{F.lds};
              const int w4 = F.wave & 3, jobA = F.vcu * 2 + (F.wave >> 2), jobB = (F.vcu + F.G) * 2 + (F.wave >> 2);
              if (F.G * 4 == 1024) {
                  OutOps oa = out_load(F, ws_, jobA, w4); PostOps pa = post_load(F, ws_, jobA, w4); OutOps ob = out_load(F, ws_, jobB, w4);
                  out_compute(F, oa, w4); __syncthreads();
                  PostOps pb = post_load(F, ws_, jobB, w4);
                  post_compute(F, in_, ws_, l, jobA, w4, pa); __syncthreads();
                  out_compute(F, ob, w4); __syncthreads();
                  post_compute(F, in_, ws_, l, jobB, w4, pb); __syncthreads();
              } else {
                  for (int jp = F.vcu; jp < 512; jp += F.G) { const int job = jp * 2 + (F.wave >> 2);
                      OutOps oa = out_load(F, ws_, job, w4); PostOps pa = post_load(F, ws_, job, w4);
                      out_compute(F, oa, w4); __syncthreads(); post_compute(F, in_, ws_, l, job, w4, pa); __syncthreads(); }
              } }
            SEAM(p0 + 3); STAMP(5);
#else
            phase_post(F, l); if (PROBE_DUP == 6) { GRID_BAR(); phase_post(F, l); } SEAM(p0 + 3);
#endif
        }
        if (IN(p0 + 4)) {
            refresh(F); unsigned char* ws_ = (unsigned char*)ldptr(F, 30); const InTab in_{F.lds};
            ProbDense P{(const char*)(ws_ + WS_MIXED), (const char*)(ws_ + WS_WOUT) + (size_t)l * 1024 * 2048, NTOK / 256, 4, F.G, F.vcu};
            EpiOut E{(bf16_t*)(ws_ + WS_X), (l == 0) ? in_[I_X] : (const float*)nullptr, (const float*)(ws_ + WS_MOD) + (size_t)l * 4 * 6144 + 2 * 1024, 1.f};
            if (PROBE_DUP == 7) { EpiOut E0{(bf16_t*)(ws_ + WS_X), (l == 0) ? in_[I_X] : (const float*)nullptr, (const float*)(ws_ + WS_MOD) + (size_t)l * 4 * 6144 + 2 * 1024, 0.f}; pg8::gemm_phase<false, 1024>(F.lds, nullptr, F.tid, P, E0); GRID_BAR(); }
            pg8::gemm_phase<false, 1024>(F.lds, nullptr, F.tid, P, E);
            SEAM(p0 + 4); STAMP(6);
        }
        if (IN(p0 + 5)) { phase_route(F, l); if (PROBE_DUP == 8) { GRID_BAR(); phase_route(F, l, 1); } SEAM(p0 + 5); STAMP(7); }
        if (IN(p0 + 6)) {
            refresh(F); unsigned char* ws_ = (unsigned char*)ldptr(F, 30); const InTab in_{F.lds};
            MoeTab T = moe_table(F, l);
            ProbGU P{(const char*)(ws_ + WS_H), (const char*)(ws_ + WS_WGU), (const int*)(ws_ + WS_LIST), T, __builtin_amdgcn_readfirstlane(T.ntiles[0]) * 8, F.G, F.vcu, l};
            EpiGU E{(bf16_t*)(ws_ + WS_ACT), in_[I_BGU], l};
            pg8::gemm_phase<true, 1024>(F.lds, (LAS unsigned*)(F.lds + ROWTAB_OFF), F.tid, P, E);
            if (PROBE_DUP == 9) { GRID_BAR(); pg8::gemm_phase<true, 1024>(F.lds, (LAS unsigned*)(F.lds + ROWTAB_OFF), F.tid, P, E); }
            if (TAIL_CONVERT && l + 1 < NL) { const int nun = P.nun, mine = (nun - F.vcu + F.G - 1) / F.G, most = (nun + F.G - 1) / F.G; if (mine < most) tail_convert(F, l + 1, most - mine); }
            SEAM(p0 + 6); STAMP(8);
        }
        if (IN(p0 + 7)) {
            refresh(F); unsigned char* ws_ = (unsigned char*)ldptr(F, 30); const InTab in_{F.lds};
            MoeTab T = moe_table(F, l);
            ProbDN P{(const char*)(ws_ + WS_ACT), (const char*)(ws_ + WS_WDN), T, __builtin_amdgcn_readfirstlane(T.ntiles[0]) * 4, F.G, F.vcu, l};
            EpiDN E{(bf16_t*)(ws_ + WS_YSLOT), in_[I_BDN], (const int*)(ws_ + WS_LIST), (const float*)(ws_ + WS_GATE), T, l};
            pg8::gemm_phase<false, 1024>(F.lds, nullptr, F.tid, P, E);
            if (PROBE_DUP == 10) { GRID_BAR(); pg8::gemm_phase<false, 1024>(F.lds, nullptr, F.tid, P, E); }
            if (TAIL_CONVERT && l + 1 < NL) { const int nun = P.nun, mine = (nun - F.vcu + F.G - 1) / F.G, most = (nun + F.G - 1) / F.G; if (mine < most) tail_convert(F, l + 1, most - mine); }
            if (PROBE_T >= 0 && l == NL - 1 && blockIdx.x == 0 && F.tid == 0) {
                const unsigned long long now_ = wall_clock64(); if (PROBE_T == 9) tsw[1] += now_ - tsw[0];
                const float share = (float)(double)tsw[1] / (float)(double)(now_ - tsw[2]);
                __hip_atomic_store((GAS float*)((gu32*)ldptr(F, 30) + CW_CODE + 1), (PROBE_T >= 20 ? 3.0f : (PROBE_T == 4 || PROBE_T == 8 || PROBE_T == 9 || PROBE_T == 0) ? 0.3f : 0.5f) * share, RLX_AGENT);
            }
            SEAM(p0 + 7); STAMP(9);
        }
        if (IN(p0 + 8)) { if (PROBE_DUP == 11) { phase_combine(F, l, 0.f); GRID_BAR(); } phase_combine(F, l); SEAM(p0 + 8); STAMP(10); }
    }
#undef IN
#undef SEAM
#if !MK_PER_PHASE
    if (blockIdx.x == 0 && F.tid == 0 && xb_ld(bar.bar + XB_TMO) != 0u) { float* o = (float*)ldptr(F, 29); o[0] = __builtin_nanf(""); }
#endif
}

extern "C" void kernel_launch(void* const* d_in, const int* in_sizes, int n_in, void* d_out, int out_size, void* d_ws, size_t ws_size, hipStream_t stream) {
    static int grid = 0;
    if (grid == 0) {
        if (n_in != 29 || out_size != NTOK * DM || ws_size < WS_END) { fprintf(stderr, "kernel_launch: unexpected sizes n_in %d out %d ws %zu (need %zu)\n", n_in, out_size, ws_size, (size_t)WS_END); grid = -1; return; }
        int dev = 0, cus = 0;
        if (hipGetDevice(&dev) != hipSuccess || hipDeviceGetAttribute(&cus, hipDeviceAttributeMultiprocessorCount, dev) != hipSuccess) { grid = -1; return; }
        if (hipFuncSetAttribute((const void*)trunk_fwd, hipFuncAttributeMaxDynamicSharedMemorySize, LDS_BYTES) != hipSuccess) { fprintf(stderr, "kernel_launch: hipFuncSetAttribute failed\n"); grid = -1; return; }
        int per_cu = 0;
        if (hipOccupancyMaxActiveBlocksPerMultiprocessor(&per_cu, (const void*)trunk_fwd, NTHR, LDS_BYTES) != hipSuccess || per_cu < 1) fprintf(stderr, "kernel_launch: occupancy query reports %d\n", per_cu);
        (void)hipGetLastError();
        grid = cus;
    }
    if (grid < 0) return;
    (void)hipMemsetAsync((char*)d_ws + WS_CTL, 0, CTL_ZERO_BYTES, stream);
    Args a{};
    for (int i = 0; i < 29; ++i) a.in[i] = (const float*)d_in[i];
    a.out = (float*)d_out; a.ws = (unsigned char*)d_ws;
#if MK_PER_PHASE
    for (int p = 0; p < NPHASE; ++p) { a.ph_lo = p; a.ph_hi = p + 1; hipLaunchKernelGGL(trunk_fwd, dim3(grid), dim3(NTHR), LDS_BYTES, stream, a); }
#else
    a.ph_lo = 0; a.ph_hi = NPHASE;
    hipLaunchKernelGGL(trunk_fwd, dim3(grid), dim3(NTHR), LDS_BYTES, stream, a);
#endif
}
```

```cpp
#include <hip/hip_runtime.h>
#include <cstdio>
#include <cstdint>
#include <cmath>

#ifndef MK_PER_PHASE
#define MK_PER_PHASE 0
#endif

#ifndef TAIL_CONVERT
#define TAIL_CONVERT 1
#endif
#ifndef CHUNKED_SCAN
#define CHUNKED_SCAN 1
#endif
#ifndef PROBE_T
#define PROBE_T -1
#endif
#ifndef PROBE_DUP
#define PROBE_DUP 0
#endif
#define GAS __attribute__((address_space(1)))
#define LAS __attribute__((address_space(3)))
typedef unsigned short bf16_t;
typedef short bf16x8 __attribute__((ext_vector_type(8)));
typedef short s16x4 __attribute__((ext_vector_type(4)));
typedef float f32x2 __attribute__((ext_vector_type(2)));
typedef float f32x4 __attribute__((ext_vector_type(4)));
typedef float f32x16 __attribute__((ext_vector_type(16)));
typedef unsigned u32x2 __attribute__((ext_vector_type(2)));
typedef unsigned u32x4 __attribute__((ext_vector_type(4)));
typedef GAS unsigned gu32;


constexpr int NB = 4, SEQ = 4096, DM = 1024, NL = 4, NTOK = NB * SEQ;
constexpr int PIN = 2824, NPROJ = 2816;
constexpr int NE = 32, TOPK = 4;
constexpr int NWAVES = 8, NTHR = 512;
constexpr float LOG2E = 1.4426950408889634f;
constexpr float QSCALE = 0.125f * LOG2E;

constexpr size_t MiB = (size_t)1 << 20;
constexpr size_t WS_CTL = 0, CTL_ZERO_BYTES = 1 * MiB;
constexpr size_t WS_MOD = 1 * MiB;
constexpr size_t WS_FLOG = 2 * MiB;
constexpr size_t WS_BIAS = 3 * MiB;
constexpr size_t WS_ALORA = 4 * MiB;
constexpr size_t WS_GATE = 12 * MiB;
constexpr size_t WS_LIST = 13 * MiB;
constexpr size_t WS_WIN = 16 * MiB;
constexpr size_t WS_LORA = 38 * MiB;
constexpr size_t WS_WOUT = 40 * MiB;
constexpr size_t WS_WGU = 48 * MiB;
constexpr size_t WS_WDN = 560 * MiB;
constexpr size_t WS_X = 816 * MiB;
constexpr size_t WS_H = 880 * MiB;
constexpr size_t WS_ZR = 912 * MiB;
constexpr size_t WS_ZP = 976 * MiB;
constexpr size_t WS_Q = 992 * MiB, WS_K = 1008 * MiB, WS_V = 1024 * MiB;
constexpr size_t WS_SCAN = 1040 * MiB;
constexpr int SCAN_ROW = 896;
constexpr size_t WS_G = 1136 * MiB;
constexpr size_t WS_YRAW = 1152 * MiB;
constexpr size_t WS_MIXED = 1168 * MiB;
constexpr size_t WS_ACT = 1200 * MiB;
constexpr size_t WS_YSLOT = 1344 * MiB;
constexpr size_t WS_CPG = 1472 * MiB;
constexpr size_t WS_CPSI = 1496 * MiB;
constexpr size_t WS_CY0 = 1504 * MiB;
constexpr size_t WS_CS = 1520 * MiB;
constexpr size_t WS_END = 1528 * MiB;

constexpr int CW_TMO = 0, CW_CODE = 1;
constexpr int CW_BAR = 4096;
constexpr int CW_CNT = 16384;
constexpr int CW_QUEUE = 40960;
constexpr int CW_CQ = 49152;

constexpr int RING_BYTES = 131072;
constexpr int LDS_BYTES = 147456;
constexpr int LDSCTL_OFF = 139264;
constexpr int MISC_OFF = LDSCTL_OFF;
constexpr int PTR_OFF = LDSCTL_OFF + 256;
constexpr int TAB_OFF = LDSCTL_OFF + 512;
constexpr int ROWTAB_OFF = LDSCTL_OFF + 4096;
constexpr int PCV_OFF = LDSCTL_OFF + 6144;

#define RLX_AGENT __ATOMIC_RELAXED, __HIP_MEMORY_SCOPE_AGENT
#define LDS_WAIT() asm volatile("s_waitcnt lgkmcnt(0)" ::: "memory")
#define VM_WAIT() asm volatile("s_waitcnt vmcnt(0)" ::: "memory")

__device__ __forceinline__ unsigned f2bf(float f) { unsigned u = __builtin_bit_cast(unsigned, f); return (u + 0x7fffu + ((u >> 16) & 1u)) >> 16; }
__device__ __forceinline__ unsigned pk2(float lo, float hi) { return f2bf(lo) | (f2bf(hi) << 16); }
typedef __bf16 bf16x2_t __attribute__((ext_vector_type(2)));
__device__ __forceinline__ unsigned cvtpk(float lo, float hi) { const f32x2 v = {lo, hi}; const bf16x2_t b = __builtin_convertvector(v, bf16x2_t); return __builtin_bit_cast(unsigned, b); }
__device__ __forceinline__ f32x4 unp4(u32x2 p) { return (f32x4){__builtin_bit_cast(float, p.x << 16), __builtin_bit_cast(float, p.x & 0xffff0000u), __builtin_bit_cast(float, p.y << 16), __builtin_bit_cast(float, p.y & 0xffff0000u)}; }
__device__ __forceinline__ f32x4 up4(u32x2 y) { return (f32x4){__builtin_bit_cast(float, y.x << 16), __builtin_bit_cast(float, y.x & 0xffff0000u), __builtin_bit_cast(float, y.y << 16), __builtin_bit_cast(float, y.y & 0xffff0000u)}; }
__device__ __forceinline__ u32x2 pk4(f32x4 v) { return (u32x2){cvtpk(v.x, v.y), cvtpk(v.z, v.w)}; }
__device__ __forceinline__ u32x4 pk8(f32x4 a, f32x4 b) { return (u32x4){cvtpk(a.x, a.y), cvtpk(a.z, a.w), cvtpk(b.x, b.y), cvtpk(b.z, b.w)}; }
__device__ __forceinline__ float bf2f(unsigned short b) { return __builtin_bit_cast(float, (unsigned)b << 16); }
__device__ __forceinline__ float dpp_f(float v, const int ctrl_sel) {
    const int iv = __builtin_bit_cast(int, v); int r;
    switch (ctrl_sel) { case 0: r = __builtin_amdgcn_update_dpp(0, iv, 0xB1, 0xf, 0xf, true); break; case 1: r = __builtin_amdgcn_update_dpp(0, iv, 0x4E, 0xf, 0xf, true); break;
                        case 2: r = __builtin_amdgcn_update_dpp(0, iv, 0x141, 0xf, 0xf, true); break; default: r = __builtin_amdgcn_update_dpp(0, iv, 0x140, 0xf, 0xf, true); break; }
    return __builtin_bit_cast(float, r);
}
__device__ __forceinline__ float red16(float v) { v += dpp_f(v, 0); v += dpp_f(v, 1); v += dpp_f(v, 2); v += dpp_f(v, 3); return v; }
__device__ __forceinline__ float fma_s(float a, float b, float c) { float d; asm("v_fma_f32 %0, %1, %2, %3" : "=v"(d) : "v"(a), "v"(b), "v"(c)); return d; }
__device__ __forceinline__ float fnma_s(float a, float b, float c) { float d; asm("v_fma_f32 %0, -%1, %2, %3" : "=v"(d) : "v"(a), "v"(b), "v"(c)); return d; }
__device__ __forceinline__ float mul_s(float a, float b) { float d; asm("v_mul_f32_e32 %0, %1, %2" : "=v"(d) : "v"(a), "v"(b)); return d; }
__device__ __forceinline__ float add_s(float a, float b) { float d; asm("v_add_f32_e32 %0, %1, %2" : "=v"(d) : "v"(a), "v"(b)); return d; }
__device__ __forceinline__ void red16_pair(float& a, float& b) {
    asm volatile("s_nop 1\n\t"
                 "v_add_f32_dpp %0, %0, %0 quad_perm:[1,0,3,2] row_mask:0xf bank_mask:0xf bound_ctrl:1\n\t"
                 "v_add_f32_dpp %1, %1, %1 quad_perm:[1,0,3,2] row_mask:0xf bank_mask:0xf bound_ctrl:1\n\t"
                 "s_nop 0\n\t"
                 "v_add_f32_dpp %0, %0, %0 quad_perm:[2,3,0,1] row_mask:0xf bank_mask:0xf bound_ctrl:1\n\t"
                 "v_add_f32_dpp %1, %1, %1 quad_perm:[2,3,0,1] row_mask:0xf bank_mask:0xf bound_ctrl:1\n\t"
                 "s_nop 0\n\t"
                 "v_add_f32_dpp %0, %0, %0 row_half_mirror row_mask:0xf bank_mask:0xf bound_ctrl:1\n\t"
                 "v_add_f32_dpp %1, %1, %1 row_half_mirror row_mask:0xf bank_mask:0xf bound_ctrl:1\n\t"
                 "s_nop 0\n\t"
                 "v_add_f32_dpp %0, %0, %0 row_mirror row_mask:0xf bank_mask:0xf bound_ctrl:1\n\t"
                 "v_add_f32_dpp %1, %1, %1 row_mirror row_mask:0xf bank_mask:0xf bound_ctrl:1\n\t"
                 "s_nop 0"
                 : "+v"(a), "+v"(b));
}
__device__ __forceinline__ float wave_sum(float v) {
    v = red16(v);
    { const auto rr = __builtin_amdgcn_permlane16_swap(__float_as_uint(v), __float_as_uint(v), false, false); v = __uint_as_float(rr[0]) + __uint_as_float(rr[1]); }
    { const auto rr = __builtin_amdgcn_permlane32_swap(__float_as_uint(v), __float_as_uint(v), false, false); v = __uint_as_float(rr[0]) + __uint_as_float(rr[1]); }
    return v;
}
__device__ __forceinline__ float wave_max(float v) {
    v = fmaxf(v, dpp_f(v, 0)); v = fmaxf(v, dpp_f(v, 1)); v = fmaxf(v, dpp_f(v, 2)); v = fmaxf(v, dpp_f(v, 3));
    { const auto rr = __builtin_amdgcn_permlane16_swap(__float_as_uint(v), __float_as_uint(v), false, false); v = fmaxf(__uint_as_float(rr[0]), __uint_as_float(rr[1])); }
    { const auto rr = __builtin_amdgcn_permlane32_swap(__float_as_uint(v), __float_as_uint(v), false, false); v = fmaxf(__uint_as_float(rr[0]), __uint_as_float(rr[1])); }
    return v;
}
__device__ __forceinline__ float sigmoidf_(float x) { return 1.f / (1.f + __expf(-x)); }
__device__ __forceinline__ float softplusf_(float u) { return fmaxf(u, 0.f) + log1pf(__expf(-fabsf(u))); }
__device__ __forceinline__ float softplus_fast(float u) { return fmaxf(u, 0.f) + __logf(1.f + __expf(-fabsf(u))); }

#define XB_TMO      128
#define XB_XCNT(j)  (256  + 64 * (j))
#define XB_XSUB(j)  (1280 + 64 * (j))
#define XB_XGEN(j)  (2304 + 64 * (j))
#define XB_TOP      3328
#define XB_TOPGEN   3392
#define XCD_BAR_WORDS 3456
#define XB_SPIN_CAP (1u << 18)
__device__ __forceinline__ unsigned xb_ld(unsigned* p)              { return __hip_atomic_load(p, __ATOMIC_RELAXED, __HIP_MEMORY_SCOPE_AGENT); }
__device__ __forceinline__ unsigned xb_add(unsigned* p, unsigned v) { return __hip_atomic_fetch_add(p, v, __ATOMIC_RELAXED, __HIP_MEMORY_SCOPE_AGENT); }
__device__ __forceinline__ unsigned xb_xcc_id() { return (unsigned)__builtin_amdgcn_s_getreg((3 << 11) | 20) & 0xFu; }
#define XB_SPIN(cond, bar) do { unsigned _sp = 0; while (cond) { __builtin_amdgcn_s_sleep(1); \
    if ((++_sp & 255u) == 0u) { if (xb_ld(&(bar)[XB_TMO])) break; if (_sp > XB_SPIN_CAP) { atomicAdd(&(bar)[XB_TMO], 1u); break; } } } } while (0)
struct XcdBarrier { unsigned* bar; unsigned x; volatile LAS unsigned* st; };
__device__ __forceinline__ XcdBarrier xcd_barrier_post(unsigned* bar, volatile LAS unsigned* st) {
    XcdBarrier b; b.bar = bar; b.x = xb_xcc_id(); b.st = st;
    if (threadIdx.x == 0) (void)xb_add(&bar[XB_XCNT(b.x)], 1u);
    return b;
}
__device__ __forceinline__ void xcd_barrier_complete(unsigned* bar, unsigned x, unsigned& nloc, unsigned& nx) {
    const unsigned G = gridDim.x * gridDim.y * gridDim.z;
    unsigned sum, cnt, mine, sp = 0u;
    for (;;) {
        sum = 0u; cnt = 0u; mine = 0u;
#pragma unroll
        for (unsigned j = 0; j < 16; ++j) { const unsigned c = xb_ld(&bar[XB_XCNT(j)]); sum += c; cnt += (c > 0u) ? 1u : 0u; mine = (j == x) ? c : mine; }
        if (sum == G) break;
        __builtin_amdgcn_s_sleep(1);
        if ((++sp & 255u) == 0u) { if (xb_ld(&bar[XB_TMO])) break; if (sp > XB_SPIN_CAP) { atomicAdd(&bar[XB_TMO], 1u); break; } }
    }
    nloc = mine > 0u ? mine : 1u; nx = cnt > 0u ? cnt : 1u;
}
__device__ __forceinline__ void xcd_barrier(const XcdBarrier& b) {
    asm volatile("s_waitcnt vmcnt(0)" ::: "memory");
    __syncthreads();
    if (threadIdx.x == 0) {
        unsigned* bar = b.bar;
        __builtin_amdgcn_s_waitcnt(0);
        unsigned nloc = b.st[0], nx = b.st[1];
        if (nloc == 0u) { xcd_barrier_complete(bar, b.x, nloc, nx); b.st[0] = nloc; b.st[1] = nx; }
        const unsigned old = xb_add(&bar[XB_XSUB(b.x)], 1u);
        const unsigned gen = old / nloc;
        if (old + 1u == (gen + 1u) * nloc) {
            __builtin_amdgcn_fence(__ATOMIC_RELEASE, "agent");
            asm volatile("s_waitcnt vmcnt(0)" ::: "memory");
            const unsigned og = xb_add(&bar[XB_TOP], 1u);
            const unsigned tg = og / nx;
            if (og + 1u == (tg + 1u) * nx) xb_add(&bar[XB_TOPGEN], 1u);
            else XB_SPIN(xb_ld(&bar[XB_TOPGEN]) == tg, bar);
            __builtin_amdgcn_fence(__ATOMIC_ACQUIRE, "agent");
            xb_add(&bar[XB_XGEN(b.x)], 1u);
            asm volatile("s_waitcnt vmcnt(0)" ::: "memory");
        } else {
            XB_SPIN(xb_ld(&bar[XB_XGEN(b.x)]) == gen, bar);
            __builtin_amdgcn_fence(__ATOMIC_ACQUIRE, "agent");
            asm volatile("s_waitcnt vmcnt(0)" ::: "memory");
        }
    }
    __syncthreads();
}

namespace pg8 {
constexpr int BM = 256, BK = 64, HALF = 128, HTB = HALF * BK * 2, STAGE_BYTES = 8 * HTB;
__device__ __forceinline__ int lds_byte(int r, int c) { const int st = (r >> 4) * 2 + (c >> 5), rr = r & 15, cc = c & 31, ob = rr * 64 + cc * 2; return st * 1024 + (ob ^ (((ob >> 9) & 1) << 5)); }
__device__ __forceinline__ void stage_rc(int b, int& R, int& C) { const int st = b / 1024, sb = b % 1024, swz = sb ^ (((sb >> 9) & 1) << 5); R = (st >> 1) * 16 + swz / 64; C = (st & 1) * 32 + (swz % 64) / 2; }
__device__ __forceinline__ int perm32(int rho) { const int n = rho >> 4, i = rho & 15; return 8 * (i >> 2) + 4 * n + (i & 3); }
struct Unit { int pm, pn, e; };
__device__ __forceinline__ unsigned cvt_pk_bf16(float lo, float hi) { unsigned r; asm volatile("v_cvt_pk_bf16_f32 %0, %1, %2" : "=v"(r) : "v"(lo), "v"(hi)); return r; }

template <bool GATHER, int K, class Prob, class Epi>
__device__ __forceinline__ void gemm_phase(LAS unsigned char* lds, LAS unsigned* rowtab  , const int tid, const Prob& S, const Epi& E) {
    const int wid = __builtin_amdgcn_readfirstlane(tid >> 6), lane = tid & 63, wr = wid >> 2, wc = wid & 3, fr = lane & 15, fq = lane >> 4;
    constexpr int nt = K / BK; static_assert(K % 128 == 0 && K >= 256 && (!GATHER || K == 1024), "K");
    unsigned voffA[2], voffB[2];
#pragma unroll
    for (int i = 0; i < 2; ++i) { int R, C; stage_rc(tid * 16 + i * 8192, R, C); const int Rb = (R & ~31) + perm32(R & 31); voffA[i] = (unsigned)(R * K + C) * 2u; voffB[i] = (unsigned)(Rb * K + C) * 2u; }
    constexpr size_t kstep = (size_t)(BK * 2);
    constexpr size_t hstep = (size_t)HALF * K * 2;
    const unsigned ldsw = (unsigned)wid * 1024u;
    const int aoff = lds_byte(wr * 64 + fr, fq * 8), boff = lds_byte(wc * 32 + fr, fq * 8);
#define PG8_SA(b, h) (((b) * 2 + (h)) * HTB)
#define PG8_SB(b, h) ((4 + (b) * 2 + (h)) * HTB)
#define PG8_STAGEB(bufoff, gbase) do { _Pragma("unroll") for (int _i = 0; _i < 2; ++_i) \
        __builtin_amdgcn_global_load_lds((const unsigned*)((const char*)(gbase) + voffB[_i]), (LAS unsigned*)(lds + (bufoff) + ldsw + _i * 8192), 16, 0, 0); } while (0)
#define PG8_STAGEA2(bufoff, gbase, o0, o1) do { \
        __builtin_amdgcn_global_load_lds((const unsigned*)((const char*)(gbase) + (o0)), (LAS unsigned*)(lds + (bufoff) + ldsw), 16, 0, 0); \
        __builtin_amdgcn_global_load_lds((const unsigned*)((const char*)(gbase) + (o1)), (LAS unsigned*)(lds + (bufoff) + ldsw + 8192), 16, 0, 0); } while (0)
#define PG8_STAGEA_C(bufoff, gbase, h) do { if constexpr (GATHER) PG8_STAGEA2(bufoff, gbase, oc[h][0], oc[h][1]); else PG8_STAGEA2(bufoff, (gbase) + (h) * hstep, voffA[0], voffA[1]); } while (0)
#define PG8_LDA(dst, b, h) do { _Pragma("unroll") for (int m = 0; m < 4; ++m) _Pragma("unroll") for (int k = 0; k < 2; ++k) dst[m][k] = *(const LAS bf16x8*)(lds + PG8_SA(b, h) + aoff + m * 2048 + k * 1024); } while (0)
#define PG8_LDB(dst, b, h) do { _Pragma("unroll") for (int n = 0; n < 2; ++n) _Pragma("unroll") for (int k = 0; k < 2; ++k) dst[n][k] = *(const LAS bf16x8*)(lds + PG8_SB(b, h) + boff + n * 2048 + k * 1024); } while (0)
#define PG8_MMA(ai, bj, At, Bt) do { __builtin_amdgcn_s_setprio(1); _Pragma("unroll") for (int m = 0; m < 4; ++m) _Pragma("unroll") for (int n = 0; n < 2; ++n) _Pragma("unroll") for (int k = 0; k < 2; ++k) \
        acc[ai][bj][m][n] = __builtin_amdgcn_mfma_f32_16x16x32_bf16(Bt[n][k], At[m][k], acc[ai][bj][m][n], 0, 0, 0); __builtin_amdgcn_s_setprio(0); } while (0)
#define PG8_WAIT_V(n) asm volatile("s_waitcnt vmcnt(" #n ")" ::: "memory")
#define PG8_WAIT_L(n) asm volatile("s_waitcnt lgkmcnt(" #n ")" ::: "memory")
#define PG8_BAR __builtin_amdgcn_s_barrier()
#define PG8_SCHED __builtin_amdgcn_sched_barrier(0)
    Unit cur, nxt; int ui = 0;
    if (!S.next(0, cur)) return;
    f32x4 acc[2][2][4][2];
#pragma unroll
    for (int a = 0; a < 2; ++a)
#pragma unroll
        for (int b = 0; b < 2; ++b)
#pragma unroll
            for (int m = 0; m < 4; ++m)
#pragma unroll
                for (int n = 0; n < 2; ++n) acc[a][b][m][n] = (f32x4){0.f, 0.f, 0.f, 0.f};
    bf16x8 At[4][2], B0[2][2], B1[2][2];
    const char* cA = S.a_ptr(cur); const char* cB = S.b_ptr(cur);
    unsigned oc[2][2];
    if constexpr (GATHER) {
#pragma unroll
        for (int h = 0; h < 2; ++h)
#pragma unroll
            for (int i = 0; i < 2; ++i) oc[h][i] = S.row_off(cur, h * 128 + (int)(voffA[i] >> 11)) + (voffA[i] & 2047u);
    }
    PG8_STAGEB(PG8_SB(0, 0), cB); PG8_STAGEB(PG8_SB(0, 1), cB + hstep); PG8_STAGEA_C(PG8_SA(0, 0), cA, 0); PG8_STAGEA_C(PG8_SA(0, 1), cA, 1);
    if (wr == 1) PG8_BAR;
    PG8_WAIT_V(2); PG8_BAR;
    PG8_STAGEB(PG8_SB(1, 0), cB + kstep); PG8_STAGEA_C(PG8_SA(1, 0), cA + kstep, 0); PG8_STAGEB(PG8_SB(1, 1), cB + hstep + kstep);
    PG8_WAIT_V(6); PG8_BAR;
    for (;;) {
        const bool has_next = S.next(ui + 1, nxt);
        const char* nA = cA; const char* nB = cB;
        if (has_next) { nA = S.a_ptr(nxt); nB = S.b_ptr(nxt); }
        if constexpr (GATHER) { if (has_next && tid < 256) rowtab[((ui + 1) & 1) * 256 + tid] = S.row_off(nxt, tid); }
#pragma nounroll
        for (int t = 0; t < nt; t += 2) {
            const bool last = (t == nt - 2);
            const char* a1 = cA + (size_t)(t + 1) * kstep;
            const char* a2 = last ? nA : cA + (size_t)(t + 2) * kstep; const char* b2 = last ? nB : cB + (size_t)(t + 2) * kstep;
            const char* a3 = a2 + kstep; const char* b3 = b2 + kstep;
            PG8_LDB(B0, 0, 0); PG8_LDB(B1, 0, 1); PG8_SCHED; PG8_LDA(At, 0, 0); PG8_STAGEA_C(PG8_SA(1, 1), a1, 1);
            if constexpr (GATHER) { if (last && has_next) {
#pragma unroll
                for (int h = 0; h < 2; ++h)
#pragma unroll
                    for (int i = 0; i < 2; ++i) oc[h][i] = rowtab[((ui + 1) & 1) * 256 + h * 128 + (int)(voffA[i] >> 11)] + (voffA[i] & 2047u); } }
            PG8_WAIT_V(8); PG8_WAIT_L(0); PG8_BAR; PG8_MMA(0, 0, At, B0); PG8_MMA(0, 1, At, B1); PG8_BAR; PG8_SCHED;
            PG8_LDA(At, 0, 1); PG8_STAGEB(PG8_SB(0, 0), b2); PG8_STAGEB(PG8_SB(0, 1), b2 + hstep); PG8_STAGEA_C(PG8_SA(0, 0), a2, 0);
            PG8_WAIT_V(8); PG8_WAIT_L(0); PG8_BAR; PG8_MMA(1, 0, At, B0); PG8_MMA(1, 1, At, B1); PG8_BAR; PG8_SCHED;
            PG8_LDB(B0, 1, 0); PG8_LDB(B1, 1, 1); PG8_SCHED; PG8_LDA(At, 1, 0); PG8_STAGEA_C(PG8_SA(0, 1), a2, 1);
            PG8_WAIT_V(8); PG8_WAIT_L(0); PG8_BAR; PG8_MMA(0, 0, At, B0); PG8_MMA(0, 1, At, B1); PG8_BAR; PG8_SCHED;
            PG8_LDA(At, 1, 1); PG8_STAGEB(PG8_SB(1, 0), b3); PG8_STAGEB(PG8_SB(1, 1), b3 + hstep); PG8_STAGEA_C(PG8_SA(1, 0), a3, 0);
            PG8_WAIT_V(8); PG8_WAIT_L(0); PG8_BAR; PG8_MMA(1, 0, At, B0); PG8_MMA(1, 1, At, B1); PG8_BAR; PG8_SCHED;
        }
        if (wr == 0) PG8_BAR;
        E(acc, cur, wr, wc, fr, fq);
        if (!has_next) break;
#pragma unroll
        for (int a = 0; a < 2; ++a)
#pragma unroll
            for (int b = 0; b < 2; ++b)
#pragma unroll
                for (int m = 0; m < 4; ++m)
#pragma unroll
                    for (int n = 0; n < 2; ++n) acc[a][b][m][n] = (f32x4){0.f, 0.f, 0.f, 0.f};
        cur = nxt; cA = nA; cB = nB; ++ui;
        if (wr == 1) PG8_BAR;
    }
    PG8_WAIT_V(0);
    PG8_BAR;
#undef PG8_SA
#undef PG8_SB
#undef PG8_STAGEA2
#undef PG8_STAGEA_C
#undef PG8_STAGEB
#undef PG8_LDA
#undef PG8_LDB
#undef PG8_MMA
#undef PG8_WAIT_V
#undef PG8_WAIT_L
#undef PG8_BAR
#undef PG8_SCHED
}
}

struct Frame {
    LAS unsigned char* lds;
    volatile LAS unsigned* MISC;
    int tid, lane, wave, vcu, G;
};
struct Args { const float* in[29]; float* out; unsigned char* ws; int ph_lo, ph_hi; };
__device__ __forceinline__ unsigned long long ldptr_raw(LAS unsigned char* lds, int i) {
    const unsigned long long v = *(const LAS unsigned long long*)(lds + PTR_OFF + 8 * i);
    const unsigned lo = __builtin_amdgcn_readfirstlane((unsigned)v), hi = __builtin_amdgcn_readfirstlane((unsigned)(v >> 32));
    return ((unsigned long long)hi << 32) | lo;
}
__device__ __forceinline__ void* ldptr(const Frame& F, int i) { return (void*)(GAS unsigned char*)ldptr_raw(F.lds, i); }
struct InTab { LAS unsigned char* lds; __device__ __forceinline__ const float* operator[](int i) const { return (const float*)(const GAS float*)ldptr_raw(lds, i); } };
__device__ __forceinline__ void refresh(Frame& F) { int t = F.tid; asm volatile("" : "+v"(t)); F.tid = t; F.lane = t & 63; F.wave = __builtin_amdgcn_readfirstlane(t >> 6); }


enum { I_X = 0, I_C, I_ADAW, I_ADAB, I_NORM1, I_WIN, I_WOUT, I_MU, I_W0, I_WUP, I_A0, I_AUP, I_GUP, I_KK, I_KA, I_RK, I_LNW, I_LNB, I_POOLW, I_POOLS, I_BF, I_NORM2, I_RW, I_RB, I_WGU, I_BGU, I_WDN, I_BDN, I_NORMF };

struct TItem { const float* src; bf16_t* dst; int ldw; };
__device__ __forceinline__ TItem mk_item(const float* W, int ldw, bf16_t* WT, int dst_row0, int k0, int n0) { TItem t; t.src = W + (size_t)k0 * ldw + n0; t.dst = WT + (size_t)dst_row0 * 1024 + k0; t.ldw = ldw; return t; }
__device__ __forceinline__ void ti_load(f32x4 (&t)[8], const TItem& it, int lane) {
#pragma unroll
    for (int i = 0; i < 8; ++i) t[i] = __builtin_nontemporal_load((const f32x4*)(it.src + (size_t)(8 * i + (lane >> 3)) * it.ldw + 4 * (lane & 7)));
}
__device__ __forceinline__ void ti_finish(const f32x4 (&t)[8], const TItem& it, LAS float* scr, int lane) {
#pragma unroll
    for (int i = 0; i < 8; ++i) { LAS float* d = scr + (8 * i + (lane >> 3)) * 33 + 4 * (lane & 7); d[0] = t[i].x; d[1] = t[i].y; d[2] = t[i].z; d[3] = t[i].w; }
    LDS_WAIT(); asm volatile("" ::: "memory");
    const int c = lane & 7;
#pragma unroll
    for (int j = 0; j < 4; ++j) { const int n = (lane >> 3) + 8 * j; const LAS float* s = scr + (8 * c) * 33 + n;
        u32x4 o; o.x = cvtpk(s[0 * 33], s[1 * 33]); o.y = cvtpk(s[2 * 33], s[3 * 33]); o.z = cvtpk(s[4 * 33], s[5 * 33]); o.w = cvtpk(s[6 * 33], s[7 * 33]);
        *(GAS u32x4*)(it.dst + (size_t)n * 1024 + 8 * c) = o; }
    LDS_WAIT(); asm volatile("" ::: "memory");
}
template <class Dec> __device__ __forceinline__ void convert_stream(int first, int step, int end, LAS float* scr, int lane, Dec dec) {
    f32x4 ta[8], tb[8]; TItem ia, ib;
    int it = first;
    if (it < end) { ia = dec(it); ti_load(ta, ia, lane); }
    while (it < end) {
        const int i2 = it + step;
        if (i2 < end) { ib = dec(i2); ti_load(tb, ib, lane); }
        ti_finish(ta, ia, scr, lane);
        if (i2 >= end) break;
        const int i3 = i2 + step;
        if (i3 < end) { ia = dec(i3); ti_load(ta, ia, lane); }
        ti_finish(tb, ib, scr, lane);
        it = i3;
    }
}

__device__ __forceinline__ void convert_moe_batch(Frame& F, const InTab& in_, unsigned char* ws_, int l, int q);
__device__ __forceinline__ void phase_prologue(Frame& F) {
    refresh(F); unsigned char* ws_ = (unsigned char*)ldptr(F, 30); const InTab in_{F.lds}; gu32* ctl_ = (gu32*)ws_;

    if (blockIdx.x < 192) {
        LAS float* cond = (LAS float*)F.lds;
        LAS float* part = (LAS float*)(F.lds + 16384);
        const float* c = in_[I_C];
        for (int i = F.tid; i < 4096; i += NTHR) { const float v = c[i]; cond[i] = v / (1.f + __expf(-v)); }
        __syncthreads();
        const int l = blockIdx.x / 48, col0 = (blockIdx.x % 48) * 128;
        const float* W = in_[I_ADAW] + (size_t)l * 1024 * 6144 + col0 + 2 * F.lane;
        float a[4][2];
#pragma unroll
        for (int b = 0; b < 4; ++b) { a[b][0] = 0.f; a[b][1] = 0.f; }
        const int kb = F.wave * 128;
#pragma unroll 8
        for (int k = kb; k < kb + 128; ++k) {
            const f32x2 w = __builtin_nontemporal_load((const f32x2*)(W + (size_t)k * 6144));
#pragma unroll
            for (int b = 0; b < 4; ++b) { const float cv = cond[b * 1024 + k]; a[b][0] += cv * w.x; a[b][1] += cv * w.y; }
        }
#pragma unroll
        for (int b = 0; b < 4; ++b) { part[(F.wave * 4 + b) * 128 + 2 * F.lane] = a[b][0]; part[(F.wave * 4 + b) * 128 + 2 * F.lane + 1] = a[b][1]; }
        __syncthreads();
        { const int b = F.tid >> 7, cc = F.tid & 127; float s = in_[I_ADAB][l * 6144 + col0 + cc];
#pragma unroll
          for (int w = 0; w < 8; ++w) s += part[(w * 4 + b) * 128 + cc];
          ((float*)(ws_ + WS_MOD))[(l * 4 + b) * 6144 + col0 + cc] = s; }
        __syncthreads();
    }
    {
        bf16_t* LT = (bf16_t*)(ws_ + WS_LORA);
        const float* wu = in_[I_WUP]; const float* au = in_[I_AUP]; const float* gu = in_[I_GUP];
        for (int idx = blockIdx.x * NTHR + F.tid; idx < NL * 768 * 256; idx += F.G * NTHR) {
            const int k = idx & 255, n = (idx >> 8) % 768, l = idx / (768 * 256);
            float v = 0.f;
            if (n < 256) { if (k < 64) v = wu[((size_t)l * 64 + k) * 256 + n]; }
            else if (n < 512) { if (k >= 64 && k < 128) v = au[((size_t)l * 64 + (k - 64)) * 256 + (n - 256)]; }
            else { if (k >= 128) v = gu[((size_t)l * 128 + (k - 128)) * 256 + (n - 512)]; }
            LT[idx] = (bf16_t)f2bf(v);
        }
    }
    LAS float* scr = (LAS float*)(F.lds + F.wave * 16384);
    const int gw = F.vcu * NWAVES + F.wave, NGW = F.G * NWAVES;
    constexpr int I_A = NL * 16 * 88, I_B = NL * 16 * 32;
    convert_stream(gw, NGW, I_A + I_B, scr, F.lane, [&](int r) {
        if (r < I_A) { const int l = r / (16 * 88), q = r % (16 * 88), kb = q / 88, nb = q % 88;
            return mk_item(in_[I_WIN] + (size_t)l * 1024 * PIN, PIN, (bf16_t*)(ws_ + WS_WIN) + (size_t)l * NPROJ * 1024, 32 * nb, 64 * kb, 32 * nb); }
        r -= I_A;
        const int l = r / (16 * 32), q = r % (16 * 32), kb = q / 32, nb = q % 32;
        return mk_item(in_[I_WOUT] + (size_t)l * 1024 * 1024, 1024, (bf16_t*)(ws_ + WS_WOUT) + (size_t)l * 1024 * 1024, 32 * nb, 64 * kb, 32 * nb); });
}
__device__ __forceinline__ void convert_moe_batch(Frame& F, const InTab& in_, unsigned char* ws_, int l, int q) {
    LAS float* scr = (LAS float*)(F.lds + F.wave * 16384);
    convert_stream(q * 64 + F.wave, 8, q * 64 + 64, scr, F.lane, [&](int r) {
        if (r < NE * 16 * 64) { const int e = r / (16 * 64), qq = r % (16 * 64), kb = qq / 64, nb = qq % 64; const int n0 = 32 * nb; const int le = l * NE + e;
            const int dr = (n0 < 1024) ? ((n0 >> 7) * 256 + (n0 & 127)) : ((((n0 - 1024) >> 7) * 256) + 128 + ((n0 - 1024) & 127));
            return mk_item(in_[I_WGU] + (size_t)le * 1024 * 2048, 2048, (bf16_t*)(ws_ + WS_WGU) + (size_t)le * 2048 * 1024, dr, 64 * kb, n0); }
        r -= NE * 16 * 64; const int e = r / (16 * 32), qq = r % (16 * 32), kb = qq / 32, nb = qq % 32; const int le = l * NE + e;
        return mk_item(in_[I_WDN] + (size_t)le * 1024 * 1024, 1024, (bf16_t*)(ws_ + WS_WDN) + (size_t)le * 1024 * 1024, 32 * nb, 64 * kb, 32 * nb); });
}

__device__ __forceinline__ void phase_combine(Frame& F, int l, float yscale = 1.f) {
    refresh(F); unsigned char* ws_ = (unsigned char*)ldptr(F, 30); const InTab in_{F.lds}; gu32* ctl_ = (gu32*)ws_;

    const bool has_next = (l + 1 < NL);
    LAS float* Wf = (LAS float*)F.lds;
    if (has_next) {
        const float* W = in_[I_WIN] + (size_t)(l + 1) * 1024 * PIN + NPROJ;
        f32x4 t4[4];
#pragma unroll
        for (int u = 0; u < 4; ++u) { const int i = F.tid + NTHR * u; t4[u] = *(const f32x4*)(W + (size_t)(i >> 1) * PIN + 4 * (i & 1)); }
#pragma unroll
        for (int u = 0; u < 4; ++u) { const int i = F.tid + NTHR * u; *(LAS f32x4*)(Wf + 4 * i) = t4[u]; }
    }
    __syncthreads();
    const int gw = F.vcu * NWAVES + F.wave, NGW = F.G * NWAVES;
    const float* xin = in_[I_X];
    bf16_t* X = (bf16_t*)(ws_ + WS_X);
    const float* MOD = (const float*)(ws_ + WS_MOD);
    const bf16_t* YS = (const bf16_t*)(ws_ + WS_YSLOT);
    f32x4 xn[4]; u32x2 xb[4], yn[4][4];
#define CMB_LOAD(mm) do { if (l < 0) { _Pragma("unroll") for (int j = 0; j < 4; ++j) xn[j] = *(const f32x4*)(xin + (size_t)(mm) * 1024 + 4 * F.lane + 256 * j); } \
        else { _Pragma("unroll") for (int j = 0; j < 4; ++j) xb[j] = *(const u32x2*)(X + (size_t)(mm) * 1024 + 4 * F.lane + 256 * j); } \
        if (l >= 0) { _Pragma("unroll") for (int k = 0; k < 4; ++k) _Pragma("unroll") for (int j = 0; j < 4; ++j) yn[k][j] = *(const u32x2*)(YS + ((size_t)(mm) * 4 + k) * 1024 + 4 * F.lane + 256 * j); } } while (0)
    if (gw < NTOK) CMB_LOAD(gw);
    for (int m = gw; m < NTOK; m += NGW) {
        const int b = m >> 12;
        f32x4 v[4]; u32x2 yc[4][4];
#pragma unroll
        for (int j = 0; j < 4; ++j) { v[j] = (l < 0) ? xn[j] : up4(xb[j]);
#pragma unroll
            for (int k = 0; k < 4; ++k) yc[k][j] = yn[k][j]; }
        if (m + NGW < NTOK) CMB_LOAD(m + NGW);
        if (l >= 0) {
            const float* g2 = MOD + (size_t)(l * 4 + b) * 6144 + 5 * 1024;
#pragma unroll
            for (int j = 0; j < 4; ++j) {
                f32x4 s = (f32x4){0.f, 0.f, 0.f, 0.f};
#pragma unroll
                for (int k = 0; k < 4; ++k) { const u32x2 y = yc[k][j];
                    s.x += __builtin_bit_cast(float, y.x << 16); s.y += __builtin_bit_cast(float, y.x & 0xffff0000u); s.z += __builtin_bit_cast(float, y.y << 16); s.w += __builtin_bit_cast(float, y.y & 0xffff0000u); }
                const f32x4 g = *(const f32x4*)(g2 + 4 * F.lane + 256 * j);
                v[j] = v[j] + g * yscale * s;
            }
        }
        if (l >= 0 && has_next) {
#pragma unroll
            for (int j = 0; j < 4; ++j) *(u32x2*)(X + (size_t)m * 1024 + 4 * F.lane + 256 * j) = pk4(v[j]);
        }
        float ss = 0.f;
#pragma unroll
        for (int j = 0; j < 4; ++j) ss += (v[j].x * v[j].x + v[j].y * v[j].y) + (v[j].z * v[j].z + v[j].w * v[j].w);
        const float rs = 1.f / sqrtf(wave_sum(ss) * (1.f / 1024.f) + 1e-6f);
        if (has_next) {
            const float* nw = in_[I_NORM1] + (l + 1) * 1024;
            const float* sh = MOD + (size_t)((l + 1) * 4 + b) * 6144; const float* sc = sh + 1024;
            float fl[8];
#pragma unroll
            for (int e = 0; e < 8; ++e) fl[e] = 0.f;
            bf16_t* H = (bf16_t*)(ws_ + WS_H) + (size_t)m * 1024;
#pragma unroll
            for (int j = 0; j < 4; ++j) {
                const int c0 = 4 * F.lane + 256 * j;
                const f32x4 w = *(const f32x4*)(nw + c0), s1 = *(const f32x4*)(sc + c0), s0 = *(const f32x4*)(sh + c0);
                f32x4 h = v[j] * rs * w * (s1 + 1.f) + s0;
                u32x2 o; o.x = cvtpk(h.x, h.y); o.y = cvtpk(h.z, h.w);
                *(u32x2*)(H + c0) = o;
#pragma unroll
                for (int i = 0; i < 4; ++i) {
                    const f32x4 wa = *(const LAS f32x4*)(Wf + (c0 + i) * 8), wb = *(const LAS f32x4*)(Wf + (c0 + i) * 8 + 4);
                    const float hv = h[i];
                    fl[0] += hv * wa.x; fl[1] += hv * wa.y; fl[2] += hv * wa.z; fl[3] += hv * wa.w; fl[4] += hv * wb.x; fl[5] += hv * wb.y; fl[6] += hv * wb.z; fl[7] += hv * wb.w;
                }
            }
#pragma unroll
            for (int e = 0; e < 8; ++e) fl[e] = wave_sum(fl[e]);
            if (F.lane == 0) { float* o = (float*)(ws_ + WS_FLOG) + (size_t)m * 8; *(f32x4*)o = (f32x4){fl[0], fl[1], fl[2], fl[3]}; *(f32x4*)(o + 4) = (f32x4){fl[4], fl[5], fl[6], fl[7]}; }
        } else {
            const float* nw = in_[I_NORMF]; float* out_ = (float*)ldptr(F, 29);
            const float pscale = (PROBE_T >= 0) ? 1.f + __hip_atomic_load((GAS float*)(ctl_ + CW_CODE + 1), RLX_AGENT) : 1.f;
#pragma unroll
            for (int j = 0; j < 4; ++j) { const int c0 = 4 * F.lane + 256 * j; const f32x4 w = *(const f32x4*)(nw + c0);
                *(f32x4*)(out_ + (size_t)m * 1024 + c0) = v[j] * rs * w * pscale; }
        }
    }
}

#undef CMB_LOAD
struct ProbDense {
    const char* A; const char* Bt; int nM, nN, G, vcu;
    __device__ __forceinline__ bool next(int i, pg8::Unit& u) const { const int Lx = i * G + vcu; if (Lx >= nM * nN) return false; u.pn = Lx % nN; u.pm = Lx / nN; u.e = 0; return true; }
    __device__ __forceinline__ const char* a_ptr(const pg8::Unit& u) const { return A + (size_t)u.pm * 256 * 2048; }
    __device__ __forceinline__ const char* b_ptr(const pg8::Unit& u) const { return Bt + (size_t)u.pn * 256 * 2048; }
};
struct EpiProj {
    unsigned char* ws;
    __device__ __forceinline__ void operator()(const f32x4 (&acc)[2][2][4][2], const pg8::Unit& u, int wr, int wc, int fr, int fq) const {
        const int pn = u.pn;
#pragma unroll
        for (int ai = 0; ai < 2; ++ai)
#pragma unroll
            for (int m = 0; m < 4; ++m) {
                const size_t row = (size_t)u.pm * 256 + ai * 128 + wr * 64 + m * 16 + fr;
#pragma unroll
                for (int bj = 0; bj < 2; ++bj) {
                    const int ct = bj * 128 + wc * 32 + 8 * fq;
                    const f32x4 v0 = acc[ai][bj][m][0], v1 = acc[ai][bj][m][1];
                    if (pn < 4) { *(u32x4*)((bf16_t*)(ws + WS_ZR) + row * 1024 + pn * 256 + ct) = pk8(v0, v1); }
                    else if (pn == 4) { float* p = (float*)(ws + WS_ZP) + row * 256 + ct; *(f32x4*)p = v0; *(f32x4*)(p + 4) = v1; }
                    else { const int q = pn - 5, which = q >> 1; const float sc = (which == 0) ? QSCALE : 1.f;
                        bf16_t* p = (bf16_t*)(ws + (which == 0 ? WS_Q : (which == 1 ? WS_K : WS_V))) + row * 512 + (q & 1) * 256 + ct;
                        u32x4 w; w.x = pg8::cvt_pk_bf16(v0[0] * sc, v0[1] * sc); w.y = pg8::cvt_pk_bf16(v0[2] * sc, v0[3] * sc); w.z = pg8::cvt_pk_bf16(v1[0] * sc, v1[1] * sc); w.w = pg8::cvt_pk_bf16(v1[2] * sc, v1[3] * sc);
                        *(u32x4*)p = w; }
                }
            }
    }
};
struct EpiOut {
    bf16_t* X; const float* Xin; const float* g1; float scale;
    __device__ __forceinline__ void operator()(const f32x4 (&acc)[2][2][4][2], const pg8::Unit& u, int wr, int wc, int fr, int fq) const {
        const int b = (u.pm * 256) >> 12;
#pragma unroll
        for (int bj = 0; bj < 2; ++bj) {
            const int col = u.pn * 256 + bj * 128 + wc * 32 + 8 * fq;
            const f32x4 ga = *(const f32x4*)(g1 + (size_t)b * 6144 + col), gb = *(const f32x4*)(g1 + (size_t)b * 6144 + col + 4);
#pragma unroll
            for (int ai = 0; ai < 2; ++ai)
#pragma unroll
                for (int m = 0; m < 4; ++m) {
                    const size_t row = (size_t)u.pm * 256 + ai * 128 + wr * 64 + m * 16 + fr;
                    bf16_t* p = X + row * 1024 + col;
                    f32x4 x0, x1;
                    if (Xin) { const float* pi = Xin + row * 1024 + col; x0 = *(const f32x4*)pi; x1 = *(const f32x4*)(pi + 4); }
                    else { const u32x4 xb = *(const u32x4*)p; x0 = up4((u32x2){xb.x, xb.y}); x1 = up4((u32x2){xb.z, xb.w}); }
                    *(u32x4*)p = pk8(x0 + ga * scale * acc[ai][bj][m][0], x1 + gb * scale * acc[ai][bj][m][1]);
                }
        }
    }
};

struct MoeTab { LAS int* te; LAS int* tr0; LAS int* cnt; LAS int* ntiles; };
__device__ __forceinline__ MoeTab moe_table(Frame& F, int l) {
    refresh(F); unsigned char* ws_ = (unsigned char*)ldptr(F, 30); const InTab in_{F.lds}; gu32* ctl_ = (gu32*)ws_;

    MoeTab T; T.te = (LAS int*)(F.lds + TAB_OFF); T.tr0 = T.te + 320; T.cnt = T.tr0 + 320; T.ntiles = T.cnt + 32;
    if (F.tid < 32) T.cnt[F.tid] = (int)__hip_atomic_load(ctl_ + CW_CNT + ((l + (PROBE_DUP == 8 ? 4 : 0)) * 32 + F.tid) * 64, RLX_AGENT);
    __syncthreads();
    if (F.tid < 64) {
        const int e = F.tid; const int nt_e = (e < 32) ? ((T.cnt[e & 31] + 255) >> 8) : 0;
        int incl = nt_e;
#pragma unroll
        for (int o = 1; o < 32; o <<= 1) { const int t = __shfl_up(incl, o); if (F.lane >= o) incl += t; }
        const int start = incl - nt_e;
#pragma nounroll
        for (int r = 0; r < nt_e; ++r) { T.te[start + r] = e; T.tr0[start + r] = r * 256; }
        if (e == 31) T.ntiles[0] = incl;
    }
    __syncthreads();
    return T;
}
struct ProbGU {
    const char* H; const char* W; const int* list; MoeTab T; int nun, G, vcu, l;
    __device__ __forceinline__ bool next(int i, pg8::Unit& u) const { const int Lx = i * G + vcu; if (Lx >= nun) return false; u.pm = Lx >> 3; u.pn = Lx & 7; u.e = __builtin_amdgcn_readfirstlane(T.te[u.pm]); return true; }
    __device__ __forceinline__ const char* a_ptr(const pg8::Unit&) const { return H; }
    __device__ __forceinline__ const char* b_ptr(const pg8::Unit& u) const { return W + ((size_t)(l * 32 + u.e) * 2048 + (size_t)u.pn * 256) * 2048; }
    __device__ __forceinline__ unsigned row_off(const pg8::Unit& u, int r) const { const int idx = __builtin_amdgcn_readfirstlane(T.tr0[u.pm]) + r; const int tok = (idx < __builtin_amdgcn_readfirstlane(T.cnt[u.e])) ? (list[u.e * NTOK + idx] >> 2) : 0; return (unsigned)tok * 2048u; }
};
struct EpiGU {
    bf16_t* ACT; const float* bgu; int l;
    __device__ __forceinline__ void operator()(const f32x4 (&acc)[2][2][4][2], const pg8::Unit& u, int wr, int wc, int fr, int fq) const {
        const int col = u.pn * 128 + wc * 32 + 8 * fq;
        const float* bb = bgu + (size_t)(l * 32 + u.e) * 2048 + col;
        const f32x4 bg0 = *(const f32x4*)bb, bg1 = *(const f32x4*)(bb + 4), bu0 = *(const f32x4*)(bb + 1024), bu1 = *(const f32x4*)(bb + 1028);
#pragma unroll
        for (int ai = 0; ai < 2; ++ai)
#pragma unroll
            for (int m = 0; m < 4; ++m) {
                const size_t row = (size_t)u.pm * 256 + ai * 128 + wr * 64 + m * 16 + fr;
                float a[8];
#pragma unroll
                for (int n = 0; n < 2; ++n)
#pragma unroll
                    for (int i = 0; i < 4; ++i) {
                        float g = acc[ai][0][m][n][i] + (n ? bg1[i] : bg0[i]); float up = acc[ai][1][m][n][i] + (n ? bu1[i] : bu0[i]);
                        g = fminf(g, 7.f); up = fminf(fmaxf(up, -7.f), 7.f);
                        a[n * 4 + i] = (up + 1.f) * (g / (1.f + __expf(-1.702f * g)));
                    }
                u32x4 w; w.x = pg8::cvt_pk_bf16(a[0], a[1]); w.y = pg8::cvt_pk_bf16(a[2], a[3]); w.z = pg8::cvt_pk_bf16(a[4], a[5]); w.w = pg8::cvt_pk_bf16(a[6], a[7]);
                *(u32x4*)(ACT + row * 1024 + col) = w;
            }
    }
};
struct ProbDN {
    const char* ACT; const char* W; MoeTab T; int nun, G, vcu, l;
    __device__ __forceinline__ bool next(int i, pg8::Unit& u) const { const int Lx = i * G + vcu; if (Lx >= nun) return false; u.pm = Lx >> 2; u.pn = Lx & 3; u.e = __builtin_amdgcn_readfirstlane(T.te[u.pm]); return true; }
    __device__ __forceinline__ const char* a_ptr(const pg8::Unit& u) const { return ACT + (size_t)u.pm * 256 * 2048; }
    __device__ __forceinline__ const char* b_ptr(const pg8::Unit& u) const { return W + ((size_t)(l * 32 + u.e) * 1024 + (size_t)u.pn * 256) * 2048; }
};
struct EpiDN {
    bf16_t* YS; const float* bdn; const int* list; const float* gate; MoeTab T; int l;
    __device__ __forceinline__ void operator()(const f32x4 (&acc)[2][2][4][2], const pg8::Unit& u, int wr, int wc, int fr, int fq) const {
        const int r0 = __builtin_amdgcn_readfirstlane(T.tr0[u.pm]), c = __builtin_amdgcn_readfirstlane(T.cnt[u.e]);
#pragma unroll
        for (int ai = 0; ai < 2; ++ai)
#pragma unroll
            for (int m = 0; m < 4; ++m) {
                const int idx = r0 + ai * 128 + wr * 64 + m * 16 + fr;
                if (idx < c) {
                    const int slot = list[u.e * NTOK + idx]; const float gt = gate[slot];
#pragma unroll
                    for (int bj = 0; bj < 2; ++bj) {
                        const int col = u.pn * 256 + bj * 128 + wc * 32 + 8 * fq;
                        const float* bb = bdn + (size_t)(l * 32 + u.e) * 1024 + col;
                        const f32x4 b0 = *(const f32x4*)bb, b1 = *(const f32x4*)(bb + 4);
                        const f32x4 v0 = (acc[ai][bj][m][0] + b0) * gt, v1 = (acc[ai][bj][m][1] + b1) * gt;
                        u32x4 w; w.x = pg8::cvt_pk_bf16(v0[0], v0[1]); w.y = pg8::cvt_pk_bf16(v0[2], v0[3]); w.z = pg8::cvt_pk_bf16(v1[0], v1[1]); w.w = pg8::cvt_pk_bf16(v1[2], v1[3]);
                        *(u32x4*)(YS + (size_t)slot * 1024 + col) = w;
                    }
                }
            }
    }
};

__device__ __forceinline__ void phase_prep(Frame& F, int l) {
    refresh(F); unsigned char* ws_ = (unsigned char*)ldptr(F, 30); const InTab in_{F.lds};
    if (blockIdx.x < 32) {
        const int b = blockIdx.x >> 3, hh = blockIdx.x & 7;
        const float bf = in_[I_BF][l * 8 + hh];
        const float* fl = (const float*)(ws_ + WS_FLOG) + ((size_t)b * SEQ + 8 * F.tid) * 8 + hh;
        float lf[8];
#pragma unroll
        for (int i = 0; i < 8; ++i) lf[i] = fl[i * 8];
#pragma unroll
        for (int i = 0; i < 8; ++i) { lf[i] = -softplusf_(-(lf[i] + bf)); if (i) lf[i] += lf[i - 1]; }
        float incl = lf[7];
#pragma unroll
        for (int o = 1; o < 64; o <<= 1) { const float t = __shfl_up(incl, o); if (F.lane >= o) incl += t; }
        LAS float* wtot = (LAS float*)F.lds;
        if (F.lane == 63) wtot[F.wave] = incl;
        __syncthreads();
        float off = incl - lf[7];
        for (int w = 0; w < F.wave; ++w) off += wtot[w];
        float* bo = (float*)(ws_ + WS_BIAS) + ((size_t)b * 8 + hh) * SEQ + 8 * F.tid;
        f32x4 o0, o1;
        o0.x = -(off + lf[0]) * LOG2E; o0.y = -(off + lf[1]) * LOG2E; o0.z = -(off + lf[2]) * LOG2E; o0.w = -(off + lf[3]) * LOG2E;
        o1.x = -(off + lf[4]) * LOG2E; o1.y = -(off + lf[5]) * LOG2E; o1.z = -(off + lf[6]) * LOG2E; o1.w = -(off + lf[7]) * LOG2E;
        *(f32x4*)bo = o0; *(f32x4*)(bo + 4) = o1;
    }
    const int gw = F.vcu * NWAVES + F.wave, NGW = F.G * NWAVES;
    const float* mu = in_[I_MU] + l * 1024;
    f32x4 muv[4];
#pragma unroll
    for (int j = 0; j < 4; ++j) muv[j] = *(const f32x4*)(mu + 4 * F.lane + 256 * j);
    const f32x4 kkw = *(const f32x4*)(in_[I_KK] + l * 256 + 4 * F.lane);
    const bf16_t* ZR = (const bf16_t*)(ws_ + WS_ZR);
    const int hd = F.lane >> 4, cc = 4 * (F.lane & 15);
    const float act_a = (F.lane < 16) ? 2.f : 1.f, act_b = (F.lane < 16) ? -1.f : 0.f; const bool act_id = (F.lane >= 16 && F.lane < 32);
    for (int g = gw; g < NTOK / 8; g += NGW) {
        const int m0 = g * 8;
        u32x2 raw[9][4];
        const bool hasp = (m0 & (SEQ - 1)) != 0;
#pragma unroll
        for (int i = 0; i < 9; ++i)
#pragma unroll
            for (int j = 0; j < 4; ++j) raw[i][j] = (i > 0 || hasp) ? *(const u32x2*)(ZR + (size_t)(m0 - 1 + i) * 1024 + 4 * F.lane + 256 * j) : (u32x2){0u, 0u};
        f32x4 prev[4], cur[4];
#pragma unroll
        for (int j = 0; j < 4; ++j) prev[j] = unp4(raw[0][j]);
#pragma unroll
        for (int i = 0; i < 8; ++i) {
            const int m = m0 + i, b = m >> 12, t = m & (SEQ - 1);
#pragma unroll
            for (int j = 0; j < 4; ++j) cur[j] = unp4(raw[i + 1][j]);
            f32x4 zs[4];
#pragma unroll
            for (int j = 0; j < 4; ++j) zs[j] = cur[j] + (prev[j] - cur[j]) * muv[j];
            unsigned char* o = ws_ + WS_SCAN + ((size_t)(b * 4 + hd) * SEQ + t) * SCAN_ROW + cc * 2;
            *(u32x2*)(o) = pk4(zs[0]);
            *(u32x2*)(o + 128) = pk4(zs[1]);
            *(u32x2*)(o + 256) = pk4(zs[2]);
            f32x4 kk = zs[1] * kkw;
            const float ss = red16((kk.x * kk.x + kk.y * kk.y) + (kk.z * kk.z + kk.w * kk.w));
            kk = kk * (1.f / fmaxf(sqrtf(ss), 1e-12f));
            *(u32x2*)(o + 384) = pk4(kk);
            f32x4 a4;
#pragma unroll
            for (int q = 0; q < 4; ++q) { const float x = zs[3][q]; const float sg = 1.f / (1.f + __expf(-act_a * x)); a4[q] = act_id ? x : (act_a * sg + act_b); }
            u32x2 pk; pk.x = cvtpk(a4.x, a4.y); pk.y = cvtpk(a4.z, a4.w);
            *(u32x2*)((bf16_t*)(ws_ + WS_ALORA) + (size_t)m * 256 + 4 * F.lane) = pk;
#pragma unroll
            for (int j = 0; j < 4; ++j) prev[j] = cur[j];
        }
    }
}
struct ProbLora {
    const char* A; const char* Bt; int G, vcu;
    __device__ __forceinline__ bool next(int i, pg8::Unit& u) const { const int Lx = i * G + vcu; if (Lx >= 64 * 3) return false; u.pn = Lx % 3; u.pm = Lx / 3; u.e = 0; return true; }
    __device__ __forceinline__ const char* a_ptr(const pg8::Unit& u) const { return A + (size_t)u.pm * 256 * 512; }
    __device__ __forceinline__ const char* b_ptr(const pg8::Unit& u) const { return Bt + (size_t)u.pn * 256 * 512; }
};
struct EpiLora {
    unsigned char* ws; const float* w0; const float* a0; const float* ka;
    __device__ __forceinline__ void operator()(const f32x4 (&acc)[2][2][4][2], const pg8::Unit& u, int wr, int wc, int fr, int fq) const {
        const int pn = u.pn;
#pragma unroll
        for (int bj = 0; bj < 2; ++bj) {
            const int c = bj * 128 + wc * 32 + 8 * fq, hd = c >> 6, cc = c & 63;
            f32x4 p0 = (f32x4){0.f, 0.f, 0.f, 0.f}, p1 = p0, q0 = p0, q1 = p0;
            if (pn == 0) { p0 = *(const f32x4*)(w0 + c); p1 = *(const f32x4*)(w0 + c + 4); }
            else if (pn == 1) { p0 = *(const f32x4*)(a0 + c); p1 = *(const f32x4*)(a0 + c + 4); q0 = *(const f32x4*)(ka + c); q1 = *(const f32x4*)(ka + c + 4); }
#pragma unroll
            for (int ai = 0; ai < 2; ++ai)
#pragma unroll
                for (int m = 0; m < 4; ++m) {
                    const int row = u.pm * 256 + ai * 128 + wr * 64 + m * 16 + fr, b = row >> 12, t = row & (SEQ - 1);
                    const f32x4 v0 = acc[ai][bj][m][0], v1 = acc[ai][bj][m][1];
                    unsigned char* o = ws + WS_SCAN + ((size_t)(b * 4 + hd) * SEQ + t) * SCAN_ROW;
                    if (pn == 0) {
                        f32x4 d0, d1;
#pragma unroll
                        for (int i = 0; i < 4; ++i) { d0[i] = -__expf(-softplus_fast(-(p0[i] + v0[i])) - 0.5f); d1[i] = -__expf(-softplus_fast(-(p1[i] + v1[i])) - 0.5f); if (!CHUNKED_SCAN) { d0[i] = __expf(d0[i]); d1[i] = __expf(d1[i]); } }
                        *(f32x4*)(o + 640 + cc * 4) = d0; *(f32x4*)(o + 640 + cc * 4 + 16) = d1;
                    } else if (pn == 1) {
                        const u32x4 kp = *(const u32x4*)(o + 128 + cc * 2), np = *(const u32x4*)(o + 384 + cc * 2);
                        const f32x4 k0 = unp4((u32x2){kp.x, kp.y}), k1 = unp4((u32x2){kp.z, kp.w}), n0 = unp4((u32x2){np.x, np.y}), n1 = unp4((u32x2){np.z, np.w});
                        f32x4 a_0, a_1;
#pragma unroll
                        for (int i = 0; i < 4; ++i) { a_0[i] = sigmoidf_(p0[i] + v0[i]); a_1[i] = sigmoidf_(p1[i] + v1[i]); }
                        *(u32x4*)(o + 128 + cc * 2) = pk8(k0 * ((a_0 - 1.f) * q0 + 1.f), k1 * ((a_1 - 1.f) * q1 + 1.f));
                        *(u32x4*)(o + 512 + cc * 2) = pk8(-(n0 * a_0), -(n1 * a_1));
                    } else {
                        *(u32x4*)((bf16_t*)(ws + WS_G) + (size_t)row * 256 + c) = pk8(v0, v1);
                    }
                }
        }
    }
};

constexpr int SC_STEPS = 16, SC_CHUNK_F = SC_STEPS * 384, SC_NBUF = 5, SC_PPW = SC_STEPS * 6 / 16;
struct ScanIn { f32x4 r, w, k, kk, kb; float v; };
__device__ __forceinline__ ScanIn scan_ld(const LAS float* p, int ks, int row) {
    ScanIn x; x.r = *(const LAS f32x4*)(p + ks); x.w = *(const LAS f32x4*)(p + 64 + ks); x.k = *(const LAS f32x4*)(p + 128 + ks); x.kk = *(const LAS f32x4*)(p + 256 + ks); x.kb = *(const LAS f32x4*)(p + 320 + ks); x.v = p[192 + row]; return x;
}
__device__ __forceinline__ void scan_block(Frame& F, int rb) {
    refresh(F); unsigned char* ws_ = (unsigned char*)ldptr(F, 30);
    const int bh = rb >> 2, rg = rb & 3, b = bh >> 2, h = bh & 3;
    const float* src = (const float*)(ws_ + WS_SCAN) + (size_t)bh * SEQ * 384;
    LAS float* buf = (LAS float*)F.lds;
    constexpr int NCH = SEQ / SC_STEPS;
    if (F.wave >= 4) {
        const int lw = F.wave - 4;
#define SC_ISSUE(c, slot) do { _Pragma("unroll") for (int p_ = 0; p_ < SC_PPW; ++p_) { const int pc_ = lw * SC_PPW + p_; \
            __builtin_amdgcn_global_load_lds((const unsigned*)(src + (size_t)(c) * SC_CHUNK_F + pc_ * 256 + F.lane * 4), (LAS unsigned*)(buf + (slot) * SC_CHUNK_F + pc_ * 256), 16, 0, 0); } } while (0)
#pragma unroll
        for (int c = 0; c < SC_NBUF - 1; ++c) SC_ISSUE(c, c);
        asm volatile("s_waitcnt vmcnt(%0)" :: "n"((SC_NBUF - 2) * SC_PPW) : "memory");
        __builtin_amdgcn_s_barrier();
        int slot = SC_NBUF - 1;
        for (int c = 0; c < NCH; ++c) {
            if (c + SC_NBUF - 1 < NCH) { SC_ISSUE(c + SC_NBUF - 1, slot); asm volatile("s_waitcnt vmcnt(%0)" :: "n"((SC_NBUF - 2) * SC_PPW) : "memory"); }
            else asm volatile("s_waitcnt vmcnt(0)" ::: "memory");
            slot = (slot == SC_NBUF - 1) ? 0 : slot + 1;
            __builtin_amdgcn_s_barrier();
        }
#undef SC_ISSUE
    } else {
        const int row = rg * 16 + F.wave * 4 + (F.lane >> 4), ks = (F.lane & 15) * 4, l16 = F.lane & 15;
        f32x4 s = (f32x4){0.f, 0.f, 0.f, 0.f};
        float* yout = (float*)(ws_ + WS_YRAW) + (size_t)b * SEQ * 256 + 64 * h + row;
        float yp = 0.f;
        int slot = 0;
        __builtin_amdgcn_s_barrier();
        for (int c = 0; c < NCH; ++c) {
            const LAS float* base = buf + slot * SC_CHUNK_F;
            slot = (slot == SC_NBUF - 1) ? 0 : slot + 1;
            float ykeep = 0.f;
            ScanIn cur = scan_ld(base, ks, row);
#pragma unroll
            for (int st = 0; st < SC_STEPS; ++st) {
                ScanIn nxt = cur;
                if (st + 1 < SC_STEPS) nxt = scan_ld(base + (st + 1) * 384, ks, row);
                const f32x4 vk = cur.k * cur.v;
                const float t0 = s.x * cur.kk.x + s.y * cur.kk.y, t1 = s.z * cur.kk.z + s.w * cur.kk.w;
                const f32x4 u = s * cur.w + vk;
                float sa = t0 + t1;
                red16_pair(sa, yp);
                ykeep = (l16 == st) ? yp : ykeep;
                s = u + cur.kb * sa;
                const float y0 = s.x * cur.r.x + s.y * cur.r.y, y1 = s.z * cur.r.z + s.w * cur.r.w;
                yp = y0 + y1;
                cur = nxt;
            }
            { const int g = c * SC_STEPS + l16 - 1; if (l16 < SC_STEPS && g >= 0) yout[(size_t)g * 256] = ykeep; }
            __builtin_amdgcn_s_barrier();
        }
        yp = red16(yp);
        if (l16 == 0) yout[(size_t)(SEQ - 1) * 256] = yp;
    }
}


__device__ __forceinline__ int crow(int r, int hi) { return (r & 3) + 8 * (r >> 2) + 4 * hi; }
constexpr int CK_P = 144, CK_A = 64 * CK_P;
enum { CA_KKP = 0, CA_RP, CA_BI, CA_KI, CA_VT, CA_KKPT, CA_BHT, CA_KHT, CA_TB, CA_AUK, CA_ARB, CA_ARK, CA_TF0, CA_TF1, CA_N,
       CA_W1T = CA_KKP, CA_MT = CA_BI, CA_U0T = CA_KI,
       CA_D1T = CA_BI, CA_X1T = CA_KI };
constexpr int CK_TF = CA_TF0 * CK_A;
static_assert(CA_N * CK_A <= 139264 && 64 * 68 * 4 <= 2 * CK_A, "chunk LDS map");
__device__ __forceinline__ f32x16 ck_mma(const LAS unsigned char* A, const LAS unsigned char* B, int ksteps, f32x16 acc, int r32, int hi) {
#pragma unroll 4
    for (int s = 0; s < ksteps; ++s) {
        const bf16x8 a = *(const LAS bf16x8*)(A + r32 * CK_P + (16 * s + 8 * hi) * 2);
        const bf16x8 b = *(const LAS bf16x8*)(B + r32 * CK_P + (16 * s + 8 * hi) * 2);
        acc = __builtin_amdgcn_mfma_f32_32x32x16_bf16(a, b, acc, 0, 0, 0);
    }
    return acc;
}
__device__ __forceinline__ void ck_store_t(LAS unsigned char* dst, const f32x16& c, int R0, int C0, int r32, int hi) {
#pragma unroll
    for (int g = 0; g < 4; ++g) { u32x2 w; w.x = cvtpk(c[4 * g], c[4 * g + 1]); w.y = cvtpk(c[4 * g + 2], c[4 * g + 3]); *(LAS u32x2*)(dst + (C0 + r32) * CK_P + (R0 + 8 * g + 4 * hi) * 2) = w; }
}
#define STAMPF(F_, id) do { if (PROBE_T >= 20 && blockIdx.x == 0 && (F_).tid == 0) { volatile LAS unsigned long long* tsw_ = (volatile LAS unsigned long long*)((F_).lds + MISC_OFF + 192); const unsigned long long now_ = wall_clock64(); if ((id) == PROBE_T) tsw_[1] += now_ - tsw_[0]; tsw_[0] = now_; } } while (0)
struct ChunkRows { u32x4 r, k, v, kk, kb; f32x4 w[2]; };
__device__ __forceinline__ ChunkRows chunk_load(Frame& F, unsigned char* ws_, int job) {
    const int t = F.tid & 63, c0 = (F.tid >> 6) * 8, bh = job >> 6, ch = job & 63;
    const unsigned char* row = ws_ + WS_SCAN + ((size_t)bh * SEQ + (size_t)ch * 64 + t) * SCAN_ROW;
    ChunkRows x;
    x.r = *(const u32x4*)(row + c0 * 2); x.k = *(const u32x4*)(row + 128 + c0 * 2); x.v = *(const u32x4*)(row + 256 + c0 * 2); x.kk = *(const u32x4*)(row + 384 + c0 * 2); x.kb = *(const u32x4*)(row + 512 + c0 * 2);
    x.w[0] = *(const f32x4*)(row + 640 + c0 * 4); x.w[1] = *(const f32x4*)(row + 640 + c0 * 4 + 16);
    return x;
}
__device__ __forceinline__ void chunk_job(Frame& F, unsigned char* ws_, int job, const ChunkRows& in) {
    LAS unsigned char* L = F.lds;
    LAS float* Tf = (LAS float*)(L + CK_TF);
    const int tid = F.tid, lane = F.lane, wave = F.wave, r32 = lane & 31, hi = lane >> 5;
    {
        const int t = tid & 63, c0 = (tid >> 6) * 8;
        float r_[8], k_[8], v_[8], kk_[8], kb_[8], Lt[8];
#pragma unroll
        for (int q = 0; q < 2; ++q) {
            const f32x4 r4 = unp4((u32x2){in.r[2 * q], in.r[2 * q + 1]}), k4 = unp4((u32x2){in.k[2 * q], in.k[2 * q + 1]}), v4 = unp4((u32x2){in.v[2 * q], in.v[2 * q + 1]}), n4 = unp4((u32x2){in.kk[2 * q], in.kk[2 * q + 1]}), b4 = unp4((u32x2){in.kb[2 * q], in.kb[2 * q + 1]});
#pragma unroll
            for (int i = 0; i < 4; ++i) { r_[4 * q + i] = r4[i]; k_[4 * q + i] = k4[i]; v_[4 * q + i] = v4[i]; kk_[4 * q + i] = n4[i]; kb_[4 * q + i] = -b4[i]; Lt[4 * q + i] = in.w[q][i]; }
        }
#pragma unroll
        for (int i = 0; i < 8; ++i) {
            float x = Lt[i];
            x += __builtin_bit_cast(float, __builtin_amdgcn_update_dpp(0, __builtin_bit_cast(int, x), 0x111, 0xf, 0xf, true));
            x += __builtin_bit_cast(float, __builtin_amdgcn_update_dpp(0, __builtin_bit_cast(int, x), 0x112, 0xf, 0xf, true));
            x += __builtin_bit_cast(float, __builtin_amdgcn_update_dpp(0, __builtin_bit_cast(int, x), 0x114, 0xf, 0xf, true));
            x += __builtin_bit_cast(float, __builtin_amdgcn_update_dpp(0, __builtin_bit_cast(int, x), 0x118, 0xf, 0xf, true));
            const float r0 = __builtin_bit_cast(float, __builtin_amdgcn_readlane(__builtin_bit_cast(int, x), 15)), r1 = __builtin_bit_cast(float, __builtin_amdgcn_readlane(__builtin_bit_cast(int, x), 31)), r2 = __builtin_bit_cast(float, __builtin_amdgcn_readlane(__builtin_bit_cast(int, x), 47));
            const int rw = lane >> 4;
            x += (rw >= 1 ? r0 : 0.f) + (rw >= 2 ? r1 : 0.f) + (rw >= 3 ? r2 : 0.f);
            Lt[i] = x;
        }
        float kkp[8], rp[8], bi[8], ki[8], bh_[8], kh_[8];
#pragma unroll
        for (int i = 0; i < 8; ++i) {
            const float Lm0 = __shfl_up(Lt[i], 1); const float Lm = (lane > 0) ? Lm0 : 0.f; const float Lc = __shfl(Lt[i], 63);
            const float ip = __expf(-Lt[i]);
            kkp[i] = kk_[i] * __expf(Lm); rp[i] = r_[i] * __expf(Lt[i]); bi[i] = kb_[i] * ip; ki[i] = k_[i] * ip;
            const float pc = __expf(Lc - Lt[i]); bh_[i] = kb_[i] * pc; kh_[i] = k_[i] * pc;
            if (t == 63) ((LAS float*)(L + PCV_OFF))[c0 + i] = __expf(Lc);
        }
#define CK_ROW8(arr, vals_) do { u32x4 w_ = (u32x4){cvtpk(vals_[0], vals_[1]), cvtpk(vals_[2], vals_[3]), cvtpk(vals_[4], vals_[5]), cvtpk(vals_[6], vals_[7])}; *(LAS u32x4*)(L + (arr) * CK_A + t * CK_P + c0 * 2) = w_; } while (0)
#define CK_COL8(arr, vals_) do { _Pragma("unroll") for (int i_ = 0; i_ < 8; ++i_) *(LAS unsigned short*)(L + (arr) * CK_A + (c0 + i_) * CK_P + t * 2) = (unsigned short)cvtpk(vals_[i_], 0.f); } while (0)
        CK_ROW8(CA_KKP, kkp); CK_ROW8(CA_RP, rp); CK_ROW8(CA_BI, bi); CK_ROW8(CA_KI, ki);
        CK_COL8(CA_VT, v_); CK_COL8(CA_KKPT, kkp); CK_COL8(CA_BHT, bh_); CK_COL8(CA_KHT, kh_);
#undef CK_ROW8
#undef CK_COL8
    }
    __syncthreads(); STAMPF(F, 20);
#pragma unroll
    for (int q = 0; q < 2; ++q) {
        const int id = wave * 2 + q, which = id >> 2, tj = (id >> 1) & 1, tt = id & 1;
        const LAS unsigned char* Aop = L + ((which & 1) ? CA_KI : CA_BI) * CK_A + tj * 32 * CK_P;
        const LAS unsigned char* Bop = L + ((which & 2) ? CA_RP : CA_KKP) * CK_A + tt * 32 * CK_P;
        f32x16 c = {}; c = ck_mma(Aop, Bop, 4, c, r32, hi);
        const int t = tt * 32 + r32;
#pragma unroll
        for (int i = 0; i < 16; ++i) { const int j = tj * 32 + crow(i, hi); const bool keep = (which & 2) ? (j <= t) : (j < t); if (!keep) c[i] = 0.f; }
        if (which == 0) {
#pragma unroll
            for (int g = 0; g < 4; ++g) { const int j0 = tj * 32 + 8 * g + 4 * hi; Tf[t * 68 + j0] = c[4 * g]; Tf[t * 68 + j0 + 1] = c[4 * g + 1]; Tf[t * 68 + j0 + 2] = c[4 * g + 2]; Tf[t * 68 + j0 + 3] = c[4 * g + 3]; }
        } else ck_store_t(L + ((which == 1) ? CA_AUK : (which == 2) ? CA_ARB : CA_ARK) * CK_A, c, tj * 32, tt * 32, r32, hi);
    }
    __syncthreads(); STAMPF(F, 21);
    LAS unsigned char* TB = L + CA_TB * CK_A;
    if (wave == 4) {
        const int blk = lane >> 5, c = lane & 31;
        const LAS float* ab = Tf + blk * (32 * 68 + 32);
        float x[32];
#pragma unroll
        for (int t = 0; t < 32; ++t) x[t] = 0.f;
#pragma unroll
        for (int t = 0; t < 32; ++t) {
            int z = 0;
            if (t >= 2) asm volatile("" : "+v"(z) : "v"(x[t - 2]));
            const LAS float* rowp = ab + t * 68 + z;
            float a0 = (t == c) ? 1.f : 0.f, a1 = 0.f, a2 = 0.f, a3 = 0.f;
#pragma unroll
            for (int j = 0; j < t; j += 4) { const f32x4 a4 = *(const LAS f32x4*)(rowp + j);
                a0 -= a4.x * x[j]; a1 -= a4.y * x[j + 1]; a2 -= a4.z * x[j + 2]; a3 -= a4.w * x[j + 3]; }
            x[t] = (a0 + a1) + (a2 + a3);
        }
#pragma unroll
        for (int t = 0; t < 32; ++t) *(LAS unsigned short*)(TB + (32 * blk + t) * CK_P + (32 * blk + c) * 2) = (unsigned short)f2bf(x[t]);
        if (blk == 0) {
#pragma unroll
            for (int t8 = 0; t8 < 4; ++t8) { const u32x4 w_ = (u32x4){cvtpk(x[8 * t8], x[8 * t8 + 1]), cvtpk(x[8 * t8 + 2], x[8 * t8 + 3]), cvtpk(x[8 * t8 + 4], x[8 * t8 + 5]), cvtpk(x[8 * t8 + 6], x[8 * t8 + 7])}; *(LAS u32x4*)(L + CA_D1T * CK_A + c * CK_P + t8 * 16) = w_; }
        } else {
#pragma unroll
            for (int t8 = 0; t8 < 4; ++t8) *(LAS u32x4*)(TB + c * CK_P + 64 + t8 * 16) = (u32x4){0u, 0u, 0u, 0u};
        }
    } else if (wave < 4) {
        const int tt = wave >> 1, tv = wave & 1;
        f32x16 c = {}; c = ck_mma(L + CA_AUK * CK_A + tt * 32 * CK_P, L + CA_VT * CK_A + tv * 32 * CK_P, 4, c, r32, hi);
        ck_store_t(L + CA_W1T * CK_A, c, tt * 32, tv * 32, r32, hi);
    }
    __syncthreads(); STAMPF(F, 22);
    if (wave == 0) {
        f32x16 c = {};
#pragma unroll
        for (int s = 0; s < 2; ++s) {
            const f32x4 f0 = *(const LAS f32x4*)(Tf + (32 + r32) * 68 + 16 * s + 8 * hi), f1 = *(const LAS f32x4*)(Tf + (32 + r32) * 68 + 16 * s + 8 * hi + 4);
            const u32x4 aw = (u32x4){cvtpk(f0.x, f0.y), cvtpk(f0.z, f0.w), cvtpk(f1.x, f1.y), cvtpk(f1.z, f1.w)};
            const bf16x8 b = *(const LAS bf16x8*)(L + CA_D1T * CK_A + r32 * CK_P + (16 * s + 8 * hi) * 2);
            c = __builtin_amdgcn_mfma_f32_32x32x16_bf16(__builtin_bit_cast(bf16x8, aw), b, c, 0, 0, 0);
        }
        ck_store_t(L + CA_X1T * CK_A, c, 0, 0, r32, hi);
    }
    __syncthreads(); STAMPF(F, 23);
    if (wave == 0) {
        f32x16 c = {}; c = ck_mma(L + CA_X1T * CK_A, TB + 32 * CK_P + 64, 2, c, r32, hi);
#pragma unroll
        for (int i = 0; i < 16; ++i) c[i] = -c[i];
        ck_store_t(TB + 32 * CK_P, c, 0, 0, r32, hi);
    }
    __syncthreads(); STAMPF(F, 24);
    {
        const int which = wave >> 2, tt = (wave >> 1) & 1, tc = wave & 1;
        f32x16 c = {}; c = ck_mma(L + CA_TB * CK_A + tt * 32 * CK_P, L + (which ? CA_W1T : CA_KKPT) * CK_A + tc * 32 * CK_P, 4, c, r32, hi);
        if (which) {
#pragma unroll
            for (int i = 0; i < 16; ++i) c[i] = -c[i];
        }
        ck_store_t(L + (which ? CA_U0T : CA_MT) * CK_A, c, tt * 32, tc * 32, r32, hi);
    }
    __syncthreads(); STAMPF(F, 25);
    const size_t jb = (size_t)job;
#pragma unroll
    for (int q = 0; q < 2; ++q) {
        const int id = wave * 2 + q, which = id >> 2, ta = (id >> 1) & 1, tb = id & 1;
        f32x16 c = {};
        if (which == 0) {
            c = ck_mma(L + CA_MT * CK_A + ta * 32 * CK_P, L + CA_BHT * CK_A + tb * 32 * CK_P, 4, c, r32, hi);
            const int k2 = tb * 32 + r32; const float pcv = ((const LAS float*)(L + PCV_OFF))[k2];
            bf16_t* o = (bf16_t*)(ws_ + WS_CPG + jb * 24576) + (size_t)k2 * 64;
#pragma unroll
            for (int g = 0; g < 4; ++g) { const int k1 = ta * 32 + 8 * g + 4 * hi; float x[4];
#pragma unroll
                for (int i = 0; i < 4; ++i) x[i] = ((k1 + i == k2) ? pcv : 0.f) - c[4 * g + i];
                u32x2 w_; w_.x = cvtpk(x[0], x[1]); w_.y = cvtpk(x[2], x[3]); *(u32x2*)(o + k1) = w_; }
        } else if (which == 1) {
            c = ck_mma(L + CA_BHT * CK_A + ta * 32 * CK_P, L + CA_U0T * CK_A + tb * 32 * CK_P, 4, c, r32, hi);
            c = ck_mma(L + CA_KHT * CK_A + ta * 32 * CK_P, L + CA_VT * CK_A + tb * 32 * CK_P, 4, c, r32, hi);
            float* o = (float*)(ws_ + WS_CPG + jb * 24576 + 8192) + (size_t)(ta * 32) * 64 + tb * 32 + r32;
#pragma unroll
            for (int i = 0; i < 16; ++i) o[crow(i, hi) * 64] = c[i];
        } else if (which == 2) {
            c = ck_mma(L + CA_MT * CK_A + ta * 32 * CK_P, L + CA_ARB * CK_A + tb * 32 * CK_P, 4, c, r32, hi);
            const int t = tb * 32 + r32;
            bf16_t* o = (bf16_t*)(ws_ + WS_CPSI) + jb * 4096 + (size_t)t * 64;
#pragma unroll
            for (int g = 0; g < 4; ++g) { const int k0 = ta * 32 + 8 * g + 4 * hi; const u32x2 rp2 = *(const LAS u32x2*)(L + CA_RP * CK_A + t * CK_P + k0 * 2);
                const float r0 = __builtin_bit_cast(float, rp2.x << 16), r1 = __builtin_bit_cast(float, rp2.x & 0xffff0000u), r2 = __builtin_bit_cast(float, rp2.y << 16), r3 = __builtin_bit_cast(float, rp2.y & 0xffff0000u);
                u32x2 w_; w_.x = cvtpk(r0 - c[4 * g], r1 - c[4 * g + 1]); w_.y = cvtpk(r2 - c[4 * g + 2], r3 - c[4 * g + 3]); *(u32x2*)(o + k0) = w_; }
        } else {
            c = ck_mma(L + CA_ARB * CK_A + ta * 32 * CK_P, L + CA_U0T * CK_A + tb * 32 * CK_P, 4, c, r32, hi);
            c = ck_mma(L + CA_ARK * CK_A + ta * 32 * CK_P, L + CA_VT * CK_A + tb * 32 * CK_P, 4, c, r32, hi);
            float* o = (float*)(ws_ + WS_CY0) + jb * 4096 + (size_t)(ta * 32) * 64 + tb * 32 + r32;
#pragma unroll
            for (int i = 0; i < 16; ++i) o[crow(i, hi) * 64] = c[i];
        }
    }
    __syncthreads(); STAMPF(F, 26);
}


constexpr int S2_REC = 24576, S2_NSLOT = 4, S2_SB = S2_NSLOT * S2_REC;
__device__ __forceinline__ void chunk_states(Frame& F, unsigned char* ws_, int bh) {
    LAS unsigned char* L = F.lds;
    LAS unsigned char* Sb = L + S2_SB;
    const int tid = F.tid, lane = F.lane, wave = F.wave, r32 = lane & 31, hi = lane >> 5;
    for (int i = tid; i < 64 * CK_P / 4; i += NTHR) ((LAS unsigned*)Sb)[i] = 0u;
    const unsigned char* rec0 = ws_ + WS_CPG + (size_t)bh * 64 * S2_REC;
#define S2_ISSUE(c) do { if (wave >= 4) { _Pragma("unroll") for (int p_ = 0; p_ < 6; ++p_) { const int pc_ = (wave - 4) * 6 + p_; \
        __builtin_amdgcn_global_load_lds((const unsigned*)(rec0 + (size_t)(c) * S2_REC + pc_ * 1024 + lane * 16), (LAS unsigned*)(L + ((c) & (S2_NSLOT - 1)) * S2_REC + pc_ * 1024), 16, 0, 0); } } } while (0)
    S2_ISSUE(0); S2_ISSUE(1); S2_ISSUE(2);
    if (wave >= 4) asm volatile("s_waitcnt vmcnt(12)" ::: "memory");
    __syncthreads();
    const int ti = wave >> 1, tj = wave & 1;
    for (int c = 0; c < 64; ++c) {
        if (c + 3 < 64) { S2_ISSUE(c + 3); if (wave >= 4) asm volatile("s_waitcnt vmcnt(12)" ::: "memory"); }
        else if (wave >= 4) asm volatile("s_waitcnt vmcnt(0)" ::: "memory");
        { const int row = tid >> 3, ch = tid & 7; *(u32x4*)((bf16_t*)(ws_ + WS_CS) + ((size_t)bh * 64 + c) * 4096 + row * 64 + ch * 8) = *(const LAS u32x4*)(Sb + row * CK_P + ch * 16); }
        f32x16 acc = {};
        if (wave < 4) {
            const LAS unsigned char* R = L + (c & (S2_NSLOT - 1)) * S2_REC;
            const LAS float* G = (const LAS float*)(R + 8192);
#pragma unroll
            for (int i = 0; i < 16; ++i) acc[i] = G[(ti * 32 + crow(i, hi)) * 64 + tj * 32 + r32];
#pragma unroll
            for (int s = 0; s < 4; ++s) {
                const bf16x8 a = *(const LAS bf16x8*)(R + (ti * 32 + r32) * 128 + (16 * s + 8 * hi) * 2);
                const bf16x8 b = *(const LAS bf16x8*)(Sb + (tj * 32 + r32) * CK_P + (16 * s + 8 * hi) * 2);
                acc = __builtin_amdgcn_mfma_f32_32x32x16_bf16(a, b, acc, 0, 0, 0);
            }
        }
        __syncthreads();
        if (wave < 4) ck_store_t(Sb, acc, ti * 32, tj * 32, r32, hi);
        __syncthreads();
    }
#undef S2_ISSUE
}
struct OutOps { bf16x8 a[4], b[4]; f32x16 acc; };
struct PostOps { float vv[16], rr[16], kk[16], gg[16]; };
__device__ __forceinline__ OutOps out_load(Frame& F, unsigned char* ws_, int job, int w4) {
    const int lane = F.lane, r32 = lane & 31, hi = lane >> 5, tt = w4 >> 1, tv = w4 & 1;
    const bf16_t* Psi = (const bf16_t*)(ws_ + WS_CPSI) + (size_t)job * 4096; const bf16_t* CS = (const bf16_t*)(ws_ + WS_CS) + (size_t)job * 4096; const float* Y0 = (const float*)(ws_ + WS_CY0) + (size_t)job * 4096;
    OutOps o;
#pragma unroll
    for (int s = 0; s < 4; ++s) { o.a[s] = *(const bf16x8*)(Psi + (tt * 32 + r32) * 64 + 16 * s + 8 * hi); o.b[s] = *(const bf16x8*)(CS + (tv * 32 + r32) * 64 + 16 * s + 8 * hi); }
#pragma unroll
    for (int i = 0; i < 16; ++i) o.acc[i] = Y0[(tt * 32 + crow(i, hi)) * 64 + tv * 32 + r32];
    return o;
}
__device__ __forceinline__ PostOps post_load(Frame& F, unsigned char* ws_, int job, int w4) {
    const int c = F.lane, bh = job >> 6, ch = job & 63, b = bh >> 2, h = bh & 3;
    const unsigned char* SCN = ws_ + WS_SCAN + ((size_t)bh * SEQ + (size_t)ch * 64 + w4 * 16) * SCAN_ROW + c * 2; const bf16_t* GG = (const bf16_t*)(ws_ + WS_G) + ((size_t)b * SEQ + (size_t)ch * 64 + w4 * 16) * 256 + 64 * h + c;
    PostOps p;
#pragma unroll
    for (int u = 0; u < 16; ++u) { const unsigned char* sp = SCN + (size_t)u * SCAN_ROW; p.vv[u] = bf2f(*(const unsigned short*)(sp + 256)); p.rr[u] = bf2f(*(const unsigned short*)sp); p.kk[u] = bf2f(*(const unsigned short*)(sp + 128)); p.gg[u] = bf2f(GG[(size_t)u * 256]); }
    return p;
}
__device__ __forceinline__ void out_compute(Frame& F, const OutOps& o, int w4) {
    const int lane = F.lane, r32 = lane & 31, hi = lane >> 5, tt = w4 >> 1, tv = w4 & 1;
    f32x16 acc = o.acc;
#pragma unroll
    for (int s = 0; s < 4; ++s) acc = __builtin_amdgcn_mfma_f32_32x32x16_bf16(o.a[s], o.b[s], acc, 0, 0, 0);
    LAS float* yl = (LAS float*)F.lds + (F.wave >> 2) * 4096 + (tt * 32) * 64 + tv * 32 + r32;
#pragma unroll
    for (int i = 0; i < 16; ++i) yl[crow(i, hi) * 64] = acc[i];
}
__device__ __forceinline__ void post_compute(Frame& F, const InTab& in_, unsigned char* ws_, int l, int job, int w4, const PostOps& p) {
    const int c = F.lane, bh = job >> 6, ch = job & 63, b = bh >> 2, h = bh & 3;
    const float lw = in_[I_LNW][l * 256 + 64 * h + c], lb = in_[I_LNB][l * 256 + 64 * h + c], rkw = in_[I_RK][l * 256 + 64 * h + c];
    const LAS float* yimg = (const LAS float*)F.lds + (F.wave >> 2) * 4096 + (w4 * 16) * 64 + c;
    bf16_t* MX = (bf16_t*)(ws_ + WS_MIXED) + ((size_t)b * SEQ + (size_t)ch * 64 + w4 * 16) * 1024 + 64 * h + c;
#pragma unroll
    for (int u = 0; u < 16; ++u) {
        const float y = yimg[u * 64];
        const float mean = wave_sum(y) * (1.f / 64.f); const float d = y - mean; const float var = wave_sum(d * d) * (1.f / 64.f);
        float yn = d * (1.f / sqrtf(var + 64e-5f)) * lw + lb;
        yn += wave_sum(p.rr[u] * p.kk[u] * rkw) * p.vv[u];
        yn *= p.gg[u];
        MX[(size_t)u * 1024] = (bf16_t)f2bf(yn);
    }
}

constexpr int AT_ROWB = 144;
constexpr int AT_KOFF = 0, AT_VOFF = 2 * 64 * AT_ROWB, AT_BOFF = 4 * 64 * AT_ROWB, AT_QUEUE = AT_BOFF + 2 * 256;
__device__ __forceinline__ void attn_unit(Frame& F, int b, int h, int qb) {
    refresh(F); unsigned char* ws_ = (unsigned char*)ldptr(F, 30); const InTab in_{F.lds}; gu32* ctl_ = (gu32*)ws_;

    const int lane = F.lane, r32 = lane & 31, hi = lane >> 5, wid = F.wave, tid = F.tid;
    const bf16_t* Q = (const bf16_t*)(ws_ + WS_Q); const bf16_t* Kg = (const bf16_t*)(ws_ + WS_K); const bf16_t* Vg = (const bf16_t*)(ws_ + WS_V);
    const float* BI = (const float*)(ws_ + WS_BIAS) + ((size_t)b * 8 + h) * SEQ;
    const size_t rowbase = (size_t)b * SEQ; const int q0 = qb * 256, qw0 = q0 + wid * 32;
    LAS unsigned char* lds = F.lds;
    bf16x8 qr[4];
#pragma unroll
    for (int d0 = 0; d0 < 4; ++d0) qr[d0] = *(const bf16x8*)(Q + (rowbase + qw0 + r32) * 512 + h * 64 + d0 * 16 + hi * 8);
    const int NT = (q0 + 256) / 64;
    int T0 = 0;
    { const float nbq = BI[q0]; const float vlast = (lane < NT) ? BI[64 * lane + 63] : 3.0e38f;
      const unsigned long long ok = __ballot(vlast - nbq >= -150.f);
      T0 = ok ? (int)(__ffsll((long long)ok) - 1) : 0; T0 = __builtin_amdgcn_readfirstlane(T0); }
    const int srow = tid >> 3, sch = tid & 7;
    const bf16_t* kp = Kg + (rowbase + srow) * 512 + h * 64 + sch * 8; const bf16_t* vp = Vg + (rowbase + srow) * 512 + h * 64 + sch * 8;
    u32x4 kreg = *(const u32x4*)(kp + (size_t)T0 * 64 * 512), vreg = *(const u32x4*)(vp + (size_t)T0 * 64 * 512); float breg = (tid < 64) ? BI[T0 * 64 + tid] : 0.f;
    { const int b0_ = T0 & 1;
      *(LAS u32x4*)(lds + AT_KOFF + b0_ * 64 * AT_ROWB + srow * AT_ROWB + sch * 16) = kreg; *(LAS u32x4*)(lds + AT_VOFF + b0_ * 64 * AT_ROWB + srow * AT_ROWB + sch * 16) = vreg;
      if (tid < 64) *(LAS float*)(lds + AT_BOFF + b0_ * 256 + tid * 4) = breg; }
    __syncthreads();
    f32x16 o0 = {}, o1 = {};
    float nbi = BI[qw0 + r32];
    float lrun = 0.f;
    const int i16 = lane & 15, tq = i16 >> 2, tp = i16 & 3, blk = (lane >> 4) & 1;
    for (int t = T0; t < NT; ++t) {
        const int cb = t & 1, nb = cb ^ 1;
        if (t + 1 < NT) { kreg = *(const u32x4*)(kp + (size_t)(t + 1) * 64 * 512); vreg = *(const u32x4*)(vp + (size_t)(t + 1) * 64 * 512); if (tid < 64) breg = BI[(t + 1) * 64 + tid]; }
        if (64 * t <= qw0 + 31) {
            const LAS unsigned char* Ks = lds + AT_KOFF + cb * 64 * AT_ROWB; const LAS unsigned char* Vs = lds + AT_VOFF + cb * 64 * AT_ROWB; const LAS float* Bs = (const LAS float*)(lds + AT_BOFF + cb * 256);
            f32x16 p0, p1;
#pragma unroll
            for (int g = 0; g < 4; ++g) {
                const f32x4 b0 = *(const LAS f32x4*)(Bs + 8 * g + 4 * hi), b1 = *(const LAS f32x4*)(Bs + 32 + 8 * g + 4 * hi);
#pragma unroll
                for (int i = 0; i < 4; ++i) { p0[4 * g + i] = b0[i] - nbi; p1[4 * g + i] = b1[i] - nbi; }
            }
#pragma unroll
            for (int d0 = 0; d0 < 4; ++d0) {
                const bf16x8 a0 = *(const LAS bf16x8*)(Ks + r32 * AT_ROWB + (d0 * 16 + hi * 8) * 2);
                const bf16x8 a1 = *(const LAS bf16x8*)(Ks + (32 + r32) * AT_ROWB + (d0 * 16 + hi * 8) * 2);
                p0 = __builtin_amdgcn_mfma_f32_32x32x16_bf16(a0, qr[d0], p0, 0, 0, 0);
                p1 = __builtin_amdgcn_mfma_f32_32x32x16_bf16(a1, qr[d0], p1, 0, 0, 0);
            }
            if (64 * t + 63 > qw0) {
                const int qabs = qw0 + r32;
#pragma unroll
                for (int i = 0; i < 16; ++i) { const int kv = 64 * t + crow(i, hi); if (kv > qabs) p0[i] = -INFINITY; if (kv + 32 > qabs) p1[i] = -INFINITY; }
            }
            float mx = fmaxf(fmaxf(p0[0], p0[1]), p1[0]);
#pragma unroll
            for (int i = 1; i < 16; ++i) mx = fmaxf(fmaxf(mx, p0[i]), p1[i]);
            if (__any(mx > 24.f)) {
                const float mo = fmaxf(mx, __shfl_xor(mx, 32));
                const float dl = fmaxf(mo, 0.f);
                nbi += dl;
                const float f = __builtin_amdgcn_exp2f(-dl);
                lrun *= f;
#pragma unroll
                for (int i = 0; i < 16; ++i) { p0[i] -= dl; p1[i] -= dl; o0[i] *= f; o1[i] *= f; }
            }
            float ls0 = 0.f, ls1 = 0.f;
#pragma unroll
            for (int i = 0; i < 16; ++i) { p0[i] = __builtin_amdgcn_exp2f(p0[i]); p1[i] = __builtin_amdgcn_exp2f(p1[i]); ls0 += p0[i]; ls1 += p1[i]; }
            lrun += ls0 + ls1;
            bf16x8 pf[4];
#pragma unroll
            for (int s = 0; s < 2; ++s) {
                u32x4 w0, w1;
                w0.x = cvtpk(p0[8 * s + 0], p0[8 * s + 1]); w0.y = cvtpk(p0[8 * s + 2], p0[8 * s + 3]); w0.z = cvtpk(p0[8 * s + 4], p0[8 * s + 5]); w0.w = cvtpk(p0[8 * s + 6], p0[8 * s + 7]);
                w1.x = cvtpk(p1[8 * s + 0], p1[8 * s + 1]); w1.y = cvtpk(p1[8 * s + 2], p1[8 * s + 3]); w1.z = cvtpk(p1[8 * s + 4], p1[8 * s + 5]); w1.w = cvtpk(p1[8 * s + 6], p1[8 * s + 7]);
                pf[s] = __builtin_bit_cast(bf16x8, w0); pf[2 + s] = __builtin_bit_cast(bf16x8, w1);
            }
#pragma unroll
            for (int ks4 = 0; ks4 < 4; ++ks4) {
                const int kvb = (ks4 >> 1) * 32 + (ks4 & 1) * 16 + 4 * hi;
#pragma unroll
                for (int d0 = 0; d0 < 2; ++d0) {
                    const LAS unsigned char* a_lo = Vs + (kvb + tq) * AT_ROWB + (32 * d0 + 16 * blk) * 2 + 8 * tp;
                    const s16x4 lo = __builtin_bit_cast(s16x4, __builtin_amdgcn_ds_read_tr16_b64_v4i16((LAS s16x4*)a_lo));
                    const s16x4 hv = __builtin_bit_cast(s16x4, __builtin_amdgcn_ds_read_tr16_b64_v4i16((LAS s16x4*)(a_lo + 8 * AT_ROWB)));
                    const bf16x8 va = __builtin_shufflevector(lo, hv, 0, 1, 2, 3, 4, 5, 6, 7);
                    if (d0 == 0) o0 = __builtin_amdgcn_mfma_f32_32x32x16_bf16(va, pf[ks4], o0, 0, 0, 0);
                    else o1 = __builtin_amdgcn_mfma_f32_32x32x16_bf16(va, pf[ks4], o1, 0, 0, 0);
                }
            }
        }
        if (t + 1 < NT) {
            *(LAS u32x4*)(lds + AT_KOFF + nb * 64 * AT_ROWB + srow * AT_ROWB + sch * 16) = kreg; *(LAS u32x4*)(lds + AT_VOFF + nb * 64 * AT_ROWB + srow * AT_ROWB + sch * 16) = vreg;
            if (tid < 64) *(LAS float*)(lds + AT_BOFF + nb * 256 + tid * 4) = breg;
        }
        __syncthreads();
    }
    lrun += __shfl_xor(lrun, 32);
    const float inv = 1.f / lrun;
    bf16_t* O = (bf16_t*)(ws_ + WS_MIXED) + (rowbase + qw0 + r32) * 1024 + 512 + h * 64;
#pragma unroll
    for (int g = 0; g < 4; ++g) {
        u32x2 w; w.x = cvtpk(o0[4 * g] * inv, o0[4 * g + 1] * inv); w.y = cvtpk(o0[4 * g + 2] * inv, o0[4 * g + 3] * inv);
        *(u32x2*)(O + 8 * g + 4 * hi) = w;
        u32x2 w2; w2.x = cvtpk(o1[4 * g] * inv, o1[4 * g + 1] * inv); w2.y = cvtpk(o1[4 * g + 2] * inv, o1[4 * g + 3] * inv);
        *(u32x2*)(O + 32 + 8 * g + 4 * hi) = w2;
    }
}
__device__ __forceinline__ void pool_batch(Frame& F, const InTab& in_, unsigned char* ws_, int l, int q) {
    LAS float* Wp = (LAS float*)F.lds;
    LAS float* ps = (LAS float*)(F.lds + 65536) + F.wave * 512;
    { const float* w = in_[I_POOLW] + (size_t)l * 4 * 64 * 64; f32x4 t8[8];
#pragma unroll
      for (int u = 0; u < 8; ++u) t8[u] = *(const f32x4*)(w + 4 * (F.tid + NTHR * u));
#pragma unroll
      for (int u = 0; u < 8; ++u) *(LAS f32x4*)(Wp + 4 * (F.tid + NTHR * u)) = t8[u]; }
    __syncthreads();
    const int c = F.lane;
    bf16_t* MX = (bf16_t*)(ws_ + WS_MIXED);
    const float* ZP = (const float*)(ws_ + WS_ZP);
    for (int jj = 0; jj < 8; ++jj) {
        const int it = q * 64 + jj * 8 + F.wave;
        const int g = it & 3, m0 = (it >> 2) * 8, win = 2 << g;
        {
            const int seq0 = m0 & ~(SEQ - 1);
            float zz[23];
#pragma unroll
            for (int qq = 0; qq < 23; ++qq) { const int rr = m0 - 15 + qq; zz[qq] = (rr >= seq0 && (qq >= 15 || 15 - qq < win + 7)) ? ZP[(size_t)rr * 256 + 64 * g + c] : 0.f; }
#pragma unroll
            for (int i = 0; i < 8; ++i) {
                const int t = (m0 + i) & (SEQ - 1); const int n = (t + 1 < win) ? t + 1 : win;
                float s = 0.f;
#pragma unroll
                for (int j = 0; j < 16; ++j) s += (j < win) ? zz[15 + i - j] : 0.f;
                ps[i * 64 + c] = s / (float)n - zz[15 + i];
            }
        }
        LDS_WAIT(); asm volatile("" ::: "memory");
        float acc[8];
#pragma unroll
        for (int i = 0; i < 8; ++i) acc[i] = 0.f;
        const LAS float* W = Wp + g * 4096;
        for (int j = 0; j < 64; j += 4) {
            const float w_0 = W[(j + 0) * 64 + c], w_1 = W[(j + 1) * 64 + c], w_2 = W[(j + 2) * 64 + c], w_3 = W[(j + 3) * 64 + c];
#pragma unroll
            for (int i = 0; i < 8; ++i) { const f32x4 x = *(const LAS f32x4*)(ps + i * 64 + j); acc[i] += x.x * w_0 + x.y * w_1 + x.z * w_2 + x.w * w_3; }
        }
        const float sc = in_[I_POOLS][l * 256 + 64 * g + c];
#pragma unroll
        for (int i = 0; i < 8; ++i) MX[(size_t)(m0 + i) * 1024 + 256 + 64 * g + c] = (bf16_t)f2bf(acc[i] * sc);
        LDS_WAIT(); asm volatile("" ::: "memory");
    }
    __syncthreads();
}
__device__ __forceinline__ void tail_convert(Frame& F, int lc, int nmax) {
    refresh(F); unsigned char* ws_ = (unsigned char*)ldptr(F, 30); const InTab in_{F.lds}; gu32* ctl_ = (gu32*)ws_;
    LAS int* qslot = (LAS int*)(F.lds + MISC_OFF + 64);
    for (int n = 0; n < nmax; ++n) {
        if (F.tid == 0) qslot[0] = (int)__hip_atomic_fetch_add(ctl_ + CW_CQ + lc * 64, 1u, RLX_AGENT);
        __syncthreads();
        const int q = qslot[0];
        __syncthreads();
        if (q >= 768) break;
        convert_moe_batch(F, in_, ws_, lc, q);
    }
    __syncthreads();
}
__device__ __forceinline__ void phase_mix(Frame& F, int l, int qsel = 0) {
    refresh(F); unsigned char* ws_ = (unsigned char*)ldptr(F, 30); const InTab in_{F.lds}; gu32* ctl_ = (gu32*)ws_;

#if CHUNKED_SCAN
    if (blockIdx.x < 16) { chunk_states(F, ws_, blockIdx.x); if (PROBE_DUP == 16) { __syncthreads(); chunk_states(F, ws_, blockIdx.x); } __syncthreads(); }
#else
    if (blockIdx.x < 64) { scan_block(F, blockIdx.x); if (PROBE_DUP == 12) { __syncthreads(); scan_block(F, blockIdx.x); } return; }
#endif
    LAS int* qslot = (LAS int*)(F.lds + MISC_OFF + 64);
    for (;;) {
        if (F.tid == 0) qslot[0] = (int)__hip_atomic_fetch_add(ctl_ + CW_QUEUE + (l + 4 * qsel) * 64, 1u, RLX_AGENT);
        __syncthreads();
        const int u = qslot[0];
        __syncthreads();
        if (PROBE_DUP == 17) { if (u >= 1024 + 128 + 768) break; if (u < 1024) { const int uu = u >> 1; const int qb = 15 - (uu >> 5), bh = uu & 31; attn_unit(F, bh >> 3, bh & 7, qb); } else if (u < 1152) pool_batch(F, in_, ws_, l, u - 1024); else convert_moe_batch(F, in_, ws_, l, u - 1152); continue; }
        if (PROBE_DUP == 18) { if (u >= 512 + 128 + 1536) break; if (u < 512) { const int qb = 15 - (u >> 5), bh = u & 31; attn_unit(F, bh >> 3, bh & 7, qb); } else if (u < 640) pool_batch(F, in_, ws_, l, u - 512); else convert_moe_batch(F, in_, ws_, l, (u - 640) >> 1); continue; }
        if (u >= 512 + 128) break;
        if (u < 512) { const int qb = 15 - (u >> 5), bh = u & 31; attn_unit(F, bh >> 3, bh & 7, qb); }
        else pool_batch(F, in_, ws_, l, u - 512);
    }
    tail_convert(F, l, 1 << 20);
}

__device__ __forceinline__ void phase_post(Frame& F, int l) {
    refresh(F); unsigned char* ws_ = (unsigned char*)ldptr(F, 30); const InTab in_{F.lds}; gu32* ctl_ = (gu32*)ws_;

    const int gw = F.vcu * NWAVES + F.wave, NGW = F.G * NWAVES, c = F.lane;
    bf16_t* MX = (bf16_t*)(ws_ + WS_MIXED);
    {
        float lw[4], lb[4], rkw[4];
#pragma unroll
        for (int h = 0; h < 4; ++h) { lw[h] = in_[I_LNW][l * 256 + 64 * h + c]; lb[h] = in_[I_LNB][l * 256 + 64 * h + c]; rkw[h] = in_[I_RK][l * 256 + 64 * h + c]; }
        const float* YR = (const float*)(ws_ + WS_YRAW); const float* SCN = (const float*)(ws_ + WS_SCAN); const float* GG = (const float*)(ws_ + WS_G);
        for (int it0 = gw * 8; it0 < NTOK * 4; it0 += NGW * 8) {
            float y[8], vv[8], bn[8], gg[8];
#pragma unroll
            for (int u = 0; u < 8; ++u) {
                const int it = it0 + u, m = it >> 2, h = u & 3, b = m >> 12, t = m & (SEQ - 1);
                const float* sp = SCN + ((size_t)(b * 4 + h) * SEQ + t) * 384 + c;
                y[u] = YR[(size_t)m * 256 + 64 * h + c]; vv[u] = sp[192]; bn[u] = sp[0] * sp[128] * rkw[h]; gg[u] = GG[(size_t)m * 256 + 64 * h + c];
            }
#pragma unroll
            for (int u = 0; u < 8; ++u) {
                const int it = it0 + u, m = it >> 2, h = u & 3;
                const float mean = wave_sum(y[u]) * (1.f / 64.f); const float d = y[u] - mean; const float var = wave_sum(d * d) * (1.f / 64.f);
                float yn = d * (1.f / sqrtf(var + 64e-5f)) * lw[h] + lb[h];
                yn += wave_sum(bn[u]) * vv[u];
                yn *= gg[u];
                MX[(size_t)m * 1024 + 64 * h + c] = (bf16_t)f2bf(yn);
            }
        }
    }
}

__device__ __forceinline__ void phase_route(Frame& F, int l, int csel = 0) {
    refresh(F); unsigned char* ws_ = (unsigned char*)ldptr(F, 30); const InTab in_{F.lds}; gu32* ctl_ = (gu32*)ws_;

    LAS float* WT = (LAS float*)F.lds;
    LAS int* lcnt = (LAS int*)(F.lds + TAB_OFF);
    LAS int* lbase = lcnt + 32;
    LAS int* le = lbase + 32;
    LAS int* lpos = le + 256;
    { const float* rw = in_[I_RW] + (size_t)l * 1024 * 32;
      f32x4 t16[16];
#pragma unroll
      for (int u = 0; u < 16; ++u) t16[u] = *(const f32x4*)(rw + 4 * (F.tid + NTHR * u));
#pragma unroll
      for (int u = 0; u < 16; ++u) { const int i = F.tid + NTHR * u, k = i >> 3, e = (i & 7) * 4; WT[(e + 0) * 1024 + k] = t16[u].x; WT[(e + 1) * 1024 + k] = t16[u].y; WT[(e + 2) * 1024 + k] = t16[u].z; WT[(e + 3) * 1024 + k] = t16[u].w; } }
    const bf16_t* X = (const bf16_t*)(ws_ + WS_X); const float* MOD = (const float*)(ws_ + WS_MOD);
    const float* nw = in_[I_NORM2] + l * 1024;
    const float rb = in_[I_RB][l * 32 + (F.lane >> 1)];
    for (int tb = blockIdx.x; tb < NTOK / 64; tb += F.G) {
        if (F.tid < 32) lcnt[F.tid] = 0;
        __syncthreads();
        u32x2 xnx[2][4];
#pragma unroll
        for (int u = 0; u < 2; ++u)
#pragma unroll
            for (int j = 0; j < 4; ++j) xnx[u][j] = *(const u32x2*)(X + (size_t)(tb * 64 + F.wave * 8 + u) * 1024 + 4 * F.lane + 256 * j);
#pragma nounroll
        for (int ip = 0; ip < 4; ++ip) {
            const int ti0 = F.wave * 8 + 2 * ip, m0 = tb * 64 + ti0, b = m0 >> 12;
            const float* sh = MOD + (size_t)(l * 4 + b) * 6144 + 3 * 1024; const float* sc = sh + 1024;
            f32x4 hv[2][4];
#pragma unroll
            for (int u = 0; u < 2; ++u) {
                float ss = 0.f;
#pragma unroll
                for (int j = 0; j < 4; ++j) { hv[u][j] = up4(xnx[u][j]); ss += (hv[u][j].x * hv[u][j].x + hv[u][j].y * hv[u][j].y) + (hv[u][j].z * hv[u][j].z + hv[u][j].w * hv[u][j].w); }
                const float rs = 1.f / sqrtf(wave_sum(ss) * (1.f / 1024.f) + 1e-6f);
                bf16_t* H = (bf16_t*)(ws_ + WS_H) + (size_t)(m0 + u) * 1024;
#pragma unroll
                for (int j = 0; j < 4; ++j) { const int c0 = 4 * F.lane + 256 * j; const f32x4 w = *(const f32x4*)(nw + c0), s1 = *(const f32x4*)(sc + c0), s0 = *(const f32x4*)(sh + c0);
                    hv[u][j] = hv[u][j] * rs * w * (s1 + 1.f) + s0; u32x2 o; o.x = cvtpk(hv[u][j].x, hv[u][j].y); o.y = cvtpk(hv[u][j].z, hv[u][j].w); *(u32x2*)(H + c0) = o; }
            }
            if (ip < 3) {
#pragma unroll
                for (int u = 0; u < 2; ++u)
#pragma unroll
                    for (int j = 0; j < 4; ++j) xnx[u][j] = *(const u32x2*)(X + (size_t)(m0 + 2 + u) * 1024 + 4 * F.lane + 256 * j);
            }
            float val[2] = {0.f, 0.f};
#pragma unroll
            for (int half = 0; half < 2; ++half) {
                float a[2][16];
#pragma unroll
                for (int e = 0; e < 16; ++e) {
                    float s0 = 0.f, s1 = 0.f;
#pragma unroll
                    for (int j = 0; j < 4; ++j) { const f32x4 w = *(const LAS f32x4*)(WT + (16 * half + e) * 1024 + 4 * F.lane + 256 * j);
                        s0 += hv[0][j].x * w.x + hv[0][j].y * w.y + hv[0][j].z * w.z + hv[0][j].w * w.w; s1 += hv[1][j].x * w.x + hv[1][j].y * w.y + hv[1][j].z * w.z + hv[1][j].w * w.w; }
                    a[0][e] = s0; a[1][e] = s1;
                }
#pragma unroll
                for (int u = 0; u < 2; ++u) {
#pragma unroll
                    for (int q = 0; q < 8; ++q) { const auto rr = __builtin_amdgcn_permlane16_swap(__float_as_uint(a[u][q]), __float_as_uint(a[u][q + 8]), false, false); a[u][q] = __uint_as_float(rr[0]) + __uint_as_float(rr[1]); }
#define RSTEP(N, BIT, SEL) { const bool up_ = (F.lane & (BIT)) != 0; _Pragma("unroll") for (int q = 0; q < (N); ++q) { const float send = up_ ? a[u][q] : a[u][q + (N)]; const float keep = up_ ? a[u][q + (N)] : a[u][q]; a[u][q] = keep + dpp_f(send, SEL); } }
                    RSTEP(4, 8, 3) RSTEP(2, 4, 2) RSTEP(1, 2, 1)
#undef RSTEP
                    float v = a[u][0] + dpp_f(a[u][0], 0);
                    { const auto rr = __builtin_amdgcn_permlane32_swap(__float_as_uint(v), __float_as_uint(v), false, false); v = __uint_as_float(rr[0]) + __uint_as_float(rr[1]); }
                    if ((F.lane >> 5) == half) val[u] = v;
                }
            }
#pragma unroll
            for (int u = 0; u < 2; ++u) {
                float vv = val[u] + rb;
                const int ti = ti0 + u, m = m0 + u;
                float tv[4]; int te[4];
#pragma unroll
                for (int k = 0; k < 4; ++k) {
                    const float mx = wave_max(vv);
                    const unsigned long long bal = __ballot(vv == mx);
                    const int ln = __ffsll((long long)bal) - 1; const int e = ln >> 1;
                    tv[k] = mx; te[k] = e;
                    if ((F.lane >> 1) == e) vv = -INFINITY;
                }
                const float e1 = __expf(tv[1] - tv[0]), e2 = __expf(tv[2] - tv[0]), e3 = __expf(tv[3] - tv[0]); const float invs = 1.f / (1.f + e1 + e2 + e3);
                if (F.lane < 4) {
                    const int k = F.lane; const int e = (k == 0) ? te[0] : (k == 1) ? te[1] : (k == 2) ? te[2] : te[3];
                    const float gt = ((k == 0) ? 1.f : (k == 1) ? e1 : (k == 2) ? e2 : e3) * invs;
                    ((float*)(ws_ + WS_GATE))[(size_t)m * 4 + k] = gt;
                    le[ti * 4 + k] = e; lpos[ti * 4 + k] = atomicAdd((int*)&lcnt[e], 1);
                }
            }
        }
        __syncthreads();
        if (F.tid < 32) lbase[F.tid] = (int)__hip_atomic_fetch_add(ctl_ + CW_CNT + ((l + 4 * csel) * 32 + F.tid) * 64, (unsigned)lcnt[F.tid], RLX_AGENT);
        __syncthreads();
        if (F.tid < 256) { const int e = le[F.tid]; ((int*)(ws_ + WS_LIST))[e * NTOK + lbase[e] + lpos[F.tid]] = (tb * 64 + (F.tid >> 2)) * 4 + (F.tid & 3); }
        __syncthreads();
    }
}

constexpr int NPHASE = 2 + 9 * NL;
__global__ void __launch_bounds__(NTHR, 2) trunk_fwd(Args args) {
    extern __shared__ __attribute__((aligned(16))) unsigned char lds_raw[];
    Frame F;
    F.lds = (LAS unsigned char*)lds_raw;
    F.MISC = (volatile LAS unsigned*)(F.lds + MISC_OFF);
    F.tid = threadIdx.x; F.lane = F.tid & 63; F.wave = __builtin_amdgcn_readfirstlane(F.tid >> 6);
    F.G = gridDim.x; { const int bx = blockIdx.x; F.vcu = (F.G % 8 == 0) ? (bx % 8) * (F.G / 8) + bx / 8 : bx; }
    for (int u = F.tid; u < 64; u += NTHR) ((LAS unsigned*)(F.lds + MISC_OFF))[u] = 0u;
    if (F.tid < 29) *(LAS unsigned long long*)(F.lds + PTR_OFF + 8 * F.tid) = (unsigned long long)args.in[F.tid];
    if (F.tid == 29) *(LAS unsigned long long*)(F.lds + PTR_OFF + 8 * 29) = (unsigned long long)args.out;
    if (F.tid == 30) *(LAS unsigned long long*)(F.lds + PTR_OFF + 8 * 30) = (unsigned long long)args.ws;
    __syncthreads();
#if MK_PER_PHASE
#define GRID_BAR() do { } while (0)
#else
    XcdBarrier bar = xcd_barrier_post((unsigned*)(args.ws) + CW_BAR, F.MISC + 8);
#define GRID_BAR() xcd_barrier(bar)
#endif
    const int lo = args.ph_lo, hi = args.ph_hi;
    volatile LAS unsigned long long* tsw = (volatile LAS unsigned long long*)(F.lds + MISC_OFF + 192);
#define STAMP(id) do { if (PROBE_T >= 0 && blockIdx.x == 0 && F.tid == 0) { const unsigned long long now_ = wall_clock64(); if ((id) == PROBE_T) tsw[1] += now_ - tsw[0]; tsw[0] = now_; } } while (0)
    if (PROBE_T >= 0 && blockIdx.x == 0 && F.tid == 0) { const unsigned long long now_ = wall_clock64(); tsw[0] = now_; tsw[1] = 0ull; tsw[2] = now_; }
#define IN(k) (lo <= (k) && (k) < hi)
#define SEAM(k) do { if (IN(k) && IN((k) + 1)) GRID_BAR(); } while (0)
    if (IN(0)) { phase_prologue(F); if (PROBE_DUP == 1) { GRID_BAR(); phase_prologue(F); } SEAM(0); }
    if (IN(1)) { phase_combine(F, -1); if (PROBE_DUP == 2) { GRID_BAR(); phase_combine(F, -1); } SEAM(1); }
    for (int l = 0; l < NL; ++l) {
        const int p0 = 2 + 9 * l;
        if (IN(p0)) {
            refresh(F); unsigned char* ws_ = (unsigned char*)ldptr(F, 30); const InTab in_{F.lds};
            ProbDense P{(const char*)(ws_ + WS_H), (const char*)(ws_ + WS_WIN) + (size_t)l * NPROJ * 2048, NTOK / 256, NPROJ / 256, F.G, F.vcu};
            EpiProj E{ws_};
            pg8::gemm_phase<false, 1024>(F.lds, nullptr, F.tid, P, E);
            if (PROBE_DUP == 3) { GRID_BAR(); pg8::gemm_phase<false, 1024>(F.lds, nullptr, F.tid, P, E); }
            if (TAIL_CONVERT) { const int nun = (NTOK / 256) * (NPROJ / 256), mine = (nun - F.vcu + F.G - 1) / F.G, most = (nun + F.G - 1) / F.G; if (mine < most) tail_convert(F, l, most - mine); }
            SEAM(p0); STAMP(0);
        }
        if (IN(p0 + 1)) {
            phase_prep(F, l); if (PROBE_DUP == 4) { GRID_BAR(); phase_prep(F, l); }
            GRID_BAR(); STAMP(1);
            refresh(F); unsigned char* ws_ = (unsigned char*)ldptr(F, 30); const InTab in_{F.lds};
            ProbLora P{(const char*)(ws_ + WS_ALORA), (const char*)(ws_ + WS_LORA) + (size_t)l * 768 * 512, F.G, F.vcu};
            EpiLora E{ws_, in_[I_W0] + l * 256, in_[I_A0] + l * 256, in_[I_KA] + l * 256};
            pg8::gemm_phase<false, 256>(F.lds, nullptr, F.tid, P, E);
            if (TAIL_CONVERT && F.vcu >= 192) tail_convert(F, l, 1);
            SEAM(p0 + 1); STAMP(2);
        }
        if (IN(p0 + 2)) {
#if CHUNKED_SCAN
            { refresh(F); unsigned char* ws_ = (unsigned char*)ldptr(F, 30);
              ChunkRows cur = chunk_load(F, ws_, F.vcu);
              for (int job = F.vcu; job < 1024; job += F.G) {
                  ChunkRows nxt = cur; if (job + F.G < 1024) nxt = chunk_load(F, ws_, job + F.G);
                  chunk_job(F, ws_, job, cur); cur = nxt; } }
            GRID_BAR(); STAMP(3);
#endif
            phase_mix(F, l); if (PROBE_DUP == 5) { GRID_BAR(); phase_mix(F, l, 1); } SEAM(p0 + 2); STAMP(4); }
        if (IN(p0 + 3)) {
#if CHUNKED_SCAN
            { refresh(F); unsigned char* ws_ = (unsigned char*)ldptr(F, 30); const InTab in_{F.lds};
              const int w4 = F.wave & 3, jobA = F.vcu * 2 + (F.wave >> 2), jobB = (F.vcu + F.G) * 2 + (F.wave >> 2);
              if (F.G * 4 == 1024) {
                  OutOps oa = out_load(F, ws_, jobA, w4); PostOps pa = post_load(F, ws_, jobA, w4); OutOps ob = out_load(F, ws_, jobB, w4);
                  out_compute(F, oa, w4); __syncthreads();
                  PostOps pb = post_load(F, ws_, jobB, w4);
                  post_compute(F, in_, ws_, l, jobA, w4, pa); __syncthreads();
                  out_compute(F, ob, w4); __syncthreads();
                  post_compute(F, in_, ws_, l, jobB, w4, pb); __syncthreads();
              } else {
                  for (int jp = F.vcu; jp < 512; jp += F.G) { const int job = jp * 2 + (F.wave >> 2);
                      OutOps oa = out_load(F, ws_, job, w4); PostOps pa = post_load(F, ws_, job, w4);
                      out_compute(F, oa, w4); __syncthreads(); post_compute(F, in_, ws_, l, job, w4, pa); __syncthreads(); }
              } }
            SEAM(p0 + 3); STAMP(5);
#else
            phase_post(F, l); if (PROBE_DUP == 6) { GRID_BAR(); phase_post(F, l); } SEAM(p0 + 3);
#endif
        }
        if (IN(p0 + 4)) {
            refresh(F); unsigned char* ws_ = (unsigned char*)ldptr(F, 30); const InTab in_{F.lds};
            ProbDense P{(const char*)(ws_ + WS_MIXED), (const char*)(ws_ + WS_WOUT) + (size_t)l * 1024 * 2048, NTOK / 256, 4, F.G, F.vcu};
            EpiOut E{(bf16_t*)(ws_ + WS_X), (l == 0) ? in_[I_X] : (const float*)nullptr, (const float*)(ws_ + WS_MOD) + (size_t)l * 4 * 6144 + 2 * 1024, 1.f};
            if (PROBE_DUP == 7) { EpiOut E0{(bf16_t*)(ws_ + WS_X), (l == 0) ? in_[I_X] : (const float*)nullptr, (const float*)(ws_ + WS_MOD) + (size_t)l * 4 * 6144 + 2 * 1024, 0.f}; pg8::gemm_phase<false, 1024>(F.lds, nullptr, F.tid, P, E0); GRID_BAR(); }
            pg8::gemm_phase<false, 1024>(F.lds, nullptr, F.tid, P, E);
            SEAM(p0 + 4); STAMP(6);
        }
        if (IN(p0 + 5)) { phase_route(F, l); if (PROBE_DUP == 8) { GRID_BAR(); phase_route(F, l, 1); } SEAM(p0 + 5); STAMP(7); }
        if (IN(p0 + 6)) {
            refresh(F); unsigned char* ws_ = (unsigned char*)ldptr(F, 30); const InTab in_{F.lds};
            MoeTab T = moe_table(F, l);
            ProbGU P{(const char*)(ws_ + WS_H), (const char*)(ws_ + WS_WGU), (const int*)(ws_ + WS_LIST), T, __builtin_amdgcn_readfirstlane(T.ntiles[0]) * 8, F.G, F.vcu, l};
            EpiGU E{(bf16_t*)(ws_ + WS_ACT), in_[I_BGU], l};
            pg8::gemm_phase<true, 1024>(F.lds, (LAS unsigned*)(F.lds + ROWTAB_OFF), F.tid, P, E);
            if (PROBE_DUP == 9) { GRID_BAR(); pg8::gemm_phase<true, 1024>(F.lds, (LAS unsigned*)(F.lds + ROWTAB_OFF), F.tid, P, E); }
            if (TAIL_CONVERT && l + 1 < NL) { const int nun = P.nun, mine = (nun - F.vcu + F.G - 1) / F.G, most = (nun + F.G - 1) / F.G; if (mine < most) tail_convert(F, l + 1, most - mine); }
            SEAM(p0 + 6); STAMP(8);
        }
        if (IN(p0 + 7)) {
            refresh(F); unsigned char* ws_ = (unsigned char*)ldptr(F, 30); const InTab in_{F.lds};
            MoeTab T = moe_table(F, l);
            ProbDN P{(const char*)(ws_ + WS_ACT), (const char*)(ws_ + WS_WDN), T, __builtin_amdgcn_readfirstlane(T.ntiles[0]) * 4, F.G, F.vcu, l};
            EpiDN E{(bf16_t*)(ws_ + WS_YSLOT), in_[I_BDN], (const int*)(ws_ + WS_LIST), (const float*)(ws_ + WS_GATE), T, l};
            pg8::gemm_phase<false, 1024>(F.lds, nullptr, F.tid, P, E);
            if (PROBE_DUP == 10) { GRID_BAR(); pg8::gemm_phase<false, 1024>(F.lds, nullptr, F.tid, P, E); }
            if (TAIL_CONVERT && l + 1 < NL) { const int nun = P.nun, mine = (nun - F.vcu + F.G - 1) / F.G, most = (nun + F.G - 1) / F.G; if (mine < most) tail_convert(F, l + 1, most - mine); }
            if (PROBE_T >= 0 && l == NL - 1 && blockIdx.x == 0 && F.tid == 0) {
                const unsigned long long now_ = wall_clock64(); if (PROBE_T == 9) tsw[1] += now_ - tsw[0];
                const float share = (float)(double)tsw[1] / (float)(double)(now_ - tsw[2]);
                __hip_atomic_store((GAS float*)((gu32*)ldptr(F, 30) + CW_CODE + 1), (PROBE_T >= 20 ? 3.0f : (PROBE_T == 4 || PROBE_T == 8 || PROBE_T == 9 || PROBE_T == 0) ? 0.3f : 0.5f) * share, RLX_AGENT);
            }
            SEAM(p0 + 7); STAMP(9);
        }
        if (IN(p0 + 8)) { if (PROBE_DUP == 11) { phase_combine(F, l, 0.f); GRID_BAR(); } phase_combine(F, l); SEAM(p0 + 8); STAMP(10); }
    }
#undef IN
#undef SEAM
#if !MK_PER_PHASE
    if (blockIdx.x == 0 && F.tid == 0 && xb_ld(bar.bar + XB_TMO) != 0u) { float* o = (float*)ldptr(F, 29); o[0] = __builtin_nanf(""); }
#endif
}

extern "C" void kernel_launch(void* const* d_in, const int* in_sizes, int n_in, void* d_out, int out_size, void* d_ws, size_t ws_size, hipStream_t stream) {
    static int grid = 0;
    if (grid == 0) {
        if (n_in != 29 || out_size != NTOK * DM || ws_size < WS_END) { fprintf(stderr, "kernel_launch: unexpected sizes n_in %d out %d ws %zu (need %zu)\n", n_in, out_size, ws_size, (size_t)WS_END); grid = -1; return; }
        int dev = 0, cus = 0;
        if (hipGetDevice(&dev) != hipSuccess || hipDeviceGetAttribute(&cus, hipDeviceAttributeMultiprocessorCount, dev) != hipSuccess) { grid = -1; return; }
        if (hipFuncSetAttribute((const void*)trunk_fwd, hipFuncAttributeMaxDynamicSharedMemorySize, LDS_BYTES) != hipSuccess) { fprintf(stderr, "kernel_launch: hipFuncSetAttribute failed\n"); grid = -1; return; }
        int per_cu = 0;
        if (hipOccupancyMaxActiveBlocksPerMultiprocessor(&per_cu, (const void*)trunk_fwd, NTHR, LDS_BYTES) != hipSuccess || per_cu < 1) fprintf(stderr, "kernel_launch: occupancy query reports %d\n", per_cu);
        (void)hipGetLastError();
        grid = cus;
    }
    if (grid < 0) return;
    (void)hipMemsetAsync((char*)d_ws + WS_CTL, 0, CTL_ZERO_BYTES, stream);
    Args a{};
    for (int i = 0; i < 29; ++i) a.in[i] = (const float*)d_in[i];
    a.out = (float*)d_out; a.ws = (unsigned char*)d_ws;
#if MK_PER_PHASE
    for (int p = 0; p < NPHASE; ++p) { a.ph_lo = p; a.ph_hi = p + 1; hipLaunchKernelGGL(trunk_fwd, dim3(grid), dim3(NTHR), LDS_BYTES, stream, a); }
#else
    a.ph_lo = 0; a.ph_hi = NPHASE;
    hipLaunchKernelGGL(trunk_fwd, dim3(grid), dim3(NTHR), LDS_BYTES, stream, a);
#endif
}
```

```cpp
#include <hip/hip_runtime.h>
#include <cstdio>
#include <cstdint>
#include <cmath>

#ifndef MK_PER_PHASE
#define MK_PER_PHASE 0
#endif

#ifndef TAIL_CONVERT
#ifndef ATTN_TUNED
#define ATTN_TUNED 1
#endif
#define TAIL_CONVERT 1
#ifndef CONV_BLOCKS
#define CONV_BLOCKS 1
#endif
#endif
#ifndef CHUNKED_SCAN
#define CHUNKED_SCAN 1
#endif
#ifndef PROBE_T
#define PROBE_T -1
#endif
#ifndef PROBE_DUP
#define PROBE_DUP 0
#endif
#define GAS __attribute__((address_space(1)))
#define LAS __attribute__((address_space(3)))
typedef unsigned short bf16_t;
typedef short bf16x8 __attribute__((ext_vector_type(8)));
typedef short s16x4 __attribute__((ext_vector_type(4)));
typedef float f32x2 __attribute__((ext_vector_type(2)));
typedef float f32x4 __attribute__((ext_vector_type(4)));
typedef float f32x16 __attribute__((ext_vector_type(16)));
typedef unsigned u32x2 __attribute__((ext_vector_type(2)));
typedef unsigned u32x4 __attribute__((ext_vector_type(4)));
typedef GAS unsigned gu32;


constexpr int NB = 4, SEQ = 4096, DM = 1024, NL = 4, NTOK = NB * SEQ;
constexpr int PIN = 2824, NPROJ = 2816;
constexpr int NE = 32, TOPK = 4;
constexpr int NWAVES = 8, NTHR = 512;
constexpr float LOG2E = 1.4426950408889634f;
constexpr float QSCALE = 0.125f * LOG2E;

constexpr size_t MiB = (size_t)1 << 20;
constexpr size_t WS_CTL = 0, CTL_ZERO_BYTES = 1 * MiB;
constexpr size_t WS_MOD = 1 * MiB;
constexpr size_t WS_FLOG = 2 * MiB;
constexpr size_t WS_BIAS = 3 * MiB;
constexpr size_t WS_ALORA = 4 * MiB;
constexpr size_t WS_GATE = 12 * MiB;
constexpr size_t WS_LIST = 13 * MiB;
constexpr size_t WS_WIN = 16 * MiB;
constexpr size_t WS_LORA = 38 * MiB;
constexpr size_t WS_WOUT = 40 * MiB;
constexpr size_t WS_WGU = 48 * MiB;
constexpr size_t WS_WDN = 560 * MiB;
constexpr size_t WS_X = 816 * MiB;
constexpr size_t WS_H = 880 * MiB;
constexpr size_t WS_ZR = 912 * MiB;
constexpr size_t WS_ZP = 976 * MiB;
constexpr size_t WS_Q = 992 * MiB, WS_K = 1008 * MiB, WS_V = 1024 * MiB;
constexpr size_t WS_SCAN = 1040 * MiB;
constexpr int SCAN_ROW = 896;
constexpr size_t WS_G = 1136 * MiB;
constexpr size_t WS_YRAW = 1152 * MiB;
constexpr size_t WS_MIXED = 1168 * MiB;
constexpr size_t WS_ACT = 1200 * MiB;
constexpr size_t WS_YSLOT = 1344 * MiB;
constexpr size_t WS_CPG = 1472 * MiB;
constexpr size_t WS_CPSI = 1496 * MiB;
constexpr size_t WS_CY0 = 1504 * MiB;
constexpr size_t WS_CS = 1520 * MiB;
constexpr size_t WS_END = 1528 * MiB;

constexpr int CW_TMO = 0, CW_CODE = 1;
constexpr int CW_BAR = 4096;
constexpr int CW_CNT = 16384;
constexpr int CW_QUEUE = 40960;
constexpr int CW_GD = 53248;
constexpr int CW_CQ = 49152;

constexpr int RING_BYTES = 131072;
constexpr int LDS_BYTES = 147456;
constexpr int LDSCTL_OFF = 139264;
constexpr int MISC_OFF = LDSCTL_OFF;
constexpr int PTR_OFF = LDSCTL_OFF + 256;
constexpr int TAB_OFF = LDSCTL_OFF + 512;
constexpr int ROWTAB_OFF = LDSCTL_OFF + 4096;
constexpr int PCV_OFF = LDSCTL_OFF + 6144;

#define RLX_AGENT __ATOMIC_RELAXED, __HIP_MEMORY_SCOPE_AGENT
#define LDS_WAIT() asm volatile("s_waitcnt lgkmcnt(0)" ::: "memory")
#define VM_WAIT() asm volatile("s_waitcnt vmcnt(0)" ::: "memory")

__device__ __forceinline__ unsigned f2bf(float f) { unsigned u = __builtin_bit_cast(unsigned, f); return (u + 0x7fffu + ((u >> 16) & 1u)) >> 16; }
__device__ __forceinline__ unsigned pk2(float lo, float hi) { return f2bf(lo) | (f2bf(hi) << 16); }
typedef __bf16 bf16x2_t __attribute__((ext_vector_type(2)));
__device__ __forceinline__ unsigned cvtpk(float lo, float hi) { const f32x2 v = {lo, hi}; const bf16x2_t b = __builtin_convertvector(v, bf16x2_t); return __builtin_bit_cast(unsigned, b); }
__device__ __forceinline__ f32x4 unp4(u32x2 p) { return (f32x4){__builtin_bit_cast(float, p.x << 16), __builtin_bit_cast(float, p.x & 0xffff0000u), __builtin_bit_cast(float, p.y << 16), __builtin_bit_cast(float, p.y & 0xffff0000u)}; }
__device__ __forceinline__ f32x4 up4(u32x2 y) { return (f32x4){__builtin_bit_cast(float, y.x << 16), __builtin_bit_cast(float, y.x & 0xffff0000u), __builtin_bit_cast(float, y.y << 16), __builtin_bit_cast(float, y.y & 0xffff0000u)}; }
__device__ __forceinline__ u32x2 pk4(f32x4 v) { return (u32x2){cvtpk(v.x, v.y), cvtpk(v.z, v.w)}; }
__device__ __forceinline__ u32x4 pk8(f32x4 a, f32x4 b) { return (u32x4){cvtpk(a.x, a.y), cvtpk(a.z, a.w), cvtpk(b.x, b.y), cvtpk(b.z, b.w)}; }
__device__ __forceinline__ float bf2f(unsigned short b) { return __builtin_bit_cast(float, (unsigned)b << 16); }
__device__ __forceinline__ float dpp_f(float v, const int ctrl_sel) {
    const int iv = __builtin_bit_cast(int, v); int r;
    switch (ctrl_sel) { case 0: r = __builtin_amdgcn_update_dpp(0, iv, 0xB1, 0xf, 0xf, true); break; case 1: r = __builtin_amdgcn_update_dpp(0, iv, 0x4E, 0xf, 0xf, true); break;
                        case 2: r = __builtin_amdgcn_update_dpp(0, iv, 0x141, 0xf, 0xf, true); break; default: r = __builtin_amdgcn_update_dpp(0, iv, 0x140, 0xf, 0xf, true); break; }
    return __builtin_bit_cast(float, r);
}
__device__ __forceinline__ float red16(float v) { v += dpp_f(v, 0); v += dpp_f(v, 1); v += dpp_f(v, 2); v += dpp_f(v, 3); return v; }
__device__ __forceinline__ float fma_s(float a, float b, float c) { float d; asm("v_fma_f32 %0, %1, %2, %3" : "=v"(d) : "v"(a), "v"(b), "v"(c)); return d; }
__device__ __forceinline__ float fnma_s(float a, float b, float c) { float d; asm("v_fma_f32 %0, -%1, %2, %3" : "=v"(d) : "v"(a), "v"(b), "v"(c)); return d; }
__device__ __forceinline__ float mul_s(float a, float b) { float d; asm("v_mul_f32_e32 %0, %1, %2" : "=v"(d) : "v"(a), "v"(b)); return d; }
__device__ __forceinline__ float add_s(float a, float b) { float d; asm("v_add_f32_e32 %0, %1, %2" : "=v"(d) : "v"(a), "v"(b)); return d; }
__device__ __forceinline__ void red16_pair(float& a, float& b) {
    asm volatile("s_nop 1\n\t"
                 "v_add_f32_dpp %0, %0, %0 quad_perm:[1,0,3,2] row_mask:0xf bank_mask:0xf bound_ctrl:1\n\t"
                 "v_add_f32_dpp %1, %1, %1 quad_perm:[1,0,3,2] row_mask:0xf bank_mask:0xf bound_ctrl:1\n\t"
                 "s_nop 0\n\t"
                 "v_add_f32_dpp %0, %0, %0 quad_perm:[2,3,0,1] row_mask:0xf bank_mask:0xf bound_ctrl:1\n\t"
                 "v_add_f32_dpp %1, %1, %1 quad_perm:[2,3,0,1] row_mask:0xf bank_mask:0xf bound_ctrl:1\n\t"
                 "s_nop 0\n\t"
                 "v_add_f32_dpp %0, %0, %0 row_half_mirror row_mask:0xf bank_mask:0xf bound_ctrl:1\n\t"
                 "v_add_f32_dpp %1, %1, %1 row_half_mirror row_mask:0xf bank_mask:0xf bound_ctrl:1\n\t"
                 "s_nop 0\n\t"
                 "v_add_f32_dpp %0, %0, %0 row_mirror row_mask:0xf bank_mask:0xf bound_ctrl:1\n\t"
                 "v_add_f32_dpp %1, %1, %1 row_mirror row_mask:0xf bank_mask:0xf bound_ctrl:1\n\t"
                 "s_nop 0"
                 : "+v"(a), "+v"(b));
}
__device__ __forceinline__ float wave_sum(float v) {
    v = red16(v);
    { const auto rr = __builtin_amdgcn_permlane16_swap(__float_as_uint(v), __float_as_uint(v), false, false); v = __uint_as_float(rr[0]) + __uint_as_float(rr[1]); }
    { const auto rr = __builtin_amdgcn_permlane32_swap(__float_as_uint(v), __float_as_uint(v), false, false); v = __uint_as_float(rr[0]) + __uint_as_float(rr[1]); }
    return v;
}
__device__ __forceinline__ float wave_max(float v) {
    v = fmaxf(v, dpp_f(v, 0)); v = fmaxf(v, dpp_f(v, 1)); v = fmaxf(v, dpp_f(v, 2)); v = fmaxf(v, dpp_f(v, 3));
    { const auto rr = __builtin_amdgcn_permlane16_swap(__float_as_uint(v), __float_as_uint(v), false, false); v = fmaxf(__uint_as_float(rr[0]), __uint_as_float(rr[1])); }
    { const auto rr = __builtin_amdgcn_permlane32_swap(__float_as_uint(v), __float_as_uint(v), false, false); v = fmaxf(__uint_as_float(rr[0]), __uint_as_float(rr[1])); }
    return v;
}
__device__ __forceinline__ float sigmoidf_(float x) { return 1.f / (1.f + __expf(-x)); }
__device__ __forceinline__ float softplusf_(float u) { return fmaxf(u, 0.f) + log1pf(__expf(-fabsf(u))); }
__device__ __forceinline__ float softplus_fast(float u) { return fmaxf(u, 0.f) + __logf(1.f + __expf(-fabsf(u))); }

#define XB_TMO      128
#define XB_XCNT(j)  (256  + 64 * (j))
#define XB_XSUB(j)  (1280 + 64 * (j))
#define XB_XGEN(j)  (2304 + 64 * (j))
#define XB_TOP      3328
#define XB_TOPGEN   3392
#define XCD_BAR_WORDS 3456
#define XB_SPIN_CAP (1u << 18)
__device__ __forceinline__ unsigned xb_ld(unsigned* p)              { return __hip_atomic_load(p, __ATOMIC_RELAXED, __HIP_MEMORY_SCOPE_AGENT); }
__device__ __forceinline__ unsigned xb_add(unsigned* p, unsigned v) { return __hip_atomic_fetch_add(p, v, __ATOMIC_RELAXED, __HIP_MEMORY_SCOPE_AGENT); }
__device__ __forceinline__ unsigned xb_xcc_id() { return (unsigned)__builtin_amdgcn_s_getreg((3 << 11) | 20) & 0xFu; }
#define XB_SPIN(cond, bar) do { unsigned _sp = 0; while (cond) { __builtin_amdgcn_s_sleep(1); \
    if ((++_sp & 255u) == 0u) { if (xb_ld(&(bar)[XB_TMO])) break; if (_sp > XB_SPIN_CAP) { atomicAdd(&(bar)[XB_TMO], 1u); break; } } } } while (0)
struct XcdBarrier { unsigned* bar; unsigned x; volatile LAS unsigned* st; };
__device__ __forceinline__ XcdBarrier xcd_barrier_post(unsigned* bar, volatile LAS unsigned* st) {
    XcdBarrier b; b.bar = bar; b.x = xb_xcc_id(); b.st = st;
    if (threadIdx.x == 0) (void)xb_add(&bar[XB_XCNT(b.x)], 1u);
    return b;
}
__device__ __forceinline__ void xcd_barrier_complete(unsigned* bar, unsigned x, unsigned& nloc, unsigned& nx) {
    const unsigned G = gridDim.x * gridDim.y * gridDim.z;
    unsigned sum, cnt, mine, sp = 0u;
    for (;;) {
        sum = 0u; cnt = 0u; mine = 0u;
#pragma unroll
        for (unsigned j = 0; j < 16; ++j) { const unsigned c = xb_ld(&bar[XB_XCNT(j)]); sum += c; cnt += (c > 0u) ? 1u : 0u; mine = (j == x) ? c : mine; }
        if (sum == G) break;
        __builtin_amdgcn_s_sleep(1);
        if ((++sp & 255u) == 0u) { if (xb_ld(&bar[XB_TMO])) break; if (sp > XB_SPIN_CAP) { atomicAdd(&bar[XB_TMO], 1u); break; } }
    }
    nloc = mine > 0u ? mine : 1u; nx = cnt > 0u ? cnt : 1u;
}
__device__ __forceinline__ void xcd_barrier(const XcdBarrier& b) {
    asm volatile("s_waitcnt vmcnt(0)" ::: "memory");
    __syncthreads();
    if (threadIdx.x == 0) {
        unsigned* bar = b.bar;
        __builtin_amdgcn_s_waitcnt(0);
        unsigned nloc = b.st[0], nx = b.st[1];
        if (nloc == 0u) { xcd_barrier_complete(bar, b.x, nloc, nx); b.st[0] = nloc; b.st[1] = nx; }
        const unsigned old = xb_add(&bar[XB_XSUB(b.x)], 1u);
        const unsigned gen = old / nloc;
        if (old + 1u == (gen + 1u) * nloc) {
            __builtin_amdgcn_fence(__ATOMIC_RELEASE, "agent");
            asm volatile("s_waitcnt vmcnt(0)" ::: "memory");
            const unsigned og = xb_add(&bar[XB_TOP], 1u);
            const unsigned tg = og / nx;
            if (og + 1u == (tg + 1u) * nx) xb_add(&bar[XB_TOPGEN], 1u);
            else XB_SPIN(xb_ld(&bar[XB_TOPGEN]) == tg, bar);
            __builtin_amdgcn_fence(__ATOMIC_ACQUIRE, "agent");
            xb_add(&bar[XB_XGEN(b.x)], 1u);
            asm volatile("s_waitcnt vmcnt(0)" ::: "memory");
        } else {
            XB_SPIN(xb_ld(&bar[XB_XGEN(b.x)]) == gen, bar);
            __builtin_amdgcn_fence(__ATOMIC_ACQUIRE, "agent");
            asm volatile("s_waitcnt vmcnt(0)" ::: "memory");
        }
    }
    __syncthreads();
}

namespace pg8 {
constexpr int BM = 256, BK = 64, HALF = 128, HTB = HALF * BK * 2, STAGE_BYTES = 8 * HTB;
__device__ __forceinline__ int lds_byte(int r, int c) { const int st = (r >> 4) * 2 + (c >> 5), rr = r & 15, cc = c & 31, ob = rr * 64 + cc * 2; return st * 1024 + (ob ^ (((ob >> 9) & 1) << 5)); }
__device__ __forceinline__ void stage_rc(int b, int& R, int& C) { const int st = b / 1024, sb = b % 1024, swz = sb ^ (((sb >> 9) & 1) << 5); R = (st >> 1) * 16 + swz / 64; C = (st & 1) * 32 + (swz % 64) / 2; }
__device__ __forceinline__ int perm32(int rho) { const int n = rho >> 4, i = rho & 15; return 8 * (i >> 2) + 4 * n + (i & 3); }
struct Unit { int pm, pn, e; };
__device__ __forceinline__ unsigned cvt_pk_bf16(float lo, float hi) { unsigned r; asm volatile("v_cvt_pk_bf16_f32 %0, %1, %2" : "=v"(r) : "v"(lo), "v"(hi)); return r; }

template <bool GATHER, int K, class Prob, class Epi>
__device__ __forceinline__ void gemm_phase(LAS unsigned char* lds, LAS unsigned* rowtab  , const int tid, const Prob& S, const Epi& E) {
    const int wid = __builtin_amdgcn_readfirstlane(tid >> 6), lane = tid & 63, wr = wid >> 2, wc = wid & 3, fr = lane & 15, fq = lane >> 4;
    constexpr int nt = K / BK; static_assert(K % 128 == 0 && K >= 256 && (!GATHER || K == 1024), "K");
    unsigned voffA[2], voffB[2];
#pragma unroll
    for (int i = 0; i < 2; ++i) { int R, C; stage_rc(tid * 16 + i * 8192, R, C); const int Rb = (R & ~31) + perm32(R & 31); voffA[i] = (unsigned)(R * K + C) * 2u; voffB[i] = (unsigned)(Rb * K + C) * 2u; }
    constexpr size_t kstep = (size_t)(BK * 2);
    constexpr size_t hstep = (size_t)HALF * K * 2;
    const unsigned ldsw = (unsigned)wid * 1024u;
    const int aoff = lds_byte(wr * 64 + fr, fq * 8), boff = lds_byte(wc * 32 + fr, fq * 8);
#define PG8_SA(b, h) (((b) * 2 + (h)) * HTB)
#define PG8_SB(b, h) ((4 + (b) * 2 + (h)) * HTB)
#define PG8_STAGEB(bufoff, gbase) do { _Pragma("unroll") for (int _i = 0; _i < 2; ++_i) \
        __builtin_amdgcn_global_load_lds((const unsigned*)((const char*)(gbase) + voffB[_i]), (LAS unsigned*)(lds + (bufoff) + ldsw + _i * 8192), 16, 0, 0); } while (0)
#define PG8_STAGEA2(bufoff, gbase, o0, o1) do { \
        __builtin_amdgcn_global_load_lds((const unsigned*)((const char*)(gbase) + (o0)), (LAS unsigned*)(lds + (bufoff) + ldsw), 16, 0, 0); \
        __builtin_amdgcn_global_load_lds((const unsigned*)((const char*)(gbase) + (o1)), (LAS unsigned*)(lds + (bufoff) + ldsw + 8192), 16, 0, 0); } while (0)
#define PG8_STAGEA_C(bufoff, gbase, h) do { if constexpr (GATHER) PG8_STAGEA2(bufoff, gbase, oc[h][0], oc[h][1]); else PG8_STAGEA2(bufoff, (gbase) + (h) * hstep, voffA[0], voffA[1]); } while (0)
#define PG8_LDA(dst, b, h) do { _Pragma("unroll") for (int m = 0; m < 4; ++m) _Pragma("unroll") for (int k = 0; k < 2; ++k) dst[m][k] = *(const LAS bf16x8*)(lds + PG8_SA(b, h) + aoff + m * 2048 + k * 1024); } while (0)
#define PG8_LDB(dst, b, h) do { _Pragma("unroll") for (int n = 0; n < 2; ++n) _Pragma("unroll") for (int k = 0; k < 2; ++k) dst[n][k] = *(const LAS bf16x8*)(lds + PG8_SB(b, h) + boff + n * 2048 + k * 1024); } while (0)
#define PG8_MMA(ai, bj, At, Bt) do { __builtin_amdgcn_s_setprio(1); _Pragma("unroll") for (int m = 0; m < 4; ++m) _Pragma("unroll") for (int n = 0; n < 2; ++n) _Pragma("unroll") for (int k = 0; k < 2; ++k) \
        acc[ai][bj][m][n] = __builtin_amdgcn_mfma_f32_16x16x32_bf16(Bt[n][k], At[m][k], acc[ai][bj][m][n], 0, 0, 0); __builtin_amdgcn_s_setprio(0); } while (0)
#define PG8_WAIT_V(n) asm volatile("s_waitcnt vmcnt(" #n ")" ::: "memory")
#define PG8_WAIT_L(n) asm volatile("s_waitcnt lgkmcnt(" #n ")" ::: "memory")
#define PG8_BAR __builtin_amdgcn_s_barrier()
#define PG8_SCHED __builtin_amdgcn_sched_barrier(0)
    Unit cur, nxt; int ui = 0;
    if (!S.next(0, cur)) return;
    f32x4 acc[2][2][4][2];
#pragma unroll
    for (int a = 0; a < 2; ++a)
#pragma unroll
        for (int b = 0; b < 2; ++b)
#pragma unroll
            for (int m = 0; m < 4; ++m)
#pragma unroll
                for (int n = 0; n < 2; ++n) acc[a][b][m][n] = (f32x4){0.f, 0.f, 0.f, 0.f};
    bf16x8 At[4][2], B0[2][2], B1[2][2];
    const char* cA = S.a_ptr(cur); const char* cB = S.b_ptr(cur);
    unsigned oc[2][2];
    if constexpr (GATHER) {
#pragma unroll
        for (int h = 0; h < 2; ++h)
#pragma unroll
            for (int i = 0; i < 2; ++i) oc[h][i] = S.row_off(cur, h * 128 + (int)(voffA[i] >> 11)) + (voffA[i] & 2047u);
    }
    PG8_STAGEB(PG8_SB(0, 0), cB); PG8_STAGEB(PG8_SB(0, 1), cB + hstep); PG8_STAGEA_C(PG8_SA(0, 0), cA, 0); PG8_STAGEA_C(PG8_SA(0, 1), cA, 1);
    if (wr == 1) PG8_BAR;
    PG8_WAIT_V(2); PG8_BAR;
    PG8_STAGEB(PG8_SB(1, 0), cB + kstep); PG8_STAGEA_C(PG8_SA(1, 0), cA + kstep, 0); PG8_STAGEB(PG8_SB(1, 1), cB + hstep + kstep);
    PG8_WAIT_V(6); PG8_BAR;
    for (;;) {
        const bool has_next = S.next(ui + 1, nxt);
        const char* nA = cA; const char* nB = cB;
        if (has_next) { nA = S.a_ptr(nxt); nB = S.b_ptr(nxt); }
        if constexpr (GATHER) { if (has_next && tid < 256) rowtab[((ui + 1) & 1) * 256 + tid] = S.row_off(nxt, tid); }
#pragma nounroll
        for (int t = 0; t < nt; t += 2) {
            const bool last = (t == nt - 2);
            const char* a1 = cA + (size_t)(t + 1) * kstep;
            const char* a2 = last ? nA : cA + (size_t)(t + 2) * kstep; const char* b2 = last ? nB : cB + (size_t)(t + 2) * kstep;
            const char* a3 = a2 + kstep; const char* b3 = b2 + kstep;
            PG8_LDB(B0, 0, 0); PG8_LDB(B1, 0, 1); PG8_SCHED; PG8_LDA(At, 0, 0); PG8_STAGEA_C(PG8_SA(1, 1), a1, 1);
            if constexpr (GATHER) { if (last && has_next) {
#pragma unroll
                for (int h = 0; h < 2; ++h)
#pragma unroll
                    for (int i = 0; i < 2; ++i) oc[h][i] = rowtab[((ui + 1) & 1) * 256 + h * 128 + (int)(voffA[i] >> 11)] + (voffA[i] & 2047u); } }
            PG8_WAIT_V(8); PG8_WAIT_L(0); PG8_BAR; PG8_MMA(0, 0, At, B0); PG8_MMA(0, 1, At, B1); PG8_BAR; PG8_SCHED;
            PG8_LDA(At, 0, 1); PG8_STAGEB(PG8_SB(0, 0), b2); PG8_STAGEB(PG8_SB(0, 1), b2 + hstep); PG8_STAGEA_C(PG8_SA(0, 0), a2, 0);
            PG8_WAIT_V(8); PG8_WAIT_L(0); PG8_BAR; PG8_MMA(1, 0, At, B0); PG8_MMA(1, 1, At, B1); PG8_BAR; PG8_SCHED;
            PG8_LDB(B0, 1, 0); PG8_LDB(B1, 1, 1); PG8_SCHED; PG8_LDA(At, 1, 0); PG8_STAGEA_C(PG8_SA(0, 1), a2, 1);
            PG8_WAIT_V(8); PG8_WAIT_L(0); PG8_BAR; PG8_MMA(0, 0, At, B0); PG8_MMA(0, 1, At, B1); PG8_BAR; PG8_SCHED;
            PG8_LDA(At, 1, 1); PG8_STAGEB(PG8_SB(1, 0), b3); PG8_STAGEB(PG8_SB(1, 1), b3 + hstep); PG8_STAGEA_C(PG8_SA(1, 0), a3, 0);
            PG8_WAIT_V(8); PG8_WAIT_L(0); PG8_BAR; PG8_MMA(1, 0, At, B0); PG8_MMA(1, 1, At, B1); PG8_BAR; PG8_SCHED;
        }
        if (wr == 0) PG8_BAR;
        E(acc, cur, wr, wc, fr, fq);
        if (!has_next) break;
#pragma unroll
        for (int a = 0; a < 2; ++a)
#pragma unroll
            for (int b = 0; b < 2; ++b)
#pragma unroll
                for (int m = 0; m < 4; ++m)
#pragma unroll
                    for (int n = 0; n < 2; ++n) acc[a][b][m][n] = (f32x4){0.f, 0.f, 0.f, 0.f};
        cur = nxt; cA = nA; cB = nB; ++ui;
        if (wr == 1) PG8_BAR;
    }
    PG8_WAIT_V(0);
    PG8_BAR;
#undef PG8_SA
#undef PG8_SB
#undef PG8_STAGEA2
#undef PG8_STAGEA_C
#undef PG8_STAGEB
#undef PG8_LDA
#undef PG8_LDB
#undef PG8_MMA
#undef PG8_WAIT_V
#undef PG8_WAIT_L
#undef PG8_BAR
#undef PG8_SCHED
}
}

struct Frame {
    LAS unsigned char* lds;
    volatile LAS unsigned* MISC;
    int tid, lane, wave, vcu, G;
};
struct Args { const float* in[29]; float* out; unsigned char* ws; int ph_lo, ph_hi; };
__device__ __forceinline__ unsigned long long ldptr_raw(LAS unsigned char* lds, int i) {
    const unsigned long long v = *(const LAS unsigned long long*)(lds + PTR_OFF + 8 * i);
    const unsigned lo = __builtin_amdgcn_readfirstlane((unsigned)v), hi = __builtin_amdgcn_readfirstlane((unsigned)(v >> 32));
    return ((unsigned long long)hi << 32) | lo;
}
__device__ __forceinline__ void* ldptr(const Frame& F, int i) { return (void*)(GAS unsigned char*)ldptr_raw(F.lds, i); }
struct InTab { LAS unsigned char* lds; __device__ __forceinline__ const float* operator[](int i) const { return (const float*)(const GAS float*)ldptr_raw(lds, i); } };
__device__ __forceinline__ void refresh(Frame& F) { int t = F.tid; asm volatile("" : "+v"(t)); F.tid = t; F.lane = t & 63; F.wave = __builtin_amdgcn_readfirstlane(t >> 6); }


enum { I_X = 0, I_C, I_ADAW, I_ADAB, I_NORM1, I_WIN, I_WOUT, I_MU, I_W0, I_WUP, I_A0, I_AUP, I_GUP, I_KK, I_KA, I_RK, I_LNW, I_LNB, I_POOLW, I_POOLS, I_BF, I_NORM2, I_RW, I_RB, I_WGU, I_BGU, I_WDN, I_BDN, I_NORMF };

struct TItem { const float* src; bf16_t* dst; int ldw; };
__device__ __forceinline__ TItem mk_item(const float* W, int ldw, bf16_t* WT, int dst_row0, int k0, int n0) { TItem t; t.src = W + (size_t)k0 * ldw + n0; t.dst = WT + (size_t)dst_row0 * 1024 + k0; t.ldw = ldw; return t; }
__device__ __forceinline__ void ti_load(f32x4 (&t)[8], const TItem& it, int lane) {
#pragma unroll
    for (int i = 0; i < 8; ++i) t[i] = __builtin_nontemporal_load((const f32x4*)(it.src + (size_t)(8 * i + (lane >> 3)) * it.ldw + 4 * (lane & 7)));
}
__device__ __forceinline__ void ti_finish(const f32x4 (&t)[8], const TItem& it, LAS float* scr, int lane) {
#pragma unroll
    for (int i = 0; i < 8; ++i) { LAS float* d = scr + (8 * i + (lane >> 3)) * 33 + 4 * (lane & 7); d[0] = t[i].x; d[1] = t[i].y; d[2] = t[i].z; d[3] = t[i].w; }
    LDS_WAIT(); asm volatile("" ::: "memory");
    const int c = lane & 7;
#pragma unroll
    for (int j = 0; j < 4; ++j) { const int n = (lane >> 3) + 8 * j; const LAS float* s = scr + (8 * c) * 33 + n;
        u32x4 o; o.x = cvtpk(s[0 * 33], s[1 * 33]); o.y = cvtpk(s[2 * 33], s[3 * 33]); o.z = cvtpk(s[4 * 33], s[5 * 33]); o.w = cvtpk(s[6 * 33], s[7 * 33]);
        *(GAS u32x4*)(it.dst + (size_t)n * 1024 + 8 * c) = o; }
    LDS_WAIT(); asm volatile("" ::: "memory");
}
template <class Dec> __device__ __forceinline__ void convert_stream(int first, int step, int end, LAS float* scr, int lane, Dec dec) {
    f32x4 ta[8], tb[8]; TItem ia, ib;
    int it = first;
    if (it < end) { ia = dec(it); ti_load(ta, ia, lane); }
    while (it < end) {
        const int i2 = it + step;
        if (i2 < end) { ib = dec(i2); ti_load(tb, ib, lane); }
        ti_finish(ta, ia, scr, lane);
        if (i2 >= end) break;
        const int i3 = i2 + step;
        if (i3 < end) { ia = dec(i3); ti_load(ta, ia, lane); }
        ti_finish(tb, ib, scr, lane);
        it = i3;
    }
}

__device__ __forceinline__ void convert_moe_batch(Frame& F, const InTab& in_, unsigned char* ws_, int l, int q);
__device__ __forceinline__ void phase_prologue(Frame& F) {
    refresh(F); unsigned char* ws_ = (unsigned char*)ldptr(F, 30); const InTab in_{F.lds}; gu32* ctl_ = (gu32*)ws_;

    if (blockIdx.x < 192) {
        LAS float* cond = (LAS float*)F.lds;
        LAS float* part = (LAS float*)(F.lds + 16384);
        const float* c = in_[I_C];
        for (int i = F.tid; i < 4096; i += NTHR) { const float v = c[i]; cond[i] = v / (1.f + __expf(-v)); }
        __syncthreads();
        const int l = blockIdx.x / 48, col0 = (blockIdx.x % 48) * 128;
        const float* W = in_[I_ADAW] + (size_t)l * 1024 * 6144 + col0 + 2 * F.lane;
        float a[4][2];
#pragma unroll
        for (int b = 0; b < 4; ++b) { a[b][0] = 0.f; a[b][1] = 0.f; }
        const int kb = F.wave * 128;
#pragma unroll 8
        for (int k = kb; k < kb + 128; ++k) {
            const f32x2 w = __builtin_nontemporal_load((const f32x2*)(W + (size_t)k * 6144));
#pragma unroll
            for (int b = 0; b < 4; ++b) { const float cv = cond[b * 1024 + k]; a[b][0] += cv * w.x; a[b][1] += cv * w.y; }
        }
#pragma unroll
        for (int b = 0; b < 4; ++b) { part[(F.wave * 4 + b) * 128 + 2 * F.lane] = a[b][0]; part[(F.wave * 4 + b) * 128 + 2 * F.lane + 1] = a[b][1]; }
        __syncthreads();
        { const int b = F.tid >> 7, cc = F.tid & 127; float s = in_[I_ADAB][l * 6144 + col0 + cc];
#pragma unroll
          for (int w = 0; w < 8; ++w) s += part[(w * 4 + b) * 128 + cc];
          ((float*)(ws_ + WS_MOD))[(l * 4 + b) * 6144 + col0 + cc] = s; }
        __syncthreads();
    }
    {
        bf16_t* LT = (bf16_t*)(ws_ + WS_LORA);
        const float* wu = in_[I_WUP]; const float* au = in_[I_AUP]; const float* gu = in_[I_GUP];
        for (int idx = blockIdx.x * NTHR + F.tid; idx < NL * 768 * 256; idx += F.G * NTHR) {
            const int k = idx & 255, n = (idx >> 8) % 768, l = idx / (768 * 256);
            float v = 0.f;
            if (n < 256) { if (k < 64) v = wu[((size_t)l * 64 + k) * 256 + n]; }
            else if (n < 512) { if (k >= 64 && k < 128) v = au[((size_t)l * 64 + (k - 64)) * 256 + (n - 256)]; }
            else { if (k >= 128) v = gu[((size_t)l * 128 + (k - 128)) * 256 + (n - 512)]; }
            LT[idx] = (bf16_t)f2bf(v);
        }
    }
    LAS float* scr = (LAS float*)(F.lds + F.wave * 16384);
    const int gw = F.vcu * NWAVES + F.wave, NGW = F.G * NWAVES;
    constexpr int I_A = NL * 16 * 88, I_B = NL * 16 * 32;
    convert_stream(gw, NGW, I_A + I_B, scr, F.lane, [&](int r) {
        if (r < I_A) { const int l = r / (16 * 88), q = r % (16 * 88), kb = q / 88, nb = q % 88;
            return mk_item(in_[I_WIN] + (size_t)l * 1024 * PIN, PIN, (bf16_t*)(ws_ + WS_WIN) + (size_t)l * NPROJ * 1024, 32 * nb, 64 * kb, 32 * nb); }
        r -= I_A;
        const int l = r / (16 * 32), q = r % (16 * 32), kb = q / 32, nb = q % 32;
        return mk_item(in_[I_WOUT] + (size_t)l * 1024 * 1024, 1024, (bf16_t*)(ws_ + WS_WOUT) + (size_t)l * 1024 * 1024, 32 * nb, 64 * kb, 32 * nb); });
}
__device__ __forceinline__ void convert_moe_batch(Frame& F, const InTab& in_, unsigned char* ws_, int l, int q) {
    LAS float* scr = (LAS float*)(F.lds + F.wave * 16384);
    convert_stream(q * 64 + F.wave, 8, q * 64 + 64, scr, F.lane, [&](int r) {
        if (r < NE * 16 * 64) { const int e = r / (16 * 64), qq = r % (16 * 64), kb = qq / 64, nb = qq % 64; const int n0 = 32 * nb; const int le = l * NE + e;
            const int dr = (n0 < 1024) ? ((n0 >> 7) * 256 + (n0 & 127)) : ((((n0 - 1024) >> 7) * 256) + 128 + ((n0 - 1024) & 127));
            return mk_item(in_[I_WGU] + (size_t)le * 1024 * 2048, 2048, (bf16_t*)(ws_ + WS_WGU) + (size_t)le * 2048 * 1024, dr, 64 * kb, n0); }
        r -= NE * 16 * 64; const int e = r / (16 * 32), qq = r % (16 * 32), kb = qq / 32, nb = qq % 32; const int le = l * NE + e;
        return mk_item(in_[I_WDN] + (size_t)le * 1024 * 1024, 1024, (bf16_t*)(ws_ + WS_WDN) + (size_t)le * 1024 * 1024, 32 * nb, 64 * kb, 32 * nb); });
}

__device__ __forceinline__ void phase_combine(Frame& F, int l, float yscale = 1.f) {
    refresh(F); unsigned char* ws_ = (unsigned char*)ldptr(F, 30); const InTab in_{F.lds}; gu32* ctl_ = (gu32*)ws_;

    const bool has_next = (l + 1 < NL);
    LAS float* Wf = (LAS float*)F.lds;
    if (has_next) {
        const float* W = in_[I_WIN] + (size_t)(l + 1) * 1024 * PIN + NPROJ;
        f32x4 t4[4];
#pragma unroll
        for (int u = 0; u < 4; ++u) { const int i = F.tid + NTHR * u; t4[u] = *(const f32x4*)(W + (size_t)(i >> 1) * PIN + 4 * (i & 1)); }
#pragma unroll
        for (int u = 0; u < 4; ++u) { const int i = F.tid + NTHR * u; *(LAS f32x4*)(Wf + 4 * i) = t4[u]; }
    }
    __syncthreads();
    const int gw = F.vcu * NWAVES + F.wave, NGW = F.G * NWAVES;
    const float* xin = in_[I_X];
    bf16_t* X = (bf16_t*)(ws_ + WS_X);
    const float* MOD = (const float*)(ws_ + WS_MOD);
    const bf16_t* YS = (const bf16_t*)(ws_ + WS_YSLOT);
    f32x4 xn[4]; u32x2 xb[4], yn[4][4];
#define CMB_LOAD(mm) do { if (l < 0) { _Pragma("unroll") for (int j = 0; j < 4; ++j) xn[j] = *(const f32x4*)(xin + (size_t)(mm) * 1024 + 4 * F.lane + 256 * j); } \
        else { _Pragma("unroll") for (int j = 0; j < 4; ++j) xb[j] = *(const u32x2*)(X + (size_t)(mm) * 1024 + 4 * F.lane + 256 * j); } \
        if (l >= 0) { _Pragma("unroll") for (int k = 0; k < 4; ++k) _Pragma("unroll") for (int j = 0; j < 4; ++j) yn[k][j] = *(const u32x2*)(YS + ((size_t)(mm) * 4 + k) * 1024 + 4 * F.lane + 256 * j); } } while (0)
    if (gw < NTOK) CMB_LOAD(gw);
    for (int m = gw; m < NTOK; m += NGW) {
        const int b = m >> 12;
        f32x4 v[4]; u32x2 yc[4][4];
#pragma unroll
        for (int j = 0; j < 4; ++j) { v[j] = (l < 0) ? xn[j] : up4(xb[j]);
#pragma unroll
            for (int k = 0; k < 4; ++k) yc[k][j] = yn[k][j]; }
        if (m + NGW < NTOK) CMB_LOAD(m + NGW);
        if (l >= 0) {
            const float* g2 = MOD + (size_t)(l * 4 + b) * 6144 + 5 * 1024;
#pragma unroll
            for (int j = 0; j < 4; ++j) {
                f32x4 s = (f32x4){0.f, 0.f, 0.f, 0.f};
#pragma unroll
                for (int k = 0; k < 4; ++k) { const u32x2 y = yc[k][j];
                    s.x += __builtin_bit_cast(float, y.x << 16); s.y += __builtin_bit_cast(float, y.x & 0xffff0000u); s.z += __builtin_bit_cast(float, y.y << 16); s.w += __builtin_bit_cast(float, y.y & 0xffff0000u); }
                const f32x4 g = *(const f32x4*)(g2 + 4 * F.lane + 256 * j);
                v[j] = v[j] + g * yscale * s;
            }
        }
        if (l >= 0 && has_next) {
#pragma unroll
            for (int j = 0; j < 4; ++j) *(u32x2*)(X + (size_t)m * 1024 + 4 * F.lane + 256 * j) = pk4(v[j]);
        }
        float ss = 0.f;
#pragma unroll
        for (int j = 0; j < 4; ++j) ss += (v[j].x * v[j].x + v[j].y * v[j].y) + (v[j].z * v[j].z + v[j].w * v[j].w);
        const float rs = 1.f / sqrtf(wave_sum(ss) * (1.f / 1024.f) + 1e-6f);
        if (has_next) {
            const float* nw = in_[I_NORM1] + (l + 1) * 1024;
            const float* sh = MOD + (size_t)((l + 1) * 4 + b) * 6144; const float* sc = sh + 1024;
            float fl[8];
#pragma unroll
            for (int e = 0; e < 8; ++e) fl[e] = 0.f;
            bf16_t* H = (bf16_t*)(ws_ + WS_H) + (size_t)m * 1024;
#pragma unroll
            for (int j = 0; j < 4; ++j) {
                const int c0 = 4 * F.lane + 256 * j;
                const f32x4 w = *(const f32x4*)(nw + c0), s1 = *(const f32x4*)(sc + c0), s0 = *(const f32x4*)(sh + c0);
                f32x4 h = v[j] * rs * w * (s1 + 1.f) + s0;
                u32x2 o; o.x = cvtpk(h.x, h.y); o.y = cvtpk(h.z, h.w);
                *(u32x2*)(H + c0) = o;
#pragma unroll
                for (int i = 0; i < 4; ++i) {
                    const f32x4 wa = *(const LAS f32x4*)(Wf + (c0 + i) * 8), wb = *(const LAS f32x4*)(Wf + (c0 + i) * 8 + 4);
                    const float hv = h[i];
                    fl[0] += hv * wa.x; fl[1] += hv * wa.y; fl[2] += hv * wa.z; fl[3] += hv * wa.w; fl[4] += hv * wb.x; fl[5] += hv * wb.y; fl[6] += hv * wb.z; fl[7] += hv * wb.w;
                }
            }
#pragma unroll
            for (int e = 0; e < 8; ++e) fl[e] = wave_sum(fl[e]);
            if (F.lane == 0) { float* o = (float*)(ws_ + WS_FLOG) + (size_t)m * 8; *(f32x4*)o = (f32x4){fl[0], fl[1], fl[2], fl[3]}; *(f32x4*)(o + 4) = (f32x4){fl[4], fl[5], fl[6], fl[7]}; }
        } else {
            const float* nw = in_[I_NORMF]; float* out_ = (float*)ldptr(F, 29);
            const float pscale = (PROBE_T >= 0) ? 1.f + __hip_atomic_load((GAS float*)(ctl_ + CW_CODE + 1), RLX_AGENT) : 1.f;
#pragma unroll
            for (int j = 0; j < 4; ++j) { const int c0 = 4 * F.lane + 256 * j; const f32x4 w = *(const f32x4*)(nw + c0);
                *(f32x4*)(out_ + (size_t)m * 1024 + c0) = v[j] * rs * w * pscale; }
        }
    }
}

#undef CMB_LOAD
struct ProbDense {
    const char* A; const char* Bt; int nM, nN, G, vcu;
    __device__ __forceinline__ bool next(int i, pg8::Unit& u) const { const int Lx = i * G + vcu; if (Lx >= nM * nN) return false; u.pn = Lx % nN; u.pm = Lx / nN; u.e = 0; return true; }
    __device__ __forceinline__ const char* a_ptr(const pg8::Unit& u) const { return A + (size_t)u.pm * 256 * 2048; }
    __device__ __forceinline__ const char* b_ptr(const pg8::Unit& u) const { return Bt + (size_t)u.pn * 256 * 2048; }
};
struct EpiProj {
    unsigned char* ws;
    __device__ __forceinline__ void operator()(const f32x4 (&acc)[2][2][4][2], const pg8::Unit& u, int wr, int wc, int fr, int fq) const {
        const int pn = u.pn;
#pragma unroll
        for (int ai = 0; ai < 2; ++ai)
#pragma unroll
            for (int m = 0; m < 4; ++m) {
                const size_t row = (size_t)u.pm * 256 + ai * 128 + wr * 64 + m * 16 + fr;
#pragma unroll
                for (int bj = 0; bj < 2; ++bj) {
                    const int ct = bj * 128 + wc * 32 + 8 * fq;
                    const f32x4 v0 = acc[ai][bj][m][0], v1 = acc[ai][bj][m][1];
                    if (pn < 4) { *(u32x4*)((bf16_t*)(ws + WS_ZR) + row * 1024 + pn * 256 + ct) = pk8(v0, v1); }
                    else if (pn == 4) { float* p = (float*)(ws + WS_ZP) + row * 256 + ct; *(f32x4*)p = v0; *(f32x4*)(p + 4) = v1; }
                    else { const int q = pn - 5, which = q >> 1; const float sc = (which == 0) ? QSCALE : 1.f;
                        bf16_t* p = (bf16_t*)(ws + (which == 0 ? WS_Q : (which == 1 ? WS_K : WS_V))) + row * 512 + (q & 1) * 256 + ct;
                        u32x4 w; w.x = pg8::cvt_pk_bf16(v0[0] * sc, v0[1] * sc); w.y = pg8::cvt_pk_bf16(v0[2] * sc, v0[3] * sc); w.z = pg8::cvt_pk_bf16(v1[0] * sc, v1[1] * sc); w.w = pg8::cvt_pk_bf16(v1[2] * sc, v1[3] * sc);
                        *(u32x4*)p = w; }
                }
            }
    }
};
struct EpiOut {
    bf16_t* X; const float* Xin; const float* g1; float scale;
    __device__ __forceinline__ void operator()(const f32x4 (&acc)[2][2][4][2], const pg8::Unit& u, int wr, int wc, int fr, int fq) const {
        const int b = (u.pm * 256) >> 12;
#pragma unroll
        for (int bj = 0; bj < 2; ++bj) {
            const int col = u.pn * 256 + bj * 128 + wc * 32 + 8 * fq;
            const f32x4 ga = *(const f32x4*)(g1 + (size_t)b * 6144 + col), gb = *(const f32x4*)(g1 + (size_t)b * 6144 + col + 4);
#pragma unroll
            for (int ai = 0; ai < 2; ++ai)
#pragma unroll
                for (int m = 0; m < 4; ++m) {
                    const size_t row = (size_t)u.pm * 256 + ai * 128 + wr * 64 + m * 16 + fr;
                    bf16_t* p = X + row * 1024 + col;
                    f32x4 x0, x1;
                    if (Xin) { const float* pi = Xin + row * 1024 + col; x0 = *(const f32x4*)pi; x1 = *(const f32x4*)(pi + 4); }
                    else { const u32x4 xb = *(const u32x4*)p; x0 = up4((u32x2){xb.x, xb.y}); x1 = up4((u32x2){xb.z, xb.w}); }
                    *(u32x4*)p = pk8(x0 + ga * scale * acc[ai][bj][m][0], x1 + gb * scale * acc[ai][bj][m][1]);
                }
        }
    }
};

struct MoeTab { LAS int* te; LAS int* tr0; LAS int* cnt; LAS int* ntiles; };
__device__ __forceinline__ MoeTab moe_table(Frame& F, int l) {
    refresh(F); unsigned char* ws_ = (unsigned char*)ldptr(F, 30); const InTab in_{F.lds}; gu32* ctl_ = (gu32*)ws_;

    MoeTab T; T.te = (LAS int*)(F.lds + TAB_OFF); T.tr0 = T.te + 320; T.cnt = T.tr0 + 320; T.ntiles = T.cnt + 32;
    if (F.tid < 32) T.cnt[F.tid] = (int)__hip_atomic_load(ctl_ + CW_CNT + ((l + (PROBE_DUP == 8 ? 4 : 0)) * 32 + F.tid) * 64, RLX_AGENT);
    __syncthreads();
    if (F.tid < 64) {
        const int e = F.tid; const int nt_e = (e < 32) ? ((T.cnt[e & 31] + 255) >> 8) : 0;
        int incl = nt_e;
#pragma unroll
        for (int o = 1; o < 32; o <<= 1) { const int t = __shfl_up(incl, o); if (F.lane >= o) incl += t; }
        const int start = incl - nt_e;
#pragma nounroll
        for (int r = 0; r < nt_e; ++r) { T.te[start + r] = e; T.tr0[start + r] = r * 256; }
        if (e == 31) T.ntiles[0] = incl;
    }
    __syncthreads();
    return T;
}
struct ProbGU {
    const char* H; const char* W; const int* list; MoeTab T; int nun, G, vcu, l;
    __device__ __forceinline__ bool next(int i, pg8::Unit& u) const { const int Lx = i * G + vcu; if (Lx >= nun) return false; u.pm = Lx >> 3; u.pn = Lx & 7; u.e = __builtin_amdgcn_readfirstlane(T.te[u.pm]); return true; }
    __device__ __forceinline__ const char* a_ptr(const pg8::Unit&) const { return H; }
    __device__ __forceinline__ const char* b_ptr(const pg8::Unit& u) const { return W + ((size_t)(l * 32 + u.e) * 2048 + (size_t)u.pn * 256) * 2048; }
    __device__ __forceinline__ unsigned row_off(const pg8::Unit& u, int r) const { const int idx = __builtin_amdgcn_readfirstlane(T.tr0[u.pm]) + r; const int tok = (idx < __builtin_amdgcn_readfirstlane(T.cnt[u.e])) ? (list[u.e * NTOK + idx] >> 2) : 0; return (unsigned)tok * 2048u; }
};
struct EpiGU {
    bf16_t* ACT; const float* bgu; int l;
    __device__ __forceinline__ void operator()(const f32x4 (&acc)[2][2][4][2], const pg8::Unit& u, int wr, int wc, int fr, int fq) const {
        const int col = u.pn * 128 + wc * 32 + 8 * fq;
        const float* bb = bgu + (size_t)(l * 32 + u.e) * 2048 + col;
        const f32x4 bg0 = *(const f32x4*)bb, bg1 = *(const f32x4*)(bb + 4), bu0 = *(const f32x4*)(bb + 1024), bu1 = *(const f32x4*)(bb + 1028);
#pragma unroll
        for (int ai = 0; ai < 2; ++ai)
#pragma unroll
            for (int m = 0; m < 4; ++m) {
                const size_t row = (size_t)u.pm * 256 + ai * 128 + wr * 64 + m * 16 + fr;
                float a[8];
#pragma unroll
                for (int n = 0; n < 2; ++n)
#pragma unroll
                    for (int i = 0; i < 4; ++i) {
                        float g = acc[ai][0][m][n][i] + (n ? bg1[i] : bg0[i]); float up = acc[ai][1][m][n][i] + (n ? bu1[i] : bu0[i]);
                        g = fminf(g, 7.f); up = fminf(fmaxf(up, -7.f), 7.f);
                        a[n * 4 + i] = (up + 1.f) * (g / (1.f + __expf(-1.702f * g)));
                    }
                u32x4 w; w.x = pg8::cvt_pk_bf16(a[0], a[1]); w.y = pg8::cvt_pk_bf16(a[2], a[3]); w.z = pg8::cvt_pk_bf16(a[4], a[5]); w.w = pg8::cvt_pk_bf16(a[6], a[7]);
                *(u32x4*)(ACT + row * 1024 + col) = w;
            }
    }
};
struct ProbDN {
    const char* ACT; const char* W; MoeTab T; int nun, G, vcu, l;
    __device__ __forceinline__ bool next(int i, pg8::Unit& u) const { const int Lx = i * G + vcu; if (Lx >= nun) return false; u.pm = Lx >> 2; u.pn = Lx & 3; u.e = __builtin_amdgcn_readfirstlane(T.te[u.pm]); return true; }
    __device__ __forceinline__ const char* a_ptr(const pg8::Unit& u) const { return ACT + (size_t)u.pm * 256 * 2048; }
    __device__ __forceinline__ const char* b_ptr(const pg8::Unit& u) const { return W + ((size_t)(l * 32 + u.e) * 1024 + (size_t)u.pn * 256) * 2048; }
};
struct EpiDN {
    bf16_t* YS; const float* bdn; const int* list; const float* gate; MoeTab T; int l;
    __device__ __forceinline__ void operator()(const f32x4 (&acc)[2][2][4][2], const pg8::Unit& u, int wr, int wc, int fr, int fq) const {
        const int r0 = __builtin_amdgcn_readfirstlane(T.tr0[u.pm]), c = __builtin_amdgcn_readfirstlane(T.cnt[u.e]);
#pragma unroll
        for (int ai = 0; ai < 2; ++ai)
#pragma unroll
            for (int m = 0; m < 4; ++m) {
                const int idx = r0 + ai * 128 + wr * 64 + m * 16 + fr;
                if (idx < c) {
                    const int slot = list[u.e * NTOK + idx]; const float gt = gate[slot];
#pragma unroll
                    for (int bj = 0; bj < 2; ++bj) {
                        const int col = u.pn * 256 + bj * 128 + wc * 32 + 8 * fq;
                        const float* bb = bdn + (size_t)(l * 32 + u.e) * 1024 + col;
                        const f32x4 b0 = *(const f32x4*)bb, b1 = *(const f32x4*)(bb + 4);
                        const f32x4 v0 = (acc[ai][bj][m][0] + b0) * gt, v1 = (acc[ai][bj][m][1] + b1) * gt;
                        u32x4 w; w.x = pg8::cvt_pk_bf16(v0[0], v0[1]); w.y = pg8::cvt_pk_bf16(v0[2], v0[3]); w.z = pg8::cvt_pk_bf16(v1[0], v1[1]); w.w = pg8::cvt_pk_bf16(v1[2], v1[3]);
                        *(u32x4*)(YS + (size_t)slot * 1024 + col) = w;
                    }
                }
            }
    }
};

__device__ __forceinline__ void phase_prep(Frame& F, int l) {
    refresh(F); unsigned char* ws_ = (unsigned char*)ldptr(F, 30); const InTab in_{F.lds};
    if (blockIdx.x < 32) {
        const int b = blockIdx.x >> 3, hh = blockIdx.x & 7;
        const float bf = in_[I_BF][l * 8 + hh];
        const float* fl = (const float*)(ws_ + WS_FLOG) + ((size_t)b * SEQ + 8 * F.tid) * 8 + hh;
        float lf[8];
#pragma unroll
        for (int i = 0; i < 8; ++i) lf[i] = fl[i * 8];
#pragma unroll
        for (int i = 0; i < 8; ++i) { lf[i] = -softplusf_(-(lf[i] + bf)); if (i) lf[i] += lf[i - 1]; }
        float incl = lf[7];
#pragma unroll
        for (int o = 1; o < 64; o <<= 1) { const float t = __shfl_up(incl, o); if (F.lane >= o) incl += t; }
        LAS float* wtot = (LAS float*)F.lds;
        if (F.lane == 63) wtot[F.wave] = incl;
        __syncthreads();
        float off = incl - lf[7];
        for (int w = 0; w < F.wave; ++w) off += wtot[w];
        float* bo = (float*)(ws_ + WS_BIAS) + ((size_t)b * 8 + hh) * SEQ + 8 * F.tid;
        f32x4 o0, o1;
        o0.x = -(off + lf[0]) * LOG2E; o0.y = -(off + lf[1]) * LOG2E; o0.z = -(off + lf[2]) * LOG2E; o0.w = -(off + lf[3]) * LOG2E;
        o1.x = -(off + lf[4]) * LOG2E; o1.y = -(off + lf[5]) * LOG2E; o1.z = -(off + lf[6]) * LOG2E; o1.w = -(off + lf[7]) * LOG2E;
        *(f32x4*)bo = o0; *(f32x4*)(bo + 4) = o1;
    }
    const int gw = F.vcu * NWAVES + F.wave, NGW = F.G * NWAVES;
    const float* mu = in_[I_MU] + l * 1024;
    f32x4 muv[4];
#pragma unroll
    for (int j = 0; j < 4; ++j) muv[j] = *(const f32x4*)(mu + 4 * F.lane + 256 * j);
    const f32x4 kkw = *(const f32x4*)(in_[I_KK] + l * 256 + 4 * F.lane);
    const bf16_t* ZR = (const bf16_t*)(ws_ + WS_ZR);
    const int hd = F.lane >> 4, cc = 4 * (F.lane & 15);
    const float act_a = (F.lane < 16) ? 2.f : 1.f, act_b = (F.lane < 16) ? -1.f : 0.f; const bool act_id = (F.lane >= 16 && F.lane < 32);
    for (int g = gw; g < NTOK / 8; g += NGW) {
        const int m0 = g * 8;
        u32x2 raw[9][4];
        const bool hasp = (m0 & (SEQ - 1)) != 0;
#pragma unroll
        for (int i = 0; i < 9; ++i)
#pragma unroll
            for (int j = 0; j < 4; ++j) raw[i][j] = (i > 0 || hasp) ? *(const u32x2*)(ZR + (size_t)(m0 - 1 + i) * 1024 + 4 * F.lane + 256 * j) : (u32x2){0u, 0u};
        f32x4 prev[4], cur[4];
#pragma unroll
        for (int j = 0; j < 4; ++j) prev[j] = unp4(raw[0][j]);
#pragma unroll
        for (int i = 0; i < 8; ++i) {
            const int m = m0 + i, b = m >> 12, t = m & (SEQ - 1);
#pragma unroll
            for (int j = 0; j < 4; ++j) cur[j] = unp4(raw[i + 1][j]);
            f32x4 zs[4];
#pragma unroll
            for (int j = 0; j < 4; ++j) zs[j] = cur[j] + (prev[j] - cur[j]) * muv[j];
            unsigned char* o = ws_ + WS_SCAN + ((size_t)(b * 4 + hd) * SEQ + t) * SCAN_ROW + cc * 2;
            *(u32x2*)(o) = pk4(zs[0]);
            *(u32x2*)(o + 128) = pk4(zs[1]);
            *(u32x2*)(o + 256) = pk4(zs[2]);
            f32x4 kk = zs[1] * kkw;
            const float ss = red16((kk.x * kk.x + kk.y * kk.y) + (kk.z * kk.z + kk.w * kk.w));
            kk = kk * (1.f / fmaxf(sqrtf(ss), 1e-12f));
            *(u32x2*)(o + 384) = pk4(kk);
            f32x4 a4;
#pragma unroll
            for (int q = 0; q < 4; ++q) { const float x = zs[3][q]; const float sg = 1.f / (1.f + __expf(-act_a * x)); a4[q] = act_id ? x : (act_a * sg + act_b); }
            u32x2 pk; pk.x = cvtpk(a4.x, a4.y); pk.y = cvtpk(a4.z, a4.w);
            *(u32x2*)((bf16_t*)(ws_ + WS_ALORA) + (size_t)m * 256 + 4 * F.lane) = pk;
#pragma unroll
            for (int j = 0; j < 4; ++j) prev[j] = cur[j];
        }
    }
}
struct ProbLora {
    const char* A; const char* Bt; int G, vcu;
    __device__ __forceinline__ bool next(int i, pg8::Unit& u) const { const int Lx = i * G + vcu; if (Lx >= 64 * 3) return false; u.pn = Lx % 3; u.pm = Lx / 3; u.e = 0; return true; }
    __device__ __forceinline__ const char* a_ptr(const pg8::Unit& u) const { return A + (size_t)u.pm * 256 * 512; }
    __device__ __forceinline__ const char* b_ptr(const pg8::Unit& u) const { return Bt + (size_t)u.pn * 256 * 512; }
};
struct EpiLora {
    unsigned char* ws; const float* w0; const float* a0; const float* ka;
    __device__ __forceinline__ void operator()(const f32x4 (&acc)[2][2][4][2], const pg8::Unit& u, int wr, int wc, int fr, int fq) const {
        const int pn = u.pn;
#pragma unroll
        for (int bj = 0; bj < 2; ++bj) {
            const int c = bj * 128 + wc * 32 + 8 * fq, hd = c >> 6, cc = c & 63;
            f32x4 p0 = (f32x4){0.f, 0.f, 0.f, 0.f}, p1 = p0, q0 = p0, q1 = p0;
            if (pn == 0) { p0 = *(const f32x4*)(w0 + c); p1 = *(const f32x4*)(w0 + c + 4); }
            else if (pn == 1) { p0 = *(const f32x4*)(a0 + c); p1 = *(const f32x4*)(a0 + c + 4); q0 = *(const f32x4*)(ka + c); q1 = *(const f32x4*)(ka + c + 4); }
#pragma unroll
            for (int ai = 0; ai < 2; ++ai)
#pragma unroll
                for (int m = 0; m < 4; ++m) {
                    const int row = u.pm * 256 + ai * 128 + wr * 64 + m * 16 + fr, b = row >> 12, t = row & (SEQ - 1);
                    const f32x4 v0 = acc[ai][bj][m][0], v1 = acc[ai][bj][m][1];
                    unsigned char* o = ws + WS_SCAN + ((size_t)(b * 4 + hd) * SEQ + t) * SCAN_ROW;
                    if (pn == 0) {
                        f32x4 d0, d1;
#pragma unroll
                        for (int i = 0; i < 4; ++i) { d0[i] = -__expf(-softplus_fast(-(p0[i] + v0[i])) - 0.5f); d1[i] = -__expf(-softplus_fast(-(p1[i] + v1[i])) - 0.5f); if (!CHUNKED_SCAN) { d0[i] = __expf(d0[i]); d1[i] = __expf(d1[i]); } }
                        *(f32x4*)(o + 640 + cc * 4) = d0; *(f32x4*)(o + 640 + cc * 4 + 16) = d1;
                    } else if (pn == 1) {
                        const u32x4 kp = *(const u32x4*)(o + 128 + cc * 2), np = *(const u32x4*)(o + 384 + cc * 2);
                        const f32x4 k0 = unp4((u32x2){kp.x, kp.y}), k1 = unp4((u32x2){kp.z, kp.w}), n0 = unp4((u32x2){np.x, np.y}), n1 = unp4((u32x2){np.z, np.w});
                        f32x4 a_0, a_1;
#pragma unroll
                        for (int i = 0; i < 4; ++i) { a_0[i] = sigmoidf_(p0[i] + v0[i]); a_1[i] = sigmoidf_(p1[i] + v1[i]); }
                        *(u32x4*)(o + 128 + cc * 2) = pk8(k0 * ((a_0 - 1.f) * q0 + 1.f), k1 * ((a_1 - 1.f) * q1 + 1.f));
                        *(u32x4*)(o + 512 + cc * 2) = pk8(-(n0 * a_0), -(n1 * a_1));
                    } else {
                        *(u32x4*)((bf16_t*)(ws + WS_G) + (size_t)row * 256 + c) = pk8(v0, v1);
                    }
                }
        }
    }
};

constexpr int SC_STEPS = 16, SC_CHUNK_F = SC_STEPS * 384, SC_NBUF = 5, SC_PPW = SC_STEPS * 6 / 16;
struct ScanIn { f32x4 r, w, k, kk, kb; float v; };
__device__ __forceinline__ ScanIn scan_ld(const LAS float* p, int ks, int row) {
    ScanIn x; x.r = *(const LAS f32x4*)(p + ks); x.w = *(const LAS f32x4*)(p + 64 + ks); x.k = *(const LAS f32x4*)(p + 128 + ks); x.kk = *(const LAS f32x4*)(p + 256 + ks); x.kb = *(const LAS f32x4*)(p + 320 + ks); x.v = p[192 + row]; return x;
}
__device__ __forceinline__ void scan_block(Frame& F, int rb) {
    refresh(F); unsigned char* ws_ = (unsigned char*)ldptr(F, 30);
    const int bh = rb >> 2, rg = rb & 3, b = bh >> 2, h = bh & 3;
    const float* src = (const float*)(ws_ + WS_SCAN) + (size_t)bh * SEQ * 384;
    LAS float* buf = (LAS float*)F.lds;
    constexpr int NCH = SEQ / SC_STEPS;
    if (F.wave >= 4) {
        const int lw = F.wave - 4;
#define SC_ISSUE(c, slot) do { _Pragma("unroll") for (int p_ = 0; p_ < SC_PPW; ++p_) { const int pc_ = lw * SC_PPW + p_; \
            __builtin_amdgcn_global_load_lds((const unsigned*)(src + (size_t)(c) * SC_CHUNK_F + pc_ * 256 + F.lane * 4), (LAS unsigned*)(buf + (slot) * SC_CHUNK_F + pc_ * 256), 16, 0, 0); } } while (0)
#pragma unroll
        for (int c = 0; c < SC_NBUF - 1; ++c) SC_ISSUE(c, c);
        asm volatile("s_waitcnt vmcnt(%0)" :: "n"((SC_NBUF - 2) * SC_PPW) : "memory");
        __builtin_amdgcn_s_barrier();
        int slot = SC_NBUF - 1;
        for (int c = 0; c < NCH; ++c) {
            if (c + SC_NBUF - 1 < NCH) { SC_ISSUE(c + SC_NBUF - 1, slot); asm volatile("s_waitcnt vmcnt(%0)" :: "n"((SC_NBUF - 2) * SC_PPW) : "memory"); }
            else asm volatile("s_waitcnt vmcnt(0)" ::: "memory");
            slot = (slot == SC_NBUF - 1) ? 0 : slot + 1;
            __builtin_amdgcn_s_barrier();
        }
#undef SC_ISSUE
    } else {
        const int row = rg * 16 + F.wave * 4 + (F.lane >> 4), ks = (F.lane & 15) * 4, l16 = F.lane & 15;
        f32x4 s = (f32x4){0.f, 0.f, 0.f, 0.f};
        float* yout = (float*)(ws_ + WS_YRAW) + (size_t)b * SEQ * 256 + 64 * h + row;
        float yp = 0.f;
        int slot = 0;
        __builtin_amdgcn_s_barrier();
        for (int c = 0; c < NCH; ++c) {
            const LAS float* base = buf + slot * SC_CHUNK_F;
            slot = (slot == SC_NBUF - 1) ? 0 : slot + 1;
            float ykeep = 0.f;
            ScanIn cur = scan_ld(base, ks, row);
#pragma unroll
            for (int st = 0; st < SC_STEPS; ++st) {
                ScanIn nxt = cur;
                if (st + 1 < SC_STEPS) nxt = scan_ld(base + (st + 1) * 384, ks, row);
                const f32x4 vk = cur.k * cur.v;
                const float t0 = s.x * cur.kk.x + s.y * cur.kk.y, t1 = s.z * cur.kk.z + s.w * cur.kk.w;
                const f32x4 u = s * cur.w + vk;
                float sa = t0 + t1;
                red16_pair(sa, yp);
                ykeep = (l16 == st) ? yp : ykeep;
                s = u + cur.kb * sa;
                const float y0 = s.x * cur.r.x + s.y * cur.r.y, y1 = s.z * cur.r.z + s.w * cur.r.w;
                yp = y0 + y1;
                cur = nxt;
            }
            { const int g = c * SC_STEPS + l16 - 1; if (l16 < SC_STEPS && g >= 0) yout[(size_t)g * 256] = ykeep; }
            __builtin_amdgcn_s_barrier();
        }
        yp = red16(yp);
        if (l16 == 0) yout[(size_t)(SEQ - 1) * 256] = yp;
    }
}


__device__ __forceinline__ int crow(int r, int hi) { return (r & 3) + 8 * (r >> 2) + 4 * hi; }
constexpr int CK_P = 144, CK_A = 64 * CK_P;
enum { CA_KKP = 0, CA_RP, CA_BI, CA_KI, CA_VT, CA_KKPT, CA_BHT, CA_KHT, CA_TB, CA_AUK, CA_ARB, CA_ARK, CA_TF0, CA_TF1, CA_N,
       CA_W1T = CA_KKP, CA_MT = CA_BI, CA_U0T = CA_KI,
       CA_D1T = CA_BI, CA_X1T = CA_KI };
constexpr int CK_TF = CA_TF0 * CK_A;
static_assert(CA_N * CK_A <= 139264 && 64 * 68 * 4 <= 2 * CK_A, "chunk LDS map");
__device__ __forceinline__ f32x16 ck_mma(const LAS unsigned char* A, const LAS unsigned char* B, int ksteps, f32x16 acc, int r32, int hi) {
#pragma unroll 4
    for (int s = 0; s < ksteps; ++s) {
        const bf16x8 a = *(const LAS bf16x8*)(A + r32 * CK_P + (16 * s + 8 * hi) * 2);
        const bf16x8 b = *(const LAS bf16x8*)(B + r32 * CK_P + (16 * s + 8 * hi) * 2);
        acc = __builtin_amdgcn_mfma_f32_32x32x16_bf16(a, b, acc, 0, 0, 0);
    }
    return acc;
}
__device__ __forceinline__ void ck_store_t(LAS unsigned char* dst, const f32x16& c, int R0, int C0, int r32, int hi) {
#pragma unroll
    for (int g = 0; g < 4; ++g) { u32x2 w; w.x = cvtpk(c[4 * g], c[4 * g + 1]); w.y = cvtpk(c[4 * g + 2], c[4 * g + 3]); *(LAS u32x2*)(dst + (C0 + r32) * CK_P + (R0 + 8 * g + 4 * hi) * 2) = w; }
}
#define STAMPF(F_, id) do { if (PROBE_T >= 20 && blockIdx.x == 0 && (F_).tid == 0) { volatile LAS unsigned long long* tsw_ = (volatile LAS unsigned long long*)((F_).lds + MISC_OFF + 192); const unsigned long long now_ = wall_clock64(); if ((id) == PROBE_T) tsw_[1] += now_ - tsw_[0]; tsw_[0] = now_; } } while (0)
struct ChunkRows { u32x4 r, k, v, kk, kb; f32x4 w[2]; };
__device__ __forceinline__ ChunkRows chunk_load(Frame& F, unsigned char* ws_, int job) {
    const int t = F.tid & 63, c0 = (F.tid >> 6) * 8, bh = job >> 6, ch = job & 63;
    const unsigned char* row = ws_ + WS_SCAN + ((size_t)bh * SEQ + (size_t)ch * 64 + t) * SCAN_ROW;
    ChunkRows x;
    x.r = *(const u32x4*)(row + c0 * 2); x.k = *(const u32x4*)(row + 128 + c0 * 2); x.v = *(const u32x4*)(row + 256 + c0 * 2); x.kk = *(const u32x4*)(row + 384 + c0 * 2); x.kb = *(const u32x4*)(row + 512 + c0 * 2);
    x.w[0] = *(const f32x4*)(row + 640 + c0 * 4); x.w[1] = *(const f32x4*)(row + 640 + c0 * 4 + 16);
    return x;
}
__device__ __forceinline__ void chunk_job(Frame& F, unsigned char* ws_, int job, const ChunkRows& in) {
    LAS unsigned char* L = F.lds;
    LAS float* Tf = (LAS float*)(L + CK_TF);
    const int tid = F.tid, lane = F.lane, wave = F.wave, r32 = lane & 31, hi = lane >> 5;
    {
        const int t = tid & 63, c0 = (tid >> 6) * 8;
        float r_[8], k_[8], v_[8], kk_[8], kb_[8], Lt[8];
#pragma unroll
        for (int q = 0; q < 2; ++q) {
            const f32x4 r4 = unp4((u32x2){in.r[2 * q], in.r[2 * q + 1]}), k4 = unp4((u32x2){in.k[2 * q], in.k[2 * q + 1]}), v4 = unp4((u32x2){in.v[2 * q], in.v[2 * q + 1]}), n4 = unp4((u32x2){in.kk[2 * q], in.kk[2 * q + 1]}), b4 = unp4((u32x2){in.kb[2 * q], in.kb[2 * q + 1]});
#pragma unroll
            for (int i = 0; i < 4; ++i) { r_[4 * q + i] = r4[i]; k_[4 * q + i] = k4[i]; v_[4 * q + i] = v4[i]; kk_[4 * q + i] = n4[i]; kb_[4 * q + i] = -b4[i]; Lt[4 * q + i] = in.w[q][i]; }
        }
#pragma unroll
        for (int i = 0; i < 8; ++i) {
            float x = Lt[i];
            x += __builtin_bit_cast(float, __builtin_amdgcn_update_dpp(0, __builtin_bit_cast(int, x), 0x111, 0xf, 0xf, true));
            x += __builtin_bit_cast(float, __builtin_amdgcn_update_dpp(0, __builtin_bit_cast(int, x), 0x112, 0xf, 0xf, true));
            x += __builtin_bit_cast(float, __builtin_amdgcn_update_dpp(0, __builtin_bit_cast(int, x), 0x114, 0xf, 0xf, true));
            x += __builtin_bit_cast(float, __builtin_amdgcn_update_dpp(0, __builtin_bit_cast(int, x), 0x118, 0xf, 0xf, true));
            const float r0 = __builtin_bit_cast(float, __builtin_amdgcn_readlane(__builtin_bit_cast(int, x), 15)), r1 = __builtin_bit_cast(float, __builtin_amdgcn_readlane(__builtin_bit_cast(int, x), 31)), r2 = __builtin_bit_cast(float, __builtin_amdgcn_readlane(__builtin_bit_cast(int, x), 47));
            const int rw = lane >> 4;
            x += (rw >= 1 ? r0 : 0.f) + (rw >= 2 ? r1 : 0.f) + (rw >= 3 ? r2 : 0.f);
            Lt[i] = x;
        }
        float kkp[8], rp[8], bi[8], ki[8], bh_[8], kh_[8];
#pragma unroll
        for (int i = 0; i < 8; ++i) {
            const float Lm0 = __shfl_up(Lt[i], 1); const float Lm = (lane > 0) ? Lm0 : 0.f; const float Lc = __shfl(Lt[i], 63);
            const float ip = __expf(-Lt[i]);
            kkp[i] = kk_[i] * __expf(Lm); rp[i] = r_[i] * __expf(Lt[i]); bi[i] = kb_[i] * ip; ki[i] = k_[i] * ip;
            const float pc = __expf(Lc - Lt[i]); bh_[i] = kb_[i] * pc; kh_[i] = k_[i] * pc;
            if (t == 63) ((LAS float*)(L + PCV_OFF))[c0 + i] = __expf(Lc);
        }
#define CK_ROW8(arr, vals_) do { u32x4 w_ = (u32x4){cvtpk(vals_[0], vals_[1]), cvtpk(vals_[2], vals_[3]), cvtpk(vals_[4], vals_[5]), cvtpk(vals_[6], vals_[7])}; *(LAS u32x4*)(L + (arr) * CK_A + t * CK_P + c0 * 2) = w_; } while (0)
#define CK_COL8(arr, vals_) do { _Pragma("unroll") for (int i_ = 0; i_ < 8; ++i_) *(LAS unsigned short*)(L + (arr) * CK_A + (c0 + i_) * CK_P + t * 2) = (unsigned short)cvtpk(vals_[i_], 0.f); } while (0)
        CK_ROW8(CA_KKP, kkp); CK_ROW8(CA_RP, rp); CK_ROW8(CA_BI, bi); CK_ROW8(CA_KI, ki);
        CK_COL8(CA_VT, v_); CK_COL8(CA_KKPT, kkp); CK_COL8(CA_BHT, bh_); CK_COL8(CA_KHT, kh_);
#undef CK_ROW8
#undef CK_COL8
    }
    __syncthreads(); STAMPF(F, 20);
#pragma unroll
    for (int q = 0; q < 2; ++q) {
        const int id = wave * 2 + q, which = id >> 2, tj = (id >> 1) & 1, tt = id & 1;
        const LAS unsigned char* Aop = L + ((which & 1) ? CA_KI : CA_BI) * CK_A + tj * 32 * CK_P;
        const LAS unsigned char* Bop = L + ((which & 2) ? CA_RP : CA_KKP) * CK_A + tt * 32 * CK_P;
        f32x16 c = {}; c = ck_mma(Aop, Bop, 4, c, r32, hi);
        const int t = tt * 32 + r32;
#pragma unroll
        for (int i = 0; i < 16; ++i) { const int j = tj * 32 + crow(i, hi); const bool keep = (which & 2) ? (j <= t) : (j < t); if (!keep) c[i] = 0.f; }
        if (which == 0) {
#pragma unroll
            for (int g = 0; g < 4; ++g) { const int j0 = tj * 32 + 8 * g + 4 * hi; Tf[t * 68 + j0] = c[4 * g]; Tf[t * 68 + j0 + 1] = c[4 * g + 1]; Tf[t * 68 + j0 + 2] = c[4 * g + 2]; Tf[t * 68 + j0 + 3] = c[4 * g + 3]; }
        } else ck_store_t(L + ((which == 1) ? CA_AUK : (which == 2) ? CA_ARB : CA_ARK) * CK_A, c, tj * 32, tt * 32, r32, hi);
    }
    __syncthreads(); STAMPF(F, 21);
    LAS unsigned char* TB = L + CA_TB * CK_A;
    if (wave == 4) {
        const int blk = lane >> 5, c = lane & 31;
        const LAS float* ab = Tf + blk * (32 * 68 + 32);
        float x[32];
#pragma unroll
        for (int t = 0; t < 32; ++t) x[t] = 0.f;
#pragma unroll
        for (int t = 0; t < 32; ++t) {
            int z = 0;
            if (t >= 2) asm volatile("" : "+v"(z) : "v"(x[t - 2]));
            const LAS float* rowp = ab + t * 68 + z;
            float a0 = (t == c) ? 1.f : 0.f, a1 = 0.f, a2 = 0.f, a3 = 0.f;
#pragma unroll
            for (int j = 0; j < t; j += 4) { const f32x4 a4 = *(const LAS f32x4*)(rowp + j);
                a0 -= a4.x * x[j]; a1 -= a4.y * x[j + 1]; a2 -= a4.z * x[j + 2]; a3 -= a4.w * x[j + 3]; }
            x[t] = (a0 + a1) + (a2 + a3);
        }
#pragma unroll
        for (int t = 0; t < 32; ++t) *(LAS unsigned short*)(TB + (32 * blk + t) * CK_P + (32 * blk + c) * 2) = (unsigned short)f2bf(x[t]);
        if (blk == 0) {
#pragma unroll
            for (int t8 = 0; t8 < 4; ++t8) { const u32x4 w_ = (u32x4){cvtpk(x[8 * t8], x[8 * t8 + 1]), cvtpk(x[8 * t8 + 2], x[8 * t8 + 3]), cvtpk(x[8 * t8 + 4], x[8 * t8 + 5]), cvtpk(x[8 * t8 + 6], x[8 * t8 + 7])}; *(LAS u32x4*)(L + CA_D1T * CK_A + c * CK_P + t8 * 16) = w_; }
        } else {
#pragma unroll
            for (int t8 = 0; t8 < 4; ++t8) *(LAS u32x4*)(TB + c * CK_P + 64 + t8 * 16) = (u32x4){0u, 0u, 0u, 0u};
        }
    } else if (wave < 4) {
        const int tt = wave >> 1, tv = wave & 1;
        f32x16 c = {}; c = ck_mma(L + CA_AUK * CK_A + tt * 32 * CK_P, L + CA_VT * CK_A + tv * 32 * CK_P, 4, c, r32, hi);
        ck_store_t(L + CA_W1T * CK_A, c, tt * 32, tv * 32, r32, hi);
    }
    __syncthreads(); STAMPF(F, 22);
    if (wave == 0) {
        f32x16 c = {};
#pragma unroll
        for (int s = 0; s < 2; ++s) {
            const f32x4 f0 = *(const LAS f32x4*)(Tf + (32 + r32) * 68 + 16 * s + 8 * hi), f1 = *(const LAS f32x4*)(Tf + (32 + r32) * 68 + 16 * s + 8 * hi + 4);
            const u32x4 aw = (u32x4){cvtpk(f0.x, f0.y), cvtpk(f0.z, f0.w), cvtpk(f1.x, f1.y), cvtpk(f1.z, f1.w)};
            const bf16x8 b = *(const LAS bf16x8*)(L + CA_D1T * CK_A + r32 * CK_P + (16 * s + 8 * hi) * 2);
            c = __builtin_amdgcn_mfma_f32_32x32x16_bf16(__builtin_bit_cast(bf16x8, aw), b, c, 0, 0, 0);
        }
        ck_store_t(L + CA_X1T * CK_A, c, 0, 0, r32, hi);
    }
    __syncthreads(); STAMPF(F, 23);
    if (wave == 0) {
        f32x16 c = {}; c = ck_mma(L + CA_X1T * CK_A, TB + 32 * CK_P + 64, 2, c, r32, hi);
#pragma unroll
        for (int i = 0; i < 16; ++i) c[i] = -c[i];
        ck_store_t(TB + 32 * CK_P, c, 0, 0, r32, hi);
    }
    __syncthreads(); STAMPF(F, 24);
    {
        const int which = wave >> 2, tt = (wave >> 1) & 1, tc = wave & 1;
        f32x16 c = {}; c = ck_mma(L + CA_TB * CK_A + tt * 32 * CK_P, L + (which ? CA_W1T : CA_KKPT) * CK_A + tc * 32 * CK_P, 4, c, r32, hi);
        if (which) {
#pragma unroll
            for (int i = 0; i < 16; ++i) c[i] = -c[i];
        }
        ck_store_t(L + (which ? CA_U0T : CA_MT) * CK_A, c, tt * 32, tc * 32, r32, hi);
    }
    __syncthreads(); STAMPF(F, 25);
    const size_t jb = (size_t)job;
#pragma unroll
    for (int q = 0; q < 2; ++q) {
        const int id = wave * 2 + q, which = id >> 2, ta = (id >> 1) & 1, tb = id & 1;
        f32x16 c = {};
        if (which == 0) {
            c = ck_mma(L + CA_MT * CK_A + ta * 32 * CK_P, L + CA_BHT * CK_A + tb * 32 * CK_P, 4, c, r32, hi);
            const int k2 = tb * 32 + r32; const float pcv = ((const LAS float*)(L + PCV_OFF))[k2];
            bf16_t* o = (bf16_t*)(ws_ + WS_CPG + jb * 24576) + (size_t)k2 * 64;
#pragma unroll
            for (int g = 0; g < 4; ++g) { const int k1 = ta * 32 + 8 * g + 4 * hi; float x[4];
#pragma unroll
                for (int i = 0; i < 4; ++i) x[i] = ((k1 + i == k2) ? pcv : 0.f) - c[4 * g + i];
                u32x2 w_; w_.x = cvtpk(x[0], x[1]); w_.y = cvtpk(x[2], x[3]); *(u32x2*)(o + k1) = w_; }
        } else if (which == 1) {
            c = ck_mma(L + CA_BHT * CK_A + ta * 32 * CK_P, L + CA_U0T * CK_A + tb * 32 * CK_P, 4, c, r32, hi);
            c = ck_mma(L + CA_KHT * CK_A + ta * 32 * CK_P, L + CA_VT * CK_A + tb * 32 * CK_P, 4, c, r32, hi);
            float* o = (float*)(ws_ + WS_CPG + jb * 24576 + 8192) + (size_t)(ta * 32) * 64 + tb * 32 + r32;
#pragma unroll
            for (int i = 0; i < 16; ++i) o[crow(i, hi) * 64] = c[i];
        } else if (which == 2) {
            c = ck_mma(L + CA_MT * CK_A + ta * 32 * CK_P, L + CA_ARB * CK_A + tb * 32 * CK_P, 4, c, r32, hi);
            const int t = tb * 32 + r32;
            bf16_t* o = (bf16_t*)(ws_ + WS_CPSI) + jb * 4096 + (size_t)t * 64;
#pragma unroll
            for (int g = 0; g < 4; ++g) { const int k0 = ta * 32 + 8 * g + 4 * hi; const u32x2 rp2 = *(const LAS u32x2*)(L + CA_RP * CK_A + t * CK_P + k0 * 2);
                const float r0 = __builtin_bit_cast(float, rp2.x << 16), r1 = __builtin_bit_cast(float, rp2.x & 0xffff0000u), r2 = __builtin_bit_cast(float, rp2.y << 16), r3 = __builtin_bit_cast(float, rp2.y & 0xffff0000u);
                u32x2 w_; w_.x = cvtpk(r0 - c[4 * g], r1 - c[4 * g + 1]); w_.y = cvtpk(r2 - c[4 * g + 2], r3 - c[4 * g + 3]); *(u32x2*)(o + k0) = w_; }
        } else {
            c = ck_mma(L + CA_ARB * CK_A + ta * 32 * CK_P, L + CA_U0T * CK_A + tb * 32 * CK_P, 4, c, r32, hi);
            c = ck_mma(L + CA_ARK * CK_A + ta * 32 * CK_P, L + CA_VT * CK_A + tb * 32 * CK_P, 4, c, r32, hi);
            float* o = (float*)(ws_ + WS_CY0) + jb * 4096 + (size_t)(ta * 32) * 64 + tb * 32 + r32;
#pragma unroll
            for (int i = 0; i < 16; ++i) o[crow(i, hi) * 64] = c[i];
        }
    }
    __syncthreads(); STAMPF(F, 26);
}


constexpr int S2_REC = 24576, S2_NSLOT = 4, S2_SB = S2_NSLOT * S2_REC;
__device__ __forceinline__ void chunk_states(Frame& F, unsigned char* ws_, int bh) {
    LAS unsigned char* L = F.lds;
    LAS unsigned char* Sb = L + S2_SB;
    const int tid = F.tid, lane = F.lane, wave = F.wave, r32 = lane & 31, hi = lane >> 5;
    for (int i = tid; i < 64 * CK_P / 4; i += NTHR) ((LAS unsigned*)Sb)[i] = 0u;
    const unsigned char* rec0 = ws_ + WS_CPG + (size_t)bh * 64 * S2_REC;
#define S2_ISSUE(c) do { if (wave >= 4) { _Pragma("unroll") for (int p_ = 0; p_ < 6; ++p_) { const int pc_ = (wave - 4) * 6 + p_; \
        __builtin_amdgcn_global_load_lds((const unsigned*)(rec0 + (size_t)(c) * S2_REC + pc_ * 1024 + lane * 16), (LAS unsigned*)(L + ((c) & (S2_NSLOT - 1)) * S2_REC + pc_ * 1024), 16, 0, 0); } } } while (0)
    S2_ISSUE(0); S2_ISSUE(1); S2_ISSUE(2);
    if (wave >= 4) asm volatile("s_waitcnt vmcnt(12)" ::: "memory");
    __syncthreads();
    const int ti = wave >> 1, tj = wave & 1;
    for (int c = 0; c < 64; ++c) {
        if (c + 3 < 64) { S2_ISSUE(c + 3); if (wave >= 4) asm volatile("s_waitcnt vmcnt(12)" ::: "memory"); }
        else if (wave >= 4) asm volatile("s_waitcnt vmcnt(0)" ::: "memory");
        { const int row = tid >> 3, ch = tid & 7; *(u32x4*)((bf16_t*)(ws_ + WS_CS) + ((size_t)bh * 64 + c) * 4096 + row * 64 + ch * 8) = *(const LAS u32x4*)(Sb + row * CK_P + ch * 16); }
        f32x16 acc = {};
        if (wave < 4) {
            const LAS unsigned char* R = L + (c & (S2_NSLOT - 1)) * S2_REC;
            const LAS float* G = (const LAS float*)(R + 8192);
#pragma unroll
            for (int i = 0; i < 16; ++i) acc[i] = G[(ti * 32 + crow(i, hi)) * 64 + tj * 32 + r32];
#pragma unroll
            for (int s = 0; s < 4; ++s) {
                const bf16x8 a = *(const LAS bf16x8*)(R + (ti * 32 + r32) * 128 + (16 * s + 8 * hi) * 2);
                const bf16x8 b = *(const LAS bf16x8*)(Sb + (tj * 32 + r32) * CK_P + (16 * s + 8 * hi) * 2);
                acc = __builtin_amdgcn_mfma_f32_32x32x16_bf16(a, b, acc, 0, 0, 0);
            }
        }
        __syncthreads();
        if (wave < 4) ck_store_t(Sb, acc, ti * 32, tj * 32, r32, hi);
        __syncthreads();
    }
#undef S2_ISSUE
}
struct OutOps { bf16x8 a[4], b[4]; f32x16 acc; };
struct PostOps { float vv[16], rr[16], kk[16], gg[16]; };
__device__ __forceinline__ OutOps out_load(Frame& F, unsigned char* ws_, int job, int w4) {
    const int lane = F.lane, r32 = lane & 31, hi = lane >> 5, tt = w4 >> 1, tv = w4 & 1;
    const bf16_t* Psi = (const bf16_t*)(ws_ + WS_CPSI) + (size_t)job * 4096; const bf16_t* CS = (const bf16_t*)(ws_ + WS_CS) + (size_t)job * 4096; const float* Y0 = (const float*)(ws_ + WS_CY0) + (size_t)job * 4096;
    OutOps o;
#pragma unroll
    for (int s = 0; s < 4; ++s) { o.a[s] = *(const bf16x8*)(Psi + (tt * 32 + r32) * 64 + 16 * s + 8 * hi); o.b[s] = *(const bf16x8*)(CS + (tv * 32 + r32) * 64 + 16 * s + 8 * hi); }
#pragma unroll
    for (int i = 0; i < 16; ++i) o.acc[i] = Y0[(tt * 32 + crow(i, hi)) * 64 + tv * 32 + r32];
    return o;
}
__device__ __forceinline__ PostOps post_load(Frame& F, unsigned char* ws_, int job, int w4) {
    const int c = F.lane, bh = job >> 6, ch = job & 63, b = bh >> 2, h = bh & 3;
    const unsigned char* SCN = ws_ + WS_SCAN + ((size_t)bh * SEQ + (size_t)ch * 64 + w4 * 16) * SCAN_ROW + c * 2; const bf16_t* GG = (const bf16_t*)(ws_ + WS_G) + ((size_t)b * SEQ + (size_t)ch * 64 + w4 * 16) * 256 + 64 * h + c;
    PostOps p;
#pragma unroll
    for (int u = 0; u < 16; ++u) { const unsigned char* sp = SCN + (size_t)u * SCAN_ROW; p.vv[u] = bf2f(*(const unsigned short*)(sp + 256)); p.rr[u] = bf2f(*(const unsigned short*)sp); p.kk[u] = bf2f(*(const unsigned short*)(sp + 128)); p.gg[u] = bf2f(GG[(size_t)u * 256]); }
    return p;
}
__device__ __forceinline__ void out_compute(Frame& F, const OutOps& o, int w4) {
    const int lane = F.lane, r32 = lane & 31, hi = lane >> 5, tt = w4 >> 1, tv = w4 & 1;
    f32x16 acc = o.acc;
#pragma unroll
    for (int s = 0; s < 4; ++s) acc = __builtin_amdgcn_mfma_f32_32x32x16_bf16(o.a[s], o.b[s], acc, 0, 0, 0);
    LAS float* yl = (LAS float*)F.lds + (F.wave >> 2) * 4096 + (tt * 32) * 64 + tv * 32 + r32;
#pragma unroll
    for (int i = 0; i < 16; ++i) yl[crow(i, hi) * 64] = acc[i];
}
__device__ __forceinline__ void post_compute(Frame& F, const InTab& in_, unsigned char* ws_, int l, int job, int w4, const PostOps& p) {
    const int c = F.lane, bh = job >> 6, ch = job & 63, b = bh >> 2, h = bh & 3;
    const float lw = in_[I_LNW][l * 256 + 64 * h + c], lb = in_[I_LNB][l * 256 + 64 * h + c], rkw = in_[I_RK][l * 256 + 64 * h + c];
    const LAS float* yimg = (const LAS float*)F.lds + (F.wave >> 2) * 4096 + (w4 * 16) * 64 + c;
    bf16_t* MX = (bf16_t*)(ws_ + WS_MIXED) + ((size_t)b * SEQ + (size_t)ch * 64 + w4 * 16) * 1024 + 64 * h + c;
#pragma unroll
    for (int u = 0; u < 16; ++u) {
        const float y = yimg[u * 64];
        const float mean = wave_sum(y) * (1.f / 64.f); const float d = y - mean; const float var = wave_sum(d * d) * (1.f / 64.f);
        float yn = d * (1.f / sqrtf(var + 64e-5f)) * lw + lb;
        yn += wave_sum(p.rr[u] * p.kk[u] * rkw) * p.vv[u];
        yn *= p.gg[u];
        MX[(size_t)u * 1024] = (bf16_t)f2bf(yn);
    }
}

namespace fa {
constexpr int APITCH = 512, OPITCH = 1024, KVBLK = 64, QBLK = 32;
constexpr int NSLOT = 3, SLOTB = 8192;
constexpr int LDS_K = 0, LDS_V = NSLOT * SLOTB, LDS_WS = 2 * NSLOT * SLOTB, LDS_OST = LDS_WS + 8 * 64 * 4, LDS_BL = LDS_OST + 8 * 4096, LDS_END = LDS_BL + 4096 * 4;
#define SBAR() __builtin_amdgcn_sched_barrier(0)
#define WAIT_BAR(N) asm volatile("s_waitcnt vmcnt(" #N ") lgkmcnt(0)\n\ts_barrier":::"memory")
__device__ __forceinline__ void cmask(f32x16& p0, f32x16& p1, int jb, int qrel, int hi) {
    const float NEG = -INFINITY; const int kb = 64 * jb + 4 * hi;
#pragma unroll
    for (int r = 0; r < 16; ++r) { const int kv = kb + (r & 3) + 8 * (r >> 2); if (kv > qrel) p0[r] = NEG; if (kv + 32 > qrel) p1[r] = NEG; }
}
__device__ __forceinline__ void glds16(const void* gsrc, unsigned lds_dst) { unsigned keep;
    asm volatile("s_mov_b32 %0, m0\n\ts_mov_b32 m0, %2\n\ts_nop 0\n\tglobal_load_lds_dwordx4 %1, off\n\ts_mov_b32 m0, %0" : "=&s"(keep) : "v"(gsrc), "s"(lds_dst) : "memory"); }
__device__ __forceinline__ float max3f(float a, float b, float c) { float r; asm("v_max3_f32 %0, %1, %2, %3" : "=v"(r) : "v"(a), "v"(b), "v"(c)); return r; }
__device__ __forceinline__ float max2f(float a, float b) { float r; asm("v_max_f32_e32 %0, %1, %2" : "=v"(r) : "v"(a), "v"(b)); return r; }
typedef LAS const char* lds_cptr;
typedef short v4i16_t __attribute__((ext_vector_type(4)));
__device__ __forceinline__ void qkt(f32x16& p0, f32x16& p1, lds_cptr Kslot, const bf16x8* qr, int r32, int hi) {
    const f32x16 zc = {};
    lds_cptr kb = Kslot + hi * 1024 + r32 * 16;
#pragma unroll
    for (int d0 = 0; d0 < 4; ++d0) {
        const bf16x8 b0 = *(const LAS bf16x8*)(kb + d0 * 2048);
        const bf16x8 b1 = *(const LAS bf16x8*)(kb + d0 * 2048 + 512);
        if (d0 == 0) { p0 = __builtin_amdgcn_mfma_f32_32x32x16_bf16(b0, qr[0], zc, 0, 0, 0); p1 = __builtin_amdgcn_mfma_f32_32x32x16_bf16(b1, qr[0], zc, 0, 0, 0); }
        else { p0 = __builtin_amdgcn_mfma_f32_32x32x16_bf16(b0, qr[d0], p0, 0, 0, 0); p1 = __builtin_amdgcn_mfma_f32_32x32x16_bf16(b1, qr[d0], p1, 0, 0, 0); } }
}
__device__ __forceinline__ void kload8(bf16x8* kf, lds_cptr kp) {
    kf[0] = *(const LAS bf16x8*)(kp);        kf[1] = *(const LAS bf16x8*)(kp + 512);
    kf[2] = *(const LAS bf16x8*)(kp + 2048); kf[3] = *(const LAS bf16x8*)(kp + 2560);
    kf[4] = *(const LAS bf16x8*)(kp + 4096); kf[5] = *(const LAS bf16x8*)(kp + 4608);
    kf[6] = *(const LAS bf16x8*)(kp + 6144); kf[7] = *(const LAS bf16x8*)(kp + 6656);
}
__device__ __forceinline__ void kload2(bf16x8* kf, lds_cptr kp, int j) { kf[2 * j] = *(const LAS bf16x8*)(kp + j * 2048); kf[2 * j + 1] = *(const LAS bf16x8*)(kp + j * 2048 + 512); }
__device__ __forceinline__ s16x4 vtr(lds_cptr p) { return __builtin_bit_cast(s16x4, __builtin_amdgcn_ds_read_tr16_b64_v4i16((LAS v4i16_t*)p)); }
__device__ __forceinline__ float rowmax(const f32x16& p0, const f32x16& p1) {
    float a = max3f(p0[0], p0[1], p1[0]), b = max3f(p0[2], p0[3], p1[1]); a = max3f(a, p1[2], p1[3]);
#pragma unroll
    for (int r = 4; r < 16; r += 4) { a = max3f(a, p0[r], p0[r + 1]); b = max3f(b, p0[r + 2], p0[r + 3]); a = max3f(a, p1[r], p1[r + 1]); b = max3f(b, p1[r + 2], p1[r + 3]); }
    const float m = max2f(a, b);
    auto rr = __builtin_amdgcn_permlane32_swap(__float_as_uint(m), __float_as_uint(m), false, false);
    return max2f(__uint_as_float(rr[0]), __uint_as_float(rr[1]));
}
__device__ __forceinline__ void pv(f32x16* o, int vb, bf16x8 pa0, bf16x8 pa1, bf16x8 pa2, bf16x8 pa3) {
#pragma unroll
    for (int d0 = 0; d0 < 2; ++d0) { s16x4 lo[4], hi[4];
#pragma unroll
        for (int ks = 0; ks < 4; ++ks) {
            asm volatile("ds_read_b64_tr_b16 %0,%1 offset:%c2" : "=&v"(lo[ks]) : "v"(vb), "i"(d0 * 4096 + ks * 1024) : "memory");
            asm volatile("ds_read_b64_tr_b16 %0,%1 offset:%c2" : "=&v"(hi[ks]) : "v"(vb), "i"(d0 * 4096 + ks * 1024 + 512) : "memory"); }
        asm volatile("s_waitcnt lgkmcnt(0)" ::: "memory"); SBAR();
#define PK(k) (bf16x8){lo[k][0], lo[k][1], lo[k][2], lo[k][3], hi[k][0], hi[k][1], hi[k][2], hi[k][3]}
        o[d0] = __builtin_amdgcn_mfma_f32_32x32x16_bf16(pa0, PK(0), o[d0], 0, 0, 0);
        o[d0] = __builtin_amdgcn_mfma_f32_32x32x16_bf16(pa1, PK(1), o[d0], 0, 0, 0);
        o[d0] = __builtin_amdgcn_mfma_f32_32x32x16_bf16(pa2, PK(2), o[d0], 0, 0, 0);
        o[d0] = __builtin_amdgcn_mfma_f32_32x32x16_bf16(pa3, PK(3), o[d0], 0, 0, 0);
#undef PK
    }
}
template <int THRL> __device__ __forceinline__ void attn_unit(Frame& F, int b, int h, int qb) {
    refresh(F); unsigned char* ws_ = (unsigned char*)ldptr(F, 30);
    const int tid = F.tid, lane = tid & 63, r32 = lane & 31, hi = lane >> 5; const int wid = F.wave;
    const long rowbase = (long)b * SEQ; const int q0 = qb * 256;
    const float* BI = (const float*)(ws_ + WS_BIAS) + ((size_t)b * 8 + h) * SEQ;
    lds_cptr shm3 = (lds_cptr)F.lds; const unsigned lds0 = (unsigned)(uintptr_t)F.lds;
    LAS float* wsf = (LAS float*)(F.lds + LDS_WS) + wid * 64;
    LAS float* BL = (LAS float*)(F.lds + LDS_BL);
    int T0 = 0; const float ref = BI[q0];
    { const int NTa = (q0 + 256) / 64; const float vlast = (lane < NTa) ? BI[64 * lane + 63] : 3.0e38f;
      const unsigned long long ok = __ballot(vlast - ref >= -150.f);
      T0 = ok ? (int)(__ffsll((long long)ok) - 1) : 0; T0 = __builtin_amdgcn_readfirstlane(T0) & ~1; }
    const int NT = (q0 + 256) / 64 - T0;
    const bf16_t* Qw = (const bf16_t*)(ws_ + WS_Q) + (rowbase + q0 + wid * QBLK) * APITCH + h * 64;
    const bf16_t* Kh = (const bf16_t*)(ws_ + WS_K) + (rowbase + 64 * T0) * APITCH + h * 64; const bf16_t* Vh = (const bf16_t*)(ws_ + WS_V) + (rowbase + 64 * T0) * APITCH + h * 64;
    const bf16_t* ksrc = Kh + (long)lane * APITCH + wid * 8;
    const bf16_t* vsrc = Vh + (long)(16 * (wid & 3) + (lane >> 2)) * APITCH + (wid >> 2) * 32 + (lane & 3) * 8;
    const unsigned kdst = lds0 + LDS_K + wid * 1024, vdst = lds0 + LDS_V + wid * 1024;
#define DMA_K(t, slot) glds16(ksrc + (long)(t) * KVBLK * APITCH, (unsigned)__builtin_amdgcn_readfirstlane(kdst + (slot)))
#define DMA_V(t, slot) glds16(vsrc + (long)(t) * KVBLK * APITCH, (unsigned)__builtin_amdgcn_readfirstlane(vdst + (slot)))
    const int vb0 = (int)(lds0 + LDS_V) + ((lane >> 4) & 1) * 32 + (lane & 3) * 8 + (4 * hi + ((lane & 15) >> 2)) * 64;
    bf16x8 kf[8];
    const lds_cptr kp0 = shm3 + LDS_K + hi * 1024 + r32 * 16; const lds_cptr vp0 = shm3 + LDS_V + ((lane >> 4) & 1) * 32 + (lane & 3) * 8 + (4 * hi + ((lane & 15) >> 2)) * 64;
    const LAS float* blp = BL + 4 * hi;
    DMA_K(0, 0); DMA_V(0, 0); DMA_K(1, SLOTB);
    { const int nfl = NT * 64; const float* src = BI + 64 * T0;
      for (int i = tid; i < nfl; i += NTHR) BL[i] = src[i] - ref; }
    bf16x8 qr[4];
#pragma unroll
    for (int d0 = 0; d0 < 4; ++d0) qr[d0] = *(const bf16x8*)(Qw + (long)r32 * APITCH + d0 * 16 + hi * 8);
    float mhat = BI[q0 + wid * QBLK + r32] - ref, l_reg = 0.f; f32x16 o[2]; o[0] = f32x16{}; o[1] = f32x16{}; const f32x16 zc = {};
    const int qrel = wid * QBLK + r32;
#define CMASK(P0, P1, t) do { int jb_ = (t) - (NT - 4); if (jb_ >= 0) cmask(P0, P1, jb_, qrel, hi); } while (0)
#define BIAS(P0, P1, t) do { const LAS float* bl_ = blp + (t) * 64; \
    _Pragma("unroll") for (int g_ = 0; g_ < 4; ++g_) { const f32x4 b0_ = *(const LAS f32x4*)(bl_ + 8 * g_), b1_ = *(const LAS f32x4*)(bl_ + 32 + 8 * g_); \
      _Pragma("unroll") for (int i_ = 0; i_ < 4; ++i_) { P0[4 * g_ + i_] += b0_[i_] - mhat; P1[4 * g_ + i_] += b1_[i_] - mhat; } } } while (0)
    bool resc = false;
#define RESC() do { if (resc) { asm volatile("s_waitcnt lgkmcnt(0)" ::: "memory"); \
      _Pragma("unroll") for (int d_ = 0; d_ < 2; ++d_) _Pragma("unroll") for (int r = 0; r < 16; ++r) o[d_][r] *= wsf[crow(r, hi)]; } } while (0)
    f32x16 pA0, pA1, pB0, pB1;
    int sl_prev = 0, sl_cur = 0, sl_next = SLOTB;
#define ROT() do { sl_prev = sl_cur; sl_cur = sl_next; sl_next = (sl_next == (NSLOT - 1) * SLOTB) ? 0 : sl_next + SLOTB; } while (0)
    DMA_K(2, 2 * SLOTB);
    WAIT_BAR(3);
    qkt(pA0, pA1, shm3 + LDS_K, qr, r32, hi); asm volatile("s_nop 15\n\ts_nop 7" : "+v"(pA0), "+v"(pA1)); BIAS(pA0, pA1, 0); CMASK(pA0, pA1, 0);
    { const float rm = rowmax(pA0, pA1);
      if (__any(rm > (float)THRL)) { const float dl = __builtin_fmaxf(rm, 0.f); mhat += dl;
#pragma unroll
          for (int r = 0; r < 16; ++r) { pA0[r] -= dl; pA1[r] -= dl; } } }
#pragma unroll
    for (int r = 0; r < 16; ++r) pA0[r] = __builtin_amdgcn_exp2f(pA0[r]);
#pragma unroll
    for (int r = 0; r < 16; ++r) pA1[r] = __builtin_amdgcn_exp2f(pA1[r]);
    WAIT_BAR(0);
    DMA_K(3, 0); DMA_V(1, SLOTB);
    ROT();
    kload8(kf, kp0 + sl_cur);
    WAIT_BAR(2);
    s16x4 vlo[8], vhi[8]; u32x4 pw0, pw1, pw2, pw3;
#define PKW(P, B) cvtpk(P[B], P[B + 1])
#define PAF(k) __builtin_bit_cast(bf16x8, pw##k)
#define VFR(i) (bf16x8){vlo[i][0], vlo[i][1], vlo[i][2], vlo[i][3], vhi[i][0], vhi[i][1], vhi[i][2], vhi[i][3]}
#define PINV(x) asm volatile("" : "+v"(x))
#define MX3(a, b, c) __builtin_fmaxf(__builtin_fmaxf((a), (b)), (c))
#define GAPA(MF, A0, A1, A2, A3, W0, W1, PW) do { MF; sacc += A0; sacc += A1; sacc += A2; sacc += A3; PINV(sacc); W0; W1; PINV(PW); SBAR(); } while (0)
#define EX(v) __builtin_amdgcn_exp2f(v)
#define GAPB(MF, X, B) do { MF; X[B] = EX(X[B]); X[B + 1] = EX(X[B + 1]); X[B + 2] = EX(X[B + 2]); X[B + 3] = EX(X[B + 3]); PINV(X); SBAR(); } while (0)
#define VRD(i) do { vlo[i] = vtr(vp_ + (((i) >> 2) * 4096 + ((i) & 3) * 1024)); vhi[i] = vtr(vp_ + (((i) >> 2) * 4096 + ((i) & 3) * 1024 + 512)); } while (0)
#define KRD(G, j) do { if (G) { kload2(kf, kp0 + sl_next, j); SBAR(); } } while (0)
#define STEP(C0, C1, P0, P1, t, GK, GV, GL) do { SBAR(); \
    const lds_cptr vp_ = vp0 + sl_prev; \
    VRD(0); SBAR(); float sacc = (P0[0] + P0[1]); \
    GAPA(C0 = __builtin_amdgcn_mfma_f32_32x32x16_bf16(kf[0], qr[0], zc, 0, 0, 0), P0[2], P0[3], P0[4], P0[5],     pw0[0] = PKW(P0, 0), pw0[1] = PKW(P0, 2), pw0); \
    VRD(4); SBAR(); GAPA(C1 = __builtin_amdgcn_mfma_f32_32x32x16_bf16(kf[1], qr[0], zc, 0, 0, 0), P0[6], P0[7], P0[8], P0[9],     pw0[2] = PKW(P0, 4), pw0[3] = PKW(P0, 6), pw0); \
    VRD(1); SBAR(); GAPA(C0 = __builtin_amdgcn_mfma_f32_32x32x16_bf16(kf[2], qr[1], C0, 0, 0, 0),   P0[10], P0[11], P0[12], P0[13], pw1[0] = PKW(P0, 8), pw1[1] = PKW(P0, 10), pw1); \
    VRD(5); SBAR(); GAPA(C1 = __builtin_amdgcn_mfma_f32_32x32x16_bf16(kf[3], qr[1], C1, 0, 0, 0),   P0[14], P0[15], P1[0], P1[1],   pw1[2] = PKW(P0, 12), pw1[3] = PKW(P0, 14), pw1); \
    VRD(2); SBAR(); GAPA(C0 = __builtin_amdgcn_mfma_f32_32x32x16_bf16(kf[4], qr[2], C0, 0, 0, 0),   P1[2], P1[3], P1[4], P1[5],     pw2[0] = PKW(P1, 0), pw2[1] = PKW(P1, 2), pw2); \
    VRD(6); SBAR(); GAPA(C1 = __builtin_amdgcn_mfma_f32_32x32x16_bf16(kf[5], qr[2], C1, 0, 0, 0),   P1[6], P1[7], P1[8], P1[9],     pw2[2] = PKW(P1, 4), pw2[3] = PKW(P1, 6), pw2); \
    VRD(3); SBAR(); GAPA(C0 = __builtin_amdgcn_mfma_f32_32x32x16_bf16(kf[6], qr[3], C0, 0, 0, 0),   P1[10], P1[11], P1[12], P1[13], pw3[0] = PKW(P1, 8), pw3[1] = PKW(P1, 10), pw3); \
    VRD(7); SBAR(); GAPA(C1 = __builtin_amdgcn_mfma_f32_32x32x16_bf16(kf[7], qr[3], C1, 0, 0, 0),   P1[14], P1[15], 0.f, 0.f,       pw3[2] = PKW(P1, 12), pw3[3] = PKW(P1, 14), pw3); \
    l_reg += sacc; \
    if (GK) { DMA_K((t) + 3, sl_cur); } if (GV) { DMA_V((t) + 1, sl_next); } \
    BIAS(C0, C1, t); \
    CMASK(C0, C1, t); \
    { float a = MX3(C0[0], C0[1], C1[0]), b = MX3(C0[2], C0[3], C1[1]); a = MX3(a, C1[2], C1[3]); \
      _Pragma("unroll") for (int r = 4; r < 16; r += 4) { a = MX3(a, C0[r], C0[r + 1]); b = MX3(b, C0[r + 2], C0[r + 3]); a = MX3(a, C1[r], C1[r + 1]); b = MX3(b, C1[r + 2], C1[r + 3]); } \
      float rm = __builtin_fmaxf(a, b); { auto rr = __builtin_amdgcn_permlane32_swap(__float_as_uint(rm), __float_as_uint(rm), false, false); rm = __builtin_fmaxf(__uint_as_float(rr[0]), __uint_as_float(rr[1])); } \
      resc = false; \
      if (__builtin_expect(__any(rm > (float)THRL), 0)) { const float dl = __builtin_fmaxf(rm, 0.f); mhat += dl; \
        _Pragma("unroll") for (int r = 0; r < 16; ++r) { C0[r] -= dl; C1[r] -= dl; } \
        const float f = __builtin_amdgcn_exp2f(-dl); l_reg *= f; if (hi == 0) wsf[r32] = f; resc = true; } } \
    SBAR(); \
    GAPB(o[0] = __builtin_amdgcn_mfma_f32_32x32x16_bf16(PAF(0), VFR(0), o[0], 0, 0, 0), C0, 0); \
    GAPB(o[1] = __builtin_amdgcn_mfma_f32_32x32x16_bf16(PAF(0), VFR(4), o[1], 0, 0, 0), C0, 4); \
    KRD(GL, 0); GAPB(o[0] = __builtin_amdgcn_mfma_f32_32x32x16_bf16(PAF(1), VFR(1), o[0], 0, 0, 0), C0, 8); \
    KRD(GL, 1); GAPB(o[1] = __builtin_amdgcn_mfma_f32_32x32x16_bf16(PAF(1), VFR(5), o[1], 0, 0, 0), C0, 12); \
    KRD(GL, 2); GAPB(o[0] = __builtin_amdgcn_mfma_f32_32x32x16_bf16(PAF(2), VFR(2), o[0], 0, 0, 0), C1, 0); \
    KRD(GL, 3); GAPB(o[1] = __builtin_amdgcn_mfma_f32_32x32x16_bf16(PAF(2), VFR(6), o[1], 0, 0, 0), C1, 4); \
    GAPB(o[0] = __builtin_amdgcn_mfma_f32_32x32x16_bf16(PAF(3), VFR(3), o[0], 0, 0, 0), C1, 8); \
    GAPB(o[1] = __builtin_amdgcn_mfma_f32_32x32x16_bf16(PAF(3), VFR(7), o[1], 0, 0, 0), C1, 12); \
    } while (0)
    int t = 1;
#undef CMASK
#define CMASK(P0, P1, t) do { } while (0)
    for (; t + 5 < NT; t += 2) {
        STEP(pB0, pB1, pA0, pA1, t, true, true, true);     WAIT_BAR(2); RESC(); ROT();
        STEP(pA0, pA1, pB0, pB1, t + 1, true, true, true); WAIT_BAR(2); RESC(); ROT();
    }
#undef CMASK
#define CMASK(P0, P1, t) do { int jb_ = (t) - (NT - 4); if (jb_ >= 0) cmask(P0, P1, jb_, qrel, hi); } while (0)
#define ENDW(tt) do { if ((tt) + 3 < NT) { WAIT_BAR(2); } else if ((tt) + 2 < NT) { WAIT_BAR(1); } else { WAIT_BAR(0); } } while (0)
    for (; t + 1 < NT; t += 2) {
        STEP(pB0, pB1, pA0, pA1, t, (t + 3 < NT), (t + 1 < NT), (t + 1 < NT));         ENDW(t);     RESC(); ROT();
        STEP(pA0, pA1, pB0, pB1, t + 1, (t + 4 < NT), (t + 2 < NT), (t + 2 < NT));     ENDW(t + 1); RESC(); ROT();
    }
    STEP(pB0, pB1, pA0, pA1, NT - 1, false, false, false); RESC();
    { float sacc = pB0[0] + pB0[1];
#pragma unroll
      for (int r = 2; r < 16; ++r) sacc += pB0[r];
#pragma unroll
      for (int r = 0; r < 16; ++r) sacc += pB1[r];
      l_reg += sacc;
      pw0 = (u32x4){PKW(pB0, 0), PKW(pB0, 2), PKW(pB0, 4), PKW(pB0, 6)}; pw1 = (u32x4){PKW(pB0, 8), PKW(pB0, 10), PKW(pB0, 12), PKW(pB0, 14)}; pw2 = (u32x4){PKW(pB1, 0), PKW(pB1, 2), PKW(pB1, 4), PKW(pB1, 6)}; pw3 = (u32x4){PKW(pB1, 8), PKW(pB1, 10), PKW(pB1, 12), PKW(pB1, 14)};
      SBAR(); pv(o, vb0 + sl_cur, PAF(0), PAF(1), PAF(2), PAF(3)); }
#undef PKW
#undef PAF
#undef VFR
#undef PINV
#undef MX3
#undef GAPA
#undef GAPB
#undef EX
#undef VRD
#undef KRD
#undef STEP
#undef ENDW
    { auto rr = __builtin_amdgcn_permlane32_swap(__float_as_uint(l_reg), __float_as_uint(l_reg), false, false); l_reg = __uint_as_float(rr[0]) + __uint_as_float(rr[1]); }
    if (hi == 0) wsf[32 + r32] = l_reg; asm volatile("s_waitcnt lgkmcnt(0)" ::: "memory");
    float rli[16];
#pragma unroll
    for (int r = 0; r < 16; ++r) rli[r] = __builtin_amdgcn_rcpf(wsf[32 + crow(r, hi)]);
    bf16_t* Ow = (bf16_t*)(ws_ + WS_MIXED) + (rowbase + q0 + wid * QBLK) * OPITCH + 512 + h * 64;
    { LAS bf16_t* stg = (LAS bf16_t*)(F.lds + LDS_OST) + wid * 2048;
#pragma unroll
      for (int r = 0; r < 16; ++r) { const int orow = crow(r, hi);
#pragma unroll
          for (int d0 = 0; d0 < 2; ++d0) stg[orow * 64 + d0 * 32 + r32] = (bf16_t)f2bf(o[d0][r] * rli[r]); }
      asm volatile("s_waitcnt lgkmcnt(0)" ::: "memory");
#pragma unroll
      for (int i = 0; i < 4; ++i) { const int row = i * 8 + (lane >> 3), ch = lane & 7; const u32x4 v = *(const LAS u32x4*)(stg + row * 64 + ch * 8); *(u32x4*)(Ow + (long)row * OPITCH + ch * 8) = v; } }
    asm volatile("s_waitcnt lgkmcnt(0)\n\ts_barrier" ::: "memory");
#undef DMA_K
#undef DMA_V
#undef CMASK
#undef BIAS
#undef RESC
#undef ROT
}
#undef SBAR
#undef WAIT_BAR
}

constexpr int AT_ROWB = 144;
constexpr int AT_KOFF = 0, AT_VOFF = 2 * 64 * AT_ROWB, AT_BOFF = 4 * 64 * AT_ROWB, AT_QUEUE = AT_BOFF + 2 * 256;
__device__ __forceinline__ void attn_unit(Frame& F, int b, int h, int qb) {
    refresh(F); unsigned char* ws_ = (unsigned char*)ldptr(F, 30); const InTab in_{F.lds}; gu32* ctl_ = (gu32*)ws_;

    const int lane = F.lane, r32 = lane & 31, hi = lane >> 5, wid = F.wave, tid = F.tid;
    const bf16_t* Q = (const bf16_t*)(ws_ + WS_Q); const bf16_t* Kg = (const bf16_t*)(ws_ + WS_K); const bf16_t* Vg = (const bf16_t*)(ws_ + WS_V);
    const float* BI = (const float*)(ws_ + WS_BIAS) + ((size_t)b * 8 + h) * SEQ;
    const size_t rowbase = (size_t)b * SEQ; const int q0 = qb * 256, qw0 = q0 + wid * 32;
    LAS unsigned char* lds = F.lds;
    bf16x8 qr[4];
#pragma unroll
    for (int d0 = 0; d0 < 4; ++d0) qr[d0] = *(const bf16x8*)(Q + (rowbase + qw0 + r32) * 512 + h * 64 + d0 * 16 + hi * 8);
    const int NT = (q0 + 256) / 64;
    int T0 = 0;
    { const float nbq = BI[q0]; const float vlast = (lane < NT) ? BI[64 * lane + 63] : 3.0e38f;
      const unsigned long long ok = __ballot(vlast - nbq >= -150.f);
      T0 = ok ? (int)(__ffsll((long long)ok) - 1) : 0; T0 = __builtin_amdgcn_readfirstlane(T0); }
    const int srow = tid >> 3, sch = tid & 7;
    const bf16_t* kp = Kg + (rowbase + srow) * 512 + h * 64 + sch * 8; const bf16_t* vp = Vg + (rowbase + srow) * 512 + h * 64 + sch * 8;
    u32x4 kreg = *(const u32x4*)(kp + (size_t)T0 * 64 * 512), vreg = *(const u32x4*)(vp + (size_t)T0 * 64 * 512); float breg = (tid < 64) ? BI[T0 * 64 + tid] : 0.f;
    { const int b0_ = T0 & 1;
      *(LAS u32x4*)(lds + AT_KOFF + b0_ * 64 * AT_ROWB + srow * AT_ROWB + sch * 16) = kreg; *(LAS u32x4*)(lds + AT_VOFF + b0_ * 64 * AT_ROWB + srow * AT_ROWB + sch * 16) = vreg;
      if (tid < 64) *(LAS float*)(lds + AT_BOFF + b0_ * 256 + tid * 4) = breg; }
    __syncthreads();
    f32x16 o0 = {}, o1 = {};
    float nbi = BI[qw0 + r32];
    float lrun = 0.f;
    const int i16 = lane & 15, tq = i16 >> 2, tp = i16 & 3, blk = (lane >> 4) & 1;
    for (int t = T0; t < NT; ++t) {
        const int cb = t & 1, nb = cb ^ 1;
        if (t + 1 < NT) { kreg = *(const u32x4*)(kp + (size_t)(t + 1) * 64 * 512); vreg = *(const u32x4*)(vp + (size_t)(t + 1) * 64 * 512); if (tid < 64) breg = BI[(t + 1) * 64 + tid]; }
        if (64 * t <= qw0 + 31) {
            const LAS unsigned char* Ks = lds + AT_KOFF + cb * 64 * AT_ROWB; const LAS unsigned char* Vs = lds + AT_VOFF + cb * 64 * AT_ROWB; const LAS float* Bs = (const LAS float*)(lds + AT_BOFF + cb * 256);
            f32x16 p0, p1;
#pragma unroll
            for (int g = 0; g < 4; ++g) {
                const f32x4 b0 = *(const LAS f32x4*)(Bs + 8 * g + 4 * hi), b1 = *(const LAS f32x4*)(Bs + 32 + 8 * g + 4 * hi);
#pragma unroll
                for (int i = 0; i < 4; ++i) { p0[4 * g + i] = b0[i] - nbi; p1[4 * g + i] = b1[i] - nbi; }
            }
#pragma unroll
            for (int d0 = 0; d0 < 4; ++d0) {
                const bf16x8 a0 = *(const LAS bf16x8*)(Ks + r32 * AT_ROWB + (d0 * 16 + hi * 8) * 2);
                const bf16x8 a1 = *(const LAS bf16x8*)(Ks + (32 + r32) * AT_ROWB + (d0 * 16 + hi * 8) * 2);
                p0 = __builtin_amdgcn_mfma_f32_32x32x16_bf16(a0, qr[d0], p0, 0, 0, 0);
                p1 = __builtin_amdgcn_mfma_f32_32x32x16_bf16(a1, qr[d0], p1, 0, 0, 0);
            }
            if (64 * t + 63 > qw0) {
                const int qabs = qw0 + r32;
#pragma unroll
                for (int i = 0; i < 16; ++i) { const int kv = 64 * t + crow(i, hi); if (kv > qabs) p0[i] = -INFINITY; if (kv + 32 > qabs) p1[i] = -INFINITY; }
            }
            float mx = fmaxf(fmaxf(p0[0], p0[1]), p1[0]);
#pragma unroll
            for (int i = 1; i < 16; ++i) mx = fmaxf(fmaxf(mx, p0[i]), p1[i]);
            if (__any(mx > 24.f)) {
                const float mo = fmaxf(mx, __shfl_xor(mx, 32));
                const float dl = fmaxf(mo, 0.f);
                nbi += dl;
                const float f = __builtin_amdgcn_exp2f(-dl);
                lrun *= f;
#pragma unroll
                for (int i = 0; i < 16; ++i) { p0[i] -= dl; p1[i] -= dl; o0[i] *= f; o1[i] *= f; }
            }
            float ls0 = 0.f, ls1 = 0.f;
#pragma unroll
            for (int i = 0; i < 16; ++i) { p0[i] = __builtin_amdgcn_exp2f(p0[i]); p1[i] = __builtin_amdgcn_exp2f(p1[i]); ls0 += p0[i]; ls1 += p1[i]; }
            lrun += ls0 + ls1;
            bf16x8 pf[4];
#pragma unroll
            for (int s = 0; s < 2; ++s) {
                u32x4 w0, w1;
                w0.x = cvtpk(p0[8 * s + 0], p0[8 * s + 1]); w0.y = cvtpk(p0[8 * s + 2], p0[8 * s + 3]); w0.z = cvtpk(p0[8 * s + 4], p0[8 * s + 5]); w0.w = cvtpk(p0[8 * s + 6], p0[8 * s + 7]);
                w1.x = cvtpk(p1[8 * s + 0], p1[8 * s + 1]); w1.y = cvtpk(p1[8 * s + 2], p1[8 * s + 3]); w1.z = cvtpk(p1[8 * s + 4], p1[8 * s + 5]); w1.w = cvtpk(p1[8 * s + 6], p1[8 * s + 7]);
                pf[s] = __builtin_bit_cast(bf16x8, w0); pf[2 + s] = __builtin_bit_cast(bf16x8, w1);
            }
#pragma unroll
            for (int ks4 = 0; ks4 < 4; ++ks4) {
                const int kvb = (ks4 >> 1) * 32 + (ks4 & 1) * 16 + 4 * hi;
#pragma unroll
                for (int d0 = 0; d0 < 2; ++d0) {
                    const LAS unsigned char* a_lo = Vs + (kvb + tq) * AT_ROWB + (32 * d0 + 16 * blk) * 2 + 8 * tp;
                    const s16x4 lo = __builtin_bit_cast(s16x4, __builtin_amdgcn_ds_read_tr16_b64_v4i16((LAS s16x4*)a_lo));
                    const s16x4 hv = __builtin_bit_cast(s16x4, __builtin_amdgcn_ds_read_tr16_b64_v4i16((LAS s16x4*)(a_lo + 8 * AT_ROWB)));
                    const bf16x8 va = __builtin_shufflevector(lo, hv, 0, 1, 2, 3, 4, 5, 6, 7);
                    if (d0 == 0) o0 = __builtin_amdgcn_mfma_f32_32x32x16_bf16(va, pf[ks4], o0, 0, 0, 0);
                    else o1 = __builtin_amdgcn_mfma_f32_32x32x16_bf16(va, pf[ks4], o1, 0, 0, 0);
                }
            }
        }
        if (t + 1 < NT) {
            *(LAS u32x4*)(lds + AT_KOFF + nb * 64 * AT_ROWB + srow * AT_ROWB + sch * 16) = kreg; *(LAS u32x4*)(lds + AT_VOFF + nb * 64 * AT_ROWB + srow * AT_ROWB + sch * 16) = vreg;
            if (tid < 64) *(LAS float*)(lds + AT_BOFF + nb * 256 + tid * 4) = breg;
        }
        __syncthreads();
    }
    lrun += __shfl_xor(lrun, 32);
    const float inv = 1.f / lrun;
    bf16_t* O = (bf16_t*)(ws_ + WS_MIXED) + (rowbase + qw0 + r32) * 1024 + 512 + h * 64;
#pragma unroll
    for (int g = 0; g < 4; ++g) {
        u32x2 w; w.x = cvtpk(o0[4 * g] * inv, o0[4 * g + 1] * inv); w.y = cvtpk(o0[4 * g + 2] * inv, o0[4 * g + 3] * inv);
        *(u32x2*)(O + 8 * g + 4 * hi) = w;
        u32x2 w2; w2.x = cvtpk(o1[4 * g] * inv, o1[4 * g + 1] * inv); w2.y = cvtpk(o1[4 * g + 2] * inv, o1[4 * g + 3] * inv);
        *(u32x2*)(O + 32 + 8 * g + 4 * hi) = w2;
    }
}
__device__ __forceinline__ void pool_batch(Frame& F, const InTab& in_, unsigned char* ws_, int l, int q) {
    LAS float* Wp = (LAS float*)F.lds;
    LAS float* ps = (LAS float*)(F.lds + 65536) + F.wave * 512;
    { const float* w = in_[I_POOLW] + (size_t)l * 4 * 64 * 64; f32x4 t8[8];
#pragma unroll
      for (int u = 0; u < 8; ++u) t8[u] = *(const f32x4*)(w + 4 * (F.tid + NTHR * u));
#pragma unroll
      for (int u = 0; u < 8; ++u) *(LAS f32x4*)(Wp + 4 * (F.tid + NTHR * u)) = t8[u]; }
    __syncthreads();
    const int c = F.lane;
    bf16_t* MX = (bf16_t*)(ws_ + WS_MIXED);
    const float* ZP = (const float*)(ws_ + WS_ZP);
    for (int jj = 0; jj < 8; ++jj) {
        const int it = q * 64 + jj * 8 + F.wave;
        const int g = it & 3, m0 = (it >> 2) * 8, win = 2 << g;
        {
            const int seq0 = m0 & ~(SEQ - 1);
            float zz[23];
#pragma unroll
            for (int qq = 0; qq < 23; ++qq) { const int rr = m0 - 15 + qq; zz[qq] = (rr >= seq0 && (qq >= 15 || 15 - qq < win + 7)) ? ZP[(size_t)rr * 256 + 64 * g + c] : 0.f; }
#pragma unroll
            for (int i = 0; i < 8; ++i) {
                const int t = (m0 + i) & (SEQ - 1); const int n = (t + 1 < win) ? t + 1 : win;
                float s = 0.f;
#pragma unroll
                for (int j = 0; j < 16; ++j) s += (j < win) ? zz[15 + i - j] : 0.f;
                ps[i * 64 + c] = s / (float)n - zz[15 + i];
            }
        }
        LDS_WAIT(); asm volatile("" ::: "memory");
        float acc[8];
#pragma unroll
        for (int i = 0; i < 8; ++i) acc[i] = 0.f;
        const LAS float* W = Wp + g * 4096;
        for (int j = 0; j < 64; j += 4) {
            const float w_0 = W[(j + 0) * 64 + c], w_1 = W[(j + 1) * 64 + c], w_2 = W[(j + 2) * 64 + c], w_3 = W[(j + 3) * 64 + c];
#pragma unroll
            for (int i = 0; i < 8; ++i) { const f32x4 x = *(const LAS f32x4*)(ps + i * 64 + j); acc[i] += x.x * w_0 + x.y * w_1 + x.z * w_2 + x.w * w_3; }
        }
        const float sc = in_[I_POOLS][l * 256 + 64 * g + c];
#pragma unroll
        for (int i = 0; i < 8; ++i) MX[(size_t)(m0 + i) * 1024 + 256 + 64 * g + c] = (bf16_t)f2bf(acc[i] * sc);
        LDS_WAIT(); asm volatile("" ::: "memory");
    }
    __syncthreads();
}
__device__ __forceinline__ void tail_convert(Frame& F, int lc, int nmax) {
    refresh(F); unsigned char* ws_ = (unsigned char*)ldptr(F, 30); const InTab in_{F.lds}; gu32* ctl_ = (gu32*)ws_;
    LAS int* qslot = (LAS int*)(F.lds + MISC_OFF + 64);
    for (int n = 0; n < nmax; ++n) {
        if (F.tid == 0) qslot[0] = (int)__hip_atomic_fetch_add(ctl_ + CW_CQ + lc * 64, 1u, RLX_AGENT);
        __syncthreads();
        const int q = qslot[0];
        __syncthreads();
        if (q >= 768) break;
        convert_moe_batch(F, in_, ws_, lc, q);
    }
    __syncthreads();
}
__device__ __forceinline__ void conv_worker(Frame& F, int lc, int gdw, int maxb) {
    refresh(F); unsigned char* ws_ = (unsigned char*)ldptr(F, 30); const InTab in_{F.lds}; gu32* ctl_ = (gu32*)ws_;
    LAS int* qslot = (LAS int*)(F.lds + MISC_OFF + 64);
    int last = 0;
    for (int n = 0; n < maxb && !last; ++n) {
        if (F.tid == 0) { qslot[1] = (int)__hip_atomic_load(ctl_ + gdw, RLX_AGENT); qslot[0] = (int)__hip_atomic_fetch_add(ctl_ + CW_CQ + lc * 64, 1u, RLX_AGENT); }
        __syncthreads();
        const int q = qslot[0]; last = qslot[1];
        __syncthreads();
        if (q >= 768) break;
        convert_moe_batch(F, in_, ws_, lc, q);
    }
    __syncthreads();
}
#if ATTN_TUNED
#define ATTN_CALL(F_, b_, h_, q_) fa::attn_unit<16>(F_, b_, h_, q_)
#else
#define ATTN_CALL(F_, b_, h_, q_) attn_unit(F_, b_, h_, q_)
#endif
__device__ __forceinline__ void phase_mix(Frame& F, int l, int qsel = 0) {
    refresh(F); unsigned char* ws_ = (unsigned char*)ldptr(F, 30); const InTab in_{F.lds}; gu32* ctl_ = (gu32*)ws_;

#if CHUNKED_SCAN
    if (blockIdx.x < 16) { chunk_states(F, ws_, blockIdx.x); if (PROBE_DUP == 16) { __syncthreads(); chunk_states(F, ws_, blockIdx.x); } __syncthreads(); }
#else
    if (blockIdx.x < 64) { scan_block(F, blockIdx.x); if (PROBE_DUP == 12) { __syncthreads(); scan_block(F, blockIdx.x); } return; }
#endif
    LAS int* qslot = (LAS int*)(F.lds + MISC_OFF + 64);
    for (;;) {
        if (F.tid == 0) qslot[0] = (int)__hip_atomic_fetch_add(ctl_ + CW_QUEUE + (l + 4 * qsel) * 64, 1u, RLX_AGENT);
        __syncthreads();
        const int u = qslot[0];
        __syncthreads();
        if (PROBE_DUP == 17) { if (u >= 1024 + 128 + 768) break; if (u < 1024) { const int uu = u >> 1; const int qb = 15 - (uu >> 5), bh = uu & 31; ATTN_CALL(F, bh >> 3, bh & 7, qb); } else if (u < 1152) pool_batch(F, in_, ws_, l, u - 1024); else convert_moe_batch(F, in_, ws_, l, u - 1152); continue; }
        if (PROBE_DUP == 18) { if (u >= 512 + 128 + 1536) break; if (u < 512) { const int qb = 15 - (u >> 5), bh = u & 31; ATTN_CALL(F, bh >> 3, bh & 7, qb); } else if (u < 640) pool_batch(F, in_, ws_, l, u - 512); else convert_moe_batch(F, in_, ws_, l, (u - 640) >> 1); continue; }
        if (u >= 512 + 128) break;
        if (u < 512) { const int qb = 15 - (u >> 5), bh = u & 31; ATTN_CALL(F, bh >> 3, bh & 7, qb); }
        else pool_batch(F, in_, ws_, l, u - 512);
    }
    tail_convert(F, l, 1 << 20);
}

__device__ __forceinline__ void phase_post(Frame& F, int l) {
    refresh(F); unsigned char* ws_ = (unsigned char*)ldptr(F, 30); const InTab in_{F.lds}; gu32* ctl_ = (gu32*)ws_;

    const int gw = F.vcu * NWAVES + F.wave, NGW = F.G * NWAVES, c = F.lane;
    bf16_t* MX = (bf16_t*)(ws_ + WS_MIXED);
    {
        float lw[4], lb[4], rkw[4];
#pragma unroll
        for (int h = 0; h < 4; ++h) { lw[h] = in_[I_LNW][l * 256 + 64 * h + c]; lb[h] = in_[I_LNB][l * 256 + 64 * h + c]; rkw[h] = in_[I_RK][l * 256 + 64 * h + c]; }
        const float* YR = (const float*)(ws_ + WS_YRAW); const float* SCN = (const float*)(ws_ + WS_SCAN); const float* GG = (const float*)(ws_ + WS_G);
        for (int it0 = gw * 8; it0 < NTOK * 4; it0 += NGW * 8) {
            float y[8], vv[8], bn[8], gg[8];
#pragma unroll
            for (int u = 0; u < 8; ++u) {
                const int it = it0 + u, m = it >> 2, h = u & 3, b = m >> 12, t = m & (SEQ - 1);
                const float* sp = SCN + ((size_t)(b * 4 + h) * SEQ + t) * 384 + c;
                y[u] = YR[(size_t)m * 256 + 64 * h + c]; vv[u] = sp[192]; bn[u] = sp[0] * sp[128] * rkw[h]; gg[u] = GG[(size_t)m * 256 + 64 * h + c];
            }
#pragma unroll
            for (int u = 0; u < 8; ++u) {
                const int it = it0 + u, m = it >> 2, h = u & 3;
                const float mean = wave_sum(y[u]) * (1.f / 64.f); const float d = y[u] - mean; const float var = wave_sum(d * d) * (1.f / 64.f);
                float yn = d * (1.f / sqrtf(var + 64e-5f)) * lw[h] + lb[h];
                yn += wave_sum(bn[u]) * vv[u];
                yn *= gg[u];
                MX[(size_t)m * 1024 + 64 * h + c] = (bf16_t)f2bf(yn);
            }
        }
    }
}

__device__ __forceinline__ void phase_route(Frame& F, int l, int csel = 0) {
    refresh(F); unsigned char* ws_ = (unsigned char*)ldptr(F, 30); const InTab in_{F.lds}; gu32* ctl_ = (gu32*)ws_;

    LAS float* WT = (LAS float*)F.lds;
    LAS int* lcnt = (LAS int*)(F.lds + TAB_OFF);
    LAS int* lbase = lcnt + 32;
    LAS int* le = lbase + 32;
    LAS int* lpos = le + 256;
    { const float* rw = in_[I_RW] + (size_t)l * 1024 * 32;
      f32x4 t16[16];
#pragma unroll
      for (int u = 0; u < 16; ++u) t16[u] = *(const f32x4*)(rw + 4 * (F.tid + NTHR * u));
#pragma unroll
      for (int u = 0; u < 16; ++u) { const int i = F.tid + NTHR * u, k = i >> 3, e = (i & 7) * 4; WT[(e + 0) * 1024 + k] = t16[u].x; WT[(e + 1) * 1024 + k] = t16[u].y; WT[(e + 2) * 1024 + k] = t16[u].z; WT[(e + 3) * 1024 + k] = t16[u].w; } }
    const bf16_t* X = (const bf16_t*)(ws_ + WS_X); const float* MOD = (const float*)(ws_ + WS_MOD);
    const float* nw = in_[I_NORM2] + l * 1024;
    const float rb = in_[I_RB][l * 32 + (F.lane >> 1)];
    for (int tb = blockIdx.x; tb < NTOK / 64; tb += F.G) {
        if (F.tid < 32) lcnt[F.tid] = 0;
        __syncthreads();
        u32x2 xnx[2][4];
#pragma unroll
        for (int u = 0; u < 2; ++u)
#pragma unroll
            for (int j = 0; j < 4; ++j) xnx[u][j] = *(const u32x2*)(X + (size_t)(tb * 64 + F.wave * 8 + u) * 1024 + 4 * F.lane + 256 * j);
#pragma nounroll
        for (int ip = 0; ip < 4; ++ip) {
            const int ti0 = F.wave * 8 + 2 * ip, m0 = tb * 64 + ti0, b = m0 >> 12;
            const float* sh = MOD + (size_t)(l * 4 + b) * 6144 + 3 * 1024; const float* sc = sh + 1024;
            f32x4 hv[2][4];
#pragma unroll
            for (int u = 0; u < 2; ++u) {
                float ss = 0.f;
#pragma unroll
                for (int j = 0; j < 4; ++j) { hv[u][j] = up4(xnx[u][j]); ss += (hv[u][j].x * hv[u][j].x + hv[u][j].y * hv[u][j].y) + (hv[u][j].z * hv[u][j].z + hv[u][j].w * hv[u][j].w); }
                const float rs = 1.f / sqrtf(wave_sum(ss) * (1.f / 1024.f) + 1e-6f);
                bf16_t* H = (bf16_t*)(ws_ + WS_H) + (size_t)(m0 + u) * 1024;
#pragma unroll
                for (int j = 0; j < 4; ++j) { const int c0 = 4 * F.lane + 256 * j; const f32x4 w = *(const f32x4*)(nw + c0), s1 = *(const f32x4*)(sc + c0), s0 = *(const f32x4*)(sh + c0);
                    hv[u][j] = hv[u][j] * rs * w * (s1 + 1.f) + s0; u32x2 o; o.x = cvtpk(hv[u][j].x, hv[u][j].y); o.y = cvtpk(hv[u][j].z, hv[u][j].w); *(u32x2*)(H + c0) = o; }
            }
            if (ip < 3) {
#pragma unroll
                for (int u = 0; u < 2; ++u)
#pragma unroll
                    for (int j = 0; j < 4; ++j) xnx[u][j] = *(const u32x2*)(X + (size_t)(m0 + 2 + u) * 1024 + 4 * F.lane + 256 * j);
            }
            float val[2] = {0.f, 0.f};
#pragma unroll
            for (int half = 0; half < 2; ++half) {
                float a[2][16];
#pragma unroll
                for (int e = 0; e < 16; ++e) {
                    float s0 = 0.f, s1 = 0.f;
#pragma unroll
                    for (int j = 0; j < 4; ++j) { const f32x4 w = *(const LAS f32x4*)(WT + (16 * half + e) * 1024 + 4 * F.lane + 256 * j);
                        s0 += hv[0][j].x * w.x + hv[0][j].y * w.y + hv[0][j].z * w.z + hv[0][j].w * w.w; s1 += hv[1][j].x * w.x + hv[1][j].y * w.y + hv[1][j].z * w.z + hv[1][j].w * w.w; }
                    a[0][e] = s0; a[1][e] = s1;
                }
#pragma unroll
                for (int u = 0; u < 2; ++u) {
#pragma unroll
                    for (int q = 0; q < 8; ++q) { const auto rr = __builtin_amdgcn_permlane16_swap(__float_as_uint(a[u][q]), __float_as_uint(a[u][q + 8]), false, false); a[u][q] = __uint_as_float(rr[0]) + __uint_as_float(rr[1]); }
#define RSTEP(N, BIT, SEL) { const bool up_ = (F.lane & (BIT)) != 0; _Pragma("unroll") for (int q = 0; q < (N); ++q) { const float send = up_ ? a[u][q] : a[u][q + (N)]; const float keep = up_ ? a[u][q + (N)] : a[u][q]; a[u][q] = keep + dpp_f(send, SEL); } }
                    RSTEP(4, 8, 3) RSTEP(2, 4, 2) RSTEP(1, 2, 1)
#undef RSTEP
                    float v = a[u][0] + dpp_f(a[u][0], 0);
                    { const auto rr = __builtin_amdgcn_permlane32_swap(__float_as_uint(v), __float_as_uint(v), false, false); v = __uint_as_float(rr[0]) + __uint_as_float(rr[1]); }
                    if ((F.lane >> 5) == half) val[u] = v;
                }
            }
#pragma unroll
            for (int u = 0; u < 2; ++u) {
                float vv = val[u] + rb;
                const int ti = ti0 + u, m = m0 + u;
                float tv[4]; int te[4];
#pragma unroll
                for (int k = 0; k < 4; ++k) {
                    const float mx = wave_max(vv);
                    const unsigned long long bal = __ballot(vv == mx);
                    const int ln = __ffsll((long long)bal) - 1; const int e = ln >> 1;
                    tv[k] = mx; te[k] = e;
                    if ((F.lane >> 1) == e) vv = -INFINITY;
                }
                const float e1 = __expf(tv[1] - tv[0]), e2 = __expf(tv[2] - tv[0]), e3 = __expf(tv[3] - tv[0]); const float invs = 1.f / (1.f + e1 + e2 + e3);
                if (F.lane < 4) {
                    const int k = F.lane; const int e = (k == 0) ? te[0] : (k == 1) ? te[1] : (k == 2) ? te[2] : te[3];
                    const float gt = ((k == 0) ? 1.f : (k == 1) ? e1 : (k == 2) ? e2 : e3) * invs;
                    ((float*)(ws_ + WS_GATE))[(size_t)m * 4 + k] = gt;
                    le[ti * 4 + k] = e; lpos[ti * 4 + k] = atomicAdd((int*)&lcnt[e], 1);
                }
            }
        }
        __syncthreads();
        if (F.tid < 32) lbase[F.tid] = (int)__hip_atomic_fetch_add(ctl_ + CW_CNT + ((l + 4 * csel) * 32 + F.tid) * 64, (unsigned)lcnt[F.tid], RLX_AGENT);
        __syncthreads();
        if (F.tid < 256) { const int e = le[F.tid]; ((int*)(ws_ + WS_LIST))[e * NTOK + lbase[e] + lpos[F.tid]] = (tb * 64 + (F.tid >> 2)) * 4 + (F.tid & 3); }
        __syncthreads();
    }
}

constexpr int NPHASE = 2 + 9 * NL;
__global__ void __launch_bounds__(NTHR, 2) trunk_fwd(Args args) {
    extern __shared__ __attribute__((aligned(16))) unsigned char lds_raw[];
    Frame F;
    F.lds = (LAS unsigned char*)lds_raw;
    F.MISC = (volatile LAS unsigned*)(F.lds + MISC_OFF);
    F.tid = threadIdx.x; F.lane = F.tid & 63; F.wave = __builtin_amdgcn_readfirstlane(F.tid >> 6);
    F.G = gridDim.x; { const int bx = blockIdx.x; F.vcu = (F.G % 8 == 0) ? (bx % 8) * (F.G / 8) + bx / 8 : bx; }
    for (int u = F.tid; u < 64; u += NTHR) ((LAS unsigned*)(F.lds + MISC_OFF))[u] = 0u;
    if (F.tid < 29) *(LAS unsigned long long*)(F.lds + PTR_OFF + 8 * F.tid) = (unsigned long long)args.in[F.tid];
    if (F.tid == 29) *(LAS unsigned long long*)(F.lds + PTR_OFF + 8 * 29) = (unsigned long long)args.out;
    if (F.tid == 30) *(LAS unsigned long long*)(F.lds + PTR_OFF + 8 * 30) = (unsigned long long)args.ws;
    __syncthreads();
#if MK_PER_PHASE
#define GRID_BAR() do { } while (0)
#else
    XcdBarrier bar = xcd_barrier_post((unsigned*)(args.ws) + CW_BAR, F.MISC + 8);
#define GRID_BAR() xcd_barrier(bar)
#endif
    const int lo = args.ph_lo, hi = args.ph_hi;
    volatile LAS unsigned long long* tsw = (volatile LAS unsigned long long*)(F.lds + MISC_OFF + 192);
#define STAMP(id) do { if (PROBE_T >= 0 && blockIdx.x == 0 && F.tid == 0) { const unsigned long long now_ = wall_clock64(); if ((id) == PROBE_T) tsw[1] += now_ - tsw[0]; tsw[0] = now_; } } while (0)
    if (PROBE_T >= 0 && blockIdx.x == 0 && F.tid == 0) { const unsigned long long now_ = wall_clock64(); tsw[0] = now_; tsw[1] = 0ull; tsw[2] = now_; }
#define IN(k) (lo <= (k) && (k) < hi)
#define SEAM(k) do { if (IN(k) && IN((k) + 1)) GRID_BAR(); } while (0)
    if (IN(0)) { phase_prologue(F); if (PROBE_DUP == 1) { GRID_BAR(); phase_prologue(F); } SEAM(0); }
    if (IN(1)) { phase_combine(F, -1); if (PROBE_DUP == 2) { GRID_BAR(); phase_combine(F, -1); } SEAM(1); }
    for (int l = 0; l < NL; ++l) {
        const int p0 = 2 + 9 * l;
        if (IN(p0)) {
            refresh(F); unsigned char* ws_ = (unsigned char*)ldptr(F, 30); const InTab in_{F.lds};
            ProbDense P{(const char*)(ws_ + WS_H), (const char*)(ws_ + WS_WIN) + (size_t)l * NPROJ * 2048, NTOK / 256, NPROJ / 256, F.G, F.vcu};
            EpiProj E{ws_};
            pg8::gemm_phase<false, 1024>(F.lds, nullptr, F.tid, P, E);
            if (PROBE_DUP == 3) { GRID_BAR(); pg8::gemm_phase<false, 1024>(F.lds, nullptr, F.tid, P, E); }
            if (TAIL_CONVERT) { const int nun = (NTOK / 256) * (NPROJ / 256), mine = (nun - F.vcu + F.G - 1) / F.G, most = (nun + F.G - 1) / F.G; if (mine < most) tail_convert(F, l, most - mine); }
            SEAM(p0); STAMP(0);
        }
        if (IN(p0 + 1)) {
            phase_prep(F, l); if (PROBE_DUP == 4) { GRID_BAR(); phase_prep(F, l); }
            GRID_BAR(); STAMP(1);
            refresh(F); unsigned char* ws_ = (unsigned char*)ldptr(F, 30); const InTab in_{F.lds};
            ProbLora P{(const char*)(ws_ + WS_ALORA), (const char*)(ws_ + WS_LORA) + (size_t)l * 768 * 512, F.G, F.vcu};
            EpiLora E{ws_, in_[I_W0] + l * 256, in_[I_A0] + l * 256, in_[I_KA] + l * 256};
            pg8::gemm_phase<false, 256>(F.lds, nullptr, F.tid, P, E);
            if (TAIL_CONVERT && F.vcu >= 192) tail_convert(F, l, 1);
            SEAM(p0 + 1); STAMP(2);
        }
        if (IN(p0 + 2)) {
#if CHUNKED_SCAN
            { refresh(F); unsigned char* ws_ = (unsigned char*)ldptr(F, 30);
              ChunkRows cur = chunk_load(F, ws_, F.vcu);
              for (int job = F.vcu; job < 1024; job += F.G) {
                  ChunkRows nxt = cur; if (job + F.G < 1024) nxt = chunk_load(F, ws_, job + F.G);
                  chunk_job(F, ws_, job, cur); cur = nxt; } }
            GRID_BAR(); STAMP(3);
#endif
            phase_mix(F, l); if (PROBE_DUP == 5) { GRID_BAR(); phase_mix(F, l, 1); } SEAM(p0 + 2); STAMP(4); }
        if (IN(p0 + 3)) {
#if CHUNKED_SCAN
            { refresh(F); unsigned char* ws_ = (unsigned char*)ldptr(F, 30); const InTab in_{F.lds};
              const int w4 = F.wave & 3, jobA = F.vcu * 2 + (F.wave >> 2), jobB = (F.vcu + F.G) * 2 + (F.wave >> 2);
              if (F.G * 4 == 1024) {
                  OutOps oa = out_load(F, ws_, jobA, w4); PostOps pa = post_load(F, ws_, jobA, w4); OutOps ob = out_load(F, ws_, jobB, w4);
                  out_compute(F, oa, w4); __syncthreads();
                  PostOps pb = post_load(F, ws_, jobB, w4);
                  post_compute(F, in_, ws_, l, jobA, w4, pa); __syncthreads();
                  out_compute(F, ob, w4); __syncthreads();
                  post_compute(F, in_, ws_, l, jobB, w4, pb); __syncthreads();
              } else {
                  for (int jp = F.vcu; jp < 512; jp += F.G) { const int job = jp * 2 + (F.wave >> 2);
                      OutOps oa = out_load(F, ws_, job, w4); PostOps pa = post_load(F, ws_, job, w4);
                      out_compute(F, oa, w4); __syncthreads(); post_compute(F, in_, ws_, l, job, w4, pa); __syncthreads(); }
              } }
            SEAM(p0 + 3); STAMP(5);
#else
            phase_post(F, l); if (PROBE_DUP == 6) { GRID_BAR(); phase_post(F, l); } SEAM(p0 + 3);
#endif
        }
        if (IN(p0 + 4)) {
            refresh(F); unsigned char* ws_ = (unsigned char*)ldptr(F, 30); const InTab in_{F.lds};
            ProbDense P{(const char*)(ws_ + WS_MIXED), (const char*)(ws_ + WS_WOUT) + (size_t)l * 1024 * 2048, NTOK / 256, 4, F.G, F.vcu};
            EpiOut E{(bf16_t*)(ws_ + WS_X), (l == 0) ? in_[I_X] : (const float*)nullptr, (const float*)(ws_ + WS_MOD) + (size_t)l * 4 * 6144 + 2 * 1024, 1.f};
            if (PROBE_DUP == 7) { EpiOut E0{(bf16_t*)(ws_ + WS_X), (l == 0) ? in_[I_X] : (const float*)nullptr, (const float*)(ws_ + WS_MOD) + (size_t)l * 4 * 6144 + 2 * 1024, 0.f}; pg8::gemm_phase<false, 1024>(F.lds, nullptr, F.tid, P, E0); GRID_BAR(); }
            pg8::gemm_phase<false, 1024>(F.lds, nullptr, F.tid, P, E);
            SEAM(p0 + 4); STAMP(6);
        }
        if (IN(p0 + 5)) { phase_route(F, l); if (PROBE_DUP == 8) { GRID_BAR(); phase_route(F, l, 1); } SEAM(p0 + 5); STAMP(7); }
        if (IN(p0 + 6)) {
            refresh(F); unsigned char* ws_ = (unsigned char*)ldptr(F, 30); const InTab in_{F.lds};
            MoeTab T = moe_table(F, l);
            const int nun = __builtin_amdgcn_readfirstlane(T.ntiles[0]) * 8;
            int cvb = 0;
            if (CONV_BLOCKS && TAIL_CONVERT && l + 1 < NL && F.G % 64 == 0) { const int R = (nun + F.G - 1) / F.G, Gg = (nun + R - 1) / R; cvb = (F.G - Gg) >> 3; }
            const int pxc = F.G >> 3, per = pxc - cvb, xi = F.vcu % pxc, gG = 8 * per, gv = (F.vcu / pxc) * per + xi;
            if (xi < per) {
                ProbGU P{(const char*)(ws_ + WS_H), (const char*)(ws_ + WS_WGU), (const int*)(ws_ + WS_LIST), T, nun, gG, gv, l};
                EpiGU E{(bf16_t*)(ws_ + WS_ACT), in_[I_BGU], l};
                pg8::gemm_phase<true, 1024>(F.lds, (LAS unsigned*)(F.lds + ROWTAB_OFF), F.tid, P, E);
                if (PROBE_DUP == 9) { GRID_BAR(); pg8::gemm_phase<true, 1024>(F.lds, (LAS unsigned*)(F.lds + ROWTAB_OFF), F.tid, P, E); }
                if (TAIL_CONVERT && l + 1 < NL) { if (F.tid == 0) __hip_atomic_fetch_add((gu32*)ldptr(F, 30) + CW_GD + (l * 2 + 0) * 64, 1u, RLX_AGENT);
                    const int mine = (nun - gv + gG - 1) / gG, most = (nun + gG - 1) / gG; if (mine < most) tail_convert(F, l + 1, most - mine); }
            } else conv_worker(F, l + 1, CW_GD + (l * 2 + 0) * 64, 2 * ((nun + gG - 1) / gG) + 1);
            SEAM(p0 + 6); STAMP(8);
        }
        if (IN(p0 + 7)) {
            refresh(F); unsigned char* ws_ = (unsigned char*)ldptr(F, 30); const InTab in_{F.lds};
            MoeTab T = moe_table(F, l);
            const int nun = __builtin_amdgcn_readfirstlane(T.ntiles[0]) * 4;
            int cvb = 0;
            if (CONV_BLOCKS && TAIL_CONVERT && l + 1 < NL && F.G % 64 == 0) { const int R = (nun + F.G - 1) / F.G, Gg = (nun + R - 1) / R; cvb = (F.G - Gg) >> 3; }
            const int pxc = F.G >> 3, per = pxc - cvb, xi = F.vcu % pxc, gG = 8 * per, gv = (F.vcu / pxc) * per + xi;
            if (xi < per) {
                ProbDN P{(const char*)(ws_ + WS_ACT), (const char*)(ws_ + WS_WDN), T, nun, gG, gv, l};
                EpiDN E{(bf16_t*)(ws_ + WS_YSLOT), in_[I_BDN], (const int*)(ws_ + WS_LIST), (const float*)(ws_ + WS_GATE), T, l};
                pg8::gemm_phase<false, 1024>(F.lds, nullptr, F.tid, P, E);
                if (PROBE_DUP == 10) { GRID_BAR(); pg8::gemm_phase<false, 1024>(F.lds, nullptr, F.tid, P, E); }
                if (TAIL_CONVERT && l + 1 < NL) { if (F.tid == 0) __hip_atomic_fetch_add((gu32*)ldptr(F, 30) + CW_GD + (l * 2 + 1) * 64, 1u, RLX_AGENT);
                    const int mine = (nun - gv + gG - 1) / gG, most = (nun + gG - 1) / gG; if (mine < most) tail_convert(F, l + 1, most - mine); }
            } else conv_worker(F, l + 1, CW_GD + (l * 2 + 1) * 64, 2 * ((nun + gG - 1) / gG) + 1);
            if (PROBE_T >= 0 && l == NL - 1 && blockIdx.x == 0 && F.tid == 0) {
                const unsigned long long now_ = wall_clock64(); if (PROBE_T == 9) tsw[1] += now_ - tsw[0];
                const float share = (float)(double)tsw[1] / (float)(double)(now_ - tsw[2]);
                __hip_atomic_store((GAS float*)((gu32*)ldptr(F, 30) + CW_CODE + 1), (PROBE_T >= 20 ? 3.0f : (PROBE_T == 4 || PROBE_T == 8 || PROBE_T == 9 || PROBE_T == 0) ? 0.3f : 0.5f) * share, RLX_AGENT);
            }
            SEAM(p0 + 7); STAMP(9);
        }
        if (IN(p0 + 8)) { if (PROBE_DUP == 11) { phase_combine(F, l, 0.f); GRID_BAR(); } phase_combine(F, l); SEAM(p0 + 8); STAMP(10); }
    }
#undef IN
#undef SEAM
#if !MK_PER_PHASE
    if (blockIdx.x == 0 && F.tid == 0 && xb_ld(bar.bar + XB_TMO) != 0u) { float* o = (float*)ldptr(F, 29); o[0] = __builtin_nanf(""); }
#endif
}

extern "C" void kernel_launch(void* const* d_in, const int* in_sizes, int n_in, void* d_out, int out_size, void* d_ws, size_t ws_size, hipStream_t stream) {
    static int grid = 0;
    if (grid == 0) {
        if (n_in != 29 || out_size != NTOK * DM || ws_size < WS_END) { fprintf(stderr, "kernel_launch: unexpected sizes n_in %d out %d ws %zu (need %zu)\n", n_in, out_size, ws_size, (size_t)WS_END); grid = -1; return; }
        int dev = 0, cus = 0;
        if (hipGetDevice(&dev) != hipSuccess || hipDeviceGetAttribute(&cus, hipDeviceAttributeMultiprocessorCount, dev) != hipSuccess) { grid = -1; return; }
        if (hipFuncSetAttribute((const void*)trunk_fwd, hipFuncAttributeMaxDynamicSharedMemorySize, LDS_BYTES) != hipSuccess) { fprintf(stderr, "kernel_launch: hipFuncSetAttribute failed\n"); grid = -1; return; }
        int per_cu = 0;
        if (hipOccupancyMaxActiveBlocksPerMultiprocessor(&per_cu, (const void*)trunk_fwd, NTHR, LDS_BYTES) != hipSuccess || per_cu < 1) fprintf(stderr, "kernel_launch: occupancy query reports %d\n", per_cu);
        (void)hipGetLastError();
        grid = cus;
    }
    if (grid < 0) return;
    (void)hipMemsetAsync((char*)d_ws + WS_CTL, 0, CTL_ZERO_BYTES, stream);
    Args a{};
    for (int i = 0; i < 29; ++i) a.in[i] = (const float*)d_in[i];
    a.out = (float*)d_out; a.ws = (unsigned char*)d_ws;
#if MK_PER_PHASE
    for (int p = 0; p < NPHASE; ++p) { a.ph_lo = p; a.ph_hi = p + 1; hipLaunchKernelGGL(trunk_fwd, dim3(grid), dim3(NTHR), LDS_BYTES, stream, a); }
#else
    a.ph_lo = 0; a.ph_hi = NPHASE;
    hipLaunchKernelGGL(trunk_fwd, dim3(grid), dim3(NTHR), LDS_BYTES, stream, a);
#endif
}
```

```cpp
#include <hip/hip_runtime.h>
#include <cstdio>
#include <cstdint>
#include <cmath>

#ifndef MK_PER_PHASE
#define MK_PER_PHASE 0
#endif

#ifndef TAIL_CONVERT
#ifndef ATTN_TUNED
#define ATTN_TUNED 1
#endif
#define TAIL_CONVERT 1
#ifndef CONV_BLOCKS
#define CONV_BLOCKS 1
#endif
#endif
#ifndef CHUNKED_SCAN
#define CHUNKED_SCAN 1
#endif
#ifndef PROBE_T
#define PROBE_T -1
#endif
#ifndef PROBE_DUP
#define PROBE_DUP 0
#endif
#define GAS __attribute__((address_space(1)))
#define LAS __attribute__((address_space(3)))
typedef unsigned short bf16_t;
typedef short bf16x8 __attribute__((ext_vector_type(8)));
typedef short s16x4 __attribute__((ext_vector_type(4)));
typedef float f32x2 __attribute__((ext_vector_type(2)));
typedef float f32x4 __attribute__((ext_vector_type(4)));
typedef float f32x16 __attribute__((ext_vector_type(16)));
typedef unsigned u32x2 __attribute__((ext_vector_type(2)));
typedef unsigned u32x4 __attribute__((ext_vector_type(4)));
typedef GAS unsigned gu32;


constexpr int NB = 4, SEQ = 4096, DM = 1024, NL = 4, NTOK = NB * SEQ;
constexpr int PIN = 2824, NPROJ = 2816;
constexpr int NE = 32, TOPK = 4;
constexpr int NWAVES = 8, NTHR = 512;
constexpr float LOG2E = 1.4426950408889634f;
constexpr float QSCALE = 0.125f * LOG2E;

constexpr size_t MiB = (size_t)1 << 20;
constexpr size_t WS_CTL = 0, CTL_ZERO_BYTES = 1 * MiB;
constexpr size_t WS_MOD = 1 * MiB;
constexpr size_t WS_FLOG = 2 * MiB;
constexpr size_t WS_BIAS = 3 * MiB;
constexpr size_t WS_ALORA = 4 * MiB;
constexpr size_t WS_GATE = 12 * MiB;
constexpr size_t WS_LIST = 13 * MiB;
constexpr size_t WS_WIN = 16 * MiB;
constexpr size_t WS_LORA = 38 * MiB;
constexpr size_t WS_WOUT = 40 * MiB;
constexpr size_t WS_WGU = 48 * MiB;
constexpr size_t WS_WDN = 560 * MiB;
constexpr size_t WS_X = 816 * MiB;
constexpr size_t WS_H = 880 * MiB;
constexpr size_t WS_ZR = 912 * MiB;
constexpr size_t WS_ZP = 976 * MiB;
constexpr size_t WS_Q = 992 * MiB, WS_K = 1008 * MiB, WS_V = 1024 * MiB;
constexpr size_t WS_SCAN = 1040 * MiB;
constexpr int SCAN_ROW = 896;
constexpr size_t WS_G = 1136 * MiB;
constexpr size_t WS_YRAW = 1152 * MiB;
constexpr size_t WS_MIXED = 1168 * MiB;
constexpr size_t WS_ACT = 1200 * MiB;
constexpr size_t WS_YSLOT = 1344 * MiB;
constexpr size_t WS_CPG = 1472 * MiB;
constexpr size_t WS_CPSI = 1496 * MiB;
constexpr size_t WS_CY0 = 1504 * MiB;
constexpr size_t WS_CS = 1520 * MiB;
constexpr size_t WS_END = 1528 * MiB;

constexpr int CW_TMO = 0, CW_CODE = 1;
constexpr int CW_BAR = 4096;
constexpr int CW_CNT = 16384;
constexpr int CW_QUEUE = 40960;
constexpr int CW_GD = 53248;
constexpr int CW_CQ = 49152;

constexpr int RING_BYTES = 131072;
constexpr int LDS_BYTES = 147456;
constexpr int LDSCTL_OFF = 139264;
constexpr int MISC_OFF = LDSCTL_OFF;
constexpr int PTR_OFF = LDSCTL_OFF + 256;
constexpr int TAB_OFF = LDSCTL_OFF + 512;
constexpr int ROWTAB_OFF = LDSCTL_OFF + 4096;
constexpr int PCV_OFF = LDSCTL_OFF + 6144;

#define RLX_AGENT __ATOMIC_RELAXED, __HIP_MEMORY_SCOPE_AGENT
#define LDS_WAIT() asm volatile("s_waitcnt lgkmcnt(0)" ::: "memory")
#define VM_WAIT() asm volatile("s_waitcnt vmcnt(0)" ::: "memory")

__device__ __forceinline__ unsigned f2bf(float f) { unsigned u = __builtin_bit_cast(unsigned, f); return (u + 0x7fffu + ((u >> 16) & 1u)) >> 16; }
__device__ __forceinline__ unsigned pk2(float lo, float hi) { return f2bf(lo) | (f2bf(hi) << 16); }
typedef __bf16 bf16x2_t __attribute__((ext_vector_type(2)));
__device__ __forceinline__ unsigned cvtpk(float lo, float hi) { const f32x2 v = {lo, hi}; const bf16x2_t b = __builtin_convertvector(v, bf16x2_t); return __builtin_bit_cast(unsigned, b); }
__device__ __forceinline__ f32x4 unp4(u32x2 p) { return (f32x4){__builtin_bit_cast(float, p.x << 16), __builtin_bit_cast(float, p.x & 0xffff0000u), __builtin_bit_cast(float, p.y << 16), __builtin_bit_cast(float, p.y & 0xffff0000u)}; }
__device__ __forceinline__ f32x4 up4(u32x2 y) { return (f32x4){__builtin_bit_cast(float, y.x << 16), __builtin_bit_cast(float, y.x & 0xffff0000u), __builtin_bit_cast(float, y.y << 16), __builtin_bit_cast(float, y.y & 0xffff0000u)}; }
__device__ __forceinline__ u32x2 pk4(f32x4 v) { return (u32x2){cvtpk(v.x, v.y), cvtpk(v.z, v.w)}; }
__device__ __forceinline__ u32x4 pk8(f32x4 a, f32x4 b) { return (u32x4){cvtpk(a.x, a.y), cvtpk(a.z, a.w), cvtpk(b.x, b.y), cvtpk(b.z, b.w)}; }
__device__ __forceinline__ float bf2f(unsigned short b) { return __builtin_bit_cast(float, (unsigned)b << 16); }
__device__ __forceinline__ float dpp_f(float v, const int ctrl_sel) {
    const int iv = __builtin_bit_cast(int, v); int r;
    switch (ctrl_sel) { case 0: r = __builtin_amdgcn_update_dpp(0, iv, 0xB1, 0xf, 0xf, true); break; case 1: r = __builtin_amdgcn_update_dpp(0, iv, 0x4E, 0xf, 0xf, true); break;
                        case 2: r = __builtin_amdgcn_update_dpp(0, iv, 0x141, 0xf, 0xf, true); break; default: r = __builtin_amdgcn_update_dpp(0, iv, 0x140, 0xf, 0xf, true); break; }
    return __builtin_bit_cast(float, r);
}
__device__ __forceinline__ float red16(float v) { v += dpp_f(v, 0); v += dpp_f(v, 1); v += dpp_f(v, 2); v += dpp_f(v, 3); return v; }
__device__ __forceinline__ float fma_s(float a, float b, float c) { float d; asm("v_fma_f32 %0, %1, %2, %3" : "=v"(d) : "v"(a), "v"(b), "v"(c)); return d; }
__device__ __forceinline__ float fnma_s(float a, float b, float c) { float d; asm("v_fma_f32 %0, -%1, %2, %3" : "=v"(d) : "v"(a), "v"(b), "v"(c)); return d; }
__device__ __forceinline__ float mul_s(float a, float b) { float d; asm("v_mul_f32_e32 %0, %1, %2" : "=v"(d) : "v"(a), "v"(b)); return d; }
__device__ __forceinline__ float add_s(float a, float b) { float d; asm("v_add_f32_e32 %0, %1, %2" : "=v"(d) : "v"(a), "v"(b)); return d; }
__device__ __forceinline__ void red16_pair(float& a, float& b) {
    asm volatile("s_nop 1\n\t"
                 "v_add_f32_dpp %0, %0, %0 quad_perm:[1,0,3,2] row_mask:0xf bank_mask:0xf bound_ctrl:1\n\t"
                 "v_add_f32_dpp %1, %1, %1 quad_perm:[1,0,3,2] row_mask:0xf bank_mask:0xf bound_ctrl:1\n\t"
                 "s_nop 0\n\t"
                 "v_add_f32_dpp %0, %0, %0 quad_perm:[2,3,0,1] row_mask:0xf bank_mask:0xf bound_ctrl:1\n\t"
                 "v_add_f32_dpp %1, %1, %1 quad_perm:[2,3,0,1] row_mask:0xf bank_mask:0xf bound_ctrl:1\n\t"
                 "s_nop 0\n\t"
                 "v_add_f32_dpp %0, %0, %0 row_half_mirror row_mask:0xf bank_mask:0xf bound_ctrl:1\n\t"
                 "v_add_f32_dpp %1, %1, %1 row_half_mirror row_mask:0xf bank_mask:0xf bound_ctrl:1\n\t"
                 "s_nop 0\n\t"
                 "v_add_f32_dpp %0, %0, %0 row_mirror row_mask:0xf bank_mask:0xf bound_ctrl:1\n\t"
                 "v_add_f32_dpp %1, %1, %1 row_mirror row_mask:0xf bank_mask:0xf bound_ctrl:1\n\t"
                 "s_nop 0"
                 : "+v"(a), "+v"(b));
}
__device__ __forceinline__ float wave_sum(float v) {
    v = red16(v);
    { const auto rr = __builtin_amdgcn_permlane16_swap(__float_as_uint(v), __float_as_uint(v), false, false); v = __uint_as_float(rr[0]) + __uint_as_float(rr[1]); }
    { const auto rr = __builtin_amdgcn_permlane32_swap(__float_as_uint(v), __float_as_uint(v), false, false); v = __uint_as_float(rr[0]) + __uint_as_float(rr[1]); }
    return v;
}
__device__ __forceinline__ float wave_max(float v) {
    v = fmaxf(v, dpp_f(v, 0)); v = fmaxf(v, dpp_f(v, 1)); v = fmaxf(v, dpp_f(v, 2)); v = fmaxf(v, dpp_f(v, 3));
    { const auto rr = __builtin_amdgcn_permlane16_swap(__float_as_uint(v), __float_as_uint(v), false, false); v = fmaxf(__uint_as_float(rr[0]), __uint_as_float(rr[1])); }
    { const auto rr = __builtin_amdgcn_permlane32_swap(__float_as_uint(v), __float_as_uint(v), false, false); v = fmaxf(__uint_as_float(rr[0]), __uint_as_float(rr[1])); }
    return v;
}
__device__ __forceinline__ float sigmoidf_(float x) { return 1.f / (1.f + __expf(-x)); }
__device__ __forceinline__ float softplusf_(float u) { return fmaxf(u, 0.f) + log1pf(__expf(-fabsf(u))); }
__device__ __forceinline__ float softplus_fast(float u) { return fmaxf(u, 0.f) + __logf(1.f + __expf(-fabsf(u))); }

#define XB_TMO      128
#define XB_XCNT(j)  (256  + 64 * (j))
#define XB_XSUB(j)  (1280 + 64 * (j))
#define XB_XGEN(j)  (2304 + 64 * (j))
#define XB_TOP      3328
#define XB_TOPGEN   3392
#define XCD_BAR_WORDS 3456
#define XB_SPIN_CAP (1u << 18)
__device__ __forceinline__ unsigned xb_ld(unsigned* p)              { return __hip_atomic_load(p, __ATOMIC_RELAXED, __HIP_MEMORY_SCOPE_AGENT); }
__device__ __forceinline__ unsigned xb_add(unsigned* p, unsigned v) { return __hip_atomic_fetch_add(p, v, __ATOMIC_RELAXED, __HIP_MEMORY_SCOPE_AGENT); }
__device__ __forceinline__ unsigned xb_xcc_id() { return (unsigned)__builtin_amdgcn_s_getreg((3 << 11) | 20) & 0xFu; }
#define XB_SPIN(cond, bar) do { unsigned _sp = 0; while (cond) { __builtin_amdgcn_s_sleep(1); \
    if ((++_sp & 255u) == 0u) { if (xb_ld(&(bar)[XB_TMO])) break; if (_sp > XB_SPIN_CAP) { atomicAdd(&(bar)[XB_TMO], 1u); break; } } } } while (0)
struct XcdBarrier { unsigned* bar; unsigned x; volatile LAS unsigned* st; };
__device__ __forceinline__ XcdBarrier xcd_barrier_post(unsigned* bar, volatile LAS unsigned* st) {
    XcdBarrier b; b.bar = bar; b.x = xb_xcc_id(); b.st = st;
    if (threadIdx.x == 0) (void)xb_add(&bar[XB_XCNT(b.x)], 1u);
    return b;
}
__device__ __forceinline__ void xcd_barrier_complete(unsigned* bar, unsigned x, unsigned& nloc, unsigned& nx) {
    const unsigned G = gridDim.x * gridDim.y * gridDim.z;
    unsigned sum, cnt, mine, sp = 0u;
    for (;;) {
        sum = 0u; cnt = 0u; mine = 0u;
#pragma unroll
        for (unsigned j = 0; j < 16; ++j) { const unsigned c = xb_ld(&bar[XB_XCNT(j)]); sum += c; cnt += (c > 0u) ? 1u : 0u; mine = (j == x) ? c : mine; }
        if (sum == G) break;
        __builtin_amdgcn_s_sleep(1);
        if ((++sp & 255u) == 0u) { if (xb_ld(&bar[XB_TMO])) break; if (sp > XB_SPIN_CAP) { atomicAdd(&bar[XB_TMO], 1u); break; } }
    }
    nloc = mine > 0u ? mine : 1u; nx = cnt > 0u ? cnt : 1u;
}
__device__ __forceinline__ void xcd_barrier(const XcdBarrier& b) {
    asm volatile("s_waitcnt vmcnt(0)" ::: "memory");
    __syncthreads();
    if (threadIdx.x == 0) {
        unsigned* bar = b.bar;
        __builtin_amdgcn_s_waitcnt(0);
        unsigned nloc = b.st[0], nx = b.st[1];
        if (nloc == 0u) { xcd_barrier_complete(bar, b.x, nloc, nx); b.st[0] = nloc; b.st[1] = nx; }
        const unsigned old = xb_add(&bar[XB_XSUB(b.x)], 1u);
        const unsigned gen = old / nloc;
        if (old + 1u == (gen + 1u) * nloc) {
            __builtin_amdgcn_fence(__ATOMIC_RELEASE, "agent");
            asm volatile("s_waitcnt vmcnt(0)" ::: "memory");
            const unsigned og = xb_add(&bar[XB_TOP], 1u);
            const unsigned tg = og / nx;
            if (og + 1u == (tg + 1u) * nx) xb_add(&bar[XB_TOPGEN], 1u);
            else XB_SPIN(xb_ld(&bar[XB_TOPGEN]) == tg, bar);
            __builtin_amdgcn_fence(__ATOMIC_ACQUIRE, "agent");
            xb_add(&bar[XB_XGEN(b.x)], 1u);
            asm volatile("s_waitcnt vmcnt(0)" ::: "memory");
        } else {
            XB_SPIN(xb_ld(&bar[XB_XGEN(b.x)]) == gen, bar);
            __builtin_amdgcn_fence(__ATOMIC_ACQUIRE, "agent");
            asm volatile("s_waitcnt vmcnt(0)" ::: "memory");
        }
    }
    __syncthreads();
}

namespace pg8 {
constexpr int BM = 256, BK = 64, HALF = 128, HTB = HALF * BK * 2, STAGE_BYTES = 8 * HTB;
__device__ __forceinline__ int lds_byte(int r, int c) { const int st = (r >> 4) * 2 + (c >> 5), rr = r & 15, cc = c & 31, ob = rr * 64 + cc * 2; return st * 1024 + (ob ^ (((ob >> 9) & 1) << 5)); }
__device__ __forceinline__ void stage_rc(int b, int& R, int& C) { const int st = b / 1024, sb = b % 1024, swz = sb ^ (((sb >> 9) & 1) << 5); R = (st >> 1) * 16 + swz / 64; C = (st & 1) * 32 + (swz % 64) / 2; }
__device__ __forceinline__ int perm32(int rho) { const int n = rho >> 4, i = rho & 15; return 8 * (i >> 2) + 4 * n + (i & 3); }
struct Unit { int pm, pn, e; };
__device__ __forceinline__ unsigned cvt_pk_bf16(float lo, float hi) { unsigned r; asm volatile("v_cvt_pk_bf16_f32 %0, %1, %2" : "=v"(r) : "v"(lo), "v"(hi)); return r; }

template <bool GATHER, int K, class Prob, class Epi>
__device__ __forceinline__ void gemm_phase(LAS unsigned char* lds, LAS unsigned* rowtab  , const int tid, const Prob& S, const Epi& E) {
    const int wid = __builtin_amdgcn_readfirstlane(tid >> 6), lane = tid & 63, wr = wid >> 2, wc = wid & 3, fr = lane & 15, fq = lane >> 4;
    constexpr int nt = K / BK; static_assert(K % 128 == 0 && K >= 256 && (!GATHER || K == 1024), "K");
    unsigned voffA[2], voffB[2];
#pragma unroll
    for (int i = 0; i < 2; ++i) { int R, C; stage_rc(tid * 16 + i * 8192, R, C); const int Rb = (R & ~31) + perm32(R & 31); voffA[i] = (unsigned)(R * K + C) * 2u; voffB[i] = (unsigned)(Rb * K + C) * 2u; }
    constexpr size_t kstep = (size_t)(BK * 2);
    constexpr size_t hstep = (size_t)HALF * K * 2;
    const unsigned ldsw = (unsigned)wid * 1024u;
    const int aoff = lds_byte(wr * 64 + fr, fq * 8), boff = lds_byte(wc * 32 + fr, fq * 8);
#define PG8_SA(b, h) (((b) * 2 + (h)) * HTB)
#define PG8_SB(b, h) ((4 + (b) * 2 + (h)) * HTB)
#define PG8_STAGEB(bufoff, gbase) do { _Pragma("unroll") for (int _i = 0; _i < 2; ++_i) \
        __builtin_amdgcn_global_load_lds((const unsigned*)((const char*)(gbase) + voffB[_i]), (LAS unsigned*)(lds + (bufoff) + ldsw + _i * 8192), 16, 0, 0); } while (0)
#define PG8_STAGEA2(bufoff, gbase, o0, o1) do { \
        __builtin_amdgcn_global_load_lds((const unsigned*)((const char*)(gbase) + (o0)), (LAS unsigned*)(lds + (bufoff) + ldsw), 16, 0, 0); \
        __builtin_amdgcn_global_load_lds((const unsigned*)((const char*)(gbase) + (o1)), (LAS unsigned*)(lds + (bufoff) + ldsw + 8192), 16, 0, 0); } while (0)
#define PG8_STAGEA_C(bufoff, gbase, h) do { if constexpr (GATHER) PG8_STAGEA2(bufoff, gbase, oc[h][0], oc[h][1]); else PG8_STAGEA2(bufoff, (gbase) + (h) * hstep, voffA[0], voffA[1]); } while (0)
#define PG8_LDA(dst, b, h) do { _Pragma("unroll") for (int m = 0; m < 4; ++m) _Pragma("unroll") for (int k = 0; k < 2; ++k) dst[m][k] = *(const LAS bf16x8*)(lds + PG8_SA(b, h) + aoff + m * 2048 + k * 1024); } while (0)
#define PG8_LDB(dst, b, h) do { _Pragma("unroll") for (int n = 0; n < 2; ++n) _Pragma("unroll") for (int k = 0; k < 2; ++k) dst[n][k] = *(const LAS bf16x8*)(lds + PG8_SB(b, h) + boff + n * 2048 + k * 1024); } while (0)
#define PG8_MMA(ai, bj, At, Bt) do { __builtin_amdgcn_s_setprio(1); _Pragma("unroll") for (int m = 0; m < 4; ++m) _Pragma("unroll") for (int n = 0; n < 2; ++n) _Pragma("unroll") for (int k = 0; k < 2; ++k) \
        acc[ai][bj][m][n] = __builtin_amdgcn_mfma_f32_16x16x32_bf16(Bt[n][k], At[m][k], acc[ai][bj][m][n], 0, 0, 0); __builtin_amdgcn_s_setprio(0); } while (0)
#define PG8_WAIT_V(n) asm volatile("s_waitcnt vmcnt(" #n ")" ::: "memory")
#define PG8_WAIT_L(n) asm volatile("s_waitcnt lgkmcnt(" #n ")" ::: "memory")
#define PG8_BAR __builtin_amdgcn_s_barrier()
#define PG8_SCHED __builtin_amdgcn_sched_barrier(0)
    Unit cur, nxt; int ui = 0;
    if (!S.next(0, cur)) return;
    f32x4 acc[2][2][4][2];
#pragma unroll
    for (int a = 0; a < 2; ++a)
#pragma unroll
        for (int b = 0; b < 2; ++b)
#pragma unroll
            for (int m = 0; m < 4; ++m)
#pragma unroll
                for (int n = 0; n < 2; ++n) acc[a][b][m][n] = (f32x4){0.f, 0.f, 0.f, 0.f};
    bf16x8 At[4][2], B0[2][2], B1[2][2];
    const char* cA = S.a_ptr(cur); const char* cB = S.b_ptr(cur);
    unsigned oc[2][2];
    if constexpr (GATHER) {
#pragma unroll
        for (int h = 0; h < 2; ++h)
#pragma unroll
            for (int i = 0; i < 2; ++i) oc[h][i] = S.row_off(cur, h * 128 + (int)(voffA[i] >> 11)) + (voffA[i] & 2047u);
    }
    PG8_STAGEB(PG8_SB(0, 0), cB); PG8_STAGEB(PG8_SB(0, 1), cB + hstep); PG8_STAGEA_C(PG8_SA(0, 0), cA, 0); PG8_STAGEA_C(PG8_SA(0, 1), cA, 1);
    if (wr == 1) PG8_BAR;
    PG8_WAIT_V(2); PG8_BAR;
    PG8_STAGEB(PG8_SB(1, 0), cB + kstep); PG8_STAGEA_C(PG8_SA(1, 0), cA + kstep, 0); PG8_STAGEB(PG8_SB(1, 1), cB + hstep + kstep);
    PG8_WAIT_V(6); PG8_BAR;
    for (;;) {
        const bool has_next = S.next(ui + 1, nxt);
        const char* nA = cA; const char* nB = cB;
        if (has_next) { nA = S.a_ptr(nxt); nB = S.b_ptr(nxt); }
        if constexpr (GATHER) { if (has_next && tid < 256) rowtab[((ui + 1) & 1) * 256 + tid] = S.row_off(nxt, tid); }
#pragma nounroll
        for (int t = 0; t < nt; t += 2) {
            const bool last = (t == nt - 2);
            const char* a1 = cA + (size_t)(t + 1) * kstep;
            const char* a2 = last ? nA : cA + (size_t)(t + 2) * kstep; const char* b2 = last ? nB : cB + (size_t)(t + 2) * kstep;
            const char* a3 = a2 + kstep; const char* b3 = b2 + kstep;
            PG8_LDB(B0, 0, 0); PG8_LDB(B1, 0, 1); PG8_SCHED; PG8_LDA(At, 0, 0); PG8_STAGEA_C(PG8_SA(1, 1), a1, 1);
            if constexpr (GATHER) { if (last && has_next) {
#pragma unroll
                for (int h = 0; h < 2; ++h)
#pragma unroll
                    for (int i = 0; i < 2; ++i) oc[h][i] = rowtab[((ui + 1) & 1) * 256 + h * 128 + (int)(voffA[i] >> 11)] + (voffA[i] & 2047u); } }
            PG8_WAIT_V(8); PG8_WAIT_L(0); PG8_BAR; PG8_MMA(0, 0, At, B0); PG8_MMA(0, 1, At, B1); PG8_BAR; PG8_SCHED;
            PG8_LDA(At, 0, 1); PG8_STAGEB(PG8_SB(0, 0), b2); PG8_STAGEB(PG8_SB(0, 1), b2 + hstep); PG8_STAGEA_C(PG8_SA(0, 0), a2, 0);
            PG8_WAIT_V(8); PG8_WAIT_L(0); PG8_BAR; PG8_MMA(1, 0, At, B0); PG8_MMA(1, 1, At, B1); PG8_BAR; PG8_SCHED;
            PG8_LDB(B0, 1, 0); PG8_LDB(B1, 1, 1); PG8_SCHED; PG8_LDA(At, 1, 0); PG8_STAGEA_C(PG8_SA(0, 1), a2, 1);
            PG8_WAIT_V(8); PG8_WAIT_L(0); PG8_BAR; PG8_MMA(0, 0, At, B0); PG8_MMA(0, 1, At, B1); PG8_BAR; PG8_SCHED;
            PG8_LDA(At, 1, 1); PG8_STAGEB(PG8_SB(1, 0), b3); PG8_STAGEB(PG8_SB(1, 1), b3 + hstep); PG8_STAGEA_C(PG8_SA(1, 0), a3, 0);
            PG8_WAIT_V(8); PG8_WAIT_L(0); PG8_BAR; PG8_MMA(1, 0, At, B0); PG8_MMA(1, 1, At, B1); PG8_BAR; PG8_SCHED;
        }
        if (wr == 0) PG8_BAR;
        E(acc, cur, wr, wc, fr, fq);
        if (!has_next) break;
#pragma unroll
        for (int a = 0; a < 2; ++a)
#pragma unroll
            for (int b = 0; b < 2; ++b)
#pragma unroll
                for (int m = 0; m < 4; ++m)
#pragma unroll
                    for (int n = 0; n < 2; ++n) acc[a][b][m][n] = (f32x4){0.f, 0.f, 0.f, 0.f};
        cur = nxt; cA = nA; cB = nB; ++ui;
        if (wr == 1) PG8_BAR;
    }
    PG8_WAIT_V(0);
    PG8_BAR;
#undef PG8_SA
#undef PG8_SB
#undef PG8_STAGEA2
#undef PG8_STAGEA_C
#undef PG8_STAGEB
#undef PG8_LDA
#undef PG8_LDB
#undef PG8_MMA
#undef PG8_WAIT_V
#undef PG8_WAIT_L
#undef PG8_BAR
#undef PG8_SCHED
}
}

struct Frame {
    LAS unsigned char* lds;
    volatile LAS unsigned* MISC;
    int tid, lane, wave, vcu, G;
};
struct Args { const float* in[29]; float* out; unsigned char* ws; int ph_lo, ph_hi; };
__device__ __forceinline__ unsigned long long ldptr_raw(LAS unsigned char* lds, int i) {
    const unsigned long long v = *(const LAS unsigned long long*)(lds + PTR_OFF + 8 * i);
    const unsigned lo = __builtin_amdgcn_readfirstlane((unsigned)v), hi = __builtin_amdgcn_readfirstlane((unsigned)(v >> 32));
    return ((unsigned long long)hi << 32) | lo;
}
__device__ __forceinline__ void* ldptr(const Frame& F, int i) { return (void*)(GAS unsigned char*)ldptr_raw(F.lds, i); }
struct InTab { LAS unsigned char* lds; __device__ __forceinline__ const float* operator[](int i) const { return (const float*)(const GAS float*)ldptr_raw(lds, i); } };
__device__ __forceinline__ void refresh(Frame& F) { int t = F.tid; asm volatile("" : "+v"(t)); F.tid = t; F.lane = t & 63; F.wave = __builtin_amdgcn_readfirstlane(t >> 6); }


enum { I_X = 0, I_C, I_ADAW, I_ADAB, I_NORM1, I_WIN, I_WOUT, I_MU, I_W0, I_WUP, I_A0, I_AUP, I_GUP, I_KK, I_KA, I_RK, I_LNW, I_LNB, I_POOLW, I_POOLS, I_BF, I_NORM2, I_RW, I_RB, I_WGU, I_BGU, I_WDN, I_BDN, I_NORMF };

struct TItem { const float* src; bf16_t* dst; int ldw; };
__device__ __forceinline__ TItem mk_item(const float* W, int ldw, bf16_t* WT, int dst_row0, int k0, int n0) { TItem t; t.src = W + (size_t)k0 * ldw + n0; t.dst = WT + (size_t)dst_row0 * 1024 + k0; t.ldw = ldw; return t; }
__device__ __forceinline__ void ti_load(f32x4 (&t)[8], const TItem& it, int lane) {
#pragma unroll
    for (int i = 0; i < 8; ++i) t[i] = __builtin_nontemporal_load((const f32x4*)(it.src + (size_t)(8 * i + (lane >> 3)) * it.ldw + 4 * (lane & 7)));
}
__device__ __forceinline__ void ti_finish(const f32x4 (&t)[8], const TItem& it, LAS float* scr, int lane) {
#pragma unroll
    for (int i = 0; i < 8; ++i) { LAS float* d = scr + (8 * i + (lane >> 3)) * 33 + 4 * (lane & 7); d[0] = t[i].x; d[1] = t[i].y; d[2] = t[i].z; d[3] = t[i].w; }
    LDS_WAIT(); asm volatile("" ::: "memory");
    const int c = lane & 7;
#pragma unroll
    for (int j = 0; j < 4; ++j) { const int n = (lane >> 3) + 8 * j; const LAS float* s = scr + (8 * c) * 33 + n;
        u32x4 o; o.x = cvtpk(s[0 * 33], s[1 * 33]); o.y = cvtpk(s[2 * 33], s[3 * 33]); o.z = cvtpk(s[4 * 33], s[5 * 33]); o.w = cvtpk(s[6 * 33], s[7 * 33]);
        *(GAS u32x4*)(it.dst + (size_t)n * 1024 + 8 * c) = o; }
    LDS_WAIT(); asm volatile("" ::: "memory");
}
template <class Dec> __device__ __forceinline__ void convert_stream(int first, int step, int end, LAS float* scr, int lane, Dec dec) {
    f32x4 ta[8], tb[8]; TItem ia, ib;
    int it = first;
    if (it < end) { ia = dec(it); ti_load(ta, ia, lane); }
    while (it < end) {
        const int i2 = it + step;
        if (i2 < end) { ib = dec(i2); ti_load(tb, ib, lane); }
        ti_finish(ta, ia, scr, lane);
        if (i2 >= end) break;
        const int i3 = i2 + step;
        if (i3 < end) { ia = dec(i3); ti_load(ta, ia, lane); }
        ti_finish(tb, ib, scr, lane);
        it = i3;
    }
}

__device__ __forceinline__ void convert_moe_batch(Frame& F, const InTab& in_, unsigned char* ws_, int l, int q);
__device__ __forceinline__ void phase_prologue(Frame& F) {
    refresh(F); unsigned char* ws_ = (unsigned char*)ldptr(F, 30); const InTab in_{F.lds}; gu32* ctl_ = (gu32*)ws_;

    if (blockIdx.x < 192) {
        LAS float* cond = (LAS float*)F.lds;
        LAS float* part = (LAS float*)(F.lds + 16384);
        const float* c = in_[I_C];
        for (int i = F.tid; i < 4096; i += NTHR) { const float v = c[i]; cond[i] = v / (1.f + __expf(-v)); }
        __syncthreads();
        const int l = blockIdx.x / 48, col0 = (blockIdx.x % 48) * 128;
        const float* W = in_[I_ADAW] + (size_t)l * 1024 * 6144 + col0 + 2 * F.lane;
        float a[4][2];
#pragma unroll
        for (int b = 0; b < 4; ++b) { a[b][0] = 0.f; a[b][1] = 0.f; }
        const int kb = F.wave * 128;
#pragma unroll 8
        for (int k = kb; k < kb + 128; ++k) {
            const f32x2 w = __builtin_nontemporal_load((const f32x2*)(W + (size_t)k * 6144));
#pragma unroll
            for (int b = 0; b < 4; ++b) { const float cv = cond[b * 1024 + k]; a[b][0] += cv * w.x; a[b][1] += cv * w.y; }
        }
#pragma unroll
        for (int b = 0; b < 4; ++b) { part[(F.wave * 4 + b) * 128 + 2 * F.lane] = a[b][0]; part[(F.wave * 4 + b) * 128 + 2 * F.lane + 1] = a[b][1]; }
        __syncthreads();
        { const int b = F.tid >> 7, cc = F.tid & 127; float s = in_[I_ADAB][l * 6144 + col0 + cc];
#pragma unroll
          for (int w = 0; w < 8; ++w) s += part[(w * 4 + b) * 128 + cc];
          ((float*)(ws_ + WS_MOD))[(l * 4 + b) * 6144 + col0 + cc] = s; }
        __syncthreads();
    }
    {
        bf16_t* LT = (bf16_t*)(ws_ + WS_LORA);
        const float* wu = in_[I_WUP]; const float* au = in_[I_AUP]; const float* gu = in_[I_GUP];
        for (int idx = blockIdx.x * NTHR + F.tid; idx < NL * 768 * 256; idx += F.G * NTHR) {
            const int k = idx & 255, n = (idx >> 8) % 768, l = idx / (768 * 256);
            float v = 0.f;
            if (n < 256) { if (k < 64) v = wu[((size_t)l * 64 + k) * 256 + n]; }
            else if (n < 512) { if (k >= 64 && k < 128) v = au[((size_t)l * 64 + (k - 64)) * 256 + (n - 256)]; }
            else { if (k >= 128) v = gu[((size_t)l * 128 + (k - 128)) * 256 + (n - 512)]; }
            LT[idx] = (bf16_t)f2bf(v);
        }
    }
    LAS float* scr = (LAS float*)(F.lds + F.wave * 16384);
    const int gw = F.vcu * NWAVES + F.wave, NGW = F.G * NWAVES;
    constexpr int I_A = NL * 16 * 88, I_B = NL * 16 * 32;
    convert_stream(gw, NGW, I_A + I_B, scr, F.lane, [&](int r) {
        if (r < I_A) { const int l = r / (16 * 88), q = r % (16 * 88), kb = q / 88, nb = q % 88;
            return mk_item(in_[I_WIN] + (size_t)l * 1024 * PIN, PIN, (bf16_t*)(ws_ + WS_WIN) + (size_t)l * NPROJ * 1024, 32 * nb, 64 * kb, 32 * nb); }
        r -= I_A;
        const int l = r / (16 * 32), q = r % (16 * 32), kb = q / 32, nb = q % 32;
        return mk_item(in_[I_WOUT] + (size_t)l * 1024 * 1024, 1024, (bf16_t*)(ws_ + WS_WOUT) + (size_t)l * 1024 * 1024, 32 * nb, 64 * kb, 32 * nb); });
}
__device__ __forceinline__ void convert_moe_batch(Frame& F, const InTab& in_, unsigned char* ws_, int l, int q) {
    LAS float* scr = (LAS float*)(F.lds + F.wave * 16384);
    convert_stream(q * 64 + F.wave, 8, q * 64 + 64, scr, F.lane, [&](int r) {
        if (r < NE * 16 * 64) { const int e = r / (16 * 64), qq = r % (16 * 64), kb = qq / 64, nb = qq % 64; const int n0 = 32 * nb; const int le = l * NE + e;
            const int dr = (n0 < 1024) ? ((n0 >> 7) * 256 + (n0 & 127)) : ((((n0 - 1024) >> 7) * 256) + 128 + ((n0 - 1024) & 127));
            return mk_item(in_[I_WGU] + (size_t)le * 1024 * 2048, 2048, (bf16_t*)(ws_ + WS_WGU) + (size_t)le * 2048 * 1024, dr, 64 * kb, n0); }
        r -= NE * 16 * 64; const int e = r / (16 * 32), qq = r % (16 * 32), kb = qq / 32, nb = qq % 32; const int le = l * NE + e;
        return mk_item(in_[I_WDN] + (size_t)le * 1024 * 1024, 1024, (bf16_t*)(ws_ + WS_WDN) + (size_t)le * 1024 * 1024, 32 * nb, 64 * kb, 32 * nb); });
}

__device__ __forceinline__ void phase_combine(Frame& F, int l, float yscale = 1.f) {
    refresh(F); unsigned char* ws_ = (unsigned char*)ldptr(F, 30); const InTab in_{F.lds}; gu32* ctl_ = (gu32*)ws_;

    const bool has_next = (l + 1 < NL);
    LAS float* Wf = (LAS float*)F.lds;
    if (has_next) {
        const float* W = in_[I_WIN] + (size_t)(l + 1) * 1024 * PIN + NPROJ;
        f32x4 t4[4];
#pragma unroll
        for (int u = 0; u < 4; ++u) { const int i = F.tid + NTHR * u; t4[u] = *(const f32x4*)(W + (size_t)(i >> 1) * PIN + 4 * (i & 1)); }
#pragma unroll
        for (int u = 0; u < 4; ++u) { const int i = F.tid + NTHR * u; *(LAS f32x4*)(Wf + 4 * i) = t4[u]; }
    }
    __syncthreads();
    const int gw = F.vcu * NWAVES + F.wave, NGW = F.G * NWAVES;
    const float* xin = in_[I_X];
    bf16_t* X = (bf16_t*)(ws_ + WS_X);
    const float* MOD = (const float*)(ws_ + WS_MOD);
    const bf16_t* YS = (const bf16_t*)(ws_ + WS_YSLOT);
    f32x4 xn[4]; u32x2 xb[4], yn[4][4];
#define CMB_LOAD(mm) do { if (l < 0) { _Pragma("unroll") for (int j = 0; j < 4; ++j) xn[j] = *(const f32x4*)(xin + (size_t)(mm) * 1024 + 4 * F.lane + 256 * j); } \
        else { _Pragma("unroll") for (int j = 0; j < 4; ++j) xb[j] = *(const u32x2*)(X + (size_t)(mm) * 1024 + 4 * F.lane + 256 * j); } \
        if (l >= 0) { _Pragma("unroll") for (int k = 0; k < 4; ++k) _Pragma("unroll") for (int j = 0; j < 4; ++j) yn[k][j] = *(const u32x2*)(YS + ((size_t)(mm) * 4 + k) * 1024 + 4 * F.lane + 256 * j); } } while (0)
    if (gw < NTOK) CMB_LOAD(gw);
    for (int m = gw; m < NTOK; m += NGW) {
        const int b = m >> 12;
        f32x4 v[4]; u32x2 yc[4][4];
#pragma unroll
        for (int j = 0; j < 4; ++j) { v[j] = (l < 0) ? xn[j] : up4(xb[j]);
#pragma unroll
            for (int k = 0; k < 4; ++k) yc[k][j] = yn[k][j]; }
        if (m + NGW < NTOK) CMB_LOAD(m + NGW);
        if (l >= 0) {
            const float* g2 = MOD + (size_t)(l * 4 + b) * 6144 + 5 * 1024;
#pragma unroll
            for (int j = 0; j < 4; ++j) {
                f32x4 s = (f32x4){0.f, 0.f, 0.f, 0.f};
#pragma unroll
                for (int k = 0; k < 4; ++k) { const u32x2 y = yc[k][j];
                    s.x += __builtin_bit_cast(float, y.x << 16); s.y += __builtin_bit_cast(float, y.x & 0xffff0000u); s.z += __builtin_bit_cast(float, y.y << 16); s.w += __builtin_bit_cast(float, y.y & 0xffff0000u); }
                const f32x4 g = *(const f32x4*)(g2 + 4 * F.lane + 256 * j);
                v[j] = v[j] + g * yscale * s;
            }
        }
        if (l >= 0 && has_next) {
#pragma unroll
            for (int j = 0; j < 4; ++j) *(u32x2*)(X + (size_t)m * 1024 + 4 * F.lane + 256 * j) = pk4(v[j]);
        }
        float ss = 0.f;
#pragma unroll
        for (int j = 0; j < 4; ++j) ss += (v[j].x * v[j].x + v[j].y * v[j].y) + (v[j].z * v[j].z + v[j].w * v[j].w);
        const float rs = 1.f / sqrtf(wave_sum(ss) * (1.f / 1024.f) + 1e-6f);
        if (has_next) {
            const float* nw = in_[I_NORM1] + (l + 1) * 1024;
            const float* sh = MOD + (size_t)((l + 1) * 4 + b) * 6144; const float* sc = sh + 1024;
            float fl[8];
#pragma unroll
            for (int e = 0; e < 8; ++e) fl[e] = 0.f;
            bf16_t* H = (bf16_t*)(ws_ + WS_H) + (size_t)m * 1024;
#pragma unroll
            for (int j = 0; j < 4; ++j) {
                const int c0 = 4 * F.lane + 256 * j;
                const f32x4 w = *(const f32x4*)(nw + c0), s1 = *(const f32x4*)(sc + c0), s0 = *(const f32x4*)(sh + c0);
                f32x4 h = v[j] * rs * w * (s1 + 1.f) + s0;
                u32x2 o; o.x = cvtpk(h.x, h.y); o.y = cvtpk(h.z, h.w);
                *(u32x2*)(H + c0) = o;
#pragma unroll
                for (int i = 0; i < 4; ++i) {
                    const f32x4 wa = *(const LAS f32x4*)(Wf + (c0 + i) * 8), wb = *(const LAS f32x4*)(Wf + (c0 + i) * 8 + 4);
                    const float hv = h[i];
                    fl[0] += hv * wa.x; fl[1] += hv * wa.y; fl[2] += hv * wa.z; fl[3] += hv * wa.w; fl[4] += hv * wb.x; fl[5] += hv * wb.y; fl[6] += hv * wb.z; fl[7] += hv * wb.w;
                }
            }
#pragma unroll
            for (int e = 0; e < 8; ++e) fl[e] = wave_sum(fl[e]);
            if (F.lane == 0) { float* o = (float*)(ws_ + WS_FLOG) + (size_t)m * 8; *(f32x4*)o = (f32x4){fl[0], fl[1], fl[2], fl[3]}; *(f32x4*)(o + 4) = (f32x4){fl[4], fl[5], fl[6], fl[7]}; }
        } else {
            const float* nw = in_[I_NORMF]; float* out_ = (float*)ldptr(F, 29);
            const float pscale = (PROBE_T >= 0) ? 1.f + __hip_atomic_load((GAS float*)(ctl_ + CW_CODE + 1), RLX_AGENT) : 1.f;
#pragma unroll
            for (int j = 0; j < 4; ++j) { const int c0 = 4 * F.lane + 256 * j; const f32x4 w = *(const f32x4*)(nw + c0);
                *(f32x4*)(out_ + (size_t)m * 1024 + c0) = v[j] * rs * w * pscale; }
        }
    }
}

#undef CMB_LOAD
struct ProbDense {
    const char* A; const char* Bt; int nM, nN, G, vcu;
    __device__ __forceinline__ bool next(int i, pg8::Unit& u) const { const int Lx = i * G + vcu; if (Lx >= nM * nN) return false; u.pn = Lx % nN; u.pm = Lx / nN; u.e = 0; return true; }
    __device__ __forceinline__ const char* a_ptr(const pg8::Unit& u) const { return A + (size_t)u.pm * 256 * 2048; }
    __device__ __forceinline__ const char* b_ptr(const pg8::Unit& u) const { return Bt + (size_t)u.pn * 256 * 2048; }
};
struct EpiProj {
    unsigned char* ws;
    __device__ __forceinline__ void operator()(const f32x4 (&acc)[2][2][4][2], const pg8::Unit& u, int wr, int wc, int fr, int fq) const {
        const int pn = u.pn;
#pragma unroll
        for (int ai = 0; ai < 2; ++ai)
#pragma unroll
            for (int m = 0; m < 4; ++m) {
                const size_t row = (size_t)u.pm * 256 + ai * 128 + wr * 64 + m * 16 + fr;
#pragma unroll
                for (int bj = 0; bj < 2; ++bj) {
                    const int ct = bj * 128 + wc * 32 + 8 * fq;
                    const f32x4 v0 = acc[ai][bj][m][0], v1 = acc[ai][bj][m][1];
                    if (pn < 4) { *(u32x4*)((bf16_t*)(ws + WS_ZR) + row * 1024 + pn * 256 + ct) = pk8(v0, v1); }
                    else if (pn == 4) { float* p = (float*)(ws + WS_ZP) + row * 256 + ct; *(f32x4*)p = v0; *(f32x4*)(p + 4) = v1; }
                    else { const int q = pn - 5, which = q >> 1; const float sc = (which == 0) ? QSCALE : 1.f;
                        bf16_t* p = (bf16_t*)(ws + (which == 0 ? WS_Q : (which == 1 ? WS_K : WS_V))) + row * 512 + (q & 1) * 256 + ct;
                        u32x4 w; w.x = pg8::cvt_pk_bf16(v0[0] * sc, v0[1] * sc); w.y = pg8::cvt_pk_bf16(v0[2] * sc, v0[3] * sc); w.z = pg8::cvt_pk_bf16(v1[0] * sc, v1[1] * sc); w.w = pg8::cvt_pk_bf16(v1[2] * sc, v1[3] * sc);
                        *(u32x4*)p = w; }
                }
            }
    }
};
struct EpiOut {
    bf16_t* X; const float* Xin; const float* g1; float scale;
    __device__ __forceinline__ void operator()(const f32x4 (&acc)[2][2][4][2], const pg8::Unit& u, int wr, int wc, int fr, int fq) const {
        const int b = (u.pm * 256) >> 12;
#pragma unroll
        for (int bj = 0; bj < 2; ++bj) {
            const int col = u.pn * 256 + bj * 128 + wc * 32 + 8 * fq;
            const f32x4 ga = *(const f32x4*)(g1 + (size_t)b * 6144 + col), gb = *(const f32x4*)(g1 + (size_t)b * 6144 + col + 4);
#pragma unroll
            for (int ai = 0; ai < 2; ++ai)
#pragma unroll
                for (int m = 0; m < 4; ++m) {
                    const size_t row = (size_t)u.pm * 256 + ai * 128 + wr * 64 + m * 16 + fr;
                    bf16_t* p = X + row * 1024 + col;
                    f32x4 x0, x1;
                    if (Xin) { const float* pi = Xin + row * 1024 + col; x0 = *(const f32x4*)pi; x1 = *(const f32x4*)(pi + 4); }
                    else { const u32x4 xb = *(const u32x4*)p; x0 = up4((u32x2){xb.x, xb.y}); x1 = up4((u32x2){xb.z, xb.w}); }
                    *(u32x4*)p = pk8(x0 + ga * scale * acc[ai][bj][m][0], x1 + gb * scale * acc[ai][bj][m][1]);
                }
        }
    }
};

struct MoeTab { LAS int* te; LAS int* tr0; LAS int* cnt; LAS int* ntiles; };
__device__ __forceinline__ MoeTab moe_table(Frame& F, int l) {
    refresh(F); unsigned char* ws_ = (unsigned char*)ldptr(F, 30); const InTab in_{F.lds}; gu32* ctl_ = (gu32*)ws_;

    MoeTab T; T.te = (LAS int*)(F.lds + TAB_OFF); T.tr0 = T.te + 320; T.cnt = T.tr0 + 320; T.ntiles = T.cnt + 32;
    if (F.tid < 32) T.cnt[F.tid] = (int)__hip_atomic_load(ctl_ + CW_CNT + ((l + (PROBE_DUP == 8 ? 4 : 0)) * 32 + F.tid) * 64, RLX_AGENT);
    __syncthreads();
    if (F.tid < 64) {
        const int e = F.tid; const int nt_e = (e < 32) ? ((T.cnt[e & 31] + 255) >> 8) : 0;
        int incl = nt_e;
#pragma unroll
        for (int o = 1; o < 32; o <<= 1) { const int t = __shfl_up(incl, o); if (F.lane >= o) incl += t; }
        const int start = incl - nt_e;
#pragma nounroll
        for (int r = 0; r < nt_e; ++r) { T.te[start + r] = e; T.tr0[start + r] = r * 256; }
        if (e == 31) T.ntiles[0] = incl;
    }
    __syncthreads();
    return T;
}
struct ProbGU {
    const char* H; const char* W; const int* list; MoeTab T; int nun, G, vcu, l;
    __device__ __forceinline__ bool next(int i, pg8::Unit& u) const { const int Lx = i * G + vcu; if (Lx >= nun) return false; u.pm = Lx >> 3; u.pn = Lx & 7; u.e = __builtin_amdgcn_readfirstlane(T.te[u.pm]); return true; }
    __device__ __forceinline__ const char* a_ptr(const pg8::Unit&) const { return H; }
    __device__ __forceinline__ const char* b_ptr(const pg8::Unit& u) const { return W + ((size_t)(l * 32 + u.e) * 2048 + (size_t)u.pn * 256) * 2048; }
    __device__ __forceinline__ unsigned row_off(const pg8::Unit& u, int r) const { const int idx = __builtin_amdgcn_readfirstlane(T.tr0[u.pm]) + r; const int tok = (idx < __builtin_amdgcn_readfirstlane(T.cnt[u.e])) ? (list[u.e * NTOK + idx] >> 2) : 0; return (unsigned)tok * 2048u; }
};
struct EpiGU {
    bf16_t* ACT; const float* bgu; int l;
    __device__ __forceinline__ void operator()(const f32x4 (&acc)[2][2][4][2], const pg8::Unit& u, int wr, int wc, int fr, int fq) const {
        const int col = u.pn * 128 + wc * 32 + 8 * fq;
        const float* bb = bgu + (size_t)(l * 32 + u.e) * 2048 + col;
        const f32x4 bg0 = *(const f32x4*)bb, bg1 = *(const f32x4*)(bb + 4), bu0 = *(const f32x4*)(bb + 1024), bu1 = *(const f32x4*)(bb + 1028);
#pragma unroll
        for (int ai = 0; ai < 2; ++ai)
#pragma unroll
            for (int m = 0; m < 4; ++m) {
                const size_t row = (size_t)u.pm * 256 + ai * 128 + wr * 64 + m * 16 + fr;
                float a[8];
#pragma unroll
                for (int n = 0; n < 2; ++n)
#pragma unroll
                    for (int i = 0; i < 4; ++i) {
                        float g = acc[ai][0][m][n][i] + (n ? bg1[i] : bg0[i]); float up = acc[ai][1][m][n][i] + (n ? bu1[i] : bu0[i]);
                        g = fminf(g, 7.f); up = fminf(fmaxf(up, -7.f), 7.f);
                        a[n * 4 + i] = (up + 1.f) * (g / (1.f + __expf(-1.702f * g)));
                    }
                u32x4 w; w.x = pg8::cvt_pk_bf16(a[0], a[1]); w.y = pg8::cvt_pk_bf16(a[2], a[3]); w.z = pg8::cvt_pk_bf16(a[4], a[5]); w.w = pg8::cvt_pk_bf16(a[6], a[7]);
                *(u32x4*)(ACT + row * 1024 + col) = w;
            }
    }
};
struct ProbDN {
    const char* ACT; const char* W; MoeTab T; int nun, G, vcu, l;
    __device__ __forceinline__ bool next(int i, pg8::Unit& u) const { const int Lx = i * G + vcu; if (Lx >= nun) return false; u.pm = Lx >> 2; u.pn = Lx & 3; u.e = __builtin_amdgcn_readfirstlane(T.te[u.pm]); return true; }
    __device__ __forceinline__ const char* a_ptr(const pg8::Unit& u) const { return ACT + (size_t)u.pm * 256 * 2048; }
    __device__ __forceinline__ const char* b_ptr(const pg8::Unit& u) const { return W + ((size_t)(l * 32 + u.e) * 1024 + (size_t)u.pn * 256) * 2048; }
};
struct EpiDN {
    bf16_t* YS; const float* bdn; const int* list; const float* gate; MoeTab T; int l;
    __device__ __forceinline__ void operator()(const f32x4 (&acc)[2][2][4][2], const pg8::Unit& u, int wr, int wc, int fr, int fq) const {
        const int r0 = __builtin_amdgcn_readfirstlane(T.tr0[u.pm]), c = __builtin_amdgcn_readfirstlane(T.cnt[u.e]);
#pragma unroll
        for (int ai = 0; ai < 2; ++ai)
#pragma unroll
            for (int m = 0; m < 4; ++m) {
                const int idx = r0 + ai * 128 + wr * 64 + m * 16 + fr;
                if (idx < c) {
                    const int slot = list[u.e * NTOK + idx]; const float gt = gate[slot];
#pragma unroll
                    for (int bj = 0; bj < 2; ++bj) {
                        const int col = u.pn * 256 + bj * 128 + wc * 32 + 8 * fq;
                        const float* bb = bdn + (size_t)(l * 32 + u.e) * 1024 + col;
                        const f32x4 b0 = *(const f32x4*)bb, b1 = *(const f32x4*)(bb + 4);
                        const f32x4 v0 = (acc[ai][bj][m][0] + b0) * gt, v1 = (acc[ai][bj][m][1] + b1) * gt;
                        u32x4 w; w.x = pg8::cvt_pk_bf16(v0[0], v0[1]); w.y = pg8::cvt_pk_bf16(v0[2], v0[3]); w.z = pg8::cvt_pk_bf16(v1[0], v1[1]); w.w = pg8::cvt_pk_bf16(v1[2], v1[3]);
                        *(u32x4*)(YS + (size_t)slot * 1024 + col) = w;
                    }
                }
            }
    }
};

__device__ __forceinline__ void phase_prep(Frame& F, int l) {
    refresh(F); unsigned char* ws_ = (unsigned char*)ldptr(F, 30); const InTab in_{F.lds};
    if (blockIdx.x < 32) {
        const int b = blockIdx.x >> 3, hh = blockIdx.x & 7;
        const float bf = in_[I_BF][l * 8 + hh];
        const float* fl = (const float*)(ws_ + WS_FLOG) + ((size_t)b * SEQ + 8 * F.tid) * 8 + hh;
        float lf[8];
#pragma unroll
        for (int i = 0; i < 8; ++i) lf[i] = fl[i * 8];
#pragma unroll
        for (int i = 0; i < 8; ++i) { lf[i] = -softplusf_(-(lf[i] + bf)); if (i) lf[i] += lf[i - 1]; }
        float incl = lf[7];
#pragma unroll
        for (int o = 1; o < 64; o <<= 1) { const float t = __shfl_up(incl, o); if (F.lane >= o) incl += t; }
        LAS float* wtot = (LAS float*)F.lds;
        if (F.lane == 63) wtot[F.wave] = incl;
        __syncthreads();
        float off = incl - lf[7];
        for (int w = 0; w < F.wave; ++w) off += wtot[w];
        float* bo = (float*)(ws_ + WS_BIAS) + ((size_t)b * 8 + hh) * SEQ + 8 * F.tid;
        f32x4 o0, o1;
        o0.x = -(off + lf[0]) * LOG2E; o0.y = -(off + lf[1]) * LOG2E; o0.z = -(off + lf[2]) * LOG2E; o0.w = -(off + lf[3]) * LOG2E;
        o1.x = -(off + lf[4]) * LOG2E; o1.y = -(off + lf[5]) * LOG2E; o1.z = -(off + lf[6]) * LOG2E; o1.w = -(off + lf[7]) * LOG2E;
        *(f32x4*)bo = o0; *(f32x4*)(bo + 4) = o1;
    }
    const int gw = F.vcu * NWAVES + F.wave, NGW = F.G * NWAVES;
    const float* mu = in_[I_MU] + l * 1024;
    f32x4 muv[4];
#pragma unroll
    for (int j = 0; j < 4; ++j) muv[j] = *(const f32x4*)(mu + 4 * F.lane + 256 * j);
    const f32x4 kkw = *(const f32x4*)(in_[I_KK] + l * 256 + 4 * F.lane);
    const bf16_t* ZR = (const bf16_t*)(ws_ + WS_ZR);
    const int hd = F.lane >> 4, cc = 4 * (F.lane & 15);
    const float act_a = (F.lane < 16) ? 2.f : 1.f, act_b = (F.lane < 16) ? -1.f : 0.f; const bool act_id = (F.lane >= 16 && F.lane < 32);
    for (int g = gw; g < NTOK / 8; g += NGW) {
        const int m0 = g * 8;
        u32x2 raw[9][4];
        const bool hasp = (m0 & (SEQ - 1)) != 0;
#pragma unroll
        for (int i = 0; i < 9; ++i)
#pragma unroll
            for (int j = 0; j < 4; ++j) raw[i][j] = (i > 0 || hasp) ? *(const u32x2*)(ZR + (size_t)(m0 - 1 + i) * 1024 + 4 * F.lane + 256 * j) : (u32x2){0u, 0u};
        f32x4 prev[4], cur[4];
#pragma unroll
        for (int j = 0; j < 4; ++j) prev[j] = unp4(raw[0][j]);
#pragma unroll
        for (int i = 0; i < 8; ++i) {
            const int m = m0 + i, b = m >> 12, t = m & (SEQ - 1);
#pragma unroll
            for (int j = 0; j < 4; ++j) cur[j] = unp4(raw[i + 1][j]);
            f32x4 zs[4];
#pragma unroll
            for (int j = 0; j < 4; ++j) zs[j] = cur[j] + (prev[j] - cur[j]) * muv[j];
            unsigned char* o = ws_ + WS_SCAN + ((size_t)(b * 4 + hd) * SEQ + t) * SCAN_ROW + cc * 2;
            *(u32x2*)(o) = pk4(zs[0]);
            *(u32x2*)(o + 128) = pk4(zs[1]);
            *(u32x2*)(o + 256) = pk4(zs[2]);
            f32x4 kk = zs[1] * kkw;
            const float ss = red16((kk.x * kk.x + kk.y * kk.y) + (kk.z * kk.z + kk.w * kk.w));
            kk = kk * (1.f / fmaxf(sqrtf(ss), 1e-12f));
            *(u32x2*)(o + 384) = pk4(kk);
            f32x4 a4;
#pragma unroll
            for (int q = 0; q < 4; ++q) { const float x = zs[3][q]; const float sg = 1.f / (1.f + __expf(-act_a * x)); a4[q] = act_id ? x : (act_a * sg + act_b); }
            u32x2 pk; pk.x = cvtpk(a4.x, a4.y); pk.y = cvtpk(a4.z, a4.w);
            *(u32x2*)((bf16_t*)(ws_ + WS_ALORA) + (size_t)m * 256 + 4 * F.lane) = pk;
#pragma unroll
            for (int j = 0; j < 4; ++j) prev[j] = cur[j];
        }
    }
}
struct ProbLora {
    const char* A; const char* Bt; int G, vcu;
    __device__ __forceinline__ bool next(int i, pg8::Unit& u) const { const int Lx = i * G + vcu; if (Lx >= 64 * 3) return false; u.pn = Lx % 3; u.pm = Lx / 3; u.e = 0; return true; }
    __device__ __forceinline__ const char* a_ptr(const pg8::Unit& u) const { return A + (size_t)u.pm * 256 * 512; }
    __device__ __forceinline__ const char* b_ptr(const pg8::Unit& u) const { return Bt + (size_t)u.pn * 256 * 512; }
};
struct EpiLora {
    unsigned char* ws; const float* w0; const float* a0; const float* ka;
    __device__ __forceinline__ void operator()(const f32x4 (&acc)[2][2][4][2], const pg8::Unit& u, int wr, int wc, int fr, int fq) const {
        const int pn = u.pn;
#pragma unroll
        for (int bj = 0; bj < 2; ++bj) {
            const int c = bj * 128 + wc * 32 + 8 * fq, hd = c >> 6, cc = c & 63;
            f32x4 p0 = (f32x4){0.f, 0.f, 0.f, 0.f}, p1 = p0, q0 = p0, q1 = p0;
            if (pn == 0) { p0 = *(const f32x4*)(w0 + c); p1 = *(const f32x4*)(w0 + c + 4); }
            else if (pn == 1) { p0 = *(const f32x4*)(a0 + c); p1 = *(const f32x4*)(a0 + c + 4); q0 = *(const f32x4*)(ka + c); q1 = *(const f32x4*)(ka + c + 4); }
#pragma unroll
            for (int ai = 0; ai < 2; ++ai)
#pragma unroll
                for (int m = 0; m < 4; ++m) {
                    const int row = u.pm * 256 + ai * 128 + wr * 64 + m * 16 + fr, b = row >> 12, t = row & (SEQ - 1);
                    const f32x4 v0 = acc[ai][bj][m][0], v1 = acc[ai][bj][m][1];
                    unsigned char* o = ws + WS_SCAN + ((size_t)(b * 4 + hd) * SEQ + t) * SCAN_ROW;
                    if (pn == 0) {
                        f32x4 d0, d1;
#pragma unroll
                        for (int i = 0; i < 4; ++i) { d0[i] = -__expf(-softplus_fast(-(p0[i] + v0[i])) - 0.5f); d1[i] = -__expf(-softplus_fast(-(p1[i] + v1[i])) - 0.5f); if (!CHUNKED_SCAN) { d0[i] = __expf(d0[i]); d1[i] = __expf(d1[i]); } }
                        *(f32x4*)(o + 640 + cc * 4) = d0; *(f32x4*)(o + 640 + cc * 4 + 16) = d1;
                    } else if (pn == 1) {
                        const u32x4 kp = *(const u32x4*)(o + 128 + cc * 2), np = *(const u32x4*)(o + 384 + cc * 2);
                        const f32x4 k0 = unp4((u32x2){kp.x, kp.y}), k1 = unp4((u32x2){kp.z, kp.w}), n0 = unp4((u32x2){np.x, np.y}), n1 = unp4((u32x2){np.z, np.w});
                        f32x4 a_0, a_1;
#pragma unroll
                        for (int i = 0; i < 4; ++i) { a_0[i] = sigmoidf_(p0[i] + v0[i]); a_1[i] = sigmoidf_(p1[i] + v1[i]); }
                        *(u32x4*)(o + 128 + cc * 2) = pk8(k0 * ((a_0 - 1.f) * q0 + 1.f), k1 * ((a_1 - 1.f) * q1 + 1.f));
                        *(u32x4*)(o + 512 + cc * 2) = pk8(-(n0 * a_0), -(n1 * a_1));
                    } else {
                        *(u32x4*)((bf16_t*)(ws + WS_G) + (size_t)row * 256 + c) = pk8(v0, v1);
                    }
                }
        }
    }
};

constexpr int SC_STEPS = 16, SC_CHUNK_F = SC_STEPS * 384, SC_NBUF = 5, SC_PPW = SC_STEPS * 6 / 16;
struct ScanIn { f32x4 r, w, k, kk, kb; float v; };
__device__ __forceinline__ ScanIn scan_ld(const LAS float* p, int ks, int row) {
    ScanIn x; x.r = *(const LAS f32x4*)(p + ks); x.w = *(const LAS f32x4*)(p + 64 + ks); x.k = *(const LAS f32x4*)(p + 128 + ks); x.kk = *(const LAS f32x4*)(p + 256 + ks); x.kb = *(const LAS f32x4*)(p + 320 + ks); x.v = p[192 + row]; return x;
}
__device__ __forceinline__ void scan_block(Frame& F, int rb) {
    refresh(F); unsigned char* ws_ = (unsigned char*)ldptr(F, 30);
    const int bh = rb >> 2, rg = rb & 3, b = bh >> 2, h = bh & 3;
    const float* src = (const float*)(ws_ + WS_SCAN) + (size_t)bh * SEQ * 384;
    LAS float* buf = (LAS float*)F.lds;
    constexpr int NCH = SEQ / SC_STEPS;
    if (F.wave >= 4) {
        const int lw = F.wave - 4;
#define SC_ISSUE(c, slot) do { _Pragma("unroll") for (int p_ = 0; p_ < SC_PPW; ++p_) { const int pc_ = lw * SC_PPW + p_; \
            __builtin_amdgcn_global_load_lds((const unsigned*)(src + (size_t)(c) * SC_CHUNK_F + pc_ * 256 + F.lane * 4), (LAS unsigned*)(buf + (slot) * SC_CHUNK_F + pc_ * 256), 16, 0, 0); } } while (0)
#pragma unroll
        for (int c = 0; c < SC_NBUF - 1; ++c) SC_ISSUE(c, c);
        asm volatile("s_waitcnt vmcnt(%0)" :: "n"((SC_NBUF - 2) * SC_PPW) : "memory");
        __builtin_amdgcn_s_barrier();
        int slot = SC_NBUF - 1;
        for (int c = 0; c < NCH; ++c) {
            if (c + SC_NBUF - 1 < NCH) { SC_ISSUE(c + SC_NBUF - 1, slot); asm volatile("s_waitcnt vmcnt(%0)" :: "n"((SC_NBUF - 2) * SC_PPW) : "memory"); }
            else asm volatile("s_waitcnt vmcnt(0)" ::: "memory");
            slot = (slot == SC_NBUF - 1) ? 0 : slot + 1;
            __builtin_amdgcn_s_barrier();
        }
#undef SC_ISSUE
    } else {
        const int row = rg * 16 + F.wave * 4 + (F.lane >> 4), ks = (F.lane & 15) * 4, l16 = F.lane & 15;
        f32x4 s = (f32x4){0.f, 0.f, 0.f, 0.f};
        float* yout = (float*)(ws_ + WS_YRAW) + (size_t)b * SEQ * 256 + 64 * h + row;
        float yp = 0.f;
        int slot = 0;
        __builtin_amdgcn_s_barrier();
        for (int c = 0; c < NCH; ++c) {
            const LAS float* base = buf + slot * SC_CHUNK_F;
            slot = (slot == SC_NBUF - 1) ? 0 : slot + 1;
            float ykeep = 0.f;
            ScanIn cur = scan_ld(base, ks, row);
#pragma unroll
            for (int st = 0; st < SC_STEPS; ++st) {
                ScanIn nxt = cur;
                if (st + 1 < SC_STEPS) nxt = scan_ld(base + (st + 1) * 384, ks, row);
                const f32x4 vk = cur.k * cur.v;
                const float t0 = s.x * cur.kk.x + s.y * cur.kk.y, t1 = s.z * cur.kk.z + s.w * cur.kk.w;
                const f32x4 u = s * cur.w + vk;
                float sa = t0 + t1;
                red16_pair(sa, yp);
                ykeep = (l16 == st) ? yp : ykeep;
                s = u + cur.kb * sa;
                const float y0 = s.x * cur.r.x + s.y * cur.r.y, y1 = s.z * cur.r.z + s.w * cur.r.w;
                yp = y0 + y1;
                cur = nxt;
            }
            { const int g = c * SC_STEPS + l16 - 1; if (l16 < SC_STEPS && g >= 0) yout[(size_t)g * 256] = ykeep; }
            __builtin_amdgcn_s_barrier();
        }
        yp = red16(yp);
        if (l16 == 0) yout[(size_t)(SEQ - 1) * 256] = yp;
    }
}


__device__ __forceinline__ int crow(int r, int hi) { return (r & 3) + 8 * (r >> 2) + 4 * hi; }
constexpr int CK_P = 144, CK_A = 64 * CK_P;
enum { CA_KKP = 0, CA_RP, CA_BI, CA_KI, CA_VT, CA_KKPT, CA_BHT, CA_KHT, CA_TB, CA_AUK, CA_ARB, CA_ARK, CA_TF0, CA_TF1, CA_N,
       CA_W1T = CA_KKP, CA_MT = CA_BI, CA_U0T = CA_KI,
       CA_D1T = CA_BI, CA_X1T = CA_KI };
constexpr int CK_TF = CA_TF0 * CK_A;
static_assert(CA_N * CK_A <= 139264 && 64 * 68 * 4 <= 2 * CK_A, "chunk LDS map");
__device__ __forceinline__ f32x16 ck_mma(const LAS unsigned char* A, const LAS unsigned char* B, int ksteps, f32x16 acc, int r32, int hi) {
#pragma unroll 4
    for (int s = 0; s < ksteps; ++s) {
        const bf16x8 a = *(const LAS bf16x8*)(A + r32 * CK_P + (16 * s + 8 * hi) * 2);
        const bf16x8 b = *(const LAS bf16x8*)(B + r32 * CK_P + (16 * s + 8 * hi) * 2);
        acc = __builtin_amdgcn_mfma_f32_32x32x16_bf16(a, b, acc, 0, 0, 0);
    }
    return acc;
}
__device__ __forceinline__ void ck_store_t(LAS unsigned char* dst, const f32x16& c, int R0, int C0, int r32, int hi) {
#pragma unroll
    for (int g = 0; g < 4; ++g) { u32x2 w; w.x = cvtpk(c[4 * g], c[4 * g + 1]); w.y = cvtpk(c[4 * g + 2], c[4 * g + 3]); *(LAS u32x2*)(dst + (C0 + r32) * CK_P + (R0 + 8 * g + 4 * hi) * 2) = w; }
}
#define STAMPF(F_, id) do { if (PROBE_T >= 20 && blockIdx.x == 0 && (F_).tid == 0) { volatile LAS unsigned long long* tsw_ = (volatile LAS unsigned long long*)((F_).lds + MISC_OFF + 192); const unsigned long long now_ = wall_clock64(); if ((id) == PROBE_T) tsw_[1] += now_ - tsw_[0]; tsw_[0] = now_; } } while (0)
struct ChunkRows { u32x4 r, k, v, kk, kb; f32x4 w[2]; };
__device__ __forceinline__ ChunkRows chunk_load(Frame& F, unsigned char* ws_, int job) {
    const int t = F.tid & 63, c0 = (F.tid >> 6) * 8, bh = job >> 6, ch = job & 63;
    const unsigned char* row = ws_ + WS_SCAN + ((size_t)bh * SEQ + (size_t)ch * 64 + t) * SCAN_ROW;
    ChunkRows x;
    x.r = *(const u32x4*)(row + c0 * 2); x.k = *(const u32x4*)(row + 128 + c0 * 2); x.v = *(const u32x4*)(row + 256 + c0 * 2); x.kk = *(const u32x4*)(row + 384 + c0 * 2); x.kb = *(const u32x4*)(row + 512 + c0 * 2);
    x.w[0] = *(const f32x4*)(row + 640 + c0 * 4); x.w[1] = *(const f32x4*)(row + 640 + c0 * 4 + 16);
    return x;
}
__device__ __forceinline__ void chunk_job(Frame& F, unsigned char* ws_, int job, const ChunkRows& in) {
    LAS unsigned char* L = F.lds;
    LAS float* Tf = (LAS float*)(L + CK_TF);
    const int tid = F.tid, lane = F.lane, wave = F.wave, r32 = lane & 31, hi = lane >> 5;
    {
        const int t = tid & 63, c0 = (tid >> 6) * 8;
        float r_[8], k_[8], v_[8], kk_[8], kb_[8], Lt[8];
#pragma unroll
        for (int q = 0; q < 2; ++q) {
            const f32x4 r4 = unp4((u32x2){in.r[2 * q], in.r[2 * q + 1]}), k4 = unp4((u32x2){in.k[2 * q], in.k[2 * q + 1]}), v4 = unp4((u32x2){in.v[2 * q], in.v[2 * q + 1]}), n4 = unp4((u32x2){in.kk[2 * q], in.kk[2 * q + 1]}), b4 = unp4((u32x2){in.kb[2 * q], in.kb[2 * q + 1]});
#pragma unroll
            for (int i = 0; i < 4; ++i) { r_[4 * q + i] = r4[i]; k_[4 * q + i] = k4[i]; v_[4 * q + i] = v4[i]; kk_[4 * q + i] = n4[i]; kb_[4 * q + i] = -b4[i]; Lt[4 * q + i] = in.w[q][i]; }
        }
#pragma unroll
        for (int i = 0; i < 8; ++i) {
            float x = Lt[i];
            x += __builtin_bit_cast(float, __builtin_amdgcn_update_dpp(0, __builtin_bit_cast(int, x), 0x111, 0xf, 0xf, true));
            x += __builtin_bit_cast(float, __builtin_amdgcn_update_dpp(0, __builtin_bit_cast(int, x), 0x112, 0xf, 0xf, true));
            x += __builtin_bit_cast(float, __builtin_amdgcn_update_dpp(0, __builtin_bit_cast(int, x), 0x114, 0xf, 0xf, true));
            x += __builtin_bit_cast(float, __builtin_amdgcn_update_dpp(0, __builtin_bit_cast(int, x), 0x118, 0xf, 0xf, true));
            const float r0 = __builtin_bit_cast(float, __builtin_amdgcn_readlane(__builtin_bit_cast(int, x), 15)), r1 = __builtin_bit_cast(float, __builtin_amdgcn_readlane(__builtin_bit_cast(int, x), 31)), r2 = __builtin_bit_cast(float, __builtin_amdgcn_readlane(__builtin_bit_cast(int, x), 47));
            const int rw = lane >> 4;
            x += (rw >= 1 ? r0 : 0.f) + (rw >= 2 ? r1 : 0.f) + (rw >= 3 ? r2 : 0.f);
            Lt[i] = x;
        }
        float kkp[8], rp[8], bi[8], ki[8], bh_[8], kh_[8];
#pragma unroll
        for (int i = 0; i < 8; ++i) {
            const float Lm0 = __shfl_up(Lt[i], 1); const float Lm = (lane > 0) ? Lm0 : 0.f; const float Lc = __shfl(Lt[i], 63);
            const float ip = __expf(-Lt[i]);
            kkp[i] = kk_[i] * __expf(Lm); rp[i] = r_[i] * __expf(Lt[i]); bi[i] = kb_[i] * ip; ki[i] = k_[i] * ip;
            const float pc = __expf(Lc - Lt[i]); bh_[i] = kb_[i] * pc; kh_[i] = k_[i] * pc;
            if (t == 63) ((LAS float*)(L + PCV_OFF))[c0 + i] = __expf(Lc);
        }
#define CK_ROW8(arr, vals_) do { u32x4 w_ = (u32x4){cvtpk(vals_[0], vals_[1]), cvtpk(vals_[2], vals_[3]), cvtpk(vals_[4], vals_[5]), cvtpk(vals_[6], vals_[7])}; *(LAS u32x4*)(L + (arr) * CK_A + t * CK_P + c0 * 2) = w_; } while (0)
#define CK_COL8(arr, vals_) do { _Pragma("unroll") for (int i_ = 0; i_ < 8; ++i_) *(LAS unsigned short*)(L + (arr) * CK_A + (c0 + i_) * CK_P + t * 2) = (unsigned short)cvtpk(vals_[i_], 0.f); } while (0)
        CK_ROW8(CA_KKP, kkp); CK_ROW8(CA_RP, rp); CK_ROW8(CA_BI, bi); CK_ROW8(CA_KI, ki);
        CK_COL8(CA_VT, v_); CK_COL8(CA_KKPT, kkp); CK_COL8(CA_BHT, bh_); CK_COL8(CA_KHT, kh_);
#undef CK_ROW8
#undef CK_COL8
    }
    __syncthreads(); STAMPF(F, 20);
#pragma unroll
    for (int q = 0; q < 2; ++q) {
        const int id = wave * 2 + q, which = id >> 2, tj = (id >> 1) & 1, tt = id & 1;
        const LAS unsigned char* Aop = L + ((which & 1) ? CA_KI : CA_BI) * CK_A + tj * 32 * CK_P;
        const LAS unsigned char* Bop = L + ((which & 2) ? CA_RP : CA_KKP) * CK_A + tt * 32 * CK_P;
        f32x16 c = {}; c = ck_mma(Aop, Bop, 4, c, r32, hi);
        const int t = tt * 32 + r32;
#pragma unroll
        for (int i = 0; i < 16; ++i) { const int j = tj * 32 + crow(i, hi); const bool keep = (which & 2) ? (j <= t) : (j < t); if (!keep) c[i] = 0.f; }
        if (which == 0) {
#pragma unroll
            for (int g = 0; g < 4; ++g) { const int j0 = tj * 32 + 8 * g + 4 * hi; Tf[t * 68 + j0] = c[4 * g]; Tf[t * 68 + j0 + 1] = c[4 * g + 1]; Tf[t * 68 + j0 + 2] = c[4 * g + 2]; Tf[t * 68 + j0 + 3] = c[4 * g + 3]; }
        } else ck_store_t(L + ((which == 1) ? CA_AUK : (which == 2) ? CA_ARB : CA_ARK) * CK_A, c, tj * 32, tt * 32, r32, hi);
    }
    __syncthreads(); STAMPF(F, 21);
    LAS unsigned char* TB = L + CA_TB * CK_A;
    if (wave == 4) {
        const int blk = lane >> 5, c = lane & 31;
        const LAS float* ab = Tf + blk * (32 * 68 + 32);
        float x[32];
#pragma unroll
        for (int t = 0; t < 32; ++t) x[t] = 0.f;
#pragma unroll
        for (int t = 0; t < 32; ++t) {
            int z = 0;
            if (t >= 2) asm volatile("" : "+v"(z) : "v"(x[t - 2]));
            const LAS float* rowp = ab + t * 68 + z;
            float a0 = (t == c) ? 1.f : 0.f, a1 = 0.f, a2 = 0.f, a3 = 0.f;
#pragma unroll
            for (int j = 0; j < t; j += 4) { const f32x4 a4 = *(const LAS f32x4*)(rowp + j);
                a0 -= a4.x * x[j]; a1 -= a4.y * x[j + 1]; a2 -= a4.z * x[j + 2]; a3 -= a4.w * x[j + 3]; }
            x[t] = (a0 + a1) + (a2 + a3);
        }
#pragma unroll
        for (int t = 0; t < 32; ++t) *(LAS unsigned short*)(TB + (32 * blk + t) * CK_P + (32 * blk + c) * 2) = (unsigned short)f2bf(x[t]);
        if (blk == 0) {
#pragma unroll
            for (int t8 = 0; t8 < 4; ++t8) { const u32x4 w_ = (u32x4){cvtpk(x[8 * t8], x[8 * t8 + 1]), cvtpk(x[8 * t8 + 2], x[8 * t8 + 3]), cvtpk(x[8 * t8 + 4], x[8 * t8 + 5]), cvtpk(x[8 * t8 + 6], x[8 * t8 + 7])}; *(LAS u32x4*)(L + CA_D1T * CK_A + c * CK_P + t8 * 16) = w_; }
        } else {
#pragma unroll
            for (int t8 = 0; t8 < 4; ++t8) *(LAS u32x4*)(TB + c * CK_P + 64 + t8 * 16) = (u32x4){0u, 0u, 0u, 0u};
        }
    } else if (wave < 4) {
        const int tt = wave >> 1, tv = wave & 1;
        f32x16 c = {}; c = ck_mma(L + CA_AUK * CK_A + tt * 32 * CK_P, L + CA_VT * CK_A + tv * 32 * CK_P, 4, c, r32, hi);
        ck_store_t(L + CA_W1T * CK_A, c, tt * 32, tv * 32, r32, hi);
    }
    __syncthreads(); STAMPF(F, 22);
    if (wave == 0) {
        f32x16 c = {};
#pragma unroll
        for (int s = 0; s < 2; ++s) {
            const f32x4 f0 = *(const LAS f32x4*)(Tf + (32 + r32) * 68 + 16 * s + 8 * hi), f1 = *(const LAS f32x4*)(Tf + (32 + r32) * 68 + 16 * s + 8 * hi + 4);
            const u32x4 aw = (u32x4){cvtpk(f0.x, f0.y), cvtpk(f0.z, f0.w), cvtpk(f1.x, f1.y), cvtpk(f1.z, f1.w)};
            const bf16x8 b = *(const LAS bf16x8*)(L + CA_D1T * CK_A + r32 * CK_P + (16 * s + 8 * hi) * 2);
            c = __builtin_amdgcn_mfma_f32_32x32x16_bf16(__builtin_bit_cast(bf16x8, aw), b, c, 0, 0, 0);
        }
        ck_store_t(L + CA_X1T * CK_A, c, 0, 0, r32, hi);
    }
    __syncthreads(); STAMPF(F, 23);
    if (wave == 0) {
        f32x16 c = {}; c = ck_mma(L + CA_X1T * CK_A, TB + 32 * CK_P + 64, 2, c, r32, hi);
#pragma unroll
        for (int i = 0; i < 16; ++i) c[i] = -c[i];
        ck_store_t(TB + 32 * CK_P, c, 0, 0, r32, hi);
    }
    __syncthreads(); STAMPF(F, 24);
    {
        const int which = wave >> 2, tt = (wave >> 1) & 1, tc = wave & 1;
        f32x16 c = {}; c = ck_mma(L + CA_TB * CK_A + tt * 32 * CK_P, L + (which ? CA_W1T : CA_KKPT) * CK_A + tc * 32 * CK_P, 4, c, r32, hi);
        if (which) {
#pragma unroll
            for (int i = 0; i < 16; ++i) c[i] = -c[i];
        }
        ck_store_t(L + (which ? CA_U0T : CA_MT) * CK_A, c, tt * 32, tc * 32, r32, hi);
    }
    __syncthreads(); STAMPF(F, 25);
    const size_t jb = (size_t)job;
#pragma unroll
    for (int q = 0; q < 2; ++q) {
        const int id = wave * 2 + q, which = id >> 2, ta = (id >> 1) & 1, tb = id & 1;
        f32x16 c = {};
        if (which == 0) {
            c = ck_mma(L + CA_MT * CK_A + ta * 32 * CK_P, L + CA_BHT * CK_A + tb * 32 * CK_P, 4, c, r32, hi);
            const int k2 = tb * 32 + r32; const float pcv = ((const LAS float*)(L + PCV_OFF))[k2];
            bf16_t* o = (bf16_t*)(ws_ + WS_CPG + jb * 24576) + (size_t)k2 * 64;
#pragma unroll
            for (int g = 0; g < 4; ++g) { const int k1 = ta * 32 + 8 * g + 4 * hi; float x[4];
#pragma unroll
                for (int i = 0; i < 4; ++i) x[i] = ((k1 + i == k2) ? pcv : 0.f) - c[4 * g + i];
                u32x2 w_; w_.x = cvtpk(x[0], x[1]); w_.y = cvtpk(x[2], x[3]); *(u32x2*)(o + k1) = w_; }
        } else if (which == 1) {
            c = ck_mma(L + CA_BHT * CK_A + ta * 32 * CK_P, L + CA_U0T * CK_A + tb * 32 * CK_P, 4, c, r32, hi);
            c = ck_mma(L + CA_KHT * CK_A + ta * 32 * CK_P, L + CA_VT * CK_A + tb * 32 * CK_P, 4, c, r32, hi);
            float* o = (float*)(ws_ + WS_CPG + jb * 24576 + 8192) + (size_t)(ta * 32) * 64 + tb * 32 + r32;
#pragma unroll
            for (int i = 0; i < 16; ++i) o[crow(i, hi) * 64] = c[i];
        } else if (which == 2) {
            c = ck_mma(L + CA_MT * CK_A + ta * 32 * CK_P, L + CA_ARB * CK_A + tb * 32 * CK_P, 4, c, r32, hi);
            const int t = tb * 32 + r32;
            bf16_t* o = (bf16_t*)(ws_ + WS_CPSI) + jb * 4096 + (size_t)t * 64;
#pragma unroll
            for (int g = 0; g < 4; ++g) { const int k0 = ta * 32 + 8 * g + 4 * hi; const u32x2 rp2 = *(const LAS u32x2*)(L + CA_RP * CK_A + t * CK_P + k0 * 2);
                const float r0 = __builtin_bit_cast(float, rp2.x << 16), r1 = __builtin_bit_cast(float, rp2.x & 0xffff0000u), r2 = __builtin_bit_cast(float, rp2.y << 16), r3 = __builtin_bit_cast(float, rp2.y & 0xffff0000u);
                u32x2 w_; w_.x = cvtpk(r0 - c[4 * g], r1 - c[4 * g + 1]); w_.y = cvtpk(r2 - c[4 * g + 2], r3 - c[4 * g + 3]); *(u32x2*)(o + k0) = w_; }
        } else {
            c = ck_mma(L + CA_ARB * CK_A + ta * 32 * CK_P, L + CA_U0T * CK_A + tb * 32 * CK_P, 4, c, r32, hi);
            c = ck_mma(L + CA_ARK * CK_A + ta * 32 * CK_P, L + CA_VT * CK_A + tb * 32 * CK_P, 4, c, r32, hi);
            float* o = (float*)(ws_ + WS_CY0) + jb * 4096 + (size_t)(ta * 32) * 64 + tb * 32 + r32;
#pragma unroll
            for (int i = 0; i < 16; ++i) o[crow(i, hi) * 64] = c[i];
        }
    }
    __syncthreads(); STAMPF(F, 26);
}


constexpr int S2_REC = 24576, S2_NSLOT = 4, S2_SB = S2_NSLOT * S2_REC;
__device__ __forceinline__ void chunk_states(Frame& F, unsigned char* ws_, int bh) {
    LAS unsigned char* L = F.lds;
    LAS unsigned char* Sb = L + S2_SB;
    const int tid = F.tid, lane = F.lane, wave = F.wave, r32 = lane & 31, hi = lane >> 5;
    for (int i = tid; i < 64 * CK_P / 4; i += NTHR) ((LAS unsigned*)Sb)[i] = 0u;
    const unsigned char* rec0 = ws_ + WS_CPG + (size_t)bh * 64 * S2_REC;
#define S2_ISSUE(c) do { if (wave >= 4) { _Pragma("unroll") for (int p_ = 0; p_ < 6; ++p_) { const int pc_ = (wave - 4) * 6 + p_; \
        __builtin_amdgcn_global_load_lds((const unsigned*)(rec0 + (size_t)(c) * S2_REC + pc_ * 1024 + lane * 16), (LAS unsigned*)(L + ((c) & (S2_NSLOT - 1)) * S2_REC + pc_ * 1024), 16, 0, 0); } } } while (0)
    S2_ISSUE(0); S2_ISSUE(1); S2_ISSUE(2);
    if (wave >= 4) asm volatile("s_waitcnt vmcnt(12)" ::: "memory");
    __syncthreads();
    const int ti = wave >> 1, tj = wave & 1;
    for (int c = 0; c < 64; ++c) {
        if (c + 3 < 64) { S2_ISSUE(c + 3); if (wave >= 4) asm volatile("s_waitcnt vmcnt(12)" ::: "memory"); }
        else if (wave >= 4) asm volatile("s_waitcnt vmcnt(0)" ::: "memory");
        { const int row = tid >> 3, ch = tid & 7; *(u32x4*)((bf16_t*)(ws_ + WS_CS) + ((size_t)bh * 64 + c) * 4096 + row * 64 + ch * 8) = *(const LAS u32x4*)(Sb + row * CK_P + ch * 16); }
        f32x16 acc = {};
        if (wave < 4) {
            const LAS unsigned char* R = L + (c & (S2_NSLOT - 1)) * S2_REC;
            const LAS float* G = (const LAS float*)(R + 8192);
#pragma unroll
            for (int i = 0; i < 16; ++i) acc[i] = G[(ti * 32 + crow(i, hi)) * 64 + tj * 32 + r32];
#pragma unroll
            for (int s = 0; s < 4; ++s) {
                const bf16x8 a = *(const LAS bf16x8*)(R + (ti * 32 + r32) * 128 + (16 * s + 8 * hi) * 2);
                const bf16x8 b = *(const LAS bf16x8*)(Sb + (tj * 32 + r32) * CK_P + (16 * s + 8 * hi) * 2);
                acc = __builtin_amdgcn_mfma_f32_32x32x16_bf16(a, b, acc, 0, 0, 0);
            }
        }
        __syncthreads();
        if (wave < 4) ck_store_t(Sb, acc, ti * 32, tj * 32, r32, hi);
        __syncthreads();
    }
#undef S2_ISSUE
}
struct OutOps { bf16x8 a[4], b[4]; f32x16 acc; };
struct PostOps { float vv[16], rr[16], kk[16], gg[16]; };
__device__ __forceinline__ OutOps out_load(Frame& F, unsigned char* ws_, int job, int w4) {
    const int lane = F.lane, r32 = lane & 31, hi = lane >> 5, tt = w4 >> 1, tv = w4 & 1;
    const bf16_t* Psi = (const bf16_t*)(ws_ + WS_CPSI) + (size_t)job * 4096; const bf16_t* CS = (const bf16_t*)(ws_ + WS_CS) + (size_t)job * 4096; const float* Y0 = (const float*)(ws_ + WS_CY0) + (size_t)job * 4096;
    OutOps o;
#pragma unroll
    for (int s = 0; s < 4; ++s) { o.a[s] = *(const bf16x8*)(Psi + (tt * 32 + r32) * 64 + 16 * s + 8 * hi); o.b[s] = *(const bf16x8*)(CS + (tv * 32 + r32) * 64 + 16 * s + 8 * hi); }
#pragma unroll
    for (int i = 0; i < 16; ++i) o.acc[i] = Y0[(tt * 32 + crow(i, hi)) * 64 + tv * 32 + r32];
    return o;
}
__device__ __forceinline__ PostOps post_load(Frame& F, unsigned char* ws_, int job, int w4) {
    const int c = F.lane, bh = job >> 6, ch = job & 63, b = bh >> 2, h = bh & 3;
    const unsigned char* SCN = ws_ + WS_SCAN + ((size_t)bh * SEQ + (size_t)ch * 64 + w4 * 16) * SCAN_ROW + c * 2; const bf16_t* GG = (const bf16_t*)(ws_ + WS_G) + ((size_t)b * SEQ + (size_t)ch * 64 + w4 * 16) * 256 + 64 * h + c;
    PostOps p;
#pragma unroll
    for (int u = 0; u < 16; ++u) { const unsigned char* sp = SCN + (size_t)u * SCAN_ROW; p.vv[u] = bf2f(*(const unsigned short*)(sp + 256)); p.rr[u] = bf2f(*(const unsigned short*)sp); p.kk[u] = bf2f(*(const unsigned short*)(sp + 128)); p.gg[u] = bf2f(GG[(size_t)u * 256]); }
    return p;
}
__device__ __forceinline__ void out_compute(Frame& F, const OutOps& o, int w4) {
    const int lane = F.lane, r32 = lane & 31, hi = lane >> 5, tt = w4 >> 1, tv = w4 & 1;
    f32x16 acc = o.acc;
#pragma unroll
    for (int s = 0; s < 4; ++s) acc = __builtin_amdgcn_mfma_f32_32x32x16_bf16(o.a[s], o.b[s], acc, 0, 0, 0);
    LAS float* yl = (LAS float*)F.lds + (F.wave >> 2) * 4096 + (tt * 32) * 64 + tv * 32 + r32;
#pragma unroll
    for (int i = 0; i < 16; ++i) yl[crow(i, hi) * 64] = acc[i];
}
__device__ __forceinline__ void post_compute(Frame& F, const InTab& in_, unsigned char* ws_, int l, int job, int w4, const PostOps& p) {
    const int c = F.lane, bh = job >> 6, ch = job & 63, b = bh >> 2, h = bh & 3;
    const float lw = in_[I_LNW][l * 256 + 64 * h + c], lb = in_[I_LNB][l * 256 + 64 * h + c], rkw = in_[I_RK][l * 256 + 64 * h + c];
    const LAS float* yimg = (const LAS float*)F.lds + (F.wave >> 2) * 4096 + (w4 * 16) * 64 + c;
    bf16_t* MX = (bf16_t*)(ws_ + WS_MIXED) + ((size_t)b * SEQ + (size_t)ch * 64 + w4 * 16) * 1024 + 64 * h + c;
#pragma unroll
    for (int u = 0; u < 16; ++u) {
        const float y = yimg[u * 64];
        const float mean = wave_sum(y) * (1.f / 64.f); const float d = y - mean; const float var = wave_sum(d * d) * (1.f / 64.f);
        float yn = d * (1.f / sqrtf(var + 64e-5f)) * lw + lb;
        yn += wave_sum(p.rr[u] * p.kk[u] * rkw) * p.vv[u];
        yn *= p.gg[u];
        MX[(size_t)u * 1024] = (bf16_t)f2bf(yn);
    }
}

namespace fa {
constexpr int APITCH = 512, OPITCH = 1024, KVBLK = 64, QBLK = 32;
constexpr int NSLOT = 3, SLOTB = 8192;
constexpr int LDS_K = 0, LDS_V = NSLOT * SLOTB, LDS_WS = 2 * NSLOT * SLOTB, LDS_OST = LDS_WS + 8 * 64 * 4, LDS_BL = LDS_OST + 8 * 4096, LDS_ZB = LDS_BL + 4096 * 8, LDS_END = LDS_ZB + 16;
#define SBAR() __builtin_amdgcn_sched_barrier(0)
#define WAIT_BAR(N) asm volatile("s_waitcnt vmcnt(" #N ") lgkmcnt(0)\n\ts_barrier":::"memory")
__device__ __forceinline__ void cmask(f32x16& p0, f32x16& p1, int jb, int qrel, int hi) {
    const float NEG = -INFINITY; const int kb = 64 * jb + 4 * hi;
#pragma unroll
    for (int r = 0; r < 16; ++r) { const int kv = kb + (r & 3) + 8 * (r >> 2); if (kv > qrel) p0[r] = NEG; if (kv + 32 > qrel) p1[r] = NEG; }
}
__device__ __forceinline__ void glds16(const void* gsrc, unsigned lds_dst) { unsigned keep;
    asm volatile("s_mov_b32 %0, m0\n\ts_mov_b32 m0, %2\n\ts_nop 0\n\tglobal_load_lds_dwordx4 %1, off\n\ts_mov_b32 m0, %0" : "=&s"(keep) : "v"(gsrc), "s"(lds_dst) : "memory"); }
__device__ __forceinline__ float max3f(float a, float b, float c) { float r; asm("v_max3_f32 %0, %1, %2, %3" : "=v"(r) : "v"(a), "v"(b), "v"(c)); return r; }
__device__ __forceinline__ float max2f(float a, float b) { float r; asm("v_max_f32_e32 %0, %1, %2" : "=v"(r) : "v"(a), "v"(b)); return r; }
typedef LAS const char* lds_cptr;
typedef short v4i16_t __attribute__((ext_vector_type(4)));
__device__ __forceinline__ void qkt(f32x16& p0, f32x16& p1, lds_cptr Kslot, const bf16x8* qr, bf16x8 ba0, bf16x8 ba1, bf16x8 qb, int r32, int hi) {
    const f32x16 zc = {};
    p0 = __builtin_amdgcn_mfma_f32_32x32x16_bf16(ba0, qb, zc, 0, 0, 0); p1 = __builtin_amdgcn_mfma_f32_32x32x16_bf16(ba1, qb, zc, 0, 0, 0);
    lds_cptr kb = Kslot + hi * 1024 + r32 * 16;
#pragma unroll
    for (int d0 = 0; d0 < 4; ++d0) {
        const bf16x8 b0 = *(const LAS bf16x8*)(kb + d0 * 2048);
        const bf16x8 b1 = *(const LAS bf16x8*)(kb + d0 * 2048 + 512);
        { p0 = __builtin_amdgcn_mfma_f32_32x32x16_bf16(b0, qr[d0], p0, 0, 0, 0); p1 = __builtin_amdgcn_mfma_f32_32x32x16_bf16(b1, qr[d0], p1, 0, 0, 0); } }
}
__device__ __forceinline__ void kload8(bf16x8* kf, lds_cptr kp) {
    kf[0] = *(const LAS bf16x8*)(kp);        kf[1] = *(const LAS bf16x8*)(kp + 512);
    kf[2] = *(const LAS bf16x8*)(kp + 2048); kf[3] = *(const LAS bf16x8*)(kp + 2560);
    kf[4] = *(const LAS bf16x8*)(kp + 4096); kf[5] = *(const LAS bf16x8*)(kp + 4608);
    kf[6] = *(const LAS bf16x8*)(kp + 6144); kf[7] = *(const LAS bf16x8*)(kp + 6656);
}
__device__ __forceinline__ void kload2(bf16x8* kf, lds_cptr kp, int j) { kf[2 * j] = *(const LAS bf16x8*)(kp + j * 2048); kf[2 * j + 1] = *(const LAS bf16x8*)(kp + j * 2048 + 512); }
__device__ __forceinline__ s16x4 vtr(lds_cptr p) { return __builtin_bit_cast(s16x4, __builtin_amdgcn_ds_read_tr16_b64_v4i16((LAS v4i16_t*)p)); }
__device__ __forceinline__ float rowmax(const f32x16& p0, const f32x16& p1) {
    float a = max3f(p0[0], p0[1], p1[0]), b = max3f(p0[2], p0[3], p1[1]); a = max3f(a, p1[2], p1[3]);
#pragma unroll
    for (int r = 4; r < 16; r += 4) { a = max3f(a, p0[r], p0[r + 1]); b = max3f(b, p0[r + 2], p0[r + 3]); a = max3f(a, p1[r], p1[r + 1]); b = max3f(b, p1[r + 2], p1[r + 3]); }
    const float m = max2f(a, b);
    auto rr = __builtin_amdgcn_permlane32_swap(__float_as_uint(m), __float_as_uint(m), false, false);
    return max2f(__uint_as_float(rr[0]), __uint_as_float(rr[1]));
}
__device__ __forceinline__ void pv(f32x16* o, int vb, bf16x8 pa0, bf16x8 pa1, bf16x8 pa2, bf16x8 pa3) {
#pragma unroll
    for (int d0 = 0; d0 < 2; ++d0) { s16x4 lo[4], hi[4];
#pragma unroll
        for (int ks = 0; ks < 4; ++ks) {
            asm volatile("ds_read_b64_tr_b16 %0,%1 offset:%c2" : "=&v"(lo[ks]) : "v"(vb), "i"(d0 * 4096 + ks * 1024) : "memory");
            asm volatile("ds_read_b64_tr_b16 %0,%1 offset:%c2" : "=&v"(hi[ks]) : "v"(vb), "i"(d0 * 4096 + ks * 1024 + 512) : "memory"); }
        asm volatile("s_waitcnt lgkmcnt(0)" ::: "memory"); SBAR();
#define PK(k) (bf16x8){lo[k][0], lo[k][1], lo[k][2], lo[k][3], hi[k][0], hi[k][1], hi[k][2], hi[k][3]}
        o[d0] = __builtin_amdgcn_mfma_f32_32x32x16_bf16(pa0, PK(0), o[d0], 0, 0, 0);
        o[d0] = __builtin_amdgcn_mfma_f32_32x32x16_bf16(pa1, PK(1), o[d0], 0, 0, 0);
        o[d0] = __builtin_amdgcn_mfma_f32_32x32x16_bf16(pa2, PK(2), o[d0], 0, 0, 0);
        o[d0] = __builtin_amdgcn_mfma_f32_32x32x16_bf16(pa3, PK(3), o[d0], 0, 0, 0);
#undef PK
    }
}
template <int THRL> __device__ __forceinline__ void attn_unit(Frame& F, int b, int h, int qb) {
    refresh(F); unsigned char* ws_ = (unsigned char*)ldptr(F, 30);
    const int tid = F.tid, lane = tid & 63, r32 = lane & 31, hi = lane >> 5; const int wid = F.wave;
    const long rowbase = (long)b * SEQ; const int q0 = qb * 256;
    const float* BI = (const float*)(ws_ + WS_BIAS) + ((size_t)b * 8 + h) * SEQ;
    lds_cptr shm3 = (lds_cptr)F.lds; const unsigned lds0 = (unsigned)(uintptr_t)F.lds;
    LAS float* wsf = (LAS float*)(F.lds + LDS_WS) + wid * 64;
    LAS u32x2* BK = (LAS u32x2*)(F.lds + LDS_BL);
    int T0 = 0; const float ref = BI[q0];
    { const int NTa = (q0 + 256) / 64; const float vlast = (lane < NTa) ? BI[64 * lane + 63] : 3.0e38f;
      const unsigned long long ok = __ballot(vlast - ref >= -150.f);
      T0 = ok ? (int)(__ffsll((long long)ok) - 1) : 0; T0 = __builtin_amdgcn_readfirstlane(T0) & ~1; }
    const int NT = (q0 + 256) / 64 - T0;
    const bf16_t* Qw = (const bf16_t*)(ws_ + WS_Q) + (rowbase + q0 + wid * QBLK) * APITCH + h * 64;
    const bf16_t* Kh = (const bf16_t*)(ws_ + WS_K) + (rowbase + 64 * T0) * APITCH + h * 64; const bf16_t* Vh = (const bf16_t*)(ws_ + WS_V) + (rowbase + 64 * T0) * APITCH + h * 64;
    const bf16_t* ksrc = Kh + (long)lane * APITCH + wid * 8;
    const bf16_t* vsrc = Vh + (long)(16 * (wid & 3) + (lane >> 2)) * APITCH + (wid >> 2) * 32 + (lane & 3) * 8;
    const unsigned kdst = lds0 + LDS_K + wid * 1024, vdst = lds0 + LDS_V + wid * 1024;
#define DMA_K(t, slot) glds16(ksrc + (long)(t) * KVBLK * APITCH, (unsigned)__builtin_amdgcn_readfirstlane(kdst + (slot)))
#define DMA_V(t, slot) glds16(vsrc + (long)(t) * KVBLK * APITCH, (unsigned)__builtin_amdgcn_readfirstlane(vdst + (slot)))
    const int vb0 = (int)(lds0 + LDS_V) + ((lane >> 4) & 1) * 32 + (lane & 3) * 8 + (4 * hi + ((lane & 15) >> 2)) * 64;
    bf16x8 kf[8];
    const lds_cptr kp0 = shm3 + LDS_K + hi * 1024 + r32 * 16; const lds_cptr vp0 = shm3 + LDS_V + ((lane >> 4) & 1) * 32 + (lane & 3) * 8 + (4 * hi + ((lane & 15) >> 2)) * 64;
    const lds_cptr bkp = hi ? (shm3 + LDS_ZB) : (shm3 + LDS_BL + r32 * 8); const int bstride = hi ? 0 : 512;
    const unsigned cA = hi ? 0u : 0x3F803F80u;
    DMA_K(0, 0); DMA_V(0, 0); DMA_K(1, SLOTB);
    { const int nfl = NT * 64; const float* src = BI + 64 * T0;
      for (int i = tid; i < nfl; i += NTHR) { const float v = src[i] - ref; const unsigned b1 = f2bf(v); const float r1 = v - __builtin_bit_cast(float, b1 << 16);
          const unsigned b2 = f2bf(r1); const float r2 = r1 - __builtin_bit_cast(float, b2 << 16); const unsigned b3 = f2bf(r2); BK[i] = (u32x2){b1 | (b2 << 16), b3 | 0x3F800000u}; }
      if (tid == 0) *(LAS u32x4*)(F.lds + LDS_ZB) = (u32x4){0u, 0u, 0u, 0u}; }
    bf16x8 qr[4];
#pragma unroll
    for (int d0 = 0; d0 < 4; ++d0) qr[d0] = *(const bf16x8*)(Qw + (long)r32 * APITCH + d0 * 16 + hi * 8);
    float mhat = BI[q0 + wid * QBLK + r32] - ref, l_reg = 0.f; f32x16 o[2]; o[0] = f32x16{}; o[1] = f32x16{}; const f32x16 zc = {};
    const int qrel = wid * QBLK + r32;
#define CMASK(P0, P1, t) do { int jb_ = (t) - (NT - 4); if (jb_ >= 0) cmask(P0, P1, jb_, qrel, hi); } while (0)
    u32x4 qB;
#define MKQB() do { const float nv_ = -mhat; const unsigned n1_ = f2bf(nv_); const float r1_ = nv_ - __builtin_bit_cast(float, n1_ << 16); const unsigned n2_ = f2bf(r1_); \
      const float r2_ = r1_ - __builtin_bit_cast(float, n2_ << 16); const unsigned n3_ = f2bf(r2_); \
      qB = hi ? (u32x4){0u, 0u, 0u, 0u} : (u32x4){0x3F803F80u, 0x3F80u | (n1_ << 16), n2_ | (n3_ << 16), 0u}; } while (0)
#define BFRAG(tw) __builtin_bit_cast(bf16x8, (u32x4){tw.x, tw.y, cA, 0u})
    MKQB();
    bool resc = false;
#define RESC() do { if (resc) { asm volatile("s_waitcnt lgkmcnt(0)" ::: "memory"); \
      _Pragma("unroll") for (int d_ = 0; d_ < 2; ++d_) _Pragma("unroll") for (int r = 0; r < 16; ++r) o[d_][r] *= wsf[crow(r, hi)]; } } while (0)
    f32x16 pA0, pA1, pB0, pB1;
    int sl_prev = 0, sl_cur = 0, sl_next = SLOTB;
#define ROT() do { sl_prev = sl_cur; sl_cur = sl_next; sl_next = (sl_next == (NSLOT - 1) * SLOTB) ? 0 : sl_next + SLOTB; } while (0)
    DMA_K(2, 2 * SLOTB);
    WAIT_BAR(3);
    { const u32x2 t0_ = *(const LAS u32x2*)(bkp), t1_ = *(const LAS u32x2*)(bkp + 256);
      qkt(pA0, pA1, shm3 + LDS_K, qr, BFRAG(t0_), BFRAG(t1_), __builtin_bit_cast(bf16x8, qB), r32, hi); }
    asm volatile("s_nop 15\n\ts_nop 7" : "+v"(pA0), "+v"(pA1)); CMASK(pA0, pA1, 0);
    { const float rm = rowmax(pA0, pA1);
      if (__any(rm > (float)THRL)) { const float dl = __builtin_fmaxf(rm, 0.f); mhat += dl;
#pragma unroll
          for (int r = 0; r < 16; ++r) { pA0[r] -= dl; pA1[r] -= dl; }
          MKQB(); } }
#pragma unroll
    for (int r = 0; r < 16; ++r) pA0[r] = __builtin_amdgcn_exp2f(pA0[r]);
#pragma unroll
    for (int r = 0; r < 16; ++r) pA1[r] = __builtin_amdgcn_exp2f(pA1[r]);
    WAIT_BAR(0);
    DMA_K(3, 0); DMA_V(1, SLOTB);
    ROT();
    kload8(kf, kp0 + sl_cur);
    WAIT_BAR(2);
    s16x4 vlo[8], vhi[8]; u32x4 pw0, pw1, pw2, pw3;
#define PKW(P, B) cvtpk(P[B], P[B + 1])
#define PAF(k) __builtin_bit_cast(bf16x8, pw##k)
#define VFR(i) (bf16x8){vlo[i][0], vlo[i][1], vlo[i][2], vlo[i][3], vhi[i][0], vhi[i][1], vhi[i][2], vhi[i][3]}
#define PINV(x) asm volatile("" : "+v"(x))
#define MX3(a, b, c) __builtin_fmaxf(__builtin_fmaxf((a), (b)), (c))
#define GAPA(MF, A0, A1, A2, A3, W0, W1, PW) do { MF; sacc += A0; sacc += A1; sacc += A2; sacc += A3; PINV(sacc); W0; W1; PINV(PW); SBAR(); } while (0)
#define EX(v) __builtin_amdgcn_exp2f(v)
#define GAPB(MF, X, B) do { MF; X[B] = EX(X[B]); X[B + 1] = EX(X[B + 1]); X[B + 2] = EX(X[B + 2]); X[B + 3] = EX(X[B + 3]); PINV(X); SBAR(); } while (0)
#define VRD(i) do { vlo[i] = vtr(vp_ + (((i) >> 2) * 4096 + ((i) & 3) * 1024)); vhi[i] = vtr(vp_ + (((i) >> 2) * 4096 + ((i) & 3) * 1024 + 512)); } while (0)
#define KRD(G, j) do { if (G) { kload2(kf, kp0 + sl_next, j); SBAR(); } } while (0)
#define STEP(C0, C1, P0, P1, t, GK, GV, GL) do { SBAR(); \
    const lds_cptr vp_ = vp0 + sl_prev; const lds_cptr bk_ = bkp + (t) * bstride; \
    const u32x2 t0_ = *(const LAS u32x2*)(bk_), t1_ = *(const LAS u32x2*)(bk_ + 256); \
    VRD(0); SBAR(); float sacc = (P0[0] + P0[1]); \
    C0 = __builtin_amdgcn_mfma_f32_32x32x16_bf16(BFRAG(t0_), __builtin_bit_cast(bf16x8, qB), zc, 0, 0, 0); SBAR(); \
    C1 = __builtin_amdgcn_mfma_f32_32x32x16_bf16(BFRAG(t1_), __builtin_bit_cast(bf16x8, qB), zc, 0, 0, 0); SBAR(); \
    GAPA(C0 = __builtin_amdgcn_mfma_f32_32x32x16_bf16(kf[0], qr[0], C0, 0, 0, 0), P0[2], P0[3], P0[4], P0[5],     pw0[0] = PKW(P0, 0), pw0[1] = PKW(P0, 2), pw0); \
    VRD(4); SBAR(); GAPA(C1 = __builtin_amdgcn_mfma_f32_32x32x16_bf16(kf[1], qr[0], C1, 0, 0, 0), P0[6], P0[7], P0[8], P0[9],     pw0[2] = PKW(P0, 4), pw0[3] = PKW(P0, 6), pw0); \
    VRD(1); SBAR(); GAPA(C0 = __builtin_amdgcn_mfma_f32_32x32x16_bf16(kf[2], qr[1], C0, 0, 0, 0),   P0[10], P0[11], P0[12], P0[13], pw1[0] = PKW(P0, 8), pw1[1] = PKW(P0, 10), pw1); \
    VRD(5); SBAR(); GAPA(C1 = __builtin_amdgcn_mfma_f32_32x32x16_bf16(kf[3], qr[1], C1, 0, 0, 0),   P0[14], P0[15], P1[0], P1[1],   pw1[2] = PKW(P0, 12), pw1[3] = PKW(P0, 14), pw1); \
    VRD(2); SBAR(); GAPA(C0 = __builtin_amdgcn_mfma_f32_32x32x16_bf16(kf[4], qr[2], C0, 0, 0, 0),   P1[2], P1[3], P1[4], P1[5],     pw2[0] = PKW(P1, 0), pw2[1] = PKW(P1, 2), pw2); \
    VRD(6); SBAR(); GAPA(C1 = __builtin_amdgcn_mfma_f32_32x32x16_bf16(kf[5], qr[2], C1, 0, 0, 0),   P1[6], P1[7], P1[8], P1[9],     pw2[2] = PKW(P1, 4), pw2[3] = PKW(P1, 6), pw2); \
    VRD(3); SBAR(); GAPA(C0 = __builtin_amdgcn_mfma_f32_32x32x16_bf16(kf[6], qr[3], C0, 0, 0, 0),   P1[10], P1[11], P1[12], P1[13], pw3[0] = PKW(P1, 8), pw3[1] = PKW(P1, 10), pw3); \
    VRD(7); SBAR(); GAPA(C1 = __builtin_amdgcn_mfma_f32_32x32x16_bf16(kf[7], qr[3], C1, 0, 0, 0),   P1[14], P1[15], 0.f, 0.f,       pw3[2] = PKW(P1, 12), pw3[3] = PKW(P1, 14), pw3); \
    l_reg += sacc; \
    if (GK) { DMA_K((t) + 3, sl_cur); } if (GV) { DMA_V((t) + 1, sl_next); } \
    CMASK(C0, C1, t); \
    { float a = MX3(C0[0], C0[1], C1[0]), b = MX3(C0[2], C0[3], C1[1]); a = MX3(a, C1[2], C1[3]); \
      _Pragma("unroll") for (int r = 4; r < 16; r += 4) { a = MX3(a, C0[r], C0[r + 1]); b = MX3(b, C0[r + 2], C0[r + 3]); a = MX3(a, C1[r], C1[r + 1]); b = MX3(b, C1[r + 2], C1[r + 3]); } \
      float rm = __builtin_fmaxf(a, b); { auto rr = __builtin_amdgcn_permlane32_swap(__float_as_uint(rm), __float_as_uint(rm), false, false); rm = __builtin_fmaxf(__uint_as_float(rr[0]), __uint_as_float(rr[1])); } \
      resc = false; \
      if (__builtin_expect(__any(rm > (float)THRL), 0)) { const float dl = __builtin_fmaxf(rm, 0.f); mhat += dl; \
        _Pragma("unroll") for (int r = 0; r < 16; ++r) { C0[r] -= dl; C1[r] -= dl; } \
        const float f = __builtin_amdgcn_exp2f(-dl); l_reg *= f; if (hi == 0) wsf[r32] = f; resc = true; MKQB(); } } \
    SBAR(); \
    GAPB(o[0] = __builtin_amdgcn_mfma_f32_32x32x16_bf16(PAF(0), VFR(0), o[0], 0, 0, 0), C0, 0); \
    GAPB(o[1] = __builtin_amdgcn_mfma_f32_32x32x16_bf16(PAF(0), VFR(4), o[1], 0, 0, 0), C0, 4); \
    KRD(GL, 0); GAPB(o[0] = __builtin_amdgcn_mfma_f32_32x32x16_bf16(PAF(1), VFR(1), o[0], 0, 0, 0), C0, 8); \
    KRD(GL, 1); GAPB(o[1] = __builtin_amdgcn_mfma_f32_32x32x16_bf16(PAF(1), VFR(5), o[1], 0, 0, 0), C0, 12); \
    KRD(GL, 2); GAPB(o[0] = __builtin_amdgcn_mfma_f32_32x32x16_bf16(PAF(2), VFR(2), o[0], 0, 0, 0), C1, 0); \
    KRD(GL, 3); GAPB(o[1] = __builtin_amdgcn_mfma_f32_32x32x16_bf16(PAF(2), VFR(6), o[1], 0, 0, 0), C1, 4); \
    GAPB(o[0] = __builtin_amdgcn_mfma_f32_32x32x16_bf16(PAF(3), VFR(3), o[0], 0, 0, 0), C1, 8); \
    GAPB(o[1] = __builtin_amdgcn_mfma_f32_32x32x16_bf16(PAF(3), VFR(7), o[1], 0, 0, 0), C1, 12); \
    } while (0)
    int t = 1;
#undef CMASK
#define CMASK(P0, P1, t) do { } while (0)
    for (; t + 5 < NT; t += 2) {
        STEP(pB0, pB1, pA0, pA1, t, true, true, true);     WAIT_BAR(2); RESC(); ROT();
        STEP(pA0, pA1, pB0, pB1, t + 1, true, true, true); WAIT_BAR(2); RESC(); ROT();
    }
#undef CMASK
#define CMASK(P0, P1, t) do { int jb_ = (t) - (NT - 4); if (jb_ >= 0) cmask(P0, P1, jb_, qrel, hi); } while (0)
#define ENDW(tt) do { if ((tt) + 3 < NT) { WAIT_BAR(2); } else if ((tt) + 2 < NT) { WAIT_BAR(1); } else { WAIT_BAR(0); } } while (0)
    for (; t + 1 < NT; t += 2) {
        STEP(pB0, pB1, pA0, pA1, t, (t + 3 < NT), (t + 1 < NT), (t + 1 < NT));         ENDW(t);     RESC(); ROT();
        STEP(pA0, pA1, pB0, pB1, t + 1, (t + 4 < NT), (t + 2 < NT), (t + 2 < NT));     ENDW(t + 1); RESC(); ROT();
    }
    STEP(pB0, pB1, pA0, pA1, NT - 1, false, false, false); RESC();
    { float sacc = pB0[0] + pB0[1];
#pragma unroll
      for (int r = 2; r < 16; ++r) sacc += pB0[r];
#pragma unroll
      for (int r = 0; r < 16; ++r) sacc += pB1[r];
      l_reg += sacc;
      pw0 = (u32x4){PKW(pB0, 0), PKW(pB0, 2), PKW(pB0, 4), PKW(pB0, 6)}; pw1 = (u32x4){PKW(pB0, 8), PKW(pB0, 10), PKW(pB0, 12), PKW(pB0, 14)}; pw2 = (u32x4){PKW(pB1, 0), PKW(pB1, 2), PKW(pB1, 4), PKW(pB1, 6)}; pw3 = (u32x4){PKW(pB1, 8), PKW(pB1, 10), PKW(pB1, 12), PKW(pB1, 14)};
      SBAR(); pv(o, vb0 + sl_cur, PAF(0), PAF(1), PAF(2), PAF(3)); }
#undef PKW
#undef PAF
#undef VFR
#undef PINV
#undef MX3
#undef GAPA
#undef GAPB
#undef EX
#undef VRD
#undef KRD
#undef STEP
#undef ENDW
    { auto rr = __builtin_amdgcn_permlane32_swap(__float_as_uint(l_reg), __float_as_uint(l_reg), false, false); l_reg = __uint_as_float(rr[0]) + __uint_as_float(rr[1]); }
    if (hi == 0) wsf[32 + r32] = l_reg; asm volatile("s_waitcnt lgkmcnt(0)" ::: "memory");
    float rli[16];
#pragma unroll
    for (int r = 0; r < 16; ++r) rli[r] = __builtin_amdgcn_rcpf(wsf[32 + crow(r, hi)]);
    bf16_t* Ow = (bf16_t*)(ws_ + WS_MIXED) + (rowbase + q0 + wid * QBLK) * OPITCH + 512 + h * 64;
    { LAS bf16_t* stg = (LAS bf16_t*)(F.lds + LDS_OST) + wid * 2048;
#pragma unroll
      for (int r = 0; r < 16; ++r) { const int orow = crow(r, hi);
#pragma unroll
          for (int d0 = 0; d0 < 2; ++d0) stg[orow * 64 + d0 * 32 + r32] = (bf16_t)f2bf(o[d0][r] * rli[r]); }
      asm volatile("s_waitcnt lgkmcnt(0)" ::: "memory");
#pragma unroll
      for (int i = 0; i < 4; ++i) { const int row = i * 8 + (lane >> 3), ch = lane & 7; const u32x4 v = *(const LAS u32x4*)(stg + row * 64 + ch * 8); *(u32x4*)(Ow + (long)row * OPITCH + ch * 8) = v; } }
    asm volatile("s_waitcnt lgkmcnt(0)\n\ts_barrier" ::: "memory");
#undef DMA_K
#undef DMA_V
#undef CMASK
#undef MKQB
#undef BFRAG
#undef RESC
#undef ROT
}
#undef SBAR
#undef WAIT_BAR
}

constexpr int AT_ROWB = 144;
constexpr int AT_KOFF = 0, AT_VOFF = 2 * 64 * AT_ROWB, AT_BOFF = 4 * 64 * AT_ROWB, AT_QUEUE = AT_BOFF + 2 * 256;
__device__ __forceinline__ void attn_unit(Frame& F, int b, int h, int qb) {
    refresh(F); unsigned char* ws_ = (unsigned char*)ldptr(F, 30); const InTab in_{F.lds}; gu32* ctl_ = (gu32*)ws_;

    const int lane = F.lane, r32 = lane & 31, hi = lane >> 5, wid = F.wave, tid = F.tid;
    const bf16_t* Q = (const bf16_t*)(ws_ + WS_Q); const bf16_t* Kg = (const bf16_t*)(ws_ + WS_K); const bf16_t* Vg = (const bf16_t*)(ws_ + WS_V);
    const float* BI = (const float*)(ws_ + WS_BIAS) + ((size_t)b * 8 + h) * SEQ;
    const size_t rowbase = (size_t)b * SEQ; const int q0 = qb * 256, qw0 = q0 + wid * 32;
    LAS unsigned char* lds = F.lds;
    bf16x8 qr[4];
#pragma unroll
    for (int d0 = 0; d0 < 4; ++d0) qr[d0] = *(const bf16x8*)(Q + (rowbase + qw0 + r32) * 512 + h * 64 + d0 * 16 + hi * 8);
    const int NT = (q0 + 256) / 64;
    int T0 = 0;
    { const float nbq = BI[q0]; const float vlast = (lane < NT) ? BI[64 * lane + 63] : 3.0e38f;
      const unsigned long long ok = __ballot(vlast - nbq >= -150.f);
      T0 = ok ? (int)(__ffsll((long long)ok) - 1) : 0; T0 = __builtin_amdgcn_readfirstlane(T0); }
    const int srow = tid >> 3, sch = tid & 7;
    const bf16_t* kp = Kg + (rowbase + srow) * 512 + h * 64 + sch * 8; const bf16_t* vp = Vg + (rowbase + srow) * 512 + h * 64 + sch * 8;
    u32x4 kreg = *(const u32x4*)(kp + (size_t)T0 * 64 * 512), vreg = *(const u32x4*)(vp + (size_t)T0 * 64 * 512); float breg = (tid < 64) ? BI[T0 * 64 + tid] : 0.f;
    { const int b0_ = T0 & 1;
      *(LAS u32x4*)(lds + AT_KOFF + b0_ * 64 * AT_ROWB + srow * AT_ROWB + sch * 16) = kreg; *(LAS u32x4*)(lds + AT_VOFF + b0_ * 64 * AT_ROWB + srow * AT_ROWB + sch * 16) = vreg;
      if (tid < 64) *(LAS float*)(lds + AT_BOFF + b0_ * 256 + tid * 4) = breg; }
    __syncthreads();
    f32x16 o0 = {}, o1 = {};
    float nbi = BI[qw0 + r32];
    float lrun = 0.f;
    const int i16 = lane & 15, tq = i16 >> 2, tp = i16 & 3, blk = (lane >> 4) & 1;
    for (int t = T0; t < NT; ++t) {
        const int cb = t & 1, nb = cb ^ 1;
        if (t + 1 < NT) { kreg = *(const u32x4*)(kp + (size_t)(t + 1) * 64 * 512); vreg = *(const u32x4*)(vp + (size_t)(t + 1) * 64 * 512); if (tid < 64) breg = BI[(t + 1) * 64 + tid]; }
        if (64 * t <= qw0 + 31) {
            const LAS unsigned char* Ks = lds + AT_KOFF + cb * 64 * AT_ROWB; const LAS unsigned char* Vs = lds + AT_VOFF + cb * 64 * AT_ROWB; const LAS float* Bs = (const LAS float*)(lds + AT_BOFF + cb * 256);
            f32x16 p0, p1;
#pragma unroll
            for (int g = 0; g < 4; ++g) {
                const f32x4 b0 = *(const LAS f32x4*)(Bs + 8 * g + 4 * hi), b1 = *(const LAS f32x4*)(Bs + 32 + 8 * g + 4 * hi);
#pragma unroll
                for (int i = 0; i < 4; ++i) { p0[4 * g + i] = b0[i] - nbi; p1[4 * g + i] = b1[i] - nbi; }
            }
#pragma unroll
            for (int d0 = 0; d0 < 4; ++d0) {
                const bf16x8 a0 = *(const LAS bf16x8*)(Ks + r32 * AT_ROWB + (d0 * 16 + hi * 8) * 2);
                const bf16x8 a1 = *(const LAS bf16x8*)(Ks + (32 + r32) * AT_ROWB + (d0 * 16 + hi * 8) * 2);
                p0 = __builtin_amdgcn_mfma_f32_32x32x16_bf16(a0, qr[d0], p0, 0, 0, 0);
                p1 = __builtin_amdgcn_mfma_f32_32x32x16_bf16(a1, qr[d0], p1, 0, 0, 0);
            }
            if (64 * t + 63 > qw0) {
                const int qabs = qw0 + r32;
#pragma unroll
                for (int i = 0; i < 16; ++i) { const int kv = 64 * t + crow(i, hi); if (kv > qabs) p0[i] = -INFINITY; if (kv + 32 > qabs) p1[i] = -INFINITY; }
            }
            float mx = fmaxf(fmaxf(p0[0], p0[1]), p1[0]);
#pragma unroll
            for (int i = 1; i < 16; ++i) mx = fmaxf(fmaxf(mx, p0[i]), p1[i]);
            if (__any(mx > 24.f)) {
                const float mo = fmaxf(mx, __shfl_xor(mx, 32));
                const float dl = fmaxf(mo, 0.f);
                nbi += dl;
                const float f = __builtin_amdgcn_exp2f(-dl);
                lrun *= f;
#pragma unroll
                for (int i = 0; i < 16; ++i) { p0[i] -= dl; p1[i] -= dl; o0[i] *= f; o1[i] *= f; }
            }
            float ls0 = 0.f, ls1 = 0.f;
#pragma unroll
            for (int i = 0; i < 16; ++i) { p0[i] = __builtin_amdgcn_exp2f(p0[i]); p1[i] = __builtin_amdgcn_exp2f(p1[i]); ls0 += p0[i]; ls1 += p1[i]; }
            lrun += ls0 + ls1;
            bf16x8 pf[4];
#pragma unroll
            for (int s = 0; s < 2; ++s) {
                u32x4 w0, w1;
                w0.x = cvtpk(p0[8 * s + 0], p0[8 * s + 1]); w0.y = cvtpk(p0[8 * s + 2], p0[8 * s + 3]); w0.z = cvtpk(p0[8 * s + 4], p0[8 * s + 5]); w0.w = cvtpk(p0[8 * s + 6], p0[8 * s + 7]);
                w1.x = cvtpk(p1[8 * s + 0], p1[8 * s + 1]); w1.y = cvtpk(p1[8 * s + 2], p1[8 * s + 3]); w1.z = cvtpk(p1[8 * s + 4], p1[8 * s + 5]); w1.w = cvtpk(p1[8 * s + 6], p1[8 * s + 7]);
                pf[s] = __builtin_bit_cast(bf16x8, w0); pf[2 + s] = __builtin_bit_cast(bf16x8, w1);
            }
#pragma unroll
            for (int ks4 = 0; ks4 < 4; ++ks4) {
                const int kvb = (ks4 >> 1) * 32 + (ks4 & 1) * 16 + 4 * hi;
#pragma unroll
                for (int d0 = 0; d0 < 2; ++d0) {
                    const LAS unsigned char* a_lo = Vs + (kvb + tq) * AT_ROWB + (32 * d0 + 16 * blk) * 2 + 8 * tp;
                    const s16x4 lo = __builtin_bit_cast(s16x4, __builtin_amdgcn_ds_read_tr16_b64_v4i16((LAS s16x4*)a_lo));
                    const s16x4 hv = __builtin_bit_cast(s16x4, __builtin_amdgcn_ds_read_tr16_b64_v4i16((LAS s16x4*)(a_lo + 8 * AT_ROWB)));
                    const bf16x8 va = __builtin_shufflevector(lo, hv, 0, 1, 2, 3, 4, 5, 6, 7);
                    if (d0 == 0) o0 = __builtin_amdgcn_mfma_f32_32x32x16_bf16(va, pf[ks4], o0, 0, 0, 0);
                    else o1 = __builtin_amdgcn_mfma_f32_32x32x16_bf16(va, pf[ks4], o1, 0, 0, 0);
                }
            }
        }
        if (t + 1 < NT) {
            *(LAS u32x4*)(lds + AT_KOFF + nb * 64 * AT_ROWB + srow * AT_ROWB + sch * 16) = kreg; *(LAS u32x4*)(lds + AT_VOFF + nb * 64 * AT_ROWB + srow * AT_ROWB + sch * 16) = vreg;
            if (tid < 64) *(LAS float*)(lds + AT_BOFF + nb * 256 + tid * 4) = breg;
        }
        __syncthreads();
    }
    lrun += __shfl_xor(lrun, 32);
    const float inv = 1.f / lrun;
    bf16_t* O = (bf16_t*)(ws_ + WS_MIXED) + (rowbase + qw0 + r32) * 1024 + 512 + h * 64;
#pragma unroll
    for (int g = 0; g < 4; ++g) {
        u32x2 w; w.x = cvtpk(o0[4 * g] * inv, o0[4 * g + 1] * inv); w.y = cvtpk(o0[4 * g + 2] * inv, o0[4 * g + 3] * inv);
        *(u32x2*)(O + 8 * g + 4 * hi) = w;
        u32x2 w2; w2.x = cvtpk(o1[4 * g] * inv, o1[4 * g + 1] * inv); w2.y = cvtpk(o1[4 * g + 2] * inv, o1[4 * g + 3] * inv);
        *(u32x2*)(O + 32 + 8 * g + 4 * hi) = w2;
    }
}
__device__ __forceinline__ void pool_batch(Frame& F, const InTab& in_, unsigned char* ws_, int l, int q) {
    LAS float* Wp = (LAS float*)F.lds;
    LAS float* ps = (LAS float*)(F.lds + 65536) + F.wave * 512;
    { const float* w = in_[I_POOLW] + (size_t)l * 4 * 64 * 64; f32x4 t8[8];
#pragma unroll
      for (int u = 0; u < 8; ++u) t8[u] = *(const f32x4*)(w + 4 * (F.tid + NTHR * u));
#pragma unroll
      for (int u = 0; u < 8; ++u) *(LAS f32x4*)(Wp + 4 * (F.tid + NTHR * u)) = t8[u]; }
    __syncthreads();
    const int c = F.lane;
    bf16_t* MX = (bf16_t*)(ws_ + WS_MIXED);
    const float* ZP = (const float*)(ws_ + WS_ZP);
    for (int jj = 0; jj < 8; ++jj) {
        const int it = q * 64 + jj * 8 + F.wave;
        const int g = it & 3, m0 = (it >> 2) * 8, win = 2 << g;
        {
            const int seq0 = m0 & ~(SEQ - 1);
            float zz[23];
#pragma unroll
            for (int qq = 0; qq < 23; ++qq) { const int rr = m0 - 15 + qq; zz[qq] = (rr >= seq0 && (qq >= 15 || 15 - qq < win + 7)) ? ZP[(size_t)rr * 256 + 64 * g + c] : 0.f; }
#pragma unroll
            for (int i = 0; i < 8; ++i) {
                const int t = (m0 + i) & (SEQ - 1); const int n = (t + 1 < win) ? t + 1 : win;
                float s = 0.f;
#pragma unroll
                for (int j = 0; j < 16; ++j) s += (j < win) ? zz[15 + i - j] : 0.f;
                ps[i * 64 + c] = s / (float)n - zz[15 + i];
            }
        }
        LDS_WAIT(); asm volatile("" ::: "memory");
        float acc[8];
#pragma unroll
        for (int i = 0; i < 8; ++i) acc[i] = 0.f;
        const LAS float* W = Wp + g * 4096;
        for (int j = 0; j < 64; j += 4) {
            const float w_0 = W[(j + 0) * 64 + c], w_1 = W[(j + 1) * 64 + c], w_2 = W[(j + 2) * 64 + c], w_3 = W[(j + 3) * 64 + c];
#pragma unroll
            for (int i = 0; i < 8; ++i) { const f32x4 x = *(const LAS f32x4*)(ps + i * 64 + j); acc[i] += x.x * w_0 + x.y * w_1 + x.z * w_2 + x.w * w_3; }
        }
        const float sc = in_[I_POOLS][l * 256 + 64 * g + c];
#pragma unroll
        for (int i = 0; i < 8; ++i) MX[(size_t)(m0 + i) * 1024 + 256 + 64 * g + c] = (bf16_t)f2bf(acc[i] * sc);
        LDS_WAIT(); asm volatile("" ::: "memory");
    }
    __syncthreads();
}
__device__ __forceinline__ void tail_convert(Frame& F, int lc, int nmax) {
    refresh(F); unsigned char* ws_ = (unsigned char*)ldptr(F, 30); const InTab in_{F.lds}; gu32* ctl_ = (gu32*)ws_;
    LAS int* qslot = (LAS int*)(F.lds + MISC_OFF + 64);
    for (int n = 0; n < nmax; ++n) {
        if (F.tid == 0) qslot[0] = (int)__hip_atomic_fetch_add(ctl_ + CW_CQ + lc * 64, 1u, RLX_AGENT);
        __syncthreads();
        const int q = qslot[0];
        __syncthreads();
        if (q >= 768) break;
        convert_moe_batch(F, in_, ws_, lc, q);
    }
    __syncthreads();
}
__device__ __forceinline__ void conv_worker(Frame& F, int lc, int gdw, int maxb) {
    refresh(F); unsigned char* ws_ = (unsigned char*)ldptr(F, 30); const InTab in_{F.lds}; gu32* ctl_ = (gu32*)ws_;
    LAS int* qslot = (LAS int*)(F.lds + MISC_OFF + 64);
    int last = 0;
    for (int n = 0; n < maxb && !last; ++n) {
        if (F.tid == 0) { qslot[1] = (int)__hip_atomic_load(ctl_ + gdw, RLX_AGENT); qslot[0] = (int)__hip_atomic_fetch_add(ctl_ + CW_CQ + lc * 64, 1u, RLX_AGENT); }
        __syncthreads();
        const int q = qslot[0]; last = qslot[1];
        __syncthreads();
        if (q >= 768) break;
        convert_moe_batch(F, in_, ws_, lc, q);
    }
    __syncthreads();
}
#if ATTN_TUNED
#define ATTN_CALL(F_, b_, h_, q_) fa::attn_unit<16>(F_, b_, h_, q_)
#else
#define ATTN_CALL(F_, b_, h_, q_) attn_unit(F_, b_, h_, q_)
#endif
__device__ __forceinline__ void phase_mix(Frame& F, int l, int qsel = 0) {
    refresh(F); unsigned char* ws_ = (unsigned char*)ldptr(F, 30); const InTab in_{F.lds}; gu32* ctl_ = (gu32*)ws_;

#if CHUNKED_SCAN
    if (blockIdx.x < 16) { chunk_states(F, ws_, blockIdx.x); if (PROBE_DUP == 16) { __syncthreads(); chunk_states(F, ws_, blockIdx.x); } __syncthreads(); }
#else
    if (blockIdx.x < 64) { scan_block(F, blockIdx.x); if (PROBE_DUP == 12) { __syncthreads(); scan_block(F, blockIdx.x); } return; }
#endif
    LAS int* qslot = (LAS int*)(F.lds + MISC_OFF + 64);
    for (;;) {
        if (F.tid == 0) qslot[0] = (int)__hip_atomic_fetch_add(ctl_ + CW_QUEUE + (l + 4 * qsel) * 64, 1u, RLX_AGENT);
        __syncthreads();
        const int u = qslot[0];
        __syncthreads();
        if (PROBE_DUP == 17) { if (u >= 1024 + 128 + 768) break; if (u < 1024) { const int uu = u >> 1; const int qb = 15 - (uu >> 5), bh = uu & 31; ATTN_CALL(F, bh >> 3, bh & 7, qb); } else if (u < 1152) pool_batch(F, in_, ws_, l, u - 1024); else convert_moe_batch(F, in_, ws_, l, u - 1152); continue; }
        if (PROBE_DUP == 18) { if (u >= 512 + 128 + 1536) break; if (u < 512) { const int qb = 15 - (u >> 5), bh = u & 31; ATTN_CALL(F, bh >> 3, bh & 7, qb); } else if (u < 640) pool_batch(F, in_, ws_, l, u - 512); else convert_moe_batch(F, in_, ws_, l, (u - 640) >> 1); continue; }
        if (u >= 512 + 128) break;
        if (u < 512) { const int qb = 15 - (u >> 5), bh = u & 31; ATTN_CALL(F, bh >> 3, bh & 7, qb); }
        else pool_batch(F, in_, ws_, l, u - 512);
    }
    tail_convert(F, l, 1 << 20);
}

__device__ __forceinline__ void phase_post(Frame& F, int l) {
    refresh(F); unsigned char* ws_ = (unsigned char*)ldptr(F, 30); const InTab in_{F.lds}; gu32* ctl_ = (gu32*)ws_;

    const int gw = F.vcu * NWAVES + F.wave, NGW = F.G * NWAVES, c = F.lane;
    bf16_t* MX = (bf16_t*)(ws_ + WS_MIXED);
    {
        float lw[4], lb[4], rkw[4];
#pragma unroll
        for (int h = 0; h < 4; ++h) { lw[h] = in_[I_LNW][l * 256 + 64 * h + c]; lb[h] = in_[I_LNB][l * 256 + 64 * h + c]; rkw[h] = in_[I_RK][l * 256 + 64 * h + c]; }
        const float* YR = (const float*)(ws_ + WS_YRAW); const float* SCN = (const float*)(ws_ + WS_SCAN); const float* GG = (const float*)(ws_ + WS_G);
        for (int it0 = gw * 8; it0 < NTOK * 4; it0 += NGW * 8) {
            float y[8], vv[8], bn[8], gg[8];
#pragma unroll
            for (int u = 0; u < 8; ++u) {
                const int it = it0 + u, m = it >> 2, h = u & 3, b = m >> 12, t = m & (SEQ - 1);
                const float* sp = SCN + ((size_t)(b * 4 + h) * SEQ + t) * 384 + c;
                y[u] = YR[(size_t)m * 256 + 64 * h + c]; vv[u] = sp[192]; bn[u] = sp[0] * sp[128] * rkw[h]; gg[u] = GG[(size_t)m * 256 + 64 * h + c];
            }
#pragma unroll
            for (int u = 0; u < 8; ++u) {
                const int it = it0 + u, m = it >> 2, h = u & 3;
                const float mean = wave_sum(y[u]) * (1.f / 64.f); const float d = y[u] - mean; const float var = wave_sum(d * d) * (1.f / 64.f);
                float yn = d * (1.f / sqrtf(var + 64e-5f)) * lw[h] + lb[h];
                yn += wave_sum(bn[u]) * vv[u];
                yn *= gg[u];
                MX[(size_t)m * 1024 + 64 * h + c] = (bf16_t)f2bf(yn);
            }
        }
    }
}

__device__ __forceinline__ void phase_route(Frame& F, int l, int csel = 0) {
    refresh(F); unsigned char* ws_ = (unsigned char*)ldptr(F, 30); const InTab in_{F.lds}; gu32* ctl_ = (gu32*)ws_;

    LAS float* WT = (LAS float*)F.lds;
    LAS int* lcnt = (LAS int*)(F.lds + TAB_OFF);
    LAS int* lbase = lcnt + 32;
    LAS int* le = lbase + 32;
    LAS int* lpos = le + 256;
    { const float* rw = in_[I_RW] + (size_t)l * 1024 * 32;
      f32x4 t16[16];
#pragma unroll
      for (int u = 0; u < 16; ++u) t16[u] = *(const f32x4*)(rw + 4 * (F.tid + NTHR * u));
#pragma unroll
      for (int u = 0; u < 16; ++u) { const int i = F.tid + NTHR * u, k = i >> 3, e = (i & 7) * 4; WT[(e + 0) * 1024 + k] = t16[u].x; WT[(e + 1) * 1024 + k] = t16[u].y; WT[(e + 2) * 1024 + k] = t16[u].z; WT[(e + 3) * 1024 + k] = t16[u].w; } }
    const bf16_t* X = (const bf16_t*)(ws_ + WS_X); const float* MOD = (const float*)(ws_ + WS_MOD);
    const float* nw = in_[I_NORM2] + l * 1024;
    const float rb = in_[I_RB][l * 32 + (F.lane >> 1)];
    for (int tb = blockIdx.x; tb < NTOK / 64; tb += F.G) {
        if (F.tid < 32) lcnt[F.tid] = 0;
        __syncthreads();
        u32x2 xnx[2][4];
#pragma unroll
        for (int u = 0; u < 2; ++u)
#pragma unroll
            for (int j = 0; j < 4; ++j) xnx[u][j] = *(const u32x2*)(X + (size_t)(tb * 64 + F.wave * 8 + u) * 1024 + 4 * F.lane + 256 * j);
#pragma nounroll
        for (int ip = 0; ip < 4; ++ip) {
            const int ti0 = F.wave * 8 + 2 * ip, m0 = tb * 64 + ti0, b = m0 >> 12;
            const float* sh = MOD + (size_t)(l * 4 + b) * 6144 + 3 * 1024; const float* sc = sh + 1024;
            f32x4 hv[2][4];
#pragma unroll
            for (int u = 0; u < 2; ++u) {
                float ss = 0.f;
#pragma unroll
                for (int j = 0; j < 4; ++j) { hv[u][j] = up4(xnx[u][j]); ss += (hv[u][j].x * hv[u][j].x + hv[u][j].y * hv[u][j].y) + (hv[u][j].z * hv[u][j].z + hv[u][j].w * hv[u][j].w); }
                const float rs = 1.f / sqrtf(wave_sum(ss) * (1.f / 1024.f) + 1e-6f);
                bf16_t* H = (bf16_t*)(ws_ + WS_H) + (size_t)(m0 + u) * 1024;
#pragma unroll
                for (int j = 0; j < 4; ++j) { const int c0 = 4 * F.lane + 256 * j; const f32x4 w = *(const f32x4*)(nw + c0), s1 = *(const f32x4*)(sc + c0), s0 = *(const f32x4*)(sh + c0);
                    hv[u][j] = hv[u][j] * rs * w * (s1 + 1.f) + s0; u32x2 o; o.x = cvtpk(hv[u][j].x, hv[u][j].y); o.y = cvtpk(hv[u][j].z, hv[u][j].w); *(u32x2*)(H + c0) = o; }
            }
            if (ip < 3) {
#pragma unroll
                for (int u = 0; u < 2; ++u)
#pragma unroll
                    for (int j = 0; j < 4; ++j) xnx[u][j] = *(const u32x2*)(X + (size_t)(m0 + 2 + u) * 1024 + 4 * F.lane + 256 * j);
            }
            float val[2] = {0.f, 0.f};
#pragma unroll
            for (int half = 0; half < 2; ++half) {
                float a[2][16];
#pragma unroll
                for (int e = 0; e < 16; ++e) {
                    float s0 = 0.f, s1 = 0.f;
#pragma unroll
                    for (int j = 0; j < 4; ++j) { const f32x4 w = *(const LAS f32x4*)(WT + (16 * half + e) * 1024 + 4 * F.lane + 256 * j);
                        s0 += hv[0][j].x * w.x + hv[0][j].y * w.y + hv[0][j].z * w.z + hv[0][j].w * w.w; s1 += hv[1][j].x * w.x + hv[1][j].y * w.y + hv[1][j].z * w.z + hv[1][j].w * w.w; }
                    a[0][e] = s0; a[1][e] = s1;
                }
#pragma unroll
                for (int u = 0; u < 2; ++u) {
#pragma unroll
                    for (int q = 0; q < 8; ++q) { const auto rr = __builtin_amdgcn_permlane16_swap(__float_as_uint(a[u][q]), __float_as_uint(a[u][q + 8]), false, false); a[u][q] = __uint_as_float(rr[0]) + __uint_as_float(rr[1]); }
#define RSTEP(N, BIT, SEL) { const bool up_ = (F.lane & (BIT)) != 0; _Pragma("unroll") for (int q = 0; q < (N); ++q) { const float send = up_ ? a[u][q] : a[u][q + (N)]; const float keep = up_ ? a[u][q + (N)] : a[u][q]; a[u][q] = keep + dpp_f(send, SEL); } }
                    RSTEP(4, 8, 3) RSTEP(2, 4, 2) RSTEP(1, 2, 1)
#undef RSTEP
                    float v = a[u][0] + dpp_f(a[u][0], 0);
                    { const auto rr = __builtin_amdgcn_permlane32_swap(__float_as_uint(v), __float_as_uint(v), false, false); v = __uint_as_float(rr[0]) + __uint_as_float(rr[1]); }
                    if ((F.lane >> 5) == half) val[u] = v;
                }
            }
#pragma unroll
            for (int u = 0; u < 2; ++u) {
                float vv = val[u] + rb;
                const int ti = ti0 + u, m = m0 + u;
                float tv[4]; int te[4];
#pragma unroll
                for (int k = 0; k < 4; ++k) {
                    const float mx = wave_max(vv);
                    const unsigned long long bal = __ballot(vv == mx);
                    const int ln = __ffsll((long long)bal) - 1; const int e = ln >> 1;
                    tv[k] = mx; te[k] = e;
                    if ((F.lane >> 1) == e) vv = -INFINITY;
                }
                const float e1 = __expf(tv[1] - tv[0]), e2 = __expf(tv[2] - tv[0]), e3 = __expf(tv[3] - tv[0]); const float invs = 1.f / (1.f + e1 + e2 + e3);
                if (F.lane < 4) {
                    const int k = F.lane; const int e = (k == 0) ? te[0] : (k == 1) ? te[1] : (k == 2) ? te[2] : te[3];
                    const float gt = ((k == 0) ? 1.f : (k == 1) ? e1 : (k == 2) ? e2 : e3) * invs;
                    ((float*)(ws_ + WS_GATE))[(size_t)m * 4 + k] = gt;
                    le[ti * 4 + k] = e; lpos[ti * 4 + k] = atomicAdd((int*)&lcnt[e], 1);
                }
            }
        }
        __syncthreads();
        if (F.tid < 32) lbase[F.tid] = (int)__hip_atomic_fetch_add(ctl_ + CW_CNT + ((l + 4 * csel) * 32 + F.tid) * 64, (unsigned)lcnt[F.tid], RLX_AGENT);
        __syncthreads();
        if (F.tid < 256) { const int e = le[F.tid]; ((int*)(ws_ + WS_LIST))[e * NTOK + lbase[e] + lpos[F.tid]] = (tb * 64 + (F.tid >> 2)) * 4 + (F.tid & 3); }
        __syncthreads();
    }
}

constexpr int NPHASE = 2 + 9 * NL;
__global__ void __launch_bounds__(NTHR, 2) trunk_fwd(Args args) {
    extern __shared__ __attribute__((aligned(16))) unsigned char lds_raw[];
    Frame F;
    F.lds = (LAS unsigned char*)lds_raw;
    F.MISC = (volatile LAS unsigned*)(F.lds + MISC_OFF);
    F.tid = threadIdx.x; F.lane = F.tid & 63; F.wave = __builtin_amdgcn_readfirstlane(F.tid >> 6);
    F.G = gridDim.x; { const int bx = blockIdx.x; F.vcu = (F.G % 8 == 0) ? (bx % 8) * (F.G / 8) + bx / 8 : bx; }
    for (int u = F.tid; u < 64; u += NTHR) ((LAS unsigned*)(F.lds + MISC_OFF))[u] = 0u;
    if (F.tid < 29) *(LAS unsigned long long*)(F.lds + PTR_OFF + 8 * F.tid) = (unsigned long long)args.in[F.tid];
    if (F.tid == 29) *(LAS unsigned long long*)(F.lds + PTR_OFF + 8 * 29) = (unsigned long long)args.out;
    if (F.tid == 30) *(LAS unsigned long long*)(F.lds + PTR_OFF + 8 * 30) = (unsigned long long)args.ws;
    __syncthreads();
#if MK_PER_PHASE
#define GRID_BAR() do { } while (0)
#else
    XcdBarrier bar = xcd_barrier_post((unsigned*)(args.ws) + CW_BAR, F.MISC + 8);
#define GRID_BAR() xcd_barrier(bar)
#endif
    const int lo = args.ph_lo, hi = args.ph_hi;
    volatile LAS unsigned long long* tsw = (volatile LAS unsigned long long*)(F.lds + MISC_OFF + 192);
#define STAMP(id) do { if (PROBE_T >= 0 && blockIdx.x == 0 && F.tid == 0) { const unsigned long long now_ = wall_clock64(); if ((id) == PROBE_T) tsw[1] += now_ - tsw[0]; tsw[0] = now_; } } while (0)
    if (PROBE_T >= 0 && blockIdx.x == 0 && F.tid == 0) { const unsigned long long now_ = wall_clock64(); tsw[0] = now_; tsw[1] = 0ull; tsw[2] = now_; }
#define IN(k) (lo <= (k) && (k) < hi)
#define SEAM(k) do { if (IN(k) && IN((k) + 1)) GRID_BAR(); } while (0)
    if (IN(0)) { phase_prologue(F); if (PROBE_DUP == 1) { GRID_BAR(); phase_prologue(F); } SEAM(0); }
    if (IN(1)) { phase_combine(F, -1); if (PROBE_DUP == 2) { GRID_BAR(); phase_combine(F, -1); } SEAM(1); }
    for (int l = 0; l < NL; ++l) {
        const int p0 = 2 + 9 * l;
        if (IN(p0)) {
            refresh(F); unsigned char* ws_ = (unsigned char*)ldptr(F, 30); const InTab in_{F.lds};
            ProbDense P{(const char*)(ws_ + WS_H), (const char*)(ws_ + WS_WIN) + (size_t)l * NPROJ * 2048, NTOK / 256, NPROJ / 256, F.G, F.vcu};
            EpiProj E{ws_};
            pg8::gemm_phase<false, 1024>(F.lds, nullptr, F.tid, P, E);
            if (PROBE_DUP == 3) { GRID_BAR(); pg8::gemm_phase<false, 1024>(F.lds, nullptr, F.tid, P, E); }
            if (TAIL_CONVERT) { const int nun = (NTOK / 256) * (NPROJ / 256), mine = (nun - F.vcu + F.G - 1) / F.G, most = (nun + F.G - 1) / F.G; if (mine < most) tail_convert(F, l, most - mine); }
            SEAM(p0); STAMP(0);
        }
        if (IN(p0 + 1)) {
            phase_prep(F, l); if (PROBE_DUP == 4) { GRID_BAR(); phase_prep(F, l); }
            GRID_BAR(); STAMP(1);
            refresh(F); unsigned char* ws_ = (unsigned char*)ldptr(F, 30); const InTab in_{F.lds};
            ProbLora P{(const char*)(ws_ + WS_ALORA), (const char*)(ws_ + WS_LORA) + (size_t)l * 768 * 512, F.G, F.vcu};
            EpiLora E{ws_, in_[I_W0] + l * 256, in_[I_A0] + l * 256, in_[I_KA] + l * 256};
            pg8::gemm_phase<false, 256>(F.lds, nullptr, F.tid, P, E);
            if (TAIL_CONVERT && F.vcu >= 192) tail_convert(F, l, 1);
            SEAM(p0 + 1); STAMP(2);
        }
        if (IN(p0 + 2)) {
#if CHUNKED_SCAN
            { refresh(F); unsigned char* ws_ = (unsigned char*)ldptr(F, 30);
              ChunkRows cur = chunk_load(F, ws_, F.vcu);
              for (int job = F.vcu; job < 1024; job += F.G) {
                  ChunkRows nxt = cur; if (job + F.G < 1024) nxt = chunk_load(F, ws_, job + F.G);
                  chunk_job(F, ws_, job, cur); cur = nxt; } }
            GRID_BAR(); STAMP(3);
#endif
            phase_mix(F, l); if (PROBE_DUP == 5) { GRID_BAR(); phase_mix(F, l, 1); } SEAM(p0 + 2); STAMP(4); }
        if (IN(p0 + 3)) {
#if CHUNKED_SCAN
            { refresh(F); unsigned char* ws_ = (unsigned char*)ldptr(F, 30); const InTab in_{F.lds};
              const int w4 = F.wave & 3, jobA = F.vcu * 2 + (F.wave >> 2), jobB = (F.vcu + F.G) * 2 + (F.wave >> 2);
              if (F.G * 4 == 1024) {
                  OutOps oa = out_load(F, ws_, jobA, w4); PostOps pa = post_load(F, ws_, jobA, w4); OutOps ob = out_load(F, ws_, jobB, w4);
                  out_compute(F, oa, w4); __syncthreads();
                  PostOps pb = post_load(F, ws_, jobB, w4);
                  post_compute(F, in_, ws_, l, jobA, w4, pa); __syncthreads();
                  out_compute(F, ob, w4); __syncthreads();
                  post_compute(F, in_, ws_, l, jobB, w4, pb); __syncthreads();
              } else {
                  for (int jp = F.vcu; jp < 512; jp += F.G) { const int job = jp * 2 + (F.wave >> 2);
                      OutOps oa = out_load(F, ws_, job, w4); PostOps pa = post_load(F, ws_, job, w4);
                      out_compute(F, oa, w4); __syncthreads(); post_compute(F, in_, ws_, l, job, w4, pa); __syncthreads(); }
              } }
            SEAM(p0 + 3); STAMP(5);
#else
            phase_post(F, l); if (PROBE_DUP == 6) { GRID_BAR(); phase_post(F, l); } SEAM(p0 + 3);
#endif
        }
        if (IN(p0 + 4)) {
            refresh(F); unsigned char* ws_ = (unsigned char*)ldptr(F, 30); const InTab in_{F.lds};
            ProbDense P{(const char*)(ws_ + WS_MIXED), (const char*)(ws_ + WS_WOUT) + (size_t)l * 1024 * 2048, NTOK / 256, 4, F.G, F.vcu};
            EpiOut E{(bf16_t*)(ws_ + WS_X), (l == 0) ? in_[I_X] : (const float*)nullptr, (const float*)(ws_ + WS_MOD) + (size_t)l * 4 * 6144 + 2 * 1024, 1.f};
            if (PROBE_DUP == 7) { EpiOut E0{(bf16_t*)(ws_ + WS_X), (l == 0) ? in_[I_X] : (const float*)nullptr, (const float*)(ws_ + WS_MOD) + (size_t)l * 4 * 6144 + 2 * 1024, 0.f}; pg8::gemm_phase<false, 1024>(F.lds, nullptr, F.tid, P, E0); GRID_BAR(); }
            pg8::gemm_phase<false, 1024>(F.lds, nullptr, F.tid, P, E);
            SEAM(p0 + 4); STAMP(6);
        }
        if (IN(p0 + 5)) { phase_route(F, l); if (PROBE_DUP == 8) { GRID_BAR(); phase_route(F, l, 1); } SEAM(p0 + 5); STAMP(7); }
        if (IN(p0 + 6)) {
            refresh(F); unsigned char* ws_ = (unsigned char*)ldptr(F, 30); const InTab in_{F.lds};
            MoeTab T = moe_table(F, l);
            const int nun = __builtin_amdgcn_readfirstlane(T.ntiles[0]) * 8;
            int cvb = 0;
            if (CONV_BLOCKS && TAIL_CONVERT && l + 1 < NL && F.G % 64 == 0) { const int R = (nun + F.G - 1) / F.G, Gg = (nun + R - 1) / R; cvb = (F.G - Gg) >> 3; }
            const int pxc = F.G >> 3, per = pxc - cvb, xi = F.vcu % pxc, gG = 8 * per, gv = (F.vcu / pxc) * per + xi;
            if (xi < per) {
                ProbGU P{(const char*)(ws_ + WS_H), (const char*)(ws_ + WS_WGU), (const int*)(ws_ + WS_LIST), T, nun, gG, gv, l};
                EpiGU E{(bf16_t*)(ws_ + WS_ACT), in_[I_BGU], l};
                pg8::gemm_phase<true, 1024>(F.lds, (LAS unsigned*)(F.lds + ROWTAB_OFF), F.tid, P, E);
                if (PROBE_DUP == 9) { GRID_BAR(); pg8::gemm_phase<true, 1024>(F.lds, (LAS unsigned*)(F.lds + ROWTAB_OFF), F.tid, P, E); }
                if (TAIL_CONVERT && l + 1 < NL) { if (F.tid == 0) __hip_atomic_fetch_add((gu32*)ldptr(F, 30) + CW_GD + (l * 2 + 0) * 64, 1u, RLX_AGENT);
                    const int mine = (nun - gv + gG - 1) / gG, most = (nun + gG - 1) / gG; if (mine < most) tail_convert(F, l + 1, most - mine); }
            } else conv_worker(F, l + 1, CW_GD + (l * 2 + 0) * 64, 2 * ((nun + gG - 1) / gG) + 1);
            SEAM(p0 + 6); STAMP(8);
        }
        if (IN(p0 + 7)) {
            refresh(F); unsigned char* ws_ = (unsigned char*)ldptr(F, 30); const InTab in_{F.lds};
            MoeTab T = moe_table(F, l);
            const int nun = __builtin_amdgcn_readfirstlane(T.ntiles[0]) * 4;
            int cvb = 0;
            if (CONV_BLOCKS && TAIL_CONVERT && l + 1 < NL && F.G % 64 == 0) { const int R = (nun + F.G - 1) / F.G, Gg = (nun + R - 1) / R; cvb = (F.G - Gg) >> 3; }
            const int pxc = F.G >> 3, per = pxc - cvb, xi = F.vcu % pxc, gG = 8 * per, gv = (F.vcu / pxc) * per + xi;
            if (xi < per) {
                ProbDN P{(const char*)(ws_ + WS_ACT), (const char*)(ws_ + WS_WDN), T, nun, gG, gv, l};
                EpiDN E{(bf16_t*)(ws_ + WS_YSLOT), in_[I_BDN], (const int*)(ws_ + WS_LIST), (const float*)(ws_ + WS_GATE), T, l};
                pg8::gemm_phase<false, 1024>(F.lds, nullptr, F.tid, P, E);
                if (PROBE_DUP == 10) { GRID_BAR(); pg8::gemm_phase<false, 1024>(F.lds, nullptr, F.tid, P, E); }
                if (TAIL_CONVERT && l + 1 < NL) { if (F.tid == 0) __hip_atomic_fetch_add((gu32*)ldptr(F, 30) + CW_GD + (l * 2 + 1) * 64, 1u, RLX_AGENT);
                    const int mine = (nun - gv + gG - 1) / gG, most = (nun + gG - 1) / gG; if (mine < most) tail_convert(F, l + 1, most - mine); }
            } else conv_worker(F, l + 1, CW_GD + (l * 2 + 1) * 64, 2 * ((nun + gG - 1) / gG) + 1);
            if (PROBE_T >= 0 && l == NL - 1 && blockIdx.x == 0 && F.tid == 0) {
                const unsigned long long now_ = wall_clock64(); if (PROBE_T == 9) tsw[1] += now_ - tsw[0];
                const float share = (float)(double)tsw[1] / (float)(double)(now_ - tsw[2]);
                __hip_atomic_store((GAS float*)((gu32*)ldptr(F, 30) + CW_CODE + 1), (PROBE_T >= 20 ? 3.0f : (PROBE_T == 4 || PROBE_T == 8 || PROBE_T == 9 || PROBE_T == 0) ? 0.3f : 0.5f) * share, RLX_AGENT);
            }
            SEAM(p0 + 7); STAMP(9);
        }
        if (IN(p0 + 8)) { if (PROBE_DUP == 11) { phase_combine(F, l, 0.f); GRID_BAR(); } phase_combine(F, l); SEAM(p0 + 8); STAMP(10); }
    }
#undef IN
#undef SEAM
#if !MK_PER_PHASE
    if (blockIdx.x == 0 && F.tid == 0 && xb_ld(bar.bar + XB_TMO) != 0u) { float* o = (float*)ldptr(F, 29); o[0] = __builtin_nanf(""); }
#endif
}

extern "C" void kernel_launch(void* const* d_in, const int* in_sizes, int n_in, void* d_out, int out_size, void* d_ws, size_t ws_size, hipStream_t stream) {
    static int grid = 0;
    if (grid == 0) {
        if (n_in != 29 || out_size != NTOK * DM || ws_size < WS_END) { fprintf(stderr, "kernel_launch: unexpected sizes n_in %d out %d ws %zu (need %zu)\n", n_in, out_size, ws_size, (size_t)WS_END); grid = -1; return; }
        int dev = 0, cus = 0;
        if (hipGetDevice(&dev) != hipSuccess || hipDeviceGetAttribute(&cus, hipDeviceAttributeMultiprocessorCount, dev) != hipSuccess) { grid = -1; return; }
        if (hipFuncSetAttribute((const void*)trunk_fwd, hipFuncAttributeMaxDynamicSharedMemorySize, LDS_BYTES) != hipSuccess) { fprintf(stderr, "kernel_launch: hipFuncSetAttribute failed\n"); grid = -1; return; }
        int per_cu = 0;
        if (hipOccupancyMaxActiveBlocksPerMultiprocessor(&per_cu, (const void*)trunk_fwd, NTHR, LDS_BYTES) != hipSuccess || per_cu < 1) fprintf(stderr, "kernel_launch: occupancy query reports %d\n", per_cu);
        (void)hipGetLastError();
        grid = cus;
    }
    if (grid < 0) return;
    (void)hipMemsetAsync((char*)d_ws + WS_CTL, 0, CTL_ZERO_BYTES, stream);
    Args a{};
    for (int i = 0; i < 29; ++i) a.in[i] = (const float*)d_in[i];
    a.out = (float*)d_out; a.ws = (unsigned char*)d_ws;
#if MK_PER_PHASE
    for (int p = 0; p < NPHASE; ++p) { a.ph_lo = p; a.ph_hi = p + 1; hipLaunchKernelGGL(trunk_fwd, dim3(grid), dim3(NTHR), LDS_BYTES, stream, a); }
#else
    a.ph_lo = 0; a.ph_hi = NPHASE;
    hipLaunchKernelGGL(trunk_fwd, dim3(grid), dim3(NTHR), LDS_BYTES, stream, a);
#endif
}
```
